# Optimizing an MI355X kernel written in HIP

```python
import jax
import jax.numpy as jnp
from jax import lax
import numpy as np

D_MODEL = 1024
BATCH = 1
SEQ = 16384
DEPTH = 4
DEC_BATCH = 32
DEC_SEQ = 64
PAST_LEN = 2048

CHUNK = 64
N_MIXERS = 3
N_LAYERS_A = (DEPTH + 2) // 3
N_LAYERS_B = (DEPTH + 1) // 3
N_LAYERS_C = DEPTH // 3
RMS_EPS = 1e-6
D_FF = (8 * D_MODEL + 3 * 256 - 1) // (3 * 256) * 256

A_HEAD = 64
A_HEADS = D_MODEL // A_HEAD
A_DECAY_LORA = 64
A_AAA_LORA = 64
A_GATE_LORA = 128
A_LNX_EPS = 64e-5

B_HEADS = 4
B_DK = D_MODEL // (2 * B_HEADS)
B_DV = D_MODEL // B_HEADS
B_GATE_LORA = 16
B_GATE_TAU = 16.0

C_HEADS = 8
C_DK = D_MODEL // C_HEADS
C_DV = D_MODEL // C_HEADS
C_CONV = 4
C_QKV = C_HEADS * (2 * C_DK + C_DV)

kernel_name = "hybrid_rwkv7_gla_gdn_stream_step"


def rms_norm(x, g):
    xf = x.astype(jnp.float32)
    y = xf * lax.rsqrt(jnp.mean(xf * xf, axis=-1, keepdims=True) + RMS_EPS)
    return (y * g.astype(jnp.float32)).astype(x.dtype)


def gated_head_norm(o, gain, gate):
    on = o * lax.rsqrt(jnp.mean(o * o, axis=-1, keepdims=True) + RMS_EPS) * gain
    return on.reshape(gate.shape) * jax.nn.silu(gate)


def swiglu_ffn(x, w_in, w_out):
    gate, up = jnp.split(x @ w_in, 2, axis=-1)
    return (jax.nn.silu(gate) * up) @ w_out


def rwkv7_mix(x, shift_prev, wkv_prev, mu, w0, w1, w2, a0, a1, a2, g1, g2,
              k_k, k_a, r_k, w_rkv, w_o, lnx_w, lnx_b):
    B, T, D = x.shape
    H, N = A_HEADS, A_HEAD
    xf = x.astype(jnp.float32)
    x_prev = jnp.concatenate([shift_prev.astype(jnp.float32)[:, None, :], xf[:, :-1]], axis=1)
    xx = x_prev - xf
    xr, xw, xk, xv, xa, xg = (xf + xx * mu[i] for i in range(6))
    r = xr @ w_rkv[0]
    k = xk @ w_rkv[1]
    v = xv @ w_rkv[2]
    log_rate = -jax.nn.softplus(-(w0 + jnp.tanh(xw @ w1) @ w2)) - 0.5
    decay = jnp.exp(-jnp.exp(log_rate))
    a = jax.nn.sigmoid(a0 + (xa @ a1) @ a2)
    g = jax.nn.sigmoid(xg @ g1) @ g2
    heads = lambda t: t.reshape(B, T, H, N)
    kk = heads(k * k_k)
    kk = kk * lax.rsqrt(jnp.maximum(jnp.sum(kk * kk, axis=-1, keepdims=True), 1e-24))
    k_mod = heads(k * (1.0 + (a - 1.0) * k_a))
    r_h, v_h, w_h, a_h = heads(r), heads(v), heads(decay), heads(a)

    def step(S, inp):
        r_t, w_t, k_t, v_t, kk_t, a_t = inp
        S = (S * w_t[:, :, None, :]
             - jnp.einsum("bhvk,bhk->bhv", S, kk_t)[..., None] * (kk_t * a_t)[:, :, None, :]
             + v_t[..., None] * k_t[:, :, None, :])
        return S, jnp.einsum("bhvk,bhk->bhv", S, r_t)

    xs = tuple(jnp.moveaxis(t, 1, 0) for t in (r_h, w_h, k_mod, v_h, kk, a_h))
    S_fin, o = lax.scan(step, wkv_prev.astype(jnp.float32), xs)
    o = jnp.moveaxis(o, 0, 1)
    mean = jnp.mean(o, axis=-1, keepdims=True)
    var = jnp.mean(jnp.square(o - mean), axis=-1, keepdims=True)
    o = ((o - mean) * lax.rsqrt(var + A_LNX_EPS)).reshape(B, T, D) * lnx_w + lnx_b
    bonus = (jnp.sum(r_h * k_mod * r_k, axis=-1, keepdims=True) * v_h).reshape(B, T, D)
    y = ((o + bonus) * g) @ w_o
    return y.astype(x.dtype), x[:, -1], S_fin.astype(x.dtype)


def _blocks(t, C):
    B, T, H = t.shape[:3]
    return jnp.moveaxis(t.reshape(B, T // C, C, H, *t.shape[3:]), 3, 2)


def gla_chunked(q, k, v, gk, S0, C):
    B, T, H, DV = v.shape
    q, k, v, gk = (_blocks(t, C) for t in (q, k, v, gk))
    b = jnp.cumsum(gk, axis=-2)
    b_last = b[..., -1:, :]
    q_t = q * jnp.exp(b)
    k_t = k * jnp.exp(-b)
    k_hat = k * jnp.exp(b_last - b)
    incl = jnp.tril(jnp.ones((C, C), dtype=bool))
    A = jnp.where(incl, jnp.einsum("bnhik,bnhjk->bnhij", q_t, k_t), 0.0)
    o_intra = jnp.einsum("bnhij,bnhjv->bnhiv", A, v)
    kv_chunk = jnp.einsum("bnhjk,bnhjv->bnhkv", k_hat, v)
    chunk_decay = jnp.exp(b_last[..., 0, :])

    def step(S, inp):
        q_c, d_c, kv_c = inp
        return S * d_c[..., None] + kv_c, jnp.einsum("bhik,bhkv->bhiv", q_c, S)

    xs = tuple(jnp.moveaxis(t, 1, 0) for t in (q_t, chunk_decay, kv_chunk))
    S_fin, o_inter = lax.scan(step, S0, xs)
    o = o_intra + jnp.moveaxis(o_inter, 0, 1)
    return jnp.moveaxis(o, 2, 3).reshape(B, T, H, DV), S_fin


def gla_mix(x, kv_prev, w_in, w_a1, w_a2, b_a, onorm, w_o):
    B, T, _ = x.shape
    H, DK, DV = B_HEADS, B_DK, B_DV
    xf = x.astype(jnp.float32)
    q, k, v, gate = jnp.split(xf @ w_in, [H * DK, 2 * H * DK, 2 * H * DK + H * DV], axis=-1)
    gk = jax.nn.log_sigmoid((xf @ w_a1) @ w_a2 + b_a) / B_GATE_TAU
    o, S = gla_chunked(q.reshape(B, T, H, DK) * DK ** -0.5, k.reshape(B, T, H, DK),
                       v.reshape(B, T, H, DV), gk.reshape(B, T, H, DK),
                       kv_prev.astype(jnp.float32), min(CHUNK, T))
    y = gated_head_norm(o, onorm, gate) @ w_o
    return y.astype(x.dtype), S.astype(x.dtype)


def gdn_chunked(q, k, v, g, beta, S0, C):
    B, T, H, DV = v.shape
    q, k, v, g, beta = (_blocks(t, C) for t in (q, k, v, g, beta))
    gc = jnp.cumsum(g, axis=-1)
    incl = jnp.tril(jnp.ones((C, C), dtype=bool))
    strict = jnp.tril(jnp.ones((C, C), dtype=bool), -1)
    decay = jnp.where(incl, jnp.exp(jnp.where(incl, gc[..., :, None] - gc[..., None, :], 0.0)), 0.0)
    k_beta = k * beta[..., None]
    L = jnp.where(strict, jnp.einsum("bnhik,bnhjk->bnhij", k_beta, k) * decay, 0.0)
    rhs = jnp.concatenate([v * beta[..., None], k_beta * jnp.exp(gc)[..., None]], axis=-1)
    sol = lax.linalg.triangular_solve(jnp.eye(C, dtype=L.dtype) + L, rhs,
                                      left_side=True, lower=True, unit_diagonal=True)
    u, w = sol[..., :DV], sol[..., DV:]
    attn_qk = jnp.einsum("bnhik,bnhjk->bnhij", q, k) * decay
    q_dec = q * jnp.exp(gc)[..., None]
    k_dec = k * jnp.exp(gc[..., -1:] - gc)[..., None]
    chunk_decay = jnp.exp(gc[..., -1])

    def step(S, inp):
        q_c, k_c, u_c, w_c, a_c, d_c = inp
        v_new = u_c - jnp.einsum("bhik,bhkv->bhiv", w_c, S)
        o_c = jnp.einsum("bhik,bhkv->bhiv", q_c, S) + jnp.einsum("bhij,bhjv->bhiv", a_c, v_new)
        S = S * d_c[..., None, None] + jnp.einsum("bhjk,bhjv->bhkv", k_c, v_new)
        return S, o_c

    xs = tuple(jnp.moveaxis(t, 1, 0) for t in (q_dec, k_dec, u, w, attn_qk, chunk_decay))
    S_fin, o = lax.scan(step, S0, xs)
    o = jnp.moveaxis(o, 0, 1)
    return jnp.moveaxis(o, 2, 3).reshape(B, T, H, DV), S_fin


def gdn_mix(x, conv_prev, kv_prev, w_in, conv_w, a_log, dt_bias, onorm, w_o):
    B, T, _ = x.shape
    H, DK, DV = C_HEADS, C_DK, C_DV
    xf = x.astype(jnp.float32)
    qkv, z, b_raw, a_raw = jnp.split(xf @ w_in, [C_QKV, C_QKV + H * DV, C_QKV + H * DV + H], axis=-1)
    padded = jnp.concatenate([conv_prev.astype(jnp.float32), qkv], axis=1)
    conv = padded[:, 0:T] * conv_w[0]
    for i in range(1, C_CONV):
        conv = conv + padded[:, i:i + T] * conv_w[i]
    q, k, v = jnp.split(jax.nn.silu(conv), [H * DK, 2 * H * DK], axis=-1)
    l2 = lambda t: t * lax.rsqrt(jnp.sum(t * t, axis=-1, keepdims=True) + 1e-6)
    q = l2(q.reshape(B, T, H, DK)) * DK ** -0.5
    k = l2(k.reshape(B, T, H, DK))
    v = v.reshape(B, T, H, DV)
    beta = jax.nn.sigmoid(b_raw)
    g = -jnp.exp(a_log) * jax.nn.softplus(a_raw + dt_bias)
    o, S = gdn_chunked(q, k, v, g, beta, kv_prev.astype(jnp.float32), min(CHUNK, T))
    y = gated_head_norm(o, onorm, z) @ w_o
    return y.astype(x.dtype), padded[:, -(C_CONV - 1):].astype(x.dtype), S.astype(x.dtype)


def trunk(x, a_shift, a_wkv, b_kv, c_conv, c_kv, norm_mix, norm_ffn, norm_final,
          ffn_w_in, ffn_w_out, pa, pb, pc):
    out_a_shift, out_a_wkv, out_b_kv, out_c_conv, out_c_kv = [], [], [], [], []
    for i in range(DEPTH):
        j = i // N_MIXERS
        h = rms_norm(x, norm_mix[i])
        if i % N_MIXERS == 0:
            y, s_shift, s_wkv = rwkv7_mix(h, a_shift[j], a_wkv[j], *(p[j] for p in pa))
            out_a_shift.append(s_shift)
            out_a_wkv.append(s_wkv)
        elif i % N_MIXERS == 1:
            y, s_kv = gla_mix(h, b_kv[j], *(p[j] for p in pb))
            out_b_kv.append(s_kv)
        else:
            y, s_conv, s_kv = gdn_mix(h, c_conv[j], c_kv[j], *(p[j] for p in pc))
            out_c_conv.append(s_conv)
            out_c_kv.append(s_kv)
        x = x + y
        x = x + swiglu_ffn(rms_norm(x, norm_ffn[i]), ffn_w_in[i], ffn_w_out[i])
    return (rms_norm(x, norm_final), jnp.stack(out_a_shift), jnp.stack(out_a_wkv),
            jnp.stack(out_b_kv), jnp.stack(out_c_conv), jnp.stack(out_c_kv))


def setup_inputs(seed: int = 0) -> dict:
    key = jax.random.key(seed)
    keys = iter(jax.random.split(key, 64))

    def nrm(shape, scale):
        return jax.random.normal(next(keys), shape, jnp.float32) * scale

    def unif(shape, lo, hi):
        return jax.random.uniform(next(keys), shape, jnp.float32, lo, hi)

    D, F = D_MODEL, D_FF
    NA, NB, NCL = N_LAYERS_A, N_LAYERS_B, N_LAYERS_C
    return {
        "x_prompt": nrm((BATCH, SEQ, D), 1.0),
        "x_sample": nrm((DEC_BATCH, DEC_SEQ, D), 1.0),
        "state_a_shift": nrm((NA, DEC_BATCH, D), 1.0),
        "state_a_wkv": nrm((NA, DEC_BATCH, A_HEADS, A_HEAD, A_HEAD), 0.5),
        "state_b_kv": nrm((NB, DEC_BATCH, B_HEADS, B_DK, B_DV), 1.0),
        "state_c_conv": nrm((NCL, DEC_BATCH, C_CONV - 1, C_QKV), 1.0),
        "state_c_kv": nrm((NCL, DEC_BATCH, C_HEADS, C_DK, C_DV), 0.1),
        "norm_mix": 1.0 + nrm((DEPTH, D), 0.02),
        "norm_ffn": 1.0 + nrm((DEPTH, D), 0.02),
        "norm_final": 1.0 + nrm((D,), 0.02),
        "ffn_w_in": nrm((DEPTH, D, 2 * F), D ** -0.5),
        "ffn_w_out": nrm((DEPTH, F, D), F ** -0.5),
        "a_mu": unif((NA, 6, D), 0.0, 1.0),
        "a_w0": unif((NA, D), -6.0, -1.0),
        "a_w1": nrm((NA, D, A_DECAY_LORA), D ** -0.5),
        "a_w2": nrm((NA, A_DECAY_LORA, D), 0.1 * A_DECAY_LORA ** -0.5),
        "a_a0": nrm((NA, D), 0.1),
        "a_a1": nrm((NA, D, A_AAA_LORA), D ** -0.5),
        "a_a2": nrm((NA, A_AAA_LORA, D), 0.1 * A_AAA_LORA ** -0.5),
        "a_g1": nrm((NA, D, A_GATE_LORA), D ** -0.5),
        "a_g2": nrm((NA, A_GATE_LORA, D), A_GATE_LORA ** -0.5),
        "a_k_k": 0.85 + nrm((NA, D), 0.05),
        "a_k_a": 1.0 + nrm((NA, D), 0.05),
        "a_r_k": nrm((NA, A_HEADS, A_HEAD), 0.1),
        "a_w_rkv": nrm((NA, 3, D, D), D ** -0.5),
        "a_w_o": nrm((NA, D, D), D ** -0.5),
        "a_lnx_w": 1.0 + nrm((NA, D), 0.02),
        "a_lnx_b": nrm((NA, D), 0.02),
        "b_w_in": nrm((NB, D, 2 * B_HEADS * B_DK + 2 * B_HEADS * B_DV), D ** -0.5),
        "b_w_a1": nrm((NB, D, B_GATE_LORA), D ** -0.5),
        "b_w_a2": nrm((NB, B_GATE_LORA, B_HEADS * B_DK), B_GATE_LORA ** -0.5),
        "b_b_a": nrm((NB, B_HEADS * B_DK), 0.1),
        "b_onorm": 1.0 + nrm((NB, B_DV), 0.02),
        "b_w_o": nrm((NB, B_HEADS * B_DV, D), (B_HEADS * B_DV) ** -0.5),
        "c_w_in": nrm((NCL, D, C_QKV + C_HEADS * C_DV + 2 * C_HEADS), D ** -0.5),
        "c_conv_w": nrm((NCL, C_CONV, C_QKV), C_CONV ** -0.5),
        "c_a_log": jnp.log(unif((NCL, C_HEADS), 1.0, 16.0)),
        "c_dt_bias": jnp.log(jnp.expm1(unif((NCL, C_HEADS), 0.001, 0.1))),
        "c_onorm": 1.0 + nrm((NCL, C_DV), 0.02),
        "c_w_o": nrm((NCL, C_HEADS * C_DV, D), (C_HEADS * C_DV) ** -0.5),
    }


def reference(x_prompt, x_sample, state_a_shift, state_a_wkv, state_b_kv, state_c_conv, state_c_kv,
              norm_mix, norm_ffn, norm_final, ffn_w_in, ffn_w_out,
              a_mu, a_w0, a_w1, a_w2, a_a0, a_a1, a_a2, a_g1, a_g2, a_k_k, a_k_a, a_r_k,
              a_w_rkv, a_w_o, a_lnx_w, a_lnx_b,
              b_w_in, b_w_a1, b_w_a2, b_b_a, b_onorm, b_w_o,
              c_w_in, c_conv_w, c_a_log, c_dt_bias, c_onorm, c_w_o):
    pa = (a_mu, a_w0, a_w1, a_w2, a_a0, a_a1, a_a2, a_g1, a_g2, a_k_k, a_k_a, a_r_k,
          a_w_rkv, a_w_o, a_lnx_w, a_lnx_b)
    pb = (b_w_in, b_w_a1, b_w_a2, b_b_a, b_onorm, b_w_o)
    pc = (c_w_in, c_conv_w, c_a_log, c_dt_bias, c_onorm, c_w_o)
    bp, dt = x_prompt.shape[0], x_prompt.dtype
    zero_a_shift = jnp.zeros((N_LAYERS_A, bp, D_MODEL), dt)
    zero_a_wkv = jnp.zeros((N_LAYERS_A, bp, A_HEADS, A_HEAD, A_HEAD), dt)
    zero_b_kv = jnp.zeros((N_LAYERS_B, bp, B_HEADS, B_DK, B_DV), dt)
    zero_c_conv = jnp.zeros((N_LAYERS_C, bp, C_CONV - 1, C_QKV), dt)
    zero_c_kv = jnp.zeros((N_LAYERS_C, bp, C_HEADS, C_DK, C_DV), dt)
    y_prompt, a_shift_p, a_wkv_p, b_kv_p, c_conv_p, c_kv_p = trunk(
        x_prompt, zero_a_shift, zero_a_wkv, zero_b_kv, zero_c_conv, zero_c_kv,
        norm_mix, norm_ffn, norm_final, ffn_w_in, ffn_w_out, pa, pb, pc)
    y_sample, a_shift_s, a_wkv_s, b_kv_s, c_conv_s, c_kv_s = trunk(
        x_sample, state_a_shift, state_a_wkv, state_b_kv, state_c_conv, state_c_kv,
        norm_mix, norm_ffn, norm_final, ffn_w_in, ffn_w_out, pa, pb, pc)
    return (y_prompt, y_sample, a_shift_p, a_wkv_p, b_kv_p, c_conv_p, c_kv_p,
            a_shift_s, a_wkv_s, b_kv_s, c_conv_s, c_kv_s)
```

```cpp
#include <hip/hip_runtime.h>
#include <hip/hip_cooperative_groups.h>
#include <cstdio>
#include <cstdint>
namespace cg = cooperative_groups;

typedef unsigned short bf16;
typedef __attribute__((ext_vector_type(8))) short bf16x8;
typedef __attribute__((ext_vector_type(4))) short bf16x4;
typedef __attribute__((ext_vector_type(4))) float f32x4;

#define DEVI __device__ __forceinline__

constexpr int Dm = 1024, FF = 2816, MT = 18432, MPR = 16384, NSS = 32, NCHUNK = 288, NPCH = 256;
constexpr size_t SLOT = (size_t)MT * 1024 * 2;
constexpr size_t WS_L1 = 8 * SLOT;
constexpr size_t WS_SM = WS_L1 + (size_t)MT * 256 * 2;
constexpr size_t WS_GAM = WS_SM + (size_t)MT * 16 * 4;
constexpr size_t WS_W = WS_GAM + (size_t)NCHUNK * 1024 * 4;
constexpr size_t W_FIN = 0, W_FOUT = 5767168, W_MIX = 8650752;
constexpr size_t WS_TOTAL = WS_W + (size_t)14200000 * 2;
constexpr int LDS_BYTES = 77824;

constexpr size_t O_ASH_P = 18874368, O_AWKV_P = O_ASH_P + 2048, O_BKV_P = O_AWKV_P + 131072,
                 O_CCONV_P = O_BKV_P + 131072, O_CKV_P = O_CCONV_P + 9216, O_ASH_S = O_CKV_P + 131072,
                 O_AWKV_S = O_ASH_S + 65536, O_BKV_S = O_AWKV_S + 4194304, O_CCONV_S = O_BKV_S + 4194304,
                 O_CKV_S = O_CCONV_S + 294912;

struct P { const float* in[40]; float* out; char* ws; };
typedef const __attribute__((address_space(4))) char* kptr_t;
typedef const float* cfp_t; typedef float* fp_t; typedef char* cp_t;
DEVI kptr_t kbase() { kptr_t b = (kptr_t)__builtin_amdgcn_kernarg_segment_ptr(); asm volatile("" : "+s"(b)); return b; }
#define PIN(i) (*(const __attribute__((address_space(4))) cfp_t*)(kbase() + 8 * (i)))
#define POUT (*(const __attribute__((address_space(4))) fp_t*)(kbase() + 320))
#define PWS (*(const __attribute__((address_space(4))) cp_t*)(kbase() + 328))

DEVI bf16 f2bf(float f) { unsigned u = __float_as_uint(f); u += 0x7fffu + ((u >> 16) & 1u); return (bf16)(u >> 16); }
DEVI float bf2f(bf16 h) { return __uint_as_float(((unsigned)h) << 16); }
DEVI unsigned pack2(float a, float b) { return (unsigned)f2bf(a) | ((unsigned)f2bf(b) << 16); }
DEVI float wsum(float v) {
#pragma unroll
  for (int o = 32; o > 0; o >>= 1) v += __shfl_xor(v, o);
  return v;
}
DEVI float sigm(float x) { return 1.f / (1.f + __expf(-x)); }
DEVI float silu(float x) { return x * sigm(x); }
DEVI float softplus(float x) { return x > 20.f ? x : log1pf(__expf(x)); }
DEVI bf16* slot(const P& p, int i) { return (bf16*)(PWS + (size_t)i * SLOT); }

struct GemmDesc { const bf16* A; const bf16* A2; int lda; int ksplit; const bf16* Bt; int ldb; int tiles_m; int tiles_n; int K; };

template <class Epi>
DEVI void gemm_tile(const GemmDesc& g, int mt, int nt, Epi& epi, char* smem) {
  const int tid = threadIdx.x, lane = tid & 63, wave = tid >> 6;
  const int wm = wave >> 1, wn = wave & 1, lr = lane & 15, quad = lane >> 4;
  bf16* sA = (bf16*)smem;
  bf16* sB = sA + 2 * 128 * 48;
  f32x4 acc[4][4];
#pragma unroll
  for (int i = 0; i < 4; ++i)
#pragma unroll
    for (int j = 0; j < 4; ++j) acc[i][j] = (f32x4){0.f, 0.f, 0.f, 0.f};
  const int m0 = mt * 128, n0 = nt * 128;
  const int r0 = tid >> 2, c0 = tid & 3;
  const size_t aoff0 = (size_t)(m0 + r0) * g.lda + c0 * 8, aoff1 = aoff0 + (size_t)64 * g.lda;
  const bf16* bp0 = g.Bt + (size_t)(n0 + r0) * g.ldb + c0 * 8;
  const bf16* bp1 = bp0 + (size_t)64 * g.ldb;
  uint4 ra0, ra1, rb0, rb1;
  auto gload = [&](int k0) {
    const bf16* base = (k0 < g.ksplit) ? (g.A + k0) : (g.A2 + (k0 - g.ksplit));
    ra0 = *(const uint4*)(base + aoff0); ra1 = *(const uint4*)(base + aoff1);
    rb0 = *(const uint4*)(bp0 + k0); rb1 = *(const uint4*)(bp1 + k0);
  };
  auto lstore = [&](int buf) {
    bf16* a = sA + buf * 6144; bf16* b = sB + buf * 6144;
    *(uint4*)(a + r0 * 48 + c0 * 8) = ra0; *(uint4*)(a + (r0 + 64) * 48 + c0 * 8) = ra1;
    *(uint4*)(b + r0 * 48 + c0 * 8) = rb0; *(uint4*)(b + (r0 + 64) * 48 + c0 * 8) = rb1;
  };
  const int nk = g.K >> 5;
  gload(0); lstore(0);
  __syncthreads();
  for (int kt = 0; kt < nk; ++kt) {
    const int buf = kt & 1;
    if (kt + 1 < nk) gload((kt + 1) << 5);
    const bf16* a = sA + buf * 6144 + (wm * 64 + lr) * 48 + quad * 8;
    const bf16* b = sB + buf * 6144 + (wn * 64 + lr) * 48 + quad * 8;
    bf16x8 af[4], bfr[4];
#pragma unroll
    for (int i = 0; i < 4; ++i) { af[i] = *(const bf16x8*)(a + i * 16 * 48); bfr[i] = *(const bf16x8*)(b + i * 16 * 48); }
#pragma unroll
    for (int i = 0; i < 4; ++i)
#pragma unroll
      for (int j = 0; j < 4; ++j) acc[i][j] = __builtin_amdgcn_mfma_f32_16x16x32_bf16(af[i], bfr[j], acc[i][j], 0, 0, 0);
    if (kt + 1 < nk) lstore(buf ^ 1);
    __syncthreads();
  }
#pragma unroll
  for (int i = 0; i < 4; ++i) {
#pragma unroll
    for (int jj = 0; jj < 4; ++jj) {
      const int row = m0 + wm * 64 + i * 16 + quad * 4 + jj;
      if constexpr (Epi::PAIR) {
#pragma unroll
        for (int j = 0; j < 4; j += 2) {
          const int nn = n0 + wn * 64 + j * 16;
          epi.pair(row, (nn >> 5) * 16 + lr, acc[i][j][jj], acc[i][j + 1][jj]);
        }
      } else {
#pragma unroll
        for (int j = 0; j < 4; ++j) epi(row, n0 + wn * 64 + j * 16 + lr, acc[i][j][jj]);
      }
    }
  }
}

template <class Epi>
DEVI void gemm_job(const GemmDesc& g, Epi epi, int& tbase, char* smem) {
  const int ntiles = g.tiles_m * g.tiles_n, G = gridDim.x;
  const int first = tbase + (((int)blockIdx.x - tbase % G) + G) % G;
  const int width = 8 * g.tiles_n;
  for (int t = first; t < tbase + ntiles; t += G) {
    const int lt = t - tbase;
    const int grp = lt / width, rem = lt % width;
    gemm_tile(g, grp * 8 + (rem & 7), rem >> 3, epi, smem);
  }
  tbase += ntiles;
}

struct EpiStore { static constexpr bool PAIR = false; bf16* C; int ldc; float sc;
  DEVI void operator()(int r, int c, float v) { C[(size_t)r * ldc + c] = f2bf(v * sc); } };
struct EpiLora1 { static constexpr bool PAIR = false; bf16* C;
  DEVI void operator()(int r, int c, float v) { float o = c < 64 ? tanhf(v) : (c < 128 ? v : sigm(v)); C[(size_t)r * 256 + c] = f2bf(o); } };
struct EpiLd { static constexpr bool PAIR = false; bf16* C; const float* w0;
  DEVI void operator()(int r, int c, float v) { float x = w0[c] + v; float lr_ = -softplus(-x) - 0.5f; C[(size_t)r * 1024 + c] = f2bf(-__expf(lr_)); } };
struct EpiSig { static constexpr bool PAIR = false; bf16* C; const float* a0;
  DEVI void operator()(int r, int c, float v) { C[(size_t)r * 1024 + c] = f2bf(sigm(a0[c] + v)); } };
struct EpiAcc { static constexpr bool PAIR = false; float* X;
  DEVI void operator()(int r, int c, float v) { X[(size_t)r * 1024 + c] += v; } };
struct EpiSwiglu { static constexpr bool PAIR = true; bf16* C;
  DEVI void pair(int r, int c, float gt, float up) { C[(size_t)r * FF + c] = f2bf(silu(gt) * up); } };
struct EpiGlaIn { static constexpr bool PAIR = false; bf16 *q, *k, *v, *gate; float* sm;
  DEVI void operator()(int r, int c, float x) {
    if (c < 512) q[(size_t)r * 512 + c] = f2bf(x * 0.08838834764831845f);
    else if (c < 1024) k[(size_t)r * 512 + c - 512] = f2bf(x);
    else if (c < 2048) v[(size_t)r * 1024 + c - 1024] = f2bf(x);
    else if (c < 3072) gate[(size_t)r * 1024 + c - 2048] = f2bf(x);
    else if (c < 3088) sm[(size_t)r * 16 + c - 3072] = x;
  } };
struct EpiGdnIn { static constexpr bool PAIR = false; bf16 *qkv, *z; float* sm; float* out;
  DEVI void operator()(int r, int c, float x) {
    if (c < 3072) {
      qkv[(size_t)r * 3072 + c] = f2bf(x);
      if (r >= MPR - 3) {
        if (r < MPR) out[O_CCONV_P + (size_t)(r - (MPR - 3)) * 3072 + c] = x;
        else { int tt = (r - MPR) & 63; if (tt >= 61) out[O_CCONV_S + ((size_t)((r - MPR) >> 6) * 3 + (tt - 61)) * 3072 + c] = x; }
      }
    } else if (c < 4096) z[(size_t)r * 1024 + c - 3072] = f2bf(x);
    else if (c < 4112) sm[(size_t)r * 16 + c - 4096] = x;
  } };

template <class F>
DEVI void conv_job(F f, bf16* dst, int ldo, int Nd, int Kd, int& tbase, char* smem) {
  float* tile = (float*)smem;
  const int tn = Nd >> 6, tk = Kd >> 6, ntiles = tn * tk, G = gridDim.x, tid = threadIdx.x;
  const int first = tbase + (((int)blockIdx.x - tbase % G) + G) % G;
  for (int t = first; t < tbase + ntiles; t += G) {
    const int lt = t - tbase, n0 = (lt % tn) << 6, k0 = (lt / tn) << 6;
    const int i = tid >> 4, j4 = (tid & 15) << 2;
#pragma unroll
    for (int r = 0; r < 4; ++r) {
      float4 v = f(k0 + i + 16 * r, n0 + j4);
      float* d = tile + (i + 16 * r) * 65 + j4; d[0] = v.x; d[1] = v.y; d[2] = v.z; d[3] = v.w;
    }
    __syncthreads();
    const int jn = tid >> 2, iq = (tid & 3) << 4;
    unsigned w[8];
#pragma unroll
    for (int e = 0; e < 8; ++e) w[e] = pack2(tile[(iq + 2 * e) * 65 + jn], tile[(iq + 2 * e + 1) * 65 + jn]);
    uint4* o = (uint4*)(dst + (size_t)(n0 + jn) * ldo + k0 + iq);
    o[0] = make_uint4(w[0], w[1], w[2], w[3]); o[1] = make_uint4(w[4], w[5], w[6], w[7]);
    __syncthreads();
  }
  tbase += ntiles;
}
struct CvPlain { const float* W; int ld; int nsrc;
  DEVI float4 operator()(int k, int n) const { return n < nsrc ? *(const float4*)(W + (size_t)k * ld + n) : make_float4(0, 0, 0, 0); } };
struct CvFfnIn { const float* W;
  DEVI float4 operator()(int k, int n) const { int blk = n >> 5, w = n & 31; int src = (w < 16) ? blk * 16 + w : FF + blk * 16 + (w - 16);
    return *(const float4*)(W + (size_t)k * (2 * FF) + src); } };
struct CvLora1 { const float *w1, *a1, *g1, *mu;
  DEVI float4 operator()(int k, int n) const {
    int kk = k & 1023; float4 v; float m;
    if (n < 64) { v = *(const float4*)(w1 + kk * 64 + n); m = mu[1 * 1024 + kk]; }
    else if (n < 128) { v = *(const float4*)(a1 + kk * 64 + n - 64); m = mu[4 * 1024 + kk]; }
    else { v = *(const float4*)(g1 + kk * 128 + n - 128); m = mu[5 * 1024 + kk]; }
    float s = (k < 1024) ? (1.f - m) : m;
    return make_float4(v.x * s, v.y * s, v.z * s, v.w * s); } };
struct CvGlaIn { const float *win, *wa1;
  DEVI float4 operator()(int k, int n) const {
    if (n < 3072) return *(const float4*)(win + (size_t)k * 3072 + n);
    if (n < 3088) return *(const float4*)(wa1 + k * 16 + n - 3072);
    return make_float4(0, 0, 0, 0); } };

template <int TYPE>
DEVI void phase_norm(const P& p, int layer, int j, bool from_input, bool copy_x) {
  const int lane = threadIdx.x & 63, wave = threadIdx.x >> 6;
  const float* g = PIN(7) + layer * 1024;
  float* xres = POUT;
  bf16 *h = slot(p, 0), *hs = slot(p, 1), *xr = slot(p, 2), *xk = slot(p, 3), *xv = slot(p, 4);
  const float* mu = PIN(12) + (size_t)j * 6 * 1024;
  for (int row = blockIdx.x * 4 + wave; row < MT; row += gridDim.x * 4) {
    auto src = [&](int r) -> const float* {
      if (from_input) return r < MPR ? PIN(0) + (size_t)r * 1024 : PIN(1) + (size_t)(r - MPR) * 1024;
      return xres + (size_t)r * 1024; };
    const float* xp = src(row);
    float4 xv4[4]; float ss = 0.f;
#pragma unroll
    for (int i = 0; i < 4; ++i) { xv4[i] = *(const float4*)(xp + i * 256 + lane * 4); ss += xv4[i].x * xv4[i].x + xv4[i].y * xv4[i].y + xv4[i].z * xv4[i].z + xv4[i].w * xv4[i].w; }
    ss = wsum(ss);
    const float rstd = rsqrtf(ss * (1.f / 1024.f) + 1e-6f);
    if (copy_x) {
#pragma unroll
      for (int i = 0; i < 4; ++i) *(float4*)(xres + (size_t)row * 1024 + i * 256 + lane * 4) = xv4[i];
    }
    float hv[16];
#pragma unroll
    for (int i = 0; i < 4; ++i) { float4 gg = *(const float4*)(g + i * 256 + lane * 4);
      hv[i * 4 + 0] = xv4[i].x * rstd * gg.x; hv[i * 4 + 1] = xv4[i].y * rstd * gg.y; hv[i * 4 + 2] = xv4[i].z * rstd * gg.z; hv[i * 4 + 3] = xv4[i].w * rstd * gg.w; }
#pragma unroll
    for (int i = 0; i < 4; ++i) *(uint2*)(h + (size_t)row * 1024 + i * 256 + lane * 4) = make_uint2(pack2(hv[i * 4], hv[i * 4 + 1]), pack2(hv[i * 4 + 2], hv[i * 4 + 3]));
    if constexpr (TYPE == 0) {
      const bool is_p = row < MPR; const int tt = is_p ? row : ((row - MPR) & 63); const int b = is_p ? 0 : ((row - MPR) >> 6);
      float hp[16];
      if (tt == 0) {
        if (is_p) {
#pragma unroll
          for (int i = 0; i < 16; ++i) hp[i] = 0.f;
        } else {
          const float* sp = PIN(2) + ((size_t)j * NSS + b) * 1024;
#pragma unroll
          for (int i = 0; i < 4; ++i) { float4 v = *(const float4*)(sp + i * 256 + lane * 4); hp[i * 4] = v.x; hp[i * 4 + 1] = v.y; hp[i * 4 + 2] = v.z; hp[i * 4 + 3] = v.w; }
        }
      } else {
        const float* pp = src(row - 1); float4 pv[4]; float s2 = 0.f;
#pragma unroll
        for (int i = 0; i < 4; ++i) { pv[i] = *(const float4*)(pp + i * 256 + lane * 4); s2 += pv[i].x * pv[i].x + pv[i].y * pv[i].y + pv[i].z * pv[i].z + pv[i].w * pv[i].w; }
        s2 = wsum(s2); const float r2 = rsqrtf(s2 * (1.f / 1024.f) + 1e-6f);
#pragma unroll
        for (int i = 0; i < 4; ++i) { float4 gg = *(const float4*)(g + i * 256 + lane * 4);
          hp[i * 4] = pv[i].x * r2 * gg.x; hp[i * 4 + 1] = pv[i].y * r2 * gg.y; hp[i * 4 + 2] = pv[i].z * r2 * gg.z; hp[i * 4 + 3] = pv[i].w * r2 * gg.w; }
      }
#pragma unroll
      for (int i = 0; i < 4; ++i) {
        const int col = i * 256 + lane * 4; const size_t o = (size_t)row * 1024 + col;
        float4 m0 = *(const float4*)(mu + 0 * 1024 + col), m2 = *(const float4*)(mu + 2 * 1024 + col), m3 = *(const float4*)(mu + 3 * 1024 + col);
        const float mm0[4] = {m0.x, m0.y, m0.z, m0.w}, mm2[4] = {m2.x, m2.y, m2.z, m2.w}, mm3[4] = {m3.x, m3.y, m3.z, m3.w};
        float a[4], bb[4], c[4];
#pragma unroll
        for (int e = 0; e < 4; ++e) { float hh = hv[i * 4 + e], xx = hp[i * 4 + e] - hh; a[e] = hh + xx * mm0[e]; bb[e] = hh + xx * mm2[e]; c[e] = hh + xx * mm3[e]; }
        *(uint2*)(hs + o) = make_uint2(pack2(hp[i * 4], hp[i * 4 + 1]), pack2(hp[i * 4 + 2], hp[i * 4 + 3]));
        *(uint2*)(xr + o) = make_uint2(pack2(a[0], a[1]), pack2(a[2], a[3]));
        *(uint2*)(xk + o) = make_uint2(pack2(bb[0], bb[1]), pack2(bb[2], bb[3]));
        *(uint2*)(xv + o) = make_uint2(pack2(c[0], c[1]), pack2(c[2], c[3]));
      }
      if (is_p ? (row == MPR - 1) : (tt == 63)) {
        float* o = POUT + (is_p ? O_ASH_P + (size_t)j * 1024 : O_ASH_S + ((size_t)j * NSS + b) * 1024);
#pragma unroll
        for (int i = 0; i < 4; ++i) *(float4*)(o + i * 256 + lane * 4) = make_float4(hv[i * 4], hv[i * 4 + 1], hv[i * 4 + 2], hv[i * 4 + 3]);
      }
    }
  }
}

DEVI void phase_rms(const float* x, const float* g, bf16* dst, float* fdst) {
  const int lane = threadIdx.x & 63, wave = threadIdx.x >> 6;
  for (int row = blockIdx.x * 4 + wave; row < MT; row += gridDim.x * 4) {
    const float* xp = x + (size_t)row * 1024; float4 v[4]; float ss = 0.f;
#pragma unroll
    for (int i = 0; i < 4; ++i) { v[i] = *(const float4*)(xp + i * 256 + lane * 4); ss += v[i].x * v[i].x + v[i].y * v[i].y + v[i].z * v[i].z + v[i].w * v[i].w; }
    ss = wsum(ss); const float r = rsqrtf(ss * (1.f / 1024.f) + 1e-6f);
#pragma unroll
    for (int i = 0; i < 4; ++i) { float4 gg = *(const float4*)(g + i * 256 + lane * 4);
      float a = v[i].x * r * gg.x, b = v[i].y * r * gg.y, c = v[i].z * r * gg.z, d = v[i].w * r * gg.w;
      if (dst) *(uint2*)(dst + (size_t)row * 1024 + i * 256 + lane * 4) = make_uint2(pack2(a, b), pack2(c, d));
      else *(float4*)(fdst + (size_t)row * 1024 + i * 256 + lane * 4) = make_float4(a, b, c, d); }
  }
}

DEVI void phase_gdn_conv(const P& p) {
  const bf16* qkv = slot(p, 1); const float* cw = PIN(35); const float* cst = PIN(5);
  const int tid = threadIdx.x, lane = tid & 63;
  for (int item = blockIdx.x; item < MT * 3; item += gridDim.x) {
    const int row = item / 3, sec = item % 3, ch = sec * 1024 + tid * 4;
    const bool is_p = row < MPR; const int tt = is_p ? row : ((row - MPR) & 63); const int b = is_p ? 0 : ((row - MPR) >> 6);
    float acc[4] = {0.f, 0.f, 0.f, 0.f};
#pragma unroll
    for (int i = 0; i < 4; ++i) {
      const int pt = tt + i;
      float4 w = *(const float4*)(cw + i * 3072 + ch); float x[4];
      if (pt >= 3) { uint2 u = *(const uint2*)(qkv + (size_t)(row + i - 3) * 3072 + ch);
        x[0] = bf2f(u.x & 0xffff); x[1] = bf2f(u.x >> 16); x[2] = bf2f(u.y & 0xffff); x[3] = bf2f(u.y >> 16); }
      else if (!is_p) { float4 s = *(const float4*)(cst + ((size_t)b * 3 + pt) * 3072 + ch); x[0] = s.x; x[1] = s.y; x[2] = s.z; x[3] = s.w; }
      else { x[0] = x[1] = x[2] = x[3] = 0.f; }
      acc[0] += x[0] * w.x; acc[1] += x[1] * w.y; acc[2] += x[2] * w.z; acc[3] += x[3] * w.w;
    }
#pragma unroll
    for (int e = 0; e < 4; ++e) acc[e] = silu(acc[e]);
    if (sec < 2) {
      float ss = acc[0] * acc[0] + acc[1] * acc[1] + acc[2] * acc[2] + acc[3] * acc[3];
#pragma unroll
      for (int o = 16; o > 0; o >>= 1) ss += __shfl_xor(ss, o);
      float r = rsqrtf(ss + 1e-6f) * (sec == 0 ? 0.08838834764831845f : 1.f);
#pragma unroll
      for (int e = 0; e < 4; ++e) acc[e] *= r;
    }
    (void)lane;
    *(uint2*)(slot(p, 5 + sec) + (size_t)row * 1024 + tid * 4) = make_uint2(pack2(acc[0], acc[1]), pack2(acc[2], acc[3]));
  }
}

DEVI void mm_strip(const bf16* At, const bf16* Bt, f32x4 (&acc)[4], int wave, int lane) {
  const int lr = lane & 15, quad = lane >> 4;
#pragma unroll
  for (int ks = 0; ks < 2; ++ks) {
    bf16x8 a = *(const bf16x8*)(At + (wave * 16 + lr) * 72 + ks * 32 + quad * 8);
#pragma unroll
    for (int nb = 0; nb < 4; ++nb) {
      bf16x8 b = *(const bf16x8*)(Bt + (nb * 16 + lr) * 72 + ks * 32 + quad * 8);
      acc[nb] = __builtin_amdgcn_mfma_f32_16x16x32_bf16(a, b, acc[nb], 0, 0, 0);
    }
  }
}
DEVI void zero4(f32x4 (&a)[4]) {
#pragma unroll
  for (int i = 0; i < 4; ++i) a[i] = (f32x4){0.f, 0.f, 0.f, 0.f};
}

template <int CW> DEVI size_t cont_off(int r, int s, int LD) { const int idx = r * 64 + s; return (size_t)(idx / CW) * LD + (idx % CW); }

template <int TYPE>
DEVI void phase_prep(const P& p, int j, char* smem) {
  constexpr int NH = TYPE == 0 ? 16 : (TYPE == 1 ? 4 : 8);
  constexpr int DK = TYPE == 0 ? 64 : 128;
  constexpr int DV = TYPE == 0 ? 64 : (TYPE == 1 ? 256 : 128);
  constexpr bool LOW = TYPE != 1;
  constexpr int KT = 256 / DK, TPT = 64 / KT, DKH = DK / 64, DVH = DV / 64;
  constexpr int LDQ = TYPE == 1 ? 512 : 1024;
  bf16* X0 = (bf16*)smem; bf16* X1 = X0 + 4608; bf16* Y0 = X1 + 4608; bf16* Y1 = Y0 + 4608;
  float* Lb = (float*)smem;
  bf16* LkT = (bf16*)(smem + 16384); bf16* Ak = LkT + 4608; bf16* nAb = Ak + 4608;
  bf16* M1 = (bf16*)smem;
  bf16* Tt = (bf16*)(smem + 44032); bf16* St1 = Tt + 4608; bf16* St2 = St1 + 4608;
  if (TYPE == 1) { Y0 = (bf16*)(smem + 9216); Ak = (bf16*)(smem + 18432); St1 = (bf16*)(smem + 27648); }
  float* lgL = (float*)(smem + 36864);
  float* tot = (float*)(smem + 71680);
  float* sc_beta = (float*)(smem + 73728);
  float* sc_eg = sc_beta + 64; float* sc_lg = sc_eg + 64; float* sc_g = sc_lg + 64;

  bf16 *Aq, *Akk, *Av, *Ald = nullptr, *Aa = nullptr, *Oq, *Okt, *Ovt, *Ow = nullptr, *Obt = nullptr, *Ool, *Ou0 = nullptr;
  if (TYPE == 0) { Aq = slot(p, 5); Akk = slot(p, 6); Av = slot(p, 7); Ald = slot(p, 2); Aa = slot(p, 3);
    Oq = Aq; Okt = Akk; Ovt = Av; Ow = Ald; Obt = Aa; Ool = slot(p, 0); Ou0 = slot(p, 1); }
  else if (TYPE == 1) { Aq = slot(p, 1); Akk = slot(p, 1) + (size_t)MT * 512; Av = slot(p, 2); Oq = Aq; Okt = Akk; Ovt = Av; Ool = slot(p, 4); }
  else { Aq = slot(p, 5); Akk = slot(p, 6); Av = slot(p, 7); Oq = Aq; Okt = Akk; Ovt = Av; Ow = slot(p, 1); Obt = slot(p, 2); Ool = slot(p, 3); Ou0 = slot(p, 0); }
  float* sm = (float*)(PWS + WS_SM);
  float* gam = (float*)(PWS + WS_GAM);

  for (int item = blockIdx.x; item < NCHUNK * NH; item += gridDim.x) {
    const int c = item / NH, h = item % NH;
    const size_t rb = (size_t)c * 64;
    int tid = threadIdx.x; asm volatile("" : "+v"(tid));
    const int lane = tid & 63, wave = tid >> 6, lr = lane & 15, quad = lane >> 4;
    const int k = tid % DK, tg = tid / DK;
    const int vv = tid & 63, tgv = tid >> 6;
    unsigned qP[TPT / 2], ktP[TPT / 2], kapP[(TYPE == 0) ? TPT / 2 : 1], bvP[(TYPE == 0) ? TPT / 2 : 1];
    float lg[(TYPE == 0) ? TPT : 1], ldv[(TYPE == 0) ? TPT : 1];
    unsigned vP[DVH][8];
    auto lo16 = [](unsigned w) { return __uint_as_float(w << 16); };
    auto hi16 = [](unsigned w) { return __uint_as_float(w & 0xffff0000u); };
#define GETP(arr, e) (((e) & 1) ? hi16(arr[(e) >> 1]) : lo16(arr[(e) >> 1]))
#pragma unroll
    for (int vh = 0; vh < DVH; ++vh)
#pragma unroll
      for (int e = 0; e < 8; ++e) {
        const bf16 a = Av[(rb + tgv * 16 + 2 * e) * 1024 + h * DV + vh * 64 + vv], b = Av[(rb + tgv * 16 + 2 * e + 1) * 1024 + h * DV + vh * 64 + vv];
        vP[vh][e] = (unsigned)a | ((unsigned)b << 16);
        asm volatile("" : "+v"(vP[vh][e]));
      }
    if constexpr (TYPE == 2) {
      if (tid < 64) {
        const float a_log = PIN(36)[h], dtb = PIN(37)[h];
        const float braw = sm[(rb + tid) * 16 + h], araw = sm[(rb + tid) * 16 + 8 + h];
        const float gt = -__expf(a_log) * softplus(araw + dtb);
        sc_beta[tid] = sigm(braw); sc_eg[tid] = __expf(gt); sc_g[tid] = gt;
        float cs = gt;
#pragma unroll
        for (int o = 1; o < 64; o <<= 1) { float n = __shfl_up(cs, o); if (lane >= o) cs += n; }
        sc_lg[tid] = cs;
      }
      __syncthreads();
    }
    if constexpr (TYPE == 0) {
      const float k_k = PIN(21)[j * 1024 + h * 64 + k], k_a = PIN(22)[j * 1024 + h * 64 + k], r_k = PIN(23)[j * 1024 + h * 64 + k];
      float run = 0.f;
#pragma unroll
      for (int e2 = 0; e2 < TPT / 2; ++e2) {
        float qq[2], ka[2], kq[2], bq[2];
#pragma unroll
        for (int u = 0; u < 2; ++u) {
          const int e = e2 * 2 + u;
          const size_t o = (rb + tg * TPT + e) * 1024 + h * 64 + k;
          const float r = bf2f(Aq[o]), kr = bf2f(Akk[o]), av = bf2f(Aa[o]), l = bf2f(Ald[o]);
          const float kk = kr * k_k;
          const float inv = rsqrtf(fmaxf(wsum(kk * kk), 1e-24f));
          qq[u] = r; ka[u] = kk * inv; kq[u] = kr * (1.f + (av - 1.f) * k_a); bq[u] = ka[u] * av; ldv[e] = l;
          const float bo = wsum(r * kq[u] * r_k);
          if (lane == 0) sm[(rb + tg * TPT + e) * 16 + h] = bo;
          run += l; lg[e] = run;
        }
        qP[e2] = pack2(qq[0], qq[1]); kapP[e2] = pack2(ka[0], ka[1]); ktP[e2] = pack2(kq[0], kq[1]); bvP[e2] = pack2(bq[0], bq[1]);
        asm volatile("" : "+v"(qP[e2]), "+v"(kapP[e2]), "+v"(ktP[e2]), "+v"(bvP[e2]));
      }
      tot[tg * 128 + k] = run;
    } else if constexpr (TYPE == 1) {
      float w2[16];
#pragma unroll
      for (int i = 0; i < 16; ++i) w2[i] = PIN(30)[i * 512 + h * 128 + k];
      const float ba = PIN(31)[h * 128 + k];
      float run = 0.f;
#pragma unroll
      for (int e = 0; e < TPT; ++e) {
        const size_t row = rb + tg * TPT + e;
        float s = ba;
#pragma unroll
        for (int i = 0; i < 16; ++i) s += sm[row * 16 + i] * w2[i];
        const float gk = (fminf(s, 0.f) - log1pf(__expf(-fabsf(s)))) * (1.f / 16.f);
        run += gk; lgL[(tg * TPT + e) * 128 + k] = run;
        __builtin_amdgcn_sched_barrier(0);
      }
#pragma unroll
      for (int e2 = 0; e2 < TPT / 2; ++e2) {
        const size_t row = rb + tg * TPT + 2 * e2;
        qP[e2] = (unsigned)Aq[row * 512 + h * 128 + k] | ((unsigned)Aq[(row + 1) * 512 + h * 128 + k] << 16);
        ktP[e2] = (unsigned)Akk[row * 512 + h * 128 + k] | ((unsigned)Akk[(row + 1) * 512 + h * 128 + k] << 16);
        asm volatile("" : "+v"(qP[e2]), "+v"(ktP[e2]));
      }
      tot[tg * 128 + k] = run;
    } else {
#pragma unroll
      for (int e2 = 0; e2 < TPT / 2; ++e2) {
        const size_t o = (rb + tg * TPT + 2 * e2) * 1024 + h * 128 + k;
        qP[e2] = (unsigned)Aq[o] | ((unsigned)Aq[o + 1024] << 16);
        ktP[e2] = (unsigned)Akk[o] | ((unsigned)Akk[o + 1024] << 16);
        asm volatile("" : "+v"(qP[e2]), "+v"(ktP[e2]));
      }
    }
    __syncthreads();
    float lgC;
    if constexpr (TYPE == 2) { lgC = sc_lg[63]; }
    else {
      float off = 0.f, all = 0.f;
#pragma unroll
      for (int g2 = 0; g2 < KT; ++g2) { const float tv = tot[g2 * 128 + k]; all += tv; if (g2 < tg) off += tv; }
      if constexpr (TYPE == 0) {
#pragma unroll
        for (int e = 0; e < TPT; ++e) lg[e] += off;
      } else {
#pragma unroll
        for (int e = 0; e < TPT; ++e) lgL[(tg * TPT + e) * 128 + k] += off;
      }
      lgC = all;
    }
#define QV(e) GETP(qP, e)
#define LGV(e, t) ((TYPE == 2) ? sc_lg[t] : ((TYPE == 1) ? lgL[(t) * 128 + k] : lg[(TYPE == 0) ? (e) : 0]))
#define LPREV(e, t) ((TYPE == 0) ? (lg[(TYPE == 0) ? (e) : 0] - ldv[(TYPE == 0) ? (e) : 0]) : (sc_lg[t] - sc_g[t]))
#define KTV(e, t) ((TYPE == 2) ? (sc_beta[t] * GETP(ktP, e)) : GETP(ktP, e))
#define KAPV(e, t) ((TYPE == 2) ? GETP(ktP, e) : GETP(kapP, (TYPE == 0) ? (e) : 0))
#define BVV(e, t) ((TYPE == 2) ? (sc_beta[t] * sc_eg[t] * GETP(ktP, e)) : GETP(bvP, (TYPE == 0) ? (e) : 0))
    f32x4 sacc[LOW ? 4 : 1][4];
#pragma unroll
    for (int a = 0; a < (LOW ? 4 : 1); ++a) zero4(sacc[a]);
#pragma unroll
    for (int kh = 0; kh < DKH; ++kh) {
      if (k / 64 == kh) {
        const int kk = k & 63;
#pragma unroll
        for (int e = 0; e < TPT; ++e) {
          const int t = tg * TPT + e;
          if constexpr (TYPE == 2) {
            X0[t * 72 + kk] = f2bf(QV(e)); Y0[t * 72 + kk] = f2bf(KTV(e, t));
            X1[t * 72 + kk] = f2bf(KAPV(e, t)); Y1[t * 72 + kk] = f2bf(BVV(e, t));
          } else {
            const float lgt = LGV(e, t);
            const float el = __expf(lgt), eml = __expf(-lgt);
            X0[t * 72 + kk] = f2bf(QV(e) * el);
            Y0[t * 72 + kk] = f2bf(KTV(e, t) * eml);
            if constexpr (LOW) {
              X1[t * 72 + kk] = f2bf(KAPV(e, t) * __expf(LPREV(e, t)));
              Y1[t * 72 + kk] = f2bf(BVV(e, t) * eml);
            }
          }
          __builtin_amdgcn_sched_barrier(0);
        }
      }
      __syncthreads();
      mm_strip(X0, Y0, sacc[0], wave, lane);
      if constexpr (LOW) { mm_strip(X0, Y1, sacc[1], wave, lane); mm_strip(X1, Y0, sacc[2], wave, lane); mm_strip(X1, Y1, sacc[3], wave, lane); }
      __syncthreads();
    }
#pragma unroll
    for (int nb = 0; nb < 4; ++nb)
#pragma unroll
      for (int jj = 0; jj < 4; ++jj) {
        const int t = wave * 16 + quad * 4 + jj, s = nb * 16 + lr;
        float da = 1.f, dl = 1.f;
        if constexpr (TYPE == 2) { const float dd = sc_lg[t] - sc_lg[s]; da = __expf(fminf(dd, 0.f)); dl = __expf(fminf(dd - sc_g[t], 0.f)); }
        Ak[t * 72 + s] = f2bf(s <= t ? sacc[0][nb][jj] * da : 0.f);
        if constexpr (LOW) {
          nAb[t * 72 + s] = f2bf(s <= t ? -sacc[1][nb][jj] * da : 0.f);
          LkT[s * 72 + t] = f2bf(s < t ? sacc[2][nb][jj] * dl : 0.f);
          Lb[t * 64 + (s & 3) * 16 + (s >> 2)] = s < t ? sacc[3][nb][jj] * dl : 0.f;
        }
      }
    __syncthreads();
    f32x4 acc[4];
    if constexpr (LOW) {
      {
        const int q = lane & 3, jc = wave * 16 + (lane >> 2);
        float xr[16];
#pragma unroll
        for (int i = 0; i < 16; ++i) xr[i] = 0.f;
#pragma unroll
        for (int t = 0; t < 64; ++t) {
          float s = 0.f;
          const float* Lr = Lb + t * 64 + q * 16;
#pragma unroll
          for (int i = 0; i < (t + 3) / 4; ++i) s += Lr[i] * xr[i];
          s += __shfl_xor(s, 1); s += __shfl_xor(s, 2);
          s = ((t == jc) ? 1.f : 0.f) - s;
          xr[t >> 2] = (q == (t & 3)) ? s : xr[t >> 2];
          if (q == 0) Tt[t * 72 + jc] = f2bf(s);
          __builtin_amdgcn_sched_barrier(0);
        }
      }
      __syncthreads();
      zero4(acc); mm_strip(Tt, LkT, acc, wave, lane);
#pragma unroll
      for (int nb = 0; nb < 4; ++nb)
#pragma unroll
        for (int jj = 0; jj < 4; ++jj) M1[(wave * 16 + quad * 4 + jj) * 72 + nb * 16 + lr] = f2bf(acc[nb][jj]);
      __syncthreads();
    }
#pragma unroll
    for (int vh = 0; vh < DVH; ++vh) {
#pragma unroll
      for (int e = 0; e < 8; ++e) *(unsigned*)(St1 + vv * 72 + tgv * 16 + 2 * e) = vP[vh][e];
      __syncthreads();
      if constexpr (LOW) {
        zero4(acc); mm_strip(M1, St1, acc, wave, lane);
#pragma unroll
        for (int nb = 0; nb < 4; ++nb)
#pragma unroll
          for (int jj = 0; jj < 4; ++jj) {
            const int t = wave * 16 + quad * 4 + jj, col = nb * 16 + lr; const bf16 u = f2bf(acc[nb][jj]);
            St2[col * 72 + t] = u;
            Ou0[(rb + t) * 1024 + h * DV + vh * 64 + col] = u;
          }
        __syncthreads();
      }
      zero4(acc); mm_strip(Ak, St1, acc, wave, lane);
      if constexpr (LOW) mm_strip(nAb, St2, acc, wave, lane);
#pragma unroll
      for (int nb = 0; nb < 4; ++nb)
#pragma unroll
        for (int jj = 0; jj < 4; ++jj)
          Ool[(rb + wave * 16 + quad * 4 + jj) * 1024 + h * DV + vh * 64 + nb * 16 + lr] = f2bf(acc[nb][jj]);
      __syncthreads();
    }
    if constexpr (LOW) {
#pragma unroll
      for (int kh = 0; kh < DKH; ++kh) {
        if (k / 64 == kh) {
          const int kk = k & 63;
#pragma unroll
          for (int e = 0; e < TPT; ++e) {
            const int t = tg * TPT + e;
            St1[kk * 72 + t] = f2bf(KAPV(e, t) * __expf(LPREV(e, t)));
            LkT[t * 72 + kk] = f2bf(QV(e) * __expf(LGV(e, t)));
            __builtin_amdgcn_sched_barrier(0);
          }
        }
        __syncthreads();
        zero4(acc); mm_strip(Tt, St1, acc, wave, lane);
#pragma unroll
        for (int nb = 0; nb < 4; ++nb)
#pragma unroll
          for (int jj = 0; jj < 4; ++jj) {
            const int t = wave * 16 + quad * 4 + jj, col = nb * 16 + lr; const bf16 u = f2bf(acc[nb][jj]);
            St2[col * 72 + t] = u;
            Ow[(rb + t) * 1024 + h * DK + kh * 64 + col] = u;
          }
        __syncthreads();
        zero4(acc); mm_strip(nAb, St2, acc, wave, lane);
#pragma unroll
        for (int nb = 0; nb < 4; ++nb)
#pragma unroll
          for (int jj = 0; jj < 4; ++jj) {
            const int t = wave * 16 + quad * 4 + jj, col = nb * 16 + lr;
            Oq[(rb + t) * LDQ + h * DK + kh * 64 + col] = f2bf(acc[nb][jj] + bf2f(LkT[t * 72 + col]));
          }
        __syncthreads();
      }
    } else {
#pragma unroll
      for (int e = 0; e < TPT; ++e) { Oq[(rb + tg * TPT + e) * LDQ + h * DK + k] = f2bf(QV(e) * __expf(LGV(e, tg * TPT + e))); __builtin_amdgcn_sched_barrier(0); }
    }
    {
      unsigned wk[TPT / 2], wb[LOW ? TPT / 2 : 1];
#pragma unroll
      for (int e = 0; e < TPT; e += 2) {
        const int t0 = tg * TPT + e;
        const float d0 = __expf(lgC - LGV(e, t0)), d1 = __expf(lgC - LGV(e + 1, t0 + 1));
        wk[e / 2] = pack2(KTV(e, t0) * d0, KTV(e + 1, t0 + 1) * d1);
        if constexpr (LOW) wb[e / 2] = pack2(BVV(e, t0) * d0, BVV(e + 1, t0 + 1) * d1);
        __builtin_amdgcn_sched_barrier(0);
      }
      const size_t co = rb * LDQ + h * DK + cont_off<DK>(k, tg * TPT, LDQ);
#pragma unroll
      for (int e = 0; e < TPT / 8; ++e) {
        *(uint4*)(Okt + co + e * 8) = make_uint4(wk[e * 4], wk[e * 4 + 1], wk[e * 4 + 2], wk[e * 4 + 3]);
        if constexpr (LOW) *(uint4*)(Obt + co + e * 8) = make_uint4(wb[e * 4], wb[e * 4 + 1], wb[e * 4 + 2], wb[e * 4 + 3]);
      }
#pragma unroll
      for (int vh = 0; vh < DVH; ++vh) {
        const unsigned* wv = vP[vh];
        const size_t vo = rb * 1024 + h * DV + cont_off<DV>(vh * 64 + vv, tgv * 16, 1024);
        *(uint4*)(Ovt + vo) = make_uint4(wv[0], wv[1], wv[2], wv[3]);
        *(uint4*)(Ovt + vo + 8) = make_uint4(wv[4], wv[5], wv[6], wv[7]);
      }
      if (tg == 0) gam[((size_t)c * NH + h) * DK + k] = __expf(lgC);
    }
    __syncthreads();
  }
}

template <int TYPE>
DEVI void phase_seq(const P& p, int j) {
  constexpr int NH = TYPE == 0 ? 16 : (TYPE == 1 ? 4 : 8);
  constexpr int DK = TYPE == 0 ? 64 : 128;
  constexpr int DV = TYPE == 0 ? 64 : (TYPE == 1 ? 256 : 128);
  constexpr bool LOW = TYPE != 1;
  constexpr int NVB = DV / 16, MB = DK / 16, KS = DK / 32;
  constexpr int LDQ = TYPE == 1 ? 512 : 1024;
  constexpr int IPS = NH * NVB;
  const int lane = threadIdx.x & 63, wave = threadIdx.x >> 6, lr = lane & 15, quad = lane >> 4;
  const bf16 *Qp, *Kt, *Vt, *Wp = nullptr, *Bt = nullptr, *U0 = nullptr; bf16* Ol;
  if (TYPE == 0) { Qp = slot(p, 5); Kt = slot(p, 6); Vt = slot(p, 7); Wp = slot(p, 2); Bt = slot(p, 3); Ol = slot(p, 0); U0 = slot(p, 1); }
  else if (TYPE == 1) { Qp = slot(p, 1); Kt = slot(p, 1) + (size_t)MT * 512; Vt = slot(p, 2); Ol = slot(p, 4); }
  else { Qp = slot(p, 5); Kt = slot(p, 6); Vt = slot(p, 7); Wp = slot(p, 1); Bt = slot(p, 2); Ol = slot(p, 3); U0 = slot(p, 0); }
  const float* gam = (const float*)(PWS + WS_GAM);
  const int nitems = 33 * IPS;
  for (int item = wave * gridDim.x + blockIdx.x; item < nitems; item += gridDim.x * 4) {
    const int seq = item / IPS, rem = item % IPS, h = rem / NVB, vb = rem % NVB;
    const int c0 = seq == 0 ? 0 : NPCH + seq - 1, nc = seq == 0 ? NPCH : 1;
    const int vcol = vb * 16 + lr;
    f32x4 H[MB];
    if (seq == 0) {
#pragma unroll
      for (int m = 0; m < MB; ++m) H[m] = (f32x4){0.f, 0.f, 0.f, 0.f};
    } else {
      const int b = seq - 1;
      if (TYPE == 0) {
        const float* S = PIN(3) + (((size_t)j * NSS + b) * 16 + h) * 4096 + (size_t)vcol * 64;
#pragma unroll
        for (int m = 0; m < MB; ++m) { float4 v = *(const float4*)(S + m * 16 + quad * 4); H[m] = (f32x4){v.x, v.y, v.z, v.w}; }
      } else {
        const float* S = PIN(TYPE == 1 ? 4 : 6) + ((size_t)b * NH + h) * DK * DV + vcol;
#pragma unroll
        for (int m = 0; m < MB; ++m)
#pragma unroll
          for (int jj = 0; jj < 4; ++jj) H[m][jj] = S[(size_t)(m * 16 + quad * 4 + jj) * DV];
      }
    }
    for (int c = c0; c < c0 + nc; ++c) {
      const size_t rb = (size_t)c * 64;
      int ln = threadIdx.x & 63; asm volatile("" : "+v"(ln));
      const int lr = ln & 15, quad = ln >> 4, vcol = vb * 16 + lr;
      bf16x8 hb[KS];
#pragma unroll
      for (int ks = 0; ks < KS; ++ks) {
#pragma unroll
        for (int e = 0; e < 4; ++e) { hb[ks][e] = (short)f2bf(H[2 * ks][e]); hb[ks][4 + e] = (short)f2bf(H[2 * ks + 1][e]); }
      }
      f32x4 U[4];
#pragma unroll
      for (int tb = 0; tb < 4; ++tb) {
        const size_t trow = rb + tb * 16 + lr;
        f32x4 o, u;
#pragma unroll
        for (int jj = 0; jj < 4; ++jj) {
          const size_t orow = (rb + tb * 16 + quad * 4 + jj) * 1024 + h * DV + vcol;
          o[jj] = bf2f(Ol[orow]);
          if constexpr (LOW) u[jj] = bf2f(U0[orow]);
        }
#pragma unroll
        for (int ks = 0; ks < KS; ++ks) {
          const bf16* qp = Qp + trow * LDQ + h * DK + ks * 32 + quad * 4;
          bf16x4 lo = *(const bf16x4*)qp, hi = *(const bf16x4*)(qp + 16);
          bf16x8 a = __builtin_shufflevector(lo, hi, 0, 1, 2, 3, 4, 5, 6, 7);
          o = __builtin_amdgcn_mfma_f32_16x16x32_bf16(a, hb[ks], o, 0, 0, 0);
          if constexpr (LOW) {
            const bf16* wp = Wp + trow * 1024 + h * DK + ks * 32 + quad * 4;
            bf16x4 wl = *(const bf16x4*)wp, wh = *(const bf16x4*)(wp + 16);
            bf16x8 aw = __builtin_shufflevector(wl, wh, 0, 1, 2, 3, 4, 5, 6, 7);
            u = __builtin_amdgcn_mfma_f32_16x16x32_bf16(aw, hb[ks], u, 0, 0, 0);
          }
        }
#pragma unroll
        for (int jj = 0; jj < 4; ++jj) Ol[(rb + tb * 16 + quad * 4 + jj) * 1024 + h * DV + vcol] = f2bf(o[jj]);
        if constexpr (LOW) U[tb] = u;
        __builtin_amdgcn_sched_barrier(0);
      }
      bf16x8 vbop[2], ubop[2];
#pragma unroll
      for (int ks = 0; ks < 2; ++ks) {
        vbop[ks] = *(const bf16x8*)(Vt + rb * 1024 + h * DV + cont_off<DV>(vcol, ks * 32 + quad * 8, 1024));
        if constexpr (LOW) {
#pragma unroll
          for (int e = 0; e < 4; ++e) { ubop[ks][e] = (short)f2bf(-U[2 * ks][e]); ubop[ks][4 + e] = (short)f2bf(-U[2 * ks + 1][e]); }
        }
      }
#pragma unroll
      for (int m = 0; m < MB; ++m) {
        const float4 gv = *(const float4*)(gam + ((size_t)c * NH + h) * DK + m * 16 + quad * 4);
        f32x4 hn = (f32x4){H[m][0] * gv.x, H[m][1] * gv.y, H[m][2] * gv.z, H[m][3] * gv.w};
        const int krow = m * 16 + lr;
#pragma unroll
        for (int ks = 0; ks < 2; ++ks) {
          bf16x8 a = *(const bf16x8*)(Kt + rb * LDQ + h * DK + cont_off<DK>(krow, ks * 32 + quad * 8, LDQ));
          hn = __builtin_amdgcn_mfma_f32_16x16x32_bf16(a, vbop[ks], hn, 0, 0, 0);
          if constexpr (LOW) {
            const bf16* bp = Bt + rb * 1024 + h * DK;
            bf16x4 lo = *(const bf16x4*)(bp + cont_off<DK>(krow, ks * 32 + quad * 4, 1024));
            bf16x4 hi = *(const bf16x4*)(bp + cont_off<DK>(krow, ks * 32 + 16 + quad * 4, 1024));
            bf16x8 ab = __builtin_shufflevector(lo, hi, 0, 1, 2, 3, 4, 5, 6, 7);
            hn = __builtin_amdgcn_mfma_f32_16x16x32_bf16(ab, ubop[ks], hn, 0, 0, 0);
          }
        }
        H[m] = hn;
        __builtin_amdgcn_sched_barrier(0);
      }
    }
    if (TYPE == 0) {
      float* S = POUT + (seq == 0 ? O_AWKV_P + ((size_t)j * 16 + h) * 4096 : O_AWKV_S + (((size_t)j * NSS + (seq - 1)) * 16 + h) * 4096) + (size_t)vcol * 64;
#pragma unroll
      for (int m = 0; m < MB; ++m) *(float4*)(S + m * 16 + quad * 4) = make_float4(H[m][0], H[m][1], H[m][2], H[m][3]);
    } else {
      const size_t ob = TYPE == 1 ? (seq == 0 ? O_BKV_P : O_BKV_S + (size_t)(seq - 1) * NH * DK * DV)
                                  : (seq == 0 ? O_CKV_P : O_CKV_S + (size_t)(seq - 1) * NH * DK * DV);
      float* S = POUT + ob + (size_t)h * DK * DV + vcol;
#pragma unroll
      for (int m = 0; m < MB; ++m)
#pragma unroll
        for (int jj = 0; jj < 4; ++jj) S[(size_t)(m * 16 + quad * 4 + jj) * DV] = H[m][jj];
    }
  }
}

template <int TYPE>
DEVI void phase_post(const P& p, int j, char* smem) {
  constexpr int NH = TYPE == 0 ? 16 : (TYPE == 1 ? 4 : 8);
  constexpr int DV = TYPE == 0 ? 64 : (TYPE == 1 ? 256 : 128);
  constexpr int CPT = DV / 8;
  bf16* vt = (bf16*)smem;
  const bf16* O = slot(p, TYPE == 0 ? 0 : (TYPE == 1 ? 4 : 3));
  const bf16* G = slot(p, TYPE == 0 ? 4 : (TYPE == 1 ? 3 : 4));
  bf16* og = slot(p, TYPE == 1 ? 0 : 1);
  const float* sm = (const float*)(PWS + WS_SM);
  for (int item = blockIdx.x; item < NCHUNK * NH; item += gridDim.x) {
    const int c = item / NH, h = item % NH; const size_t rb = (size_t)c * 64;
    int tid = threadIdx.x; asm volatile("" : "+v"(tid));
    const int part = tid & 7;
    if constexpr (TYPE == 0) {
      const bf16* V = slot(p, 7) + rb * 1024 + h * 64;
      const int r = tid >> 2, q4 = (tid & 3) * 16;
      *(uint4*)(vt + r * 72 + q4) = *(const uint4*)(V + (size_t)r * 1024 + q4);
      *(uint4*)(vt + r * 72 + q4 + 8) = *(const uint4*)(V + (size_t)r * 1024 + q4 + 8);
      __syncthreads();
    }
#pragma unroll 1
    for (int pass = 0; pass < 2; ++pass) {
      const int t = pass * 32 + (tid >> 3);
      const size_t base = (rb + t) * 1024 + h * DV + part * CPT;
      float o[CPT];
#pragma unroll
      for (int e = 0; e < CPT; e += 8) {
        uint4 u = *(const uint4*)(O + base + e);
        const unsigned w[4] = {u.x, u.y, u.z, u.w};
#pragma unroll
        for (int i = 0; i < 4; ++i) { o[e + 2 * i] = bf2f(w[i] & 0xffff); o[e + 2 * i + 1] = bf2f(w[i] >> 16); }
      }
      float s1 = 0.f, s2 = 0.f;
#pragma unroll
      for (int e = 0; e < CPT; ++e) { s1 += o[e]; s2 += o[e] * o[e]; }
      s1 += __shfl_xor(s1, 1); s1 += __shfl_xor(s1, 2); s1 += __shfl_xor(s1, 4);
      s2 += __shfl_xor(s2, 1); s2 += __shfl_xor(s2, 2); s2 += __shfl_xor(s2, 4);
      if constexpr (TYPE == 0) {
        const float mean = s1 * (1.f / 64.f); float var = s2 * (1.f / 64.f) - mean * mean; var = fmaxf(var, 0.f);
        const float rs = rsqrtf(var + 64e-5f); const float bonus = sm[(rb + t) * 16 + h];
        const float* lw = PIN(26) + j * 1024 + h * 64 + part * CPT; const float* lb = PIN(27) + j * 1024 + h * 64 + part * CPT;
#pragma unroll
        for (int e = 0; e < CPT; ++e) {
          const float vv = bf2f(vt[(part * CPT + e) * 72 + t]);
          o[e] = (o[e] - mean) * rs * lw[e] + lb[e] + bonus * vv;
        }
      } else {
        const float rs = rsqrtf(s2 * (1.f / DV) + 1e-6f);
        const float* on = PIN(TYPE == 1 ? 32 : 38) + part * CPT;
#pragma unroll
        for (int e = 0; e < CPT; ++e) o[e] = o[e] * rs * on[e];
      }
#pragma unroll
      for (int e = 0; e < CPT; e += 8) {
        uint4 u = *(const uint4*)(G + base + e);
        const unsigned w[4] = {u.x, u.y, u.z, u.w}; unsigned ow[4];
#pragma unroll
        for (int i = 0; i < 4; ++i) {
          float g0 = bf2f(w[i] & 0xffff), g1 = bf2f(w[i] >> 16);
          if constexpr (TYPE != 0) { g0 = silu(g0); g1 = silu(g1); }
          ow[i] = pack2(o[e + 2 * i] * g0, o[e + 2 * i + 1] * g1);
        }
        *(uint4*)(og + base + e) = make_uint4(ow[0], ow[1], ow[2], ow[3]);
      }
    }
    if constexpr (TYPE == 0) __syncthreads();
  }
}

#ifndef DISMASK
#define DISMASK 0
#endif
#define EN(b) (!((DISMASK >> (b)) & 1))
#define GSYNC() do { __builtin_amdgcn_fence(__ATOMIC_RELEASE, "agent"); asm volatile("s_waitcnt vmcnt(0)" ::: "memory"); grid.sync(); __builtin_amdgcn_fence(__ATOMIC_ACQUIRE, "agent"); } while (0)
__global__ void __launch_bounds__(256, 1) fwd_megakernel(P p) {
  extern __shared__ __attribute__((aligned(16))) char smem[];
  cg::grid_group grid = cg::this_grid();
  bf16* wreg = (bf16*)(PWS + WS_W);
  bf16 *wfin = wreg + W_FIN, *wfout = wreg + W_FOUT, *wmix = wreg + W_MIX;
  float* sm = (float*)(PWS + WS_SM);
  for (int layer = 0; layer < 4; ++layer) {
    const int type = layer % 3, j = layer / 3;
    int tb = 0;
    if (type == 0) phase_norm<0>(p, layer, j, layer == 0, layer == 0);
    else phase_norm<1>(p, layer, j, false, false);
    conv_job(CvFfnIn{PIN(10) + (size_t)layer * 1024 * 2 * FF}, wfin, 1024, 2 * FF, 1024, tb, smem);
    conv_job(CvPlain{PIN(11) + (size_t)layer * FF * 1024, 1024, 1024}, wfout, FF, 1024, FF, tb, smem);
    if (type == 0) {
      for (int i = 0; i < 3; ++i) conv_job(CvPlain{PIN(24) + ((size_t)j * 3 + i) * 1048576, 1024, 1024}, wmix + (size_t)i * 1048576, 1024, 1024, 1024, tb, smem);
      conv_job(CvLora1{PIN(14) + (size_t)j * 65536, PIN(17) + (size_t)j * 65536, PIN(19) + (size_t)j * 131072, PIN(12) + (size_t)j * 6144}, wmix + 3145728, 2048, 256, 2048, tb, smem);
      conv_job(CvPlain{PIN(15) + (size_t)j * 65536, 1024, 1024}, wmix + 3670016, 64, 1024, 64, tb, smem);
      conv_job(CvPlain{PIN(18) + (size_t)j * 65536, 1024, 1024}, wmix + 3735552, 64, 1024, 64, tb, smem);
      conv_job(CvPlain{PIN(20) + (size_t)j * 131072, 1024, 1024}, wmix + 3801088, 128, 1024, 128, tb, smem);
      conv_job(CvPlain{PIN(25) + (size_t)j * 1048576, 1024, 1024}, wmix + 3932160, 1024, 1024, 1024, tb, smem);
    } else if (type == 1) {
      conv_job(CvGlaIn{PIN(28), PIN(29)}, wmix, 1024, 3200, 1024, tb, smem);
      conv_job(CvPlain{PIN(33), 1024, 1024}, wmix + 3276800, 1024, 1024, 1024, tb, smem);
    } else {
      conv_job(CvPlain{PIN(34), 4112, 4112}, wmix, 1024, 4224, 1024, tb, smem);
      conv_job(CvPlain{PIN(39), 1024, 1024}, wmix + 4325376, 1024, 1024, 1024, tb, smem);
    }
    GSYNC();
    tb = 0;
    const bf16* wo;
    if (type == 0) {
      for (int i = 0; i < 3; ++i)
        gemm_job(GemmDesc{slot(p, 2 + i), nullptr, 1024, 1024, wmix + (size_t)i * 1048576, 1024, 144, 8, 1024}, EpiStore{slot(p, 5 + i), 1024, 1.f}, tb, smem);
      gemm_job(GemmDesc{slot(p, 0), slot(p, 1), 1024, 1024, wmix + 3145728, 2048, 144, 2, 2048}, EpiLora1{(bf16*)(PWS + WS_L1)}, tb, smem);
      GSYNC();
      tb = 0;
      const bf16* l1 = (const bf16*)(PWS + WS_L1);
      gemm_job(GemmDesc{l1, nullptr, 256, 64, wmix + 3670016, 64, 144, 8, 64}, EpiLd{slot(p, 2), PIN(13) + j * 1024}, tb, smem);
      gemm_job(GemmDesc{l1 + 64, nullptr, 256, 64, wmix + 3735552, 64, 144, 8, 64}, EpiSig{slot(p, 3), PIN(16) + j * 1024}, tb, smem);
      gemm_job(GemmDesc{l1 + 128, nullptr, 256, 128, wmix + 3801088, 128, 144, 8, 128}, EpiStore{slot(p, 4), 1024, 1.f}, tb, smem);
      GSYNC();
      if (EN(2)) phase_prep<0>(p, j, smem);
      GSYNC();
      if (EN(5)) phase_seq<0>(p, j);
      GSYNC();
      if (EN(8)) phase_post<0>(p, j, smem);
      wo = wmix + 3932160;
    } else if (type == 1) {
      gemm_job(GemmDesc{slot(p, 0), nullptr, 1024, 1024, wmix, 1024, 144, 25, 1024},
               EpiGlaIn{slot(p, 1), slot(p, 1) + (size_t)MT * 512, slot(p, 2), slot(p, 3), sm}, tb, smem);
      GSYNC();
      if (EN(3)) phase_prep<1>(p, j, smem);
      GSYNC();
      if (EN(6)) phase_seq<1>(p, j);
      GSYNC();
      if (EN(8)) phase_post<1>(p, j, smem);
      wo = wmix + 3276800;
    } else {
      gemm_job(GemmDesc{slot(p, 0), nullptr, 1024, 1024, wmix, 1024, 144, 33, 1024},
               EpiGdnIn{slot(p, 1), slot(p, 4), sm, POUT}, tb, smem);
      GSYNC();
      if (EN(9)) phase_gdn_conv(p);
      GSYNC();
      if (EN(4)) phase_prep<2>(p, j, smem);
      GSYNC();
      if (EN(7)) phase_seq<2>(p, j);
      GSYNC();
      if (EN(8)) phase_post<2>(p, j, smem);
      wo = wmix + 4325376;
    }
    GSYNC();
    tb = 0;
    gemm_job(GemmDesc{slot(p, type == 1 ? 0 : 1), nullptr, 1024, 1024, wo, 1024, 144, 8, 1024}, EpiAcc{POUT}, tb, smem);
    GSYNC();
    phase_rms(POUT, PIN(8) + layer * 1024, slot(p, 0), nullptr);
    GSYNC();
    tb = 0;
    gemm_job(GemmDesc{slot(p, 0), nullptr, 1024, 1024, wfin, 1024, 144, 44, 1024}, EpiSwiglu{slot(p, 1)}, tb, smem);
    GSYNC();
    tb = 0;
    gemm_job(GemmDesc{slot(p, 1), nullptr, FF, FF, wfout, FF, 144, 8, FF}, EpiAcc{POUT}, tb, smem);
    GSYNC();
  }
  phase_rms(POUT, PIN(9), nullptr, POUT);
}

extern "C" void kernel_launch(void* const* d_in, const int* in_sizes, int n_in, void* d_out, int out_size,
                              void* d_ws, size_t ws_size, hipStream_t stream) {
  if (n_in < 40 || ws_size < WS_TOTAL) { fprintf(stderr, "bad args: n_in %d ws %zu need %zu\n", n_in, ws_size, (size_t)WS_TOTAL); return; }
  static int grid_blocks = 0;
  if (!grid_blocks) {
    int dev = 0, cus = 0, per_cu = 0;
    hipGetDevice(&dev);
    hipDeviceGetAttribute(&cus, hipDeviceAttributeMultiprocessorCount, dev);
    hipFuncSetAttribute((const void*)fwd_megakernel, hipFuncAttributeMaxDynamicSharedMemorySize, LDS_BYTES);
    hipOccupancyMaxActiveBlocksPerMultiprocessor(&per_cu, (const void*)fwd_megakernel, 256, LDS_BYTES);
    if (per_cu > 2) per_cu = 2;
    if (per_cu < 1) per_cu = 1;
    grid_blocks = cus * per_cu;
  }
  P p{};
  for (int i = 0; i < 40; ++i) p.in[i] = (const float*)d_in[i];
  p.out = (float*)d_out; p.ws = (char*)d_ws;
  void* args[] = {&p};
  hipError_t e = hipLaunchCooperativeKernel((const void*)fwd_megakernel, dim3(grid_blocks), dim3(256), args, LDS_BYTES, stream);
  if (e != hipSuccess) fprintf(stderr, "cooperative launch failed: %s (grid %d)\n", hipGetErrorString(e), grid_blocks);
}
```

```cpp
#include <hip/hip_runtime.h>
#include <hip/hip_cooperative_groups.h>
#include <cstdio>
#include <cstdint>
namespace cg = cooperative_groups;

typedef unsigned short bf16;
typedef __attribute__((ext_vector_type(8))) short bf16x8;
typedef __attribute__((ext_vector_type(4))) short bf16x4;
typedef __attribute__((ext_vector_type(4))) float f32x4;

#define DEVI __device__ __forceinline__

constexpr int Dm = 1024, FF = 2816, MT = 18432, MPR = 16384, NSS = 32, NCHUNK = 288, NPCH = 256;
constexpr size_t SLOT = (size_t)MT * 1024 * 2;
constexpr size_t WS_L1 = 8 * SLOT;
constexpr size_t WS_SM = WS_L1 + (size_t)MT * 256 * 2;
constexpr size_t WS_GAM = WS_SM + (size_t)MT * 16 * 4;
constexpr size_t WS_W = WS_GAM + (size_t)NCHUNK * 1024 * 4;
constexpr size_t W_FIN = 0, W_FOUT = 5767168, W_MIX = 8650752;
constexpr size_t WS_TOTAL = WS_W + (size_t)14200000 * 2;
constexpr int LDS_BYTES = 77824;

constexpr size_t O_ASH_P = 18874368, O_AWKV_P = O_ASH_P + 2048, O_BKV_P = O_AWKV_P + 131072,
                 O_CCONV_P = O_BKV_P + 131072, O_CKV_P = O_CCONV_P + 9216, O_ASH_S = O_CKV_P + 131072,
                 O_AWKV_S = O_ASH_S + 65536, O_BKV_S = O_AWKV_S + 4194304, O_CCONV_S = O_BKV_S + 4194304,
                 O_CKV_S = O_CCONV_S + 294912;

struct P { const float* in[40]; float* out; char* ws; };
typedef const __attribute__((address_space(4))) char* kptr_t;
typedef const float* cfp_t; typedef float* fp_t; typedef char* cp_t;
DEVI kptr_t kbase() { kptr_t b = (kptr_t)__builtin_amdgcn_kernarg_segment_ptr(); asm volatile("" : "+s"(b)); return b; }
#define PIN(i) (*(const __attribute__((address_space(4))) cfp_t*)(kbase() + 8 * (i)))
#define POUT (*(const __attribute__((address_space(4))) fp_t*)(kbase() + 320))
#define PWS (*(const __attribute__((address_space(4))) cp_t*)(kbase() + 328))

DEVI bf16 f2bf(float f) { unsigned u = __float_as_uint(f); u += 0x7fffu + ((u >> 16) & 1u); return (bf16)(u >> 16); }
DEVI float bf2f(bf16 h) { return __uint_as_float(((unsigned)h) << 16); }
DEVI unsigned pack2(float a, float b) { return (unsigned)f2bf(a) | ((unsigned)f2bf(b) << 16); }
DEVI float wsum(float v) {
#pragma unroll
  for (int o = 32; o > 0; o >>= 1) v += __shfl_xor(v, o);
  return v;
}
DEVI float sigm(float x) { return 1.f / (1.f + __expf(-x)); }
DEVI float silu(float x) { return x * sigm(x); }
DEVI float softplus(float x) { return x > 20.f ? x : log1pf(__expf(x)); }
DEVI bf16* slot(const P& p, int i) { return (bf16*)(PWS + (size_t)i * SLOT); }

struct GemmDesc { const bf16* A; const bf16* A2; int lda; int ksplit; const bf16* Bt; int ldb; int tiles_m; int tiles_n; int K; };

template <class Epi>
DEVI void gemm_tile(const GemmDesc& g, int mt, int nt, Epi& epi, char* smem) {
  const int tid = threadIdx.x, lane = tid & 63, wave = tid >> 6;
  const int wm = wave >> 1, wn = wave & 1, lr = lane & 15, quad = lane >> 4;
  bf16* sA = (bf16*)smem;
  bf16* sB = sA + 2 * 8192;
  f32x4 acc[4][4];
#pragma unroll
  for (int i = 0; i < 4; ++i)
#pragma unroll
    for (int j = 0; j < 4; ++j) acc[i][j] = (f32x4){0.f, 0.f, 0.f, 0.f};
  const int m0 = mt * 128, n0 = nt * 128;
  const int r0 = tid >> 3, c0 = tid & 7;
  const size_t aoff = (size_t)(m0 + r0) * g.lda + c0 * 8;
  const bf16* bp = g.Bt + (size_t)(n0 + r0) * g.ldb + c0 * 8;
  const int soff = r0 * 64 + ((c0 ^ (r0 & 7)) << 3);
typedef __attribute__((ext_vector_type(4))) unsigned u32x4;
#define GL1(i_, RA, RB) RA##i_ = *(const u32x4*)(base_ + (size_t)(32 * i_) * g.lda); RB##i_ = *(const u32x4*)(bp + k0_ + (size_t)(32 * i_) * g.ldb);
#define GLOAD(kt_, RA, RB) do { const int k0_ = (kt_) << 6; \
    const bf16* base_ = ((k0_ < g.ksplit) ? (g.A + k0_) : (g.A2 + (k0_ - g.ksplit))) + aoff; \
    GL1(0, RA, RB) GL1(1, RA, RB) GL1(2, RA, RB) GL1(3, RA, RB) } while (0)
#define LS1(buf_, i_, RA, RB) *(u32x4*)(sA + (buf_) * 8192 + soff + i_ * 2048) = RA##i_; *(u32x4*)(sB + (buf_) * 8192 + soff + i_ * 2048) = RB##i_;
#define LSTORE(buf_, RA, RB) do { LS1(buf_, 0, RA, RB) LS1(buf_, 1, RA, RB) LS1(buf_, 2, RA, RB) LS1(buf_, 3, RA, RB) } while (0)
#define GSTEP(kt_, RA, RB) do { const int buf_ = (kt_) & 1; \
    const bf16* a_ = sA + buf_ * 8192 + (wm * 64 + lr) * 64; const bf16* b_ = sB + buf_ * 8192 + (wn * 64 + lr) * 64; \
    _Pragma("unroll") for (int ks_ = 0; ks_ < 2; ++ks_) { \
      const int co_ = (((ks_ * 4 + quad) ^ (lr & 7)) << 3); bf16x8 af_[4], bf_[4]; \
      _Pragma("unroll") for (int i_ = 0; i_ < 4; ++i_) { af_[i_] = *(const bf16x8*)(a_ + i_ * 1024 + co_); bf_[i_] = *(const bf16x8*)(b_ + i_ * 1024 + co_); } \
      _Pragma("unroll") for (int i_ = 0; i_ < 4; ++i_) _Pragma("unroll") for (int j_ = 0; j_ < 4; ++j_) \
        acc[i_][j_] = __builtin_amdgcn_mfma_f32_16x16x32_bf16(af_[i_], bf_[j_], acc[i_][j_], 0, 0, 0); } \
    if ((kt_) + 1 < nk) { LSTORE(buf_ ^ 1, RA, RB); if ((kt_) + 3 < nk) GLOAD((kt_) + 3, RA, RB); } \
    __syncthreads(); } while (0)
  const int nk = g.K >> 6;
  u32x4 pa0, pa1, pa2, pa3, pb0, pb1, pb2, pb3, qa0, qa1, qa2, qa3, qb0, qb1, qb2, qb3;
  qa0 = qa1 = qa2 = qa3 = qb0 = qb1 = qb2 = qb3 = (u32x4){0u, 0u, 0u, 0u};
  GLOAD(0, pa, pb);
  if (nk > 1) GLOAD(1, qa, qb);
  LSTORE(0, pa, pb);
  if (nk > 2) GLOAD(2, pa, pb);
  __syncthreads();
  for (int kt = 0; kt < nk; kt += 2) { GSTEP(kt, qa, qb); if (kt + 1 < nk) GSTEP(kt + 1, pa, pb); }
#pragma unroll
  for (int i = 0; i < 4; ++i) {
#pragma unroll
    for (int jj = 0; jj < 4; ++jj) {
      const int row = m0 + wm * 64 + i * 16 + quad * 4 + jj;
      if constexpr (Epi::PAIR) {
#pragma unroll
        for (int j = 0; j < 4; j += 2) {
          const int nn = n0 + wn * 64 + j * 16;
          epi.pair(row, (nn >> 5) * 16 + lr, acc[i][j][jj], acc[i][j + 1][jj]);
        }
      } else {
#pragma unroll
        for (int j = 0; j < 4; ++j) epi(row, n0 + wn * 64 + j * 16 + lr, acc[i][j][jj]);
      }
    }
  }
}

template <class Epi>
DEVI void gemm_job(const GemmDesc& g, Epi epi, int& tbase, char* smem) {
  const int ntiles = g.tiles_m * g.tiles_n, G = gridDim.x;
  const int first = tbase + (((int)blockIdx.x - tbase % G) + G) % G;
  const int width = 8 * g.tiles_n;
  for (int t = first; t < tbase + ntiles; t += G) {
    const int lt = t - tbase;
    const int grp = lt / width, rem = lt % width;
    gemm_tile(g, grp * 8 + (rem & 7), rem >> 3, epi, smem);
  }
  tbase += ntiles;
}

struct EpiStore { static constexpr bool PAIR = false; bf16* C; int ldc; float sc;
  DEVI void operator()(int r, int c, float v) { C[(size_t)r * ldc + c] = f2bf(v * sc); } };
struct EpiLora1 { static constexpr bool PAIR = false; bf16* C;
  DEVI void operator()(int r, int c, float v) { float o = c < 64 ? tanhf(v) : (c < 128 ? v : sigm(v)); C[(size_t)r * 256 + c] = f2bf(o); } };
struct EpiLd { static constexpr bool PAIR = false; bf16* C; const float* w0;
  DEVI void operator()(int r, int c, float v) { float x = w0[c] + v; float lr_ = -softplus(-x) - 0.5f; C[(size_t)r * 1024 + c] = f2bf(-__expf(lr_)); } };
struct EpiSig { static constexpr bool PAIR = false; bf16* C; const float* a0;
  DEVI void operator()(int r, int c, float v) { C[(size_t)r * 1024 + c] = f2bf(sigm(a0[c] + v)); } };
struct EpiAcc { static constexpr bool PAIR = false; float* X;
  DEVI void operator()(int r, int c, float v) { X[(size_t)r * 1024 + c] += v; } };
struct EpiSwiglu { static constexpr bool PAIR = true; bf16* C;
  DEVI void pair(int r, int c, float gt, float up) { C[(size_t)r * FF + c] = f2bf(silu(gt) * up); } };
struct EpiGlaIn { static constexpr bool PAIR = false; bf16 *q, *k, *v, *gate; float* sm;
  DEVI void operator()(int r, int c, float x) {
    if (c < 512) q[(size_t)r * 512 + c] = f2bf(x * 0.08838834764831845f);
    else if (c < 1024) k[(size_t)r * 512 + c - 512] = f2bf(x);
    else if (c < 2048) v[(size_t)r * 1024 + c - 1024] = f2bf(x);
    else if (c < 3072) gate[(size_t)r * 1024 + c - 2048] = f2bf(x);
    else if (c < 3088) sm[(size_t)r * 16 + c - 3072] = x;
  } };
struct EpiGdnIn { static constexpr bool PAIR = false; bf16 *qkv, *z; float* sm; float* out;
  DEVI void operator()(int r, int c, float x) {
    if (c < 3072) {
      qkv[(size_t)r * 3072 + c] = f2bf(x);
      if (r >= MPR - 3) {
        if (r < MPR) out[O_CCONV_P + (size_t)(r - (MPR - 3)) * 3072 + c] = x;
        else { int tt = (r - MPR) & 63; if (tt >= 61) out[O_CCONV_S + ((size_t)((r - MPR) >> 6) * 3 + (tt - 61)) * 3072 + c] = x; }
      }
    } else if (c < 4096) z[(size_t)r * 1024 + c - 3072] = f2bf(x);
    else if (c < 4112) sm[(size_t)r * 16 + c - 4096] = x;
  } };

template <class F>
DEVI void conv_job(F f, bf16* dst, int ldo, int Nd, int Kd, int& tbase, char* smem) {
  float* tile = (float*)smem;
  const int tn = Nd >> 6, tk = Kd >> 6, ntiles = tn * tk, G = gridDim.x, tid = threadIdx.x;
  const int first = tbase + (((int)blockIdx.x - tbase % G) + G) % G;
  for (int t = first; t < tbase + ntiles; t += G) {
    const int lt = t - tbase, n0 = (lt % tn) << 6, k0 = (lt / tn) << 6;
    const int i = tid >> 4, j4 = (tid & 15) << 2;
#pragma unroll
    for (int r = 0; r < 4; ++r) {
      float4 v = f(k0 + i + 16 * r, n0 + j4);
      float* d = tile + (i + 16 * r) * 65 + j4; d[0] = v.x; d[1] = v.y; d[2] = v.z; d[3] = v.w;
    }
    __syncthreads();
    const int jn = tid >> 2, iq = (tid & 3) << 4;
    unsigned w[8];
#pragma unroll
    for (int e = 0; e < 8; ++e) w[e] = pack2(tile[(iq + 2 * e) * 65 + jn], tile[(iq + 2 * e + 1) * 65 + jn]);
    uint4* o = (uint4*)(dst + (size_t)(n0 + jn) * ldo + k0 + iq);
    o[0] = make_uint4(w[0], w[1], w[2], w[3]); o[1] = make_uint4(w[4], w[5], w[6], w[7]);
    __syncthreads();
  }
  tbase += ntiles;
}
struct CvPlain { const float* W; int ld; int nsrc;
  DEVI float4 operator()(int k, int n) const { return n < nsrc ? *(const float4*)(W + (size_t)k * ld + n) : make_float4(0, 0, 0, 0); } };
struct CvFfnIn { const float* W;
  DEVI float4 operator()(int k, int n) const { int blk = n >> 5, w = n & 31; int src = (w < 16) ? blk * 16 + w : FF + blk * 16 + (w - 16);
    return *(const float4*)(W + (size_t)k * (2 * FF) + src); } };
struct CvLora1 { const float *w1, *a1, *g1, *mu;
  DEVI float4 operator()(int k, int n) const {
    int kk = k & 1023; float4 v; float m;
    if (n < 64) { v = *(const float4*)(w1 + kk * 64 + n); m = mu[1 * 1024 + kk]; }
    else if (n < 128) { v = *(const float4*)(a1 + kk * 64 + n - 64); m = mu[4 * 1024 + kk]; }
    else { v = *(const float4*)(g1 + kk * 128 + n - 128); m = mu[5 * 1024 + kk]; }
    float s = (k < 1024) ? (1.f - m) : m;
    return make_float4(v.x * s, v.y * s, v.z * s, v.w * s); } };
struct CvGlaIn { const float *win, *wa1;
  DEVI float4 operator()(int k, int n) const {
    if (n < 3072) return *(const float4*)(win + (size_t)k * 3072 + n);
    if (n < 3088) return *(const float4*)(wa1 + k * 16 + n - 3072);
    return make_float4(0, 0, 0, 0); } };

template <int TYPE>
DEVI void phase_norm(const P& p, int layer, int j, bool from_input, bool copy_x) {
  const int lane = threadIdx.x & 63, wave = threadIdx.x >> 6;
  const float* g = PIN(7) + layer * 1024;
  float* xres = POUT;
  bf16 *h = slot(p, 0), *hs = slot(p, 1), *xr = slot(p, 2), *xk = slot(p, 3), *xv = slot(p, 4);
  const float* mu = PIN(12) + (size_t)j * 6 * 1024;
  for (int row = blockIdx.x * 4 + wave; row < MT; row += gridDim.x * 4) {
    auto src = [&](int r) -> const float* {
      if (from_input) return r < MPR ? PIN(0) + (size_t)r * 1024 : PIN(1) + (size_t)(r - MPR) * 1024;
      return xres + (size_t)r * 1024; };
    const float* xp = src(row);
    float4 xv4[4]; float ss = 0.f;
#pragma unroll
    for (int i = 0; i < 4; ++i) { xv4[i] = *(const float4*)(xp + i * 256 + lane * 4); ss += xv4[i].x * xv4[i].x + xv4[i].y * xv4[i].y + xv4[i].z * xv4[i].z + xv4[i].w * xv4[i].w; }
    ss = wsum(ss);
    const float rstd = rsqrtf(ss * (1.f / 1024.f) + 1e-6f);
    if (copy_x) {
#pragma unroll
      for (int i = 0; i < 4; ++i) *(float4*)(xres + (size_t)row * 1024 + i * 256 + lane * 4) = xv4[i];
    }
    float hv[16];
#pragma unroll
    for (int i = 0; i < 4; ++i) { float4 gg = *(const float4*)(g + i * 256 + lane * 4);
      hv[i * 4 + 0] = xv4[i].x * rstd * gg.x; hv[i * 4 + 1] = xv4[i].y * rstd * gg.y; hv[i * 4 + 2] = xv4[i].z * rstd * gg.z; hv[i * 4 + 3] = xv4[i].w * rstd * gg.w; }
#pragma unroll
    for (int i = 0; i < 4; ++i) *(uint2*)(h + (size_t)row * 1024 + i * 256 + lane * 4) = make_uint2(pack2(hv[i * 4], hv[i * 4 + 1]), pack2(hv[i * 4 + 2], hv[i * 4 + 3]));
    if constexpr (TYPE == 0) {
      const bool is_p = row < MPR; const int tt = is_p ? row : ((row - MPR) & 63); const int b = is_p ? 0 : ((row - MPR) >> 6);
      float hp[16];
      if (tt == 0) {
        if (is_p) {
#pragma unroll
          for (int i = 0; i < 16; ++i) hp[i] = 0.f;
        } else {
          const float* sp = PIN(2) + ((size_t)j * NSS + b) * 1024;
#pragma unroll
          for (int i = 0; i < 4; ++i) { float4 v = *(const float4*)(sp + i * 256 + lane * 4); hp[i * 4] = v.x; hp[i * 4 + 1] = v.y; hp[i * 4 + 2] = v.z; hp[i * 4 + 3] = v.w; }
        }
      } else {
        const float* pp = src(row - 1); float4 pv[4]; float s2 = 0.f;
#pragma unroll
        for (int i = 0; i < 4; ++i) { pv[i] = *(const float4*)(pp + i * 256 + lane * 4); s2 += pv[i].x * pv[i].x + pv[i].y * pv[i].y + pv[i].z * pv[i].z + pv[i].w * pv[i].w; }
        s2 = wsum(s2); const float r2 = rsqrtf(s2 * (1.f / 1024.f) + 1e-6f);
#pragma unroll
        for (int i = 0; i < 4; ++i) { float4 gg = *(const float4*)(g + i * 256 + lane * 4);
          hp[i * 4] = pv[i].x * r2 * gg.x; hp[i * 4 + 1] = pv[i].y * r2 * gg.y; hp[i * 4 + 2] = pv[i].z * r2 * gg.z; hp[i * 4 + 3] = pv[i].w * r2 * gg.w; }
      }
#pragma unroll
      for (int i = 0; i < 4; ++i) {
        const int col = i * 256 + lane * 4; const size_t o = (size_t)row * 1024 + col;
        float4 m0 = *(const float4*)(mu + 0 * 1024 + col), m2 = *(const float4*)(mu + 2 * 1024 + col), m3 = *(const float4*)(mu + 3 * 1024 + col);
        const float mm0[4] = {m0.x, m0.y, m0.z, m0.w}, mm2[4] = {m2.x, m2.y, m2.z, m2.w}, mm3[4] = {m3.x, m3.y, m3.z, m3.w};
        float a[4], bb[4], c[4];
#pragma unroll
        for (int e = 0; e < 4; ++e) { float hh = hv[i * 4 + e], xx = hp[i * 4 + e] - hh; a[e] = hh + xx * mm0[e]; bb[e] = hh + xx * mm2[e]; c[e] = hh + xx * mm3[e]; }
        *(uint2*)(hs + o) = make_uint2(pack2(hp[i * 4], hp[i * 4 + 1]), pack2(hp[i * 4 + 2], hp[i * 4 + 3]));
        *(uint2*)(xr + o) = make_uint2(pack2(a[0], a[1]), pack2(a[2], a[3]));
        *(uint2*)(xk + o) = make_uint2(pack2(bb[0], bb[1]), pack2(bb[2], bb[3]));
        *(uint2*)(xv + o) = make_uint2(pack2(c[0], c[1]), pack2(c[2], c[3]));
      }
      if (is_p ? (row == MPR - 1) : (tt == 63)) {
        float* o = POUT + (is_p ? O_ASH_P + (size_t)j * 1024 : O_ASH_S + ((size_t)j * NSS + b) * 1024);
#pragma unroll
        for (int i = 0; i < 4; ++i) *(float4*)(o + i * 256 + lane * 4) = make_float4(hv[i * 4], hv[i * 4 + 1], hv[i * 4 + 2], hv[i * 4 + 3]);
      }
    }
  }
}

DEVI void phase_rms(const float* x, const float* g, bf16* dst, float* fdst) {
  const int lane = threadIdx.x & 63, wave = threadIdx.x >> 6;
  for (int row = blockIdx.x * 4 + wave; row < MT; row += gridDim.x * 4) {
    const float* xp = x + (size_t)row * 1024; float4 v[4]; float ss = 0.f;
#pragma unroll
    for (int i = 0; i < 4; ++i) { v[i] = *(const float4*)(xp + i * 256 + lane * 4); ss += v[i].x * v[i].x + v[i].y * v[i].y + v[i].z * v[i].z + v[i].w * v[i].w; }
    ss = wsum(ss); const float r = rsqrtf(ss * (1.f / 1024.f) + 1e-6f);
#pragma unroll
    for (int i = 0; i < 4; ++i) { float4 gg = *(const float4*)(g + i * 256 + lane * 4);
      float a = v[i].x * r * gg.x, b = v[i].y * r * gg.y, c = v[i].z * r * gg.z, d = v[i].w * r * gg.w;
      if (dst) *(uint2*)(dst + (size_t)row * 1024 + i * 256 + lane * 4) = make_uint2(pack2(a, b), pack2(c, d));
      else *(float4*)(fdst + (size_t)row * 1024 + i * 256 + lane * 4) = make_float4(a, b, c, d); }
  }
}

DEVI void phase_gdn_conv(const P& p) {
  const bf16* qkv = slot(p, 1); const float* cw = PIN(35); const float* cst = PIN(5);
  const int tid = threadIdx.x, lane = tid & 63;
  for (int item = blockIdx.x; item < MT * 3; item += gridDim.x) {
    const int row = item / 3, sec = item % 3, ch = sec * 1024 + tid * 4;
    const bool is_p = row < MPR; const int tt = is_p ? row : ((row - MPR) & 63); const int b = is_p ? 0 : ((row - MPR) >> 6);
    float acc[4] = {0.f, 0.f, 0.f, 0.f};
#pragma unroll
    for (int i = 0; i < 4; ++i) {
      const int pt = tt + i;
      float4 w = *(const float4*)(cw + i * 3072 + ch); float x[4];
      if (pt >= 3) { uint2 u = *(const uint2*)(qkv + (size_t)(row + i - 3) * 3072 + ch);
        x[0] = bf2f(u.x & 0xffff); x[1] = bf2f(u.x >> 16); x[2] = bf2f(u.y & 0xffff); x[3] = bf2f(u.y >> 16); }
      else if (!is_p) { float4 s = *(const float4*)(cst + ((size_t)b * 3 + pt) * 3072 + ch); x[0] = s.x; x[1] = s.y; x[2] = s.z; x[3] = s.w; }
      else { x[0] = x[1] = x[2] = x[3] = 0.f; }
      acc[0] += x[0] * w.x; acc[1] += x[1] * w.y; acc[2] += x[2] * w.z; acc[3] += x[3] * w.w;
    }
#pragma unroll
    for (int e = 0; e < 4; ++e) acc[e] = silu(acc[e]);
    if (sec < 2) {
      float ss = acc[0] * acc[0] + acc[1] * acc[1] + acc[2] * acc[2] + acc[3] * acc[3];
#pragma unroll
      for (int o = 16; o > 0; o >>= 1) ss += __shfl_xor(ss, o);
      float r = rsqrtf(ss + 1e-6f) * (sec == 0 ? 0.08838834764831845f : 1.f);
#pragma unroll
      for (int e = 0; e < 4; ++e) acc[e] *= r;
    }
    (void)lane;
    *(uint2*)(slot(p, 5 + sec) + (size_t)row * 1024 + tid * 4) = make_uint2(pack2(acc[0], acc[1]), pack2(acc[2], acc[3]));
  }
}

DEVI void mm_strip(const bf16* At, const bf16* Bt, f32x4 (&acc)[4], int wave, int lane) {
  const int lr = lane & 15, quad = lane >> 4;
#pragma unroll
  for (int ks = 0; ks < 2; ++ks) {
    bf16x8 a = *(const bf16x8*)(At + (wave * 16 + lr) * 72 + ks * 32 + quad * 8);
#pragma unroll
    for (int nb = 0; nb < 4; ++nb) {
      bf16x8 b = *(const bf16x8*)(Bt + (nb * 16 + lr) * 72 + ks * 32 + quad * 8);
      acc[nb] = __builtin_amdgcn_mfma_f32_16x16x32_bf16(a, b, acc[nb], 0, 0, 0);
    }
  }
}
DEVI void zero4(f32x4 (&a)[4]) {
#pragma unroll
  for (int i = 0; i < 4; ++i) a[i] = (f32x4){0.f, 0.f, 0.f, 0.f};
}

template <int CW> DEVI size_t cont_off(int r, int s, int LD) { const int idx = r * 64 + s; return (size_t)(idx / CW) * LD + (idx % CW); }

template <int TYPE>
DEVI void phase_prep(const P& p, int j, char* smem) {
  constexpr int NH = TYPE == 0 ? 16 : (TYPE == 1 ? 4 : 8);
  constexpr int DK = TYPE == 0 ? 64 : 128;
  constexpr int DV = TYPE == 0 ? 64 : (TYPE == 1 ? 256 : 128);
  constexpr bool LOW = TYPE != 1;
  constexpr int KT = 256 / DK, TPT = 64 / KT, DKH = DK / 64, DVH = DV / 64;
  constexpr int LDQ = TYPE == 1 ? 512 : 1024;
  bf16* X0 = (bf16*)smem; bf16* X1 = X0 + 4608; bf16* Y0 = X1 + 4608; bf16* Y1 = Y0 + 4608;
  float* Lb = (float*)smem;
  bf16* LkT = (bf16*)(smem + 16384); bf16* Ak = LkT + 4608; bf16* nAb = Ak + 4608;
  bf16* M1 = (bf16*)smem;
  bf16* Tt = (bf16*)(smem + 44032); bf16* St1 = Tt + 4608; bf16* St2 = St1 + 4608;
  if (TYPE == 1) { Y0 = (bf16*)(smem + 9216); Ak = (bf16*)(smem + 18432); St1 = (bf16*)(smem + 27648); }
  float* lgL = (float*)(smem + 36864);
  float* tot = (float*)(smem + 71680);
  float* sc_beta = (float*)(smem + 73728);
  float* sc_eg = sc_beta + 64; float* sc_lg = sc_eg + 64; float* sc_g = sc_lg + 64;

  bf16 *Aq, *Akk, *Av, *Ald = nullptr, *Aa = nullptr, *Oq, *Okt, *Ovt, *Ow = nullptr, *Obt = nullptr, *Ool, *Ou0 = nullptr;
  if (TYPE == 0) { Aq = slot(p, 5); Akk = slot(p, 6); Av = slot(p, 7); Ald = slot(p, 2); Aa = slot(p, 3);
    Oq = Aq; Okt = Akk; Ovt = Av; Ow = Ald; Obt = Aa; Ool = slot(p, 0); Ou0 = slot(p, 1); }
  else if (TYPE == 1) { Aq = slot(p, 1); Akk = slot(p, 1) + (size_t)MT * 512; Av = slot(p, 2); Oq = Aq; Okt = Akk; Ovt = Av; Ool = slot(p, 4); }
  else { Aq = slot(p, 5); Akk = slot(p, 6); Av = slot(p, 7); Oq = Aq; Okt = Akk; Ovt = Av; Ow = slot(p, 1); Obt = slot(p, 2); Ool = slot(p, 3); Ou0 = slot(p, 0); }
  float* sm = (float*)(PWS + WS_SM);
  float* gam = (float*)(PWS + WS_GAM);

  for (int item = blockIdx.x; item < NCHUNK * NH; item += gridDim.x) {
    const int c = item / NH, h = item % NH;
    const size_t rb = (size_t)c * 64;
    int tid = threadIdx.x; asm volatile("" : "+v"(tid));
    const int lane = tid & 63, wave = tid >> 6, lr = lane & 15, quad = lane >> 4;
    const int k = tid % DK, tg = tid / DK;
    const int vv = tid & 63, tgv = tid >> 6;
    unsigned qP[TPT / 2], ktP[TPT / 2], kapP[(TYPE == 0) ? TPT / 2 : 1], bvP[(TYPE == 0) ? TPT / 2 : 1];
    float lg[(TYPE == 0) ? TPT : 1], ldv[(TYPE == 0) ? TPT : 1];
    unsigned vP[DVH][8];
    auto lo16 = [](unsigned w) { return __uint_as_float(w << 16); };
    auto hi16 = [](unsigned w) { return __uint_as_float(w & 0xffff0000u); };
#define GETP(arr, e) (((e) & 1) ? hi16(arr[(e) >> 1]) : lo16(arr[(e) >> 1]))
#pragma unroll
    for (int vh = 0; vh < DVH; ++vh)
#pragma unroll
      for (int e = 0; e < 8; ++e) {
        const bf16 a = Av[(rb + tgv * 16 + 2 * e) * 1024 + h * DV + vh * 64 + vv], b = Av[(rb + tgv * 16 + 2 * e + 1) * 1024 + h * DV + vh * 64 + vv];
        vP[vh][e] = (unsigned)a | ((unsigned)b << 16);
        asm volatile("" : "+v"(vP[vh][e]));
      }
    if constexpr (TYPE == 2) {
      if (tid < 64) {
        const float a_log = PIN(36)[h], dtb = PIN(37)[h];
        const float braw = sm[(rb + tid) * 16 + h], araw = sm[(rb + tid) * 16 + 8 + h];
        const float gt = -__expf(a_log) * softplus(araw + dtb);
        sc_beta[tid] = sigm(braw); sc_eg[tid] = __expf(gt); sc_g[tid] = gt;
        float cs = gt;
#pragma unroll
        for (int o = 1; o < 64; o <<= 1) { float n = __shfl_up(cs, o); if (lane >= o) cs += n; }
        sc_lg[tid] = cs;
      }
      __syncthreads();
    }
    if constexpr (TYPE == 0) {
      const float k_k = PIN(21)[j * 1024 + h * 64 + k], k_a = PIN(22)[j * 1024 + h * 64 + k], r_k = PIN(23)[j * 1024 + h * 64 + k];
      float run = 0.f;
#pragma unroll
      for (int e2 = 0; e2 < TPT / 2; ++e2) {
        float qq[2], ka[2], kq[2], bq[2];
#pragma unroll
        for (int u = 0; u < 2; ++u) {
          const int e = e2 * 2 + u;
          const size_t o = (rb + tg * TPT + e) * 1024 + h * 64 + k;
          const float r = bf2f(Aq[o]), kr = bf2f(Akk[o]), av = bf2f(Aa[o]), l = bf2f(Ald[o]);
          const float kk = kr * k_k;
          const float inv = rsqrtf(fmaxf(wsum(kk * kk), 1e-24f));
          qq[u] = r; ka[u] = kk * inv; kq[u] = kr * (1.f + (av - 1.f) * k_a); bq[u] = ka[u] * av; ldv[e] = l;
          const float bo = wsum(r * kq[u] * r_k);
          if (lane == 0) sm[(rb + tg * TPT + e) * 16 + h] = bo;
          run += l; lg[e] = run;
        }
        qP[e2] = pack2(qq[0], qq[1]); kapP[e2] = pack2(ka[0], ka[1]); ktP[e2] = pack2(kq[0], kq[1]); bvP[e2] = pack2(bq[0], bq[1]);
        asm volatile("" : "+v"(qP[e2]), "+v"(kapP[e2]), "+v"(ktP[e2]), "+v"(bvP[e2]));
      }
      tot[tg * 128 + k] = run;
    } else if constexpr (TYPE == 1) {
      float w2[16];
#pragma unroll
      for (int i = 0; i < 16; ++i) w2[i] = PIN(30)[i * 512 + h * 128 + k];
      const float ba = PIN(31)[h * 128 + k];
      float run = 0.f;
#pragma unroll
      for (int e = 0; e < TPT; ++e) {
        const size_t row = rb + tg * TPT + e;
        float s = ba;
#pragma unroll
        for (int i = 0; i < 16; ++i) s += sm[row * 16 + i] * w2[i];
        const float gk = (fminf(s, 0.f) - log1pf(__expf(-fabsf(s)))) * (1.f / 16.f);
        run += gk; lgL[(tg * TPT + e) * 128 + k] = run;
        __builtin_amdgcn_sched_barrier(0);
      }
#pragma unroll
      for (int e2 = 0; e2 < TPT / 2; ++e2) {
        const size_t row = rb + tg * TPT + 2 * e2;
        qP[e2] = (unsigned)Aq[row * 512 + h * 128 + k] | ((unsigned)Aq[(row + 1) * 512 + h * 128 + k] << 16);
        ktP[e2] = (unsigned)Akk[row * 512 + h * 128 + k] | ((unsigned)Akk[(row + 1) * 512 + h * 128 + k] << 16);
        asm volatile("" : "+v"(qP[e2]), "+v"(ktP[e2]));
      }
      tot[tg * 128 + k] = run;
    } else {
#pragma unroll
      for (int e2 = 0; e2 < TPT / 2; ++e2) {
        const size_t o = (rb + tg * TPT + 2 * e2) * 1024 + h * 128 + k;
        qP[e2] = (unsigned)Aq[o] | ((unsigned)Aq[o + 1024] << 16);
        ktP[e2] = (unsigned)Akk[o] | ((unsigned)Akk[o + 1024] << 16);
        asm volatile("" : "+v"(qP[e2]), "+v"(ktP[e2]));
      }
    }
    __syncthreads();
    float lgC;
    if constexpr (TYPE == 2) { lgC = sc_lg[63]; }
    else {
      float off = 0.f, all = 0.f;
#pragma unroll
      for (int g2 = 0; g2 < KT; ++g2) { const float tv = tot[g2 * 128 + k]; all += tv; if (g2 < tg) off += tv; }
      if constexpr (TYPE == 0) {
#pragma unroll
        for (int e = 0; e < TPT; ++e) lg[e] += off;
      } else {
#pragma unroll
        for (int e = 0; e < TPT; ++e) lgL[(tg * TPT + e) * 128 + k] += off;
      }
      lgC = all;
    }
#define QV(e) GETP(qP, e)
#define LGV(e, t) ((TYPE == 2) ? sc_lg[t] : ((TYPE == 1) ? lgL[(t) * 128 + k] : lg[(TYPE == 0) ? (e) : 0]))
#define LPREV(e, t) ((TYPE == 0) ? (lg[(TYPE == 0) ? (e) : 0] - ldv[(TYPE == 0) ? (e) : 0]) : (sc_lg[t] - sc_g[t]))
#define KTV(e, t) ((TYPE == 2) ? (sc_beta[t] * GETP(ktP, e)) : GETP(ktP, e))
#define KAPV(e, t) ((TYPE == 2) ? GETP(ktP, e) : GETP(kapP, (TYPE == 0) ? (e) : 0))
#define BVV(e, t) ((TYPE == 2) ? (sc_beta[t] * sc_eg[t] * GETP(ktP, e)) : GETP(bvP, (TYPE == 0) ? (e) : 0))
    f32x4 sacc[LOW ? 4 : 1][4];
#pragma unroll
    for (int a = 0; a < (LOW ? 4 : 1); ++a) zero4(sacc[a]);
#pragma unroll
    for (int kh = 0; kh < DKH; ++kh) {
      if (k / 64 == kh) {
        const int kk = k & 63;
#pragma unroll
        for (int e = 0; e < TPT; ++e) {
          const int t = tg * TPT + e;
          if constexpr (TYPE == 2) {
            X0[t * 72 + kk] = f2bf(QV(e)); Y0[t * 72 + kk] = f2bf(KTV(e, t));
            X1[t * 72 + kk] = f2bf(KAPV(e, t)); Y1[t * 72 + kk] = f2bf(BVV(e, t));
          } else {
            const float lgt = LGV(e, t);
            const float el = __expf(lgt), eml = __expf(-lgt);
            X0[t * 72 + kk] = f2bf(QV(e) * el);
            Y0[t * 72 + kk] = f2bf(KTV(e, t) * eml);
            if constexpr (LOW) {
              X1[t * 72 + kk] = f2bf(KAPV(e, t) * __expf(LPREV(e, t)));
              Y1[t * 72 + kk] = f2bf(BVV(e, t) * eml);
            }
          }
          __builtin_amdgcn_sched_barrier(0);
        }
      }
      __syncthreads();
      mm_strip(X0, Y0, sacc[0], wave, lane);
      if constexpr (LOW) { mm_strip(X0, Y1, sacc[1], wave, lane); mm_strip(X1, Y0, sacc[2], wave, lane); mm_strip(X1, Y1, sacc[3], wave, lane); }
      __syncthreads();
    }
#pragma unroll
    for (int nb = 0; nb < 4; ++nb)
#pragma unroll
      for (int jj = 0; jj < 4; ++jj) {
        const int t = wave * 16 + quad * 4 + jj, s = nb * 16 + lr;
        float da = 1.f, dl = 1.f;
        if constexpr (TYPE == 2) { const float dd = sc_lg[t] - sc_lg[s]; da = __expf(fminf(dd, 0.f)); dl = __expf(fminf(dd - sc_g[t], 0.f)); }
        Ak[t * 72 + s] = f2bf(s <= t ? sacc[0][nb][jj] * da : 0.f);
        if constexpr (LOW) {
          nAb[t * 72 + s] = f2bf(s <= t ? -sacc[1][nb][jj] * da : 0.f);
          LkT[s * 72 + t] = f2bf(s < t ? sacc[2][nb][jj] * dl : 0.f);
          Lb[t * 64 + (s & 3) * 16 + (s >> 2)] = s < t ? sacc[3][nb][jj] * dl : 0.f;
        }
      }
    __syncthreads();
    f32x4 acc[4];
    if constexpr (LOW) {
      {
        const int q = lane & 3, jc = wave * 16 + (lane >> 2);
        float xr[16];
#pragma unroll
        for (int i = 0; i < 16; ++i) xr[i] = 0.f;
#pragma unroll
        for (int t = 0; t < 64; ++t) {
          float s = 0.f;
          const float* Lr = Lb + t * 64 + q * 16;
#pragma unroll
          for (int i = 0; i < (t + 3) / 4; ++i) s += Lr[i] * xr[i];
          s += __shfl_xor(s, 1); s += __shfl_xor(s, 2);
          s = ((t == jc) ? 1.f : 0.f) - s;
          xr[t >> 2] = (q == (t & 3)) ? s : xr[t >> 2];
          if (q == 0) Tt[t * 72 + jc] = f2bf(s);
          __builtin_amdgcn_sched_barrier(0);
        }
      }
      __syncthreads();
      zero4(acc); mm_strip(Tt, LkT, acc, wave, lane);
#pragma unroll
      for (int nb = 0; nb < 4; ++nb)
#pragma unroll
        for (int jj = 0; jj < 4; ++jj) M1[(wave * 16 + quad * 4 + jj) * 72 + nb * 16 + lr] = f2bf(acc[nb][jj]);
      __syncthreads();
    }
#pragma unroll
    for (int vh = 0; vh < DVH; ++vh) {
#pragma unroll
      for (int e = 0; e < 8; ++e) *(unsigned*)(St1 + vv * 72 + tgv * 16 + 2 * e) = vP[vh][e];
      __syncthreads();
      if constexpr (LOW) {
        zero4(acc); mm_strip(M1, St1, acc, wave, lane);
#pragma unroll
        for (int nb = 0; nb < 4; ++nb)
#pragma unroll
          for (int jj = 0; jj < 4; ++jj) {
            const int t = wave * 16 + quad * 4 + jj, col = nb * 16 + lr; const bf16 u = f2bf(acc[nb][jj]);
            St2[col * 72 + t] = u;
          }
#pragma unroll
        for (int nb = 0; nb < 4; ++nb)
          *(uint2*)(Ou0 + (((((size_t)c * NH + h) * (DV / 16) + vh * 4 + nb) * 4 + wave) * 64 + lane) * 4) = make_uint2(pack2(acc[nb][0], acc[nb][1]), pack2(acc[nb][2], acc[nb][3]));
        __syncthreads();
      }
      zero4(acc); mm_strip(Ak, St1, acc, wave, lane);
      if constexpr (LOW) mm_strip(nAb, St2, acc, wave, lane);
#pragma unroll
      for (int nb = 0; nb < 4; ++nb)
        *(uint2*)(Ool + (((((size_t)c * NH + h) * (DV / 16) + vh * 4 + nb) * 4 + wave) * 64 + lane) * 4) = make_uint2(pack2(acc[nb][0], acc[nb][1]), pack2(acc[nb][2], acc[nb][3]));
      __syncthreads();
    }
    if constexpr (LOW) {
#pragma unroll
      for (int kh = 0; kh < DKH; ++kh) {
        if (k / 64 == kh) {
          const int kk = k & 63;
#pragma unroll
          for (int e = 0; e < TPT; ++e) {
            const int t = tg * TPT + e;
            St1[kk * 72 + t] = f2bf(KAPV(e, t) * __expf(LPREV(e, t)));
            LkT[t * 72 + kk] = f2bf(QV(e) * __expf(LGV(e, t)));
            __builtin_amdgcn_sched_barrier(0);
          }
        }
        __syncthreads();
        zero4(acc); mm_strip(Tt, St1, acc, wave, lane);
#pragma unroll
        for (int nb = 0; nb < 4; ++nb)
#pragma unroll
          for (int jj = 0; jj < 4; ++jj) {
            const int t = wave * 16 + quad * 4 + jj, col = nb * 16 + lr; const bf16 u = f2bf(acc[nb][jj]);
            St2[col * 72 + t] = u;
            Ow[(rb + t) * 1024 + h * DK + kh * 64 + col] = u;
          }
        __syncthreads();
        zero4(acc); mm_strip(nAb, St2, acc, wave, lane);
#pragma unroll
        for (int nb = 0; nb < 4; ++nb)
#pragma unroll
          for (int jj = 0; jj < 4; ++jj) {
            const int t = wave * 16 + quad * 4 + jj, col = nb * 16 + lr;
            Oq[(rb + t) * LDQ + h * DK + kh * 64 + col] = f2bf(acc[nb][jj] + bf2f(LkT[t * 72 + col]));
          }
        __syncthreads();
      }
    } else {
#pragma unroll
      for (int e = 0; e < TPT; ++e) { Oq[(rb + tg * TPT + e) * LDQ + h * DK + k] = f2bf(QV(e) * __expf(LGV(e, tg * TPT + e))); __builtin_amdgcn_sched_barrier(0); }
    }
    {
      unsigned wk[TPT / 2], wb[LOW ? TPT / 2 : 1];
#pragma unroll
      for (int e = 0; e < TPT; e += 2) {
        const int t0 = tg * TPT + e;
        const float d0 = __expf(lgC - LGV(e, t0)), d1 = __expf(lgC - LGV(e + 1, t0 + 1));
        wk[e / 2] = pack2(KTV(e, t0) * d0, KTV(e + 1, t0 + 1) * d1);
        if constexpr (LOW) wb[e / 2] = pack2(BVV(e, t0) * d0, BVV(e + 1, t0 + 1) * d1);
        __builtin_amdgcn_sched_barrier(0);
      }
      const size_t co = rb * LDQ + h * DK + cont_off<DK>(k, tg * TPT, LDQ);
#pragma unroll
      for (int e = 0; e < TPT / 8; ++e) {
        *(uint4*)(Okt + co + e * 8) = make_uint4(wk[e * 4], wk[e * 4 + 1], wk[e * 4 + 2], wk[e * 4 + 3]);
        if constexpr (LOW) *(uint4*)(Obt + co + e * 8) = make_uint4(wb[e * 4], wb[e * 4 + 1], wb[e * 4 + 2], wb[e * 4 + 3]);
      }
#pragma unroll
      for (int vh = 0; vh < DVH; ++vh) {
        const unsigned* wv = vP[vh];
        const size_t vo = rb * 1024 + h * DV + cont_off<DV>(vh * 64 + vv, tgv * 16, 1024);
        *(uint4*)(Ovt + vo) = make_uint4(wv[0], wv[1], wv[2], wv[3]);
        *(uint4*)(Ovt + vo + 8) = make_uint4(wv[4], wv[5], wv[6], wv[7]);
      }
      if (tg == 0) gam[((size_t)c * NH + h) * DK + k] = __expf(lgC);
    }
    __syncthreads();
  }
}

template <int TYPE>
DEVI void phase_seq(const P& p, int j) {
  constexpr int NH = TYPE == 0 ? 16 : (TYPE == 1 ? 4 : 8);
  constexpr int DK = TYPE == 0 ? 64 : 128;
  constexpr int DV = TYPE == 0 ? 64 : (TYPE == 1 ? 256 : 128);
  constexpr bool LOW = TYPE != 1;
  constexpr int NVB = DV / 16, MB = DK / 16, KS = DK / 32;
  constexpr int LDQ = TYPE == 1 ? 512 : 1024;
  constexpr int IPS = NH * NVB;
  const int lane = threadIdx.x & 63, wave = threadIdx.x >> 6, lr = lane & 15, quad = lane >> 4;
  const bf16 *Qp, *Kt, *Vt, *Wp = nullptr, *Bt = nullptr, *U0 = nullptr; bf16* Ol;
  if (TYPE == 0) { Qp = slot(p, 5); Kt = slot(p, 6); Vt = slot(p, 7); Wp = slot(p, 2); Bt = slot(p, 3); Ol = slot(p, 0); U0 = slot(p, 1); }
  else if (TYPE == 1) { Qp = slot(p, 1); Kt = slot(p, 1) + (size_t)MT * 512; Vt = slot(p, 2); Ol = slot(p, 4); }
  else { Qp = slot(p, 5); Kt = slot(p, 6); Vt = slot(p, 7); Wp = slot(p, 1); Bt = slot(p, 2); Ol = slot(p, 3); U0 = slot(p, 0); }
  const float* gam = (const float*)(PWS + WS_GAM);
  const int nitems = 33 * IPS;
  for (int item = wave * gridDim.x + blockIdx.x; item < nitems; item += gridDim.x * 4) {
    const int seq = item / IPS, rem = item % IPS, h = rem / NVB, vb = rem % NVB;
    const int c0 = seq == 0 ? 0 : NPCH + seq - 1, nc = seq == 0 ? NPCH : 1;
    const int vcol = vb * 16 + lr;
    f32x4 H[MB];
    if (seq == 0) {
#pragma unroll
      for (int m = 0; m < MB; ++m) H[m] = (f32x4){0.f, 0.f, 0.f, 0.f};
    } else {
      const int b = seq - 1;
      if (TYPE == 0) {
        const float* S = PIN(3) + (((size_t)j * NSS + b) * 16 + h) * 4096 + (size_t)vcol * 64;
#pragma unroll
        for (int m = 0; m < MB; ++m) { float4 v = *(const float4*)(S + m * 16 + quad * 4); H[m] = (f32x4){v.x, v.y, v.z, v.w}; }
      } else {
        const float* S = PIN(TYPE == 1 ? 4 : 6) + ((size_t)b * NH + h) * DK * DV + vcol;
#pragma unroll
        for (int m = 0; m < MB; ++m)
#pragma unroll
          for (int jj = 0; jj < 4; ++jj) H[m][jj] = S[(size_t)(m * 16 + quad * 4 + jj) * DV];
      }
    }
    for (int c = c0; c < c0 + nc; ++c) {
      const size_t rb = (size_t)c * 64;
      int ln = threadIdx.x & 63; asm volatile("" : "+v"(ln));
      const int lr = ln & 15, quad = ln >> 4, vcol = vb * 16 + lr;
      const bf16* qb = Qp + rb * LDQ + h * DK;
      const bf16* wb = LOW ? Wp + rb * 1024 + h * DK : nullptr;
      const bf16* kb = Kt + rb * LDQ + h * DK;
      const bf16* bb = LOW ? Bt + rb * 1024 + h * DK : nullptr;
      const bf16* vtb = Vt + rb * 1024 + h * DV;
      const size_t fo = ((((size_t)c * NH + h) * NVB + vb) * 4) * 256 + ln * 4;
      const float* gp = gam + ((size_t)c * NH + h) * DK + quad * 4;
      bf16x8 hb[KS];
#pragma unroll
      for (int ks = 0; ks < KS; ++ks) {
#pragma unroll
        for (int e = 0; e < 4; ++e) { hb[ks][e] = (short)f2bf(H[2 * ks][e]); hb[ks][4 + e] = (short)f2bf(H[2 * ks + 1][e]); }
      }
      uint2 oin[4], uin[4]; bf16x8 qa[4][KS], wa[LOW ? 4 : 1][KS];
      bf16x8 vbop[2], kfr[MB][2], bfr[LOW ? MB : 1][2]; float4 gv[MB];
#define LOAD_A(tb) do { oin[tb] = *(const uint2*)(Ol + fo + (tb) * 256); if constexpr (LOW) uin[tb] = *(const uint2*)(U0 + fo + (tb) * 256); \
        _Pragma("unroll") for (int ks = 0; ks < KS; ++ks) { const int off_ = ((tb) * 16 + lr) * LDQ + ks * 32 + quad * 4; \
          bf16x4 lo_ = *(const bf16x4*)(qb + off_), hi_ = *(const bf16x4*)(qb + off_ + 16); qa[tb][ks] = __builtin_shufflevector(lo_, hi_, 0, 1, 2, 3, 4, 5, 6, 7); \
          if constexpr (LOW) { const int ow_ = ((tb) * 16 + lr) * 1024 + ks * 32 + quad * 4; bf16x4 wl_ = *(const bf16x4*)(wb + ow_), wh_ = *(const bf16x4*)(wb + ow_ + 16); \
            wa[tb][ks] = __builtin_shufflevector(wl_, wh_, 0, 1, 2, 3, 4, 5, 6, 7); } } } while (0)
#define COMP_A(tb) do { f32x4 o_, u_; \
        o_ = (f32x4){bf2f(oin[tb].x & 0xffff), bf2f(oin[tb].x >> 16), bf2f(oin[tb].y & 0xffff), bf2f(oin[tb].y >> 16)}; \
        if constexpr (LOW) u_ = (f32x4){bf2f(uin[tb].x & 0xffff), bf2f(uin[tb].x >> 16), bf2f(uin[tb].y & 0xffff), bf2f(uin[tb].y >> 16)}; \
        _Pragma("unroll") for (int ks = 0; ks < KS; ++ks) { o_ = __builtin_amdgcn_mfma_f32_16x16x32_bf16(qa[tb][ks], hb[ks], o_, 0, 0, 0); \
          if constexpr (LOW) u_ = __builtin_amdgcn_mfma_f32_16x16x32_bf16(wa[tb][ks], hb[ks], u_, 0, 0, 0); } \
        *(uint2*)(Ol + fo + (tb) * 256) = make_uint2(pack2(o_[0], o_[1]), pack2(o_[2], o_[3])); \
        if constexpr (LOW) U[tb] = u_; } while (0)
#define LOAD_B(m) do { gv[m] = *(const float4*)(gp + (m) * 16); const int krow_ = (m) * 16 + lr; \
        _Pragma("unroll") for (int ks = 0; ks < 2; ++ks) { kfr[m][ks] = *(const bf16x8*)(kb + cont_off<DK>(krow_, ks * 32 + quad * 8, LDQ)); \
          if constexpr (LOW) { bf16x4 lo_ = *(const bf16x4*)(bb + cont_off<DK>(krow_, ks * 32 + quad * 4, 1024)); \
            bf16x4 hi_ = *(const bf16x4*)(bb + cont_off<DK>(krow_, ks * 32 + 16 + quad * 4, 1024)); bfr[m][ks] = __builtin_shufflevector(lo_, hi_, 0, 1, 2, 3, 4, 5, 6, 7); } } } while (0)
#define COMP_B(m) do { f32x4 hn_ = (f32x4){H[m][0] * gv[m].x, H[m][1] * gv[m].y, H[m][2] * gv[m].z, H[m][3] * gv[m].w}; \
        _Pragma("unroll") for (int ks = 0; ks < 2; ++ks) { hn_ = __builtin_amdgcn_mfma_f32_16x16x32_bf16(kfr[m][ks], vbop[ks], hn_, 0, 0, 0); \
          if constexpr (LOW) hn_ = __builtin_amdgcn_mfma_f32_16x16x32_bf16(bfr[m][ks], ubop[ks], hn_, 0, 0, 0); } \
        H[m] = hn_; } while (0)
      f32x4 U[4];
      LOAD_A(0); LOAD_A(1); LOAD_A(2); LOAD_A(3);
      __builtin_amdgcn_sched_barrier(0);
      COMP_A(0); COMP_A(1);
#pragma unroll
      for (int ks = 0; ks < 2; ++ks) vbop[ks] = *(const bf16x8*)(vtb + cont_off<DV>(vcol, ks * 32 + quad * 8, 1024));
#pragma unroll
      for (int m = 0; m < MB / 2; ++m) LOAD_B(m);
      __builtin_amdgcn_sched_barrier(0);
      COMP_A(2); COMP_A(3);
#pragma unroll
      for (int m = MB / 2; m < MB; ++m) LOAD_B(m);
      __builtin_amdgcn_sched_barrier(0);
      bf16x8 ubop[2];
      if constexpr (LOW) {
#pragma unroll
        for (int ks = 0; ks < 2; ++ks)
#pragma unroll
          for (int e = 0; e < 4; ++e) { ubop[ks][e] = (short)f2bf(-U[2 * ks][e]); ubop[ks][4 + e] = (short)f2bf(-U[2 * ks + 1][e]); }
      }
#pragma unroll
      for (int m = 0; m < MB / 2; ++m) COMP_B(m);
      __builtin_amdgcn_sched_barrier(0);
#pragma unroll
      for (int m = MB / 2; m < MB; ++m) COMP_B(m);
      __builtin_amdgcn_sched_barrier(0);
#undef LOAD_A
#undef COMP_A
#undef LOAD_B
#undef COMP_B
    }
    if (TYPE == 0) {
      float* S = POUT + (seq == 0 ? O_AWKV_P + ((size_t)j * 16 + h) * 4096 : O_AWKV_S + (((size_t)j * NSS + (seq - 1)) * 16 + h) * 4096) + (size_t)vcol * 64;
#pragma unroll
      for (int m = 0; m < MB; ++m) *(float4*)(S + m * 16 + quad * 4) = make_float4(H[m][0], H[m][1], H[m][2], H[m][3]);
    } else {
      const size_t ob = TYPE == 1 ? (seq == 0 ? O_BKV_P : O_BKV_S + (size_t)(seq - 1) * NH * DK * DV)
                                  : (seq == 0 ? O_CKV_P : O_CKV_S + (size_t)(seq - 1) * NH * DK * DV);
      float* S = POUT + ob + (size_t)h * DK * DV + vcol;
#pragma unroll
      for (int m = 0; m < MB; ++m)
#pragma unroll
        for (int jj = 0; jj < 4; ++jj) S[(size_t)(m * 16 + quad * 4 + jj) * DV] = H[m][jj];
    }
  }
}

template <int TYPE>
DEVI void phase_post(const P& p, int j, char* smem) {
  constexpr int NH = TYPE == 0 ? 16 : (TYPE == 1 ? 4 : 8);
  constexpr int DV = TYPE == 0 ? 64 : (TYPE == 1 ? 256 : 128);
  constexpr int CPT = DV / 8;
  bf16* vt = (bf16*)smem;
  bf16* ot = (bf16*)(smem + 9216);
  const bf16* O = slot(p, TYPE == 0 ? 0 : (TYPE == 1 ? 4 : 3));
  const bf16* G = slot(p, TYPE == 0 ? 4 : (TYPE == 1 ? 3 : 4));
  bf16* og = slot(p, TYPE == 1 ? 0 : 1);
  const float* sm = (const float*)(PWS + WS_SM);
  for (int item = blockIdx.x; item < NCHUNK * NH; item += gridDim.x) {
    const int c = item / NH, h = item % NH; const size_t rb = (size_t)c * 64;
    int tid = threadIdx.x; asm volatile("" : "+v"(tid));
    const int part = tid & 7;
    if constexpr (TYPE == 0) {
      const bf16* V = slot(p, 7) + rb * 1024 + h * 64;
      const int r = tid >> 2, q4 = (tid & 3) * 16;
      *(uint4*)(vt + r * 72 + q4) = *(const uint4*)(V + (size_t)r * 1024 + q4);
      *(uint4*)(vt + r * 72 + q4 + 8) = *(const uint4*)(V + (size_t)r * 1024 + q4 + 8);
      __syncthreads();
    }
    {
      const uint4* srcp = (const uint4*)(O + ((size_t)c * NH + h) * 64 * DV);
#pragma unroll
      for (int i = 0; i < DV / 32; ++i) *(uint4*)(ot + (size_t)(i * 256 + tid) * 8) = srcp[i * 256 + tid];
      __syncthreads();
    }
#pragma unroll 1
    for (int pass = 0; pass < 2; ++pass) {
      const int t = pass * 32 + (tid >> 3);
      const size_t base = (rb + t) * 1024 + h * DV + part * CPT;
      float o[CPT];
#pragma unroll
      for (int e = 0; e < CPT; ++e) {
        const int v = part * CPT + e;
        o[e] = bf2f(ot[(((v >> 4) * 4 + (t >> 4)) * 64 + ((t & 15) >> 2) * 16 + (v & 15)) * 4 + (t & 3)]);
      }
      float s1 = 0.f, s2 = 0.f;
#pragma unroll
      for (int e = 0; e < CPT; ++e) { s1 += o[e]; s2 += o[e] * o[e]; }
      s1 += __shfl_xor(s1, 1); s1 += __shfl_xor(s1, 2); s1 += __shfl_xor(s1, 4);
      s2 += __shfl_xor(s2, 1); s2 += __shfl_xor(s2, 2); s2 += __shfl_xor(s2, 4);
      if constexpr (TYPE == 0) {
        const float mean = s1 * (1.f / 64.f); float var = s2 * (1.f / 64.f) - mean * mean; var = fmaxf(var, 0.f);
        const float rs = rsqrtf(var + 64e-5f); const float bonus = sm[(rb + t) * 16 + h];
        const float* lw = PIN(26) + j * 1024 + h * 64 + part * CPT; const float* lb = PIN(27) + j * 1024 + h * 64 + part * CPT;
#pragma unroll
        for (int e = 0; e < CPT; ++e) {
          const float vv = bf2f(vt[(part * CPT + e) * 72 + t]);
          o[e] = (o[e] - mean) * rs * lw[e] + lb[e] + bonus * vv;
        }
      } else {
        const float rs = rsqrtf(s2 * (1.f / DV) + 1e-6f);
        const float* on = PIN(TYPE == 1 ? 32 : 38) + part * CPT;
#pragma unroll
        for (int e = 0; e < CPT; ++e) o[e] = o[e] * rs * on[e];
      }
#pragma unroll
      for (int e = 0; e < CPT; e += 8) {
        uint4 u = *(const uint4*)(G + base + e);
        const unsigned w[4] = {u.x, u.y, u.z, u.w}; unsigned ow[4];
#pragma unroll
        for (int i = 0; i < 4; ++i) {
          float g0 = bf2f(w[i] & 0xffff), g1 = bf2f(w[i] >> 16);
          if constexpr (TYPE != 0) { g0 = silu(g0); g1 = silu(g1); }
          ow[i] = pack2(o[e + 2 * i] * g0, o[e + 2 * i + 1] * g1);
        }
        *(uint4*)(og + base + e) = make_uint4(ow[0], ow[1], ow[2], ow[3]);
      }
    }
    __syncthreads();
  }
}

#ifndef DISMASK
#define DISMASK 0
#endif
#define EN(b) (!((DISMASK >> (b)) & 1))
#define GSYNC() do { asm volatile("s_waitcnt vmcnt(0)" ::: "memory"); grid.sync(); } while (0)
__global__ void __launch_bounds__(256, 1) fwd_megakernel(P p) {
  extern __shared__ __attribute__((aligned(16))) char smem[];
  cg::grid_group grid = cg::this_grid();
  bf16* wreg = (bf16*)(PWS + WS_W);
  bf16 *wfin = wreg + W_FIN, *wfout = wreg + W_FOUT, *wmix = wreg + W_MIX;
  float* sm = (float*)(PWS + WS_SM);
  for (int layer = 0; layer < 4; ++layer) {
    const int type = layer % 3, j = layer / 3;
    int tb = 0;
    if (type == 0) phase_norm<0>(p, layer, j, layer == 0, layer == 0);
    else phase_norm<1>(p, layer, j, false, false);
    conv_job(CvFfnIn{PIN(10) + (size_t)layer * 1024 * 2 * FF}, wfin, 1024, 2 * FF, 1024, tb, smem);
    conv_job(CvPlain{PIN(11) + (size_t)layer * FF * 1024, 1024, 1024}, wfout, FF, 1024, FF, tb, smem);
    if (type == 0) {
      for (int i = 0; i < 3; ++i) conv_job(CvPlain{PIN(24) + ((size_t)j * 3 + i) * 1048576, 1024, 1024}, wmix + (size_t)i * 1048576, 1024, 1024, 1024, tb, smem);
      conv_job(CvLora1{PIN(14) + (size_t)j * 65536, PIN(17) + (size_t)j * 65536, PIN(19) + (size_t)j * 131072, PIN(12) + (size_t)j * 6144}, wmix + 3145728, 2048, 256, 2048, tb, smem);
      conv_job(CvPlain{PIN(15) + (size_t)j * 65536, 1024, 1024}, wmix + 3670016, 64, 1024, 64, tb, smem);
      conv_job(CvPlain{PIN(18) + (size_t)j * 65536, 1024, 1024}, wmix + 3735552, 64, 1024, 64, tb, smem);
      conv_job(CvPlain{PIN(20) + (size_t)j * 131072, 1024, 1024}, wmix + 3801088, 128, 1024, 128, tb, smem);
      conv_job(CvPlain{PIN(25) + (size_t)j * 1048576, 1024, 1024}, wmix + 3932160, 1024, 1024, 1024, tb, smem);
    } else if (type == 1) {
      conv_job(CvGlaIn{PIN(28), PIN(29)}, wmix, 1024, 3200, 1024, tb, smem);
      conv_job(CvPlain{PIN(33), 1024, 1024}, wmix + 3276800, 1024, 1024, 1024, tb, smem);
    } else {
      conv_job(CvPlain{PIN(34), 4112, 4112}, wmix, 1024, 4224, 1024, tb, smem);
      conv_job(CvPlain{PIN(39), 1024, 1024}, wmix + 4325376, 1024, 1024, 1024, tb, smem);
    }
    GSYNC();
    tb = 0;
    const bf16* wo;
    if (type == 0) {
      for (int i = 0; i < 3; ++i)
        gemm_job(GemmDesc{slot(p, 2 + i), nullptr, 1024, 1024, wmix + (size_t)i * 1048576, 1024, 144, 8, 1024}, EpiStore{slot(p, 5 + i), 1024, 1.f}, tb, smem);
      gemm_job(GemmDesc{slot(p, 0), slot(p, 1), 1024, 1024, wmix + 3145728, 2048, 144, 2, 2048}, EpiLora1{(bf16*)(PWS + WS_L1)}, tb, smem);
      GSYNC();
      tb = 0;
      const bf16* l1 = (const bf16*)(PWS + WS_L1);
      gemm_job(GemmDesc{l1, nullptr, 256, 64, wmix + 3670016, 64, 144, 8, 64}, EpiLd{slot(p, 2), PIN(13) + j * 1024}, tb, smem);
      gemm_job(GemmDesc{l1 + 64, nullptr, 256, 64, wmix + 3735552, 64, 144, 8, 64}, EpiSig{slot(p, 3), PIN(16) + j * 1024}, tb, smem);
      gemm_job(GemmDesc{l1 + 128, nullptr, 256, 128, wmix + 3801088, 128, 144, 8, 128}, EpiStore{slot(p, 4), 1024, 1.f}, tb, smem);
      GSYNC();
      if (EN(2)) phase_prep<0>(p, j, smem);
      GSYNC();
      if (EN(5)) phase_seq<0>(p, j);
      GSYNC();
      if (EN(8)) phase_post<0>(p, j, smem);
      wo = wmix + 3932160;
    } else if (type == 1) {
      gemm_job(GemmDesc{slot(p, 0), nullptr, 1024, 1024, wmix, 1024, 144, 25, 1024},
               EpiGlaIn{slot(p, 1), slot(p, 1) + (size_t)MT * 512, slot(p, 2), slot(p, 3), sm}, tb, smem);
      GSYNC();
      if (EN(3)) phase_prep<1>(p, j, smem);
      GSYNC();
      if (EN(6)) phase_seq<1>(p, j);
      GSYNC();
      if (EN(8)) phase_post<1>(p, j, smem);
      wo = wmix + 3276800;
    } else {
      gemm_job(GemmDesc{slot(p, 0), nullptr, 1024, 1024, wmix, 1024, 144, 33, 1024},
               EpiGdnIn{slot(p, 1), slot(p, 4), sm, POUT}, tb, smem);
      GSYNC();
      if (EN(9)) phase_gdn_conv(p);
      GSYNC();
      if (EN(4)) phase_prep<2>(p, j, smem);
      GSYNC();
      if (EN(7)) phase_seq<2>(p, j);
      GSYNC();
      if (EN(8)) phase_post<2>(p, j, smem);
      wo = wmix + 4325376;
    }
    GSYNC();
    tb = 0;
    gemm_job(GemmDesc{slot(p, type == 1 ? 0 : 1), nullptr, 1024, 1024, wo, 1024, 144, 8, 1024}, EpiAcc{POUT}, tb, smem);
    GSYNC();
    phase_rms(POUT, PIN(8) + layer * 1024, slot(p, 0), nullptr);
    GSYNC();
    tb = 0;
    gemm_job(GemmDesc{slot(p, 0), nullptr, 1024, 1024, wfin, 1024, 144, 44, 1024}, EpiSwiglu{slot(p, 1)}, tb, smem);
    GSYNC();
    tb = 0;
    gemm_job(GemmDesc{slot(p, 1), nullptr, FF, FF, wfout, FF, 144, 8, FF}, EpiAcc{POUT}, tb, smem);
    GSYNC();
  }
  phase_rms(POUT, PIN(9), nullptr, POUT);
}

extern "C" void kernel_launch(void* const* d_in, const int* in_sizes, int n_in, void* d_out, int out_size,
                              void* d_ws, size_t ws_size, hipStream_t stream) {
  if (n_in < 40 || ws_size < WS_TOTAL) { fprintf(stderr, "bad args: n_in %d ws %zu need %zu\n", n_in, ws_size, (size_t)WS_TOTAL); return; }
  static int grid_blocks = 0;
  if (!grid_blocks) {
    int dev = 0, cus = 0, per_cu = 0;
    hipGetDevice(&dev);
    hipDeviceGetAttribute(&cus, hipDeviceAttributeMultiprocessorCount, dev);
    hipFuncSetAttribute((const void*)fwd_megakernel, hipFuncAttributeMaxDynamicSharedMemorySize, LDS_BYTES);
    hipOccupancyMaxActiveBlocksPerMultiprocessor(&per_cu, (const void*)fwd_megakernel, 256, LDS_BYTES);
    if (per_cu > 2) per_cu = 2;
    if (per_cu < 1) per_cu = 1;
    grid_blocks = cus * per_cu;
  }
  P p{};
  for (int i = 0; i < 40; ++i) p.in[i] = (const float*)d_in[i];
  p.out = (float*)d_out; p.ws = (char*)d_ws;
  void* args[] = {&p};
  hipError_t e = hipLaunchCooperativeKernel((const void*)fwd_megakernel, dim3(grid_blocks), dim3(256), args, LDS_BYTES, stream);
  if (e != hipSuccess) fprintf(stderr, "cooperative launch failed: %s (grid %d)\n", hipGetErrorString(e), grid_blocks);
}
```

```cpp
#include <hip/hip_runtime.h>
#include <hip/hip_cooperative_groups.h>
#include <cstdio>
#include <cstdint>
namespace cg = cooperative_groups;

typedef unsigned short bf16;
typedef __attribute__((ext_vector_type(8))) short bf16x8;
typedef __attribute__((ext_vector_type(4))) short bf16x4;
typedef __attribute__((ext_vector_type(4))) float f32x4;
typedef __attribute__((ext_vector_type(4))) unsigned u32x4;
typedef __attribute__((ext_vector_type(2))) unsigned u32x2;

#define DEVI __device__ __forceinline__

constexpr int Dm = 1024, FF = 2816, MT = 18432, MPR = 16384, NSS = 32, NCHUNK = 288, NPCH = 256;
constexpr size_t SLOT = (size_t)MT * 1024 * 2;
constexpr size_t WS_L1 = 8 * SLOT;
constexpr size_t WS_SM = WS_L1 + (size_t)MT * 256 * 2;
constexpr size_t WS_GAM = WS_SM + (size_t)MT * 16 * 4;
constexpr size_t WS_W = WS_GAM + (size_t)NCHUNK * 1024 * 4;
constexpr size_t W_FIN = 0, W_FOUT = 5767168, W_MIX = 8650752;
constexpr size_t WS_TOTAL = WS_W + (size_t)14200000 * 2;
constexpr int LDS_BYTES = 77824;

constexpr size_t O_ASH_P = 18874368, O_AWKV_P = O_ASH_P + 2048, O_BKV_P = O_AWKV_P + 131072,
                 O_CCONV_P = O_BKV_P + 131072, O_CKV_P = O_CCONV_P + 9216, O_ASH_S = O_CKV_P + 131072,
                 O_AWKV_S = O_ASH_S + 65536, O_BKV_S = O_AWKV_S + 4194304, O_CCONV_S = O_BKV_S + 4194304,
                 O_CKV_S = O_CCONV_S + 294912;

struct P { const float* in[40]; float* out; char* ws; };
typedef const __attribute__((address_space(4))) char* kptr_t;
typedef const float* cfp_t; typedef float* fp_t; typedef char* cp_t;
DEVI kptr_t kbase() { kptr_t b = (kptr_t)__builtin_amdgcn_kernarg_segment_ptr(); asm volatile("" : "+s"(b)); return b; }
#define PIN(i) (*(const __attribute__((address_space(4))) cfp_t*)(kbase() + 8 * (i)))
#define POUT (*(const __attribute__((address_space(4))) fp_t*)(kbase() + 320))
#define PWS (*(const __attribute__((address_space(4))) cp_t*)(kbase() + 328))

typedef __attribute__((ext_vector_type(2))) float f32x2;
typedef __attribute__((ext_vector_type(2))) __bf16 bf16x2v;
DEVI unsigned pack2(float a, float b) { f32x2 v = {a, b}; bf16x2v r = __builtin_convertvector(v, bf16x2v); return __builtin_bit_cast(unsigned, r); }
DEVI bf16 f2bf(float f) { return (bf16)(pack2(f, 0.f) & 0xffffu); }
DEVI float bf2f(bf16 h) { return __uint_as_float(((unsigned)h) << 16); }
DEVI float wsum(float v) {
#pragma unroll
  for (int o = 32; o > 0; o >>= 1) v += __shfl_xor(v, o);
  return v;
}
DEVI float sigm(float x) { return 1.f / (1.f + __expf(-x)); }
DEVI float silu(float x) { return x * sigm(x); }
DEVI float softplus(float x) { return x > 20.f ? x : log1pf(__expf(x)); }
DEVI bf16* slot(const P& p, int i) { return (bf16*)(PWS + (size_t)i * SLOT); }

struct GemmDesc { const bf16* A; const bf16* A2; int lda; int ksplit; const bf16* Bt; int ldb; int tiles_m; int tiles_n; int K; };

template <class Epi>
DEVI void gemm_tile(const GemmDesc& g, int mt, int nt, Epi& epi, char* smem) {
  const int tid = threadIdx.x, lane = tid & 63, wave = tid >> 6;
  const int wm = wave >> 1, wn = wave & 1, lr = lane & 15, quad = lane >> 4;
  bf16* sA = (bf16*)smem;
  bf16* sB = sA + 2 * 8192;
  f32x4 acc[4][4];
#pragma unroll
  for (int i = 0; i < 4; ++i)
#pragma unroll
    for (int j = 0; j < 4; ++j) acc[i][j] = (f32x4){0.f, 0.f, 0.f, 0.f};
  const int m0 = mt * 128, n0 = nt * 128;
  const int r0 = tid >> 3, c0 = tid & 7;
  const size_t aoff = (size_t)(m0 + r0) * g.lda + c0 * 8;
  const bf16* bp = g.Bt + (size_t)(n0 + r0) * g.ldb + c0 * 8;
  const int soff = r0 * 64 + ((c0 ^ (r0 & 7)) << 3);
#define GL1(i_, RA, RB) RA##i_ = *(const u32x4*)(base_ + (size_t)(32 * i_) * g.lda); RB##i_ = *(const u32x4*)(bp + k0_ + (size_t)(32 * i_) * g.ldb);
#define GLOAD(kt_, RA, RB) do { const int k0_ = (kt_) << 6; \
    const bf16* base_ = ((k0_ < g.ksplit) ? (g.A + k0_) : (g.A2 + (k0_ - g.ksplit))) + aoff; \
    GL1(0, RA, RB) GL1(1, RA, RB) GL1(2, RA, RB) GL1(3, RA, RB) } while (0)
#define LS1(buf_, i_, RA, RB) *(u32x4*)(sA + (buf_) * 8192 + soff + i_ * 2048) = RA##i_; *(u32x4*)(sB + (buf_) * 8192 + soff + i_ * 2048) = RB##i_;
#define LSTORE(buf_, RA, RB) do { LS1(buf_, 0, RA, RB) LS1(buf_, 1, RA, RB) LS1(buf_, 2, RA, RB) LS1(buf_, 3, RA, RB) } while (0)
#define GSTEP(kt_, RA, RB) do { const int buf_ = (kt_) & 1; \
    const bf16* a_ = sA + buf_ * 8192 + (wm * 64 + lr) * 64; const bf16* b_ = sB + buf_ * 8192 + (wn * 64 + lr) * 64; \
    _Pragma("unroll") for (int ks_ = 0; ks_ < 2; ++ks_) { \
      const int co_ = (((ks_ * 4 + quad) ^ (lr & 7)) << 3); bf16x8 af_[4], bf_[4]; \
      _Pragma("unroll") for (int i_ = 0; i_ < 4; ++i_) { af_[i_] = *(const bf16x8*)(a_ + i_ * 1024 + co_); bf_[i_] = *(const bf16x8*)(b_ + i_ * 1024 + co_); } \
      _Pragma("unroll") for (int i_ = 0; i_ < 4; ++i_) _Pragma("unroll") for (int j_ = 0; j_ < 4; ++j_) \
        acc[i_][j_] = __builtin_amdgcn_mfma_f32_16x16x32_bf16(af_[i_], bf_[j_], acc[i_][j_], 0, 0, 0); } \
    if ((kt_) + 1 < nk) { LSTORE(buf_ ^ 1, RA, RB); if ((kt_) + 3 < nk) GLOAD((kt_) + 3, RA, RB); } \
    __syncthreads(); } while (0)
  const int nk = g.K >> 6;
  u32x4 pa0, pa1, pa2, pa3, pb0, pb1, pb2, pb3, qa0, qa1, qa2, qa3, qb0, qb1, qb2, qb3;
  qa0 = qa1 = qa2 = qa3 = qb0 = qb1 = qb2 = qb3 = (u32x4){0u, 0u, 0u, 0u};
  GLOAD(0, pa, pb);
  if (nk > 1) GLOAD(1, qa, qb);
  LSTORE(0, pa, pb);
  if (nk > 2) GLOAD(2, pa, pb);
  __syncthreads();
  for (int kt = 0; kt < nk; kt += 2) { GSTEP(kt, qa, qb); if (kt + 1 < nk) GSTEP(kt + 1, pa, pb); }
#pragma unroll
  for (int i = 0; i < 4; ++i) {
#pragma unroll
    for (int jj = 0; jj < 4; ++jj) {
      const int row = m0 + wm * 64 + i * 16 + quad * 4 + jj;
      if constexpr (Epi::PAIR) {
#pragma unroll
        for (int j = 0; j < 4; j += 2) {
          const int nn = n0 + wn * 64 + j * 16;
          epi.pair(row, (nn >> 5) * 16 + lr, acc[i][j][jj], acc[i][j + 1][jj]);
        }
      } else {
#pragma unroll
        for (int j = 0; j < 4; ++j) epi(row, n0 + wn * 64 + j * 16 + lr, acc[i][j][jj]);
      }
    }
  }
}

template <class Epi>
DEVI void gemm_job(const GemmDesc& g, Epi epi, int& tbase, char* smem) {
  const int ntiles = g.tiles_m * g.tiles_n, G = gridDim.x;
  const int first = tbase + (((int)blockIdx.x - tbase % G) + G) % G;
  const int width = 8 * g.tiles_n;
  for (int t = first; t < tbase + ntiles; t += G) {
    const int lt = t - tbase;
    const int grp = lt / width, rem = lt % width;
    gemm_tile(g, grp * 8 + (rem & 7), rem >> 3, epi, smem);
  }
  tbase += ntiles;
}

struct EpiStore { static constexpr bool PAIR = false; bf16* C; int ldc; float sc;
  DEVI void operator()(int r, int c, float v) { C[(size_t)r * ldc + c] = f2bf(v * sc); } };
struct EpiLora1 { static constexpr bool PAIR = false; bf16* C;
  DEVI void operator()(int r, int c, float v) { float o = c < 64 ? tanhf(v) : (c < 128 ? v : sigm(v)); C[(size_t)r * 256 + c] = f2bf(o); } };
struct EpiLd { static constexpr bool PAIR = false; bf16* C; const float* w0;
  DEVI void operator()(int r, int c, float v) { float x = w0[c] + v; float lr_ = -softplus(-x) - 0.5f; C[(size_t)r * 1024 + c] = f2bf(-__expf(lr_)); } };
struct EpiSig { static constexpr bool PAIR = false; bf16* C; const float* a0;
  DEVI void operator()(int r, int c, float v) { C[(size_t)r * 1024 + c] = f2bf(sigm(a0[c] + v)); } };
struct EpiAcc { static constexpr bool PAIR = false; float* X;
  DEVI void operator()(int r, int c, float v) { X[(size_t)r * 1024 + c] += v; } };
struct EpiSwiglu { static constexpr bool PAIR = true; bf16* C;
  DEVI void pair(int r, int c, float gt, float up) { C[(size_t)r * FF + c] = f2bf(silu(gt) * up); } };
struct EpiGlaIn { static constexpr bool PAIR = false; bf16 *q, *k, *v, *gate; float* sm;
  DEVI void operator()(int r, int c, float x) {
    if (c < 512) q[(size_t)r * 512 + c] = f2bf(x * 0.08838834764831845f);
    else if (c < 1024) k[(size_t)r * 512 + c - 512] = f2bf(x);
    else if (c < 2048) v[(size_t)r * 1024 + c - 1024] = f2bf(x);
    else if (c < 3072) gate[(size_t)r * 1024 + c - 2048] = f2bf(x);
    else if (c < 3088) sm[(size_t)r * 16 + c - 3072] = x;
  } };
struct EpiGdnIn { static constexpr bool PAIR = false; bf16 *qkv, *z; float* sm; float* out;
  DEVI void operator()(int r, int c, float x) {
    if (c < 3072) {
      qkv[(size_t)r * 3072 + c] = f2bf(x);
      if (r >= MPR - 3) {
        if (r < MPR) out[O_CCONV_P + (size_t)(r - (MPR - 3)) * 3072 + c] = x;
        else { int tt = (r - MPR) & 63; if (tt >= 61) out[O_CCONV_S + ((size_t)((r - MPR) >> 6) * 3 + (tt - 61)) * 3072 + c] = x; }
      }
    } else if (c < 4096) z[(size_t)r * 1024 + c - 3072] = f2bf(x);
    else if (c < 4112) sm[(size_t)r * 16 + c - 4096] = x;
  } };

template <class F>
DEVI void conv_job(F f, bf16* dst, int ldo, int Nd, int Kd, int& tbase, char* smem) {
  float* tile = (float*)smem;
  const int tn = Nd >> 6, tk = Kd >> 6, ntiles = tn * tk, G = gridDim.x, tid = threadIdx.x;
  const int first = tbase + (((int)blockIdx.x - tbase % G) + G) % G;
  for (int t = first; t < tbase + ntiles; t += G) {
    const int lt = t - tbase, n0 = (lt % tn) << 6, k0 = (lt / tn) << 6;
    const int i = tid >> 4, j4 = (tid & 15) << 2;
#pragma unroll
    for (int r = 0; r < 4; ++r) {
      float4 v = f(k0 + i + 16 * r, n0 + j4);
      float* d = tile + (i + 16 * r) * 65 + j4; d[0] = v.x; d[1] = v.y; d[2] = v.z; d[3] = v.w;
    }
    __syncthreads();
    const int jn = tid >> 2, iq = (tid & 3) << 4;
    unsigned w[8];
#pragma unroll
    for (int e = 0; e < 8; ++e) w[e] = pack2(tile[(iq + 2 * e) * 65 + jn], tile[(iq + 2 * e + 1) * 65 + jn]);
    uint4* o = (uint4*)(dst + (size_t)(n0 + jn) * ldo + k0 + iq);
    o[0] = make_uint4(w[0], w[1], w[2], w[3]); o[1] = make_uint4(w[4], w[5], w[6], w[7]);
    __syncthreads();
  }
  tbase += ntiles;
}
struct CvPlain { const float* W; int ld; int nsrc;
  DEVI float4 operator()(int k, int n) const { return n < nsrc ? *(const float4*)(W + (size_t)k * ld + n) : make_float4(0, 0, 0, 0); } };
struct CvFfnIn { const float* W;
  DEVI float4 operator()(int k, int n) const { int blk = n >> 5, w = n & 31; int src = (w < 16) ? blk * 16 + w : FF + blk * 16 + (w - 16);
    return *(const float4*)(W + (size_t)k * (2 * FF) + src); } };
struct CvLora1 { const float *w1, *a1, *g1, *mu;
  DEVI float4 operator()(int k, int n) const {
    int kk = k & 1023; float4 v; float m;
    if (n < 64) { v = *(const float4*)(w1 + kk * 64 + n); m = mu[1 * 1024 + kk]; }
    else if (n < 128) { v = *(const float4*)(a1 + kk * 64 + n - 64); m = mu[4 * 1024 + kk]; }
    else { v = *(const float4*)(g1 + kk * 128 + n - 128); m = mu[5 * 1024 + kk]; }
    float s = (k < 1024) ? (1.f - m) : m;
    return make_float4(v.x * s, v.y * s, v.z * s, v.w * s); } };
struct CvGlaIn { const float *win, *wa1;
  DEVI float4 operator()(int k, int n) const {
    if (n < 3072) return *(const float4*)(win + (size_t)k * 3072 + n);
    if (n < 3088) return *(const float4*)(wa1 + k * 16 + n - 3072);
    return make_float4(0, 0, 0, 0); } };

template <int TYPE>
DEVI void phase_norm(const P& p, int layer, int j, bool from_input, bool copy_x) {
  const int lane = threadIdx.x & 63, wave = threadIdx.x >> 6;
  const float* g = PIN(7) + layer * 1024;
  float* xres = POUT;
  bf16 *h = slot(p, 0), *hs = slot(p, 1), *xr = slot(p, 2), *xk = slot(p, 3), *xv = slot(p, 4);
  const float* mu = PIN(12) + (size_t)j * 6 * 1024;
  for (int row = blockIdx.x * 4 + wave; row < MT; row += gridDim.x * 4) {
    auto src = [&](int r) -> const float* {
      if (from_input) return r < MPR ? PIN(0) + (size_t)r * 1024 : PIN(1) + (size_t)(r - MPR) * 1024;
      return xres + (size_t)r * 1024; };
    const float* xp = src(row);
    float4 xv4[4]; float ss = 0.f;
#pragma unroll
    for (int i = 0; i < 4; ++i) { xv4[i] = *(const float4*)(xp + i * 256 + lane * 4); ss += xv4[i].x * xv4[i].x + xv4[i].y * xv4[i].y + xv4[i].z * xv4[i].z + xv4[i].w * xv4[i].w; }
    ss = wsum(ss);
    const float rstd = rsqrtf(ss * (1.f / 1024.f) + 1e-6f);
    if (copy_x) {
#pragma unroll
      for (int i = 0; i < 4; ++i) *(float4*)(xres + (size_t)row * 1024 + i * 256 + lane * 4) = xv4[i];
    }
    float hv[16];
#pragma unroll
    for (int i = 0; i < 4; ++i) { float4 gg = *(const float4*)(g + i * 256 + lane * 4);
      hv[i * 4 + 0] = xv4[i].x * rstd * gg.x; hv[i * 4 + 1] = xv4[i].y * rstd * gg.y; hv[i * 4 + 2] = xv4[i].z * rstd * gg.z; hv[i * 4 + 3] = xv4[i].w * rstd * gg.w; }
#pragma unroll
    for (int i = 0; i < 4; ++i) *(uint2*)(h + (size_t)row * 1024 + i * 256 + lane * 4) = make_uint2(pack2(hv[i * 4], hv[i * 4 + 1]), pack2(hv[i * 4 + 2], hv[i * 4 + 3]));
    if constexpr (TYPE == 0) {
      const bool is_p = row < MPR; const int tt = is_p ? row : ((row - MPR) & 63); const int b = is_p ? 0 : ((row - MPR) >> 6);
      float hp[16];
      if (tt == 0) {
        if (is_p) {
#pragma unroll
          for (int i = 0; i < 16; ++i) hp[i] = 0.f;
        } else {
          const float* sp = PIN(2) + ((size_t)j * NSS + b) * 1024;
#pragma unroll
          for (int i = 0; i < 4; ++i) { float4 v = *(const float4*)(sp + i * 256 + lane * 4); hp[i * 4] = v.x; hp[i * 4 + 1] = v.y; hp[i * 4 + 2] = v.z; hp[i * 4 + 3] = v.w; }
        }
      } else {
        const float* pp = src(row - 1); float4 pv[4]; float s2 = 0.f;
#pragma unroll
        for (int i = 0; i < 4; ++i) { pv[i] = *(const float4*)(pp + i * 256 + lane * 4); s2 += pv[i].x * pv[i].x + pv[i].y * pv[i].y + pv[i].z * pv[i].z + pv[i].w * pv[i].w; }
        s2 = wsum(s2); const float r2 = rsqrtf(s2 * (1.f / 1024.f) + 1e-6f);
#pragma unroll
        for (int i = 0; i < 4; ++i) { float4 gg = *(const float4*)(g + i * 256 + lane * 4);
          hp[i * 4] = pv[i].x * r2 * gg.x; hp[i * 4 + 1] = pv[i].y * r2 * gg.y; hp[i * 4 + 2] = pv[i].z * r2 * gg.z; hp[i * 4 + 3] = pv[i].w * r2 * gg.w; }
      }
#pragma unroll
      for (int i = 0; i < 4; ++i) {
        const int col = i * 256 + lane * 4; const size_t o = (size_t)row * 1024 + col;
        float4 m0 = *(const float4*)(mu + 0 * 1024 + col), m2 = *(const float4*)(mu + 2 * 1024 + col), m3 = *(const float4*)(mu + 3 * 1024 + col);
        const float mm0[4] = {m0.x, m0.y, m0.z, m0.w}, mm2[4] = {m2.x, m2.y, m2.z, m2.w}, mm3[4] = {m3.x, m3.y, m3.z, m3.w};
        float a[4], bb[4], c[4];
#pragma unroll
        for (int e = 0; e < 4; ++e) { float hh = hv[i * 4 + e], xx = hp[i * 4 + e] - hh; a[e] = hh + xx * mm0[e]; bb[e] = hh + xx * mm2[e]; c[e] = hh + xx * mm3[e]; }
        *(uint2*)(hs + o) = make_uint2(pack2(hp[i * 4], hp[i * 4 + 1]), pack2(hp[i * 4 + 2], hp[i * 4 + 3]));
        *(uint2*)(xr + o) = make_uint2(pack2(a[0], a[1]), pack2(a[2], a[3]));
        *(uint2*)(xk + o) = make_uint2(pack2(bb[0], bb[1]), pack2(bb[2], bb[3]));
        *(uint2*)(xv + o) = make_uint2(pack2(c[0], c[1]), pack2(c[2], c[3]));
      }
      if (is_p ? (row == MPR - 1) : (tt == 63)) {
        float* o = POUT + (is_p ? O_ASH_P + (size_t)j * 1024 : O_ASH_S + ((size_t)j * NSS + b) * 1024);
#pragma unroll
        for (int i = 0; i < 4; ++i) *(float4*)(o + i * 256 + lane * 4) = make_float4(hv[i * 4], hv[i * 4 + 1], hv[i * 4 + 2], hv[i * 4 + 3]);
      }
    }
  }
}

DEVI void phase_rms(const float* x, const float* g, bf16* dst, float* fdst) {
  const int lane = threadIdx.x & 63, wave = threadIdx.x >> 6;
  for (int row = blockIdx.x * 4 + wave; row < MT; row += gridDim.x * 4) {
    const float* xp = x + (size_t)row * 1024; float4 v[4]; float ss = 0.f;
#pragma unroll
    for (int i = 0; i < 4; ++i) { v[i] = *(const float4*)(xp + i * 256 + lane * 4); ss += v[i].x * v[i].x + v[i].y * v[i].y + v[i].z * v[i].z + v[i].w * v[i].w; }
    ss = wsum(ss); const float r = rsqrtf(ss * (1.f / 1024.f) + 1e-6f);
#pragma unroll
    for (int i = 0; i < 4; ++i) { float4 gg = *(const float4*)(g + i * 256 + lane * 4);
      float a = v[i].x * r * gg.x, b = v[i].y * r * gg.y, c = v[i].z * r * gg.z, d = v[i].w * r * gg.w;
      if (dst) *(uint2*)(dst + (size_t)row * 1024 + i * 256 + lane * 4) = make_uint2(pack2(a, b), pack2(c, d));
      else *(float4*)(fdst + (size_t)row * 1024 + i * 256 + lane * 4) = make_float4(a, b, c, d); }
  }
}

DEVI void phase_gdn_conv(const P& p) {
  const bf16* qkv = slot(p, 1); const float* cw = PIN(35); const float* cst = PIN(5);
  const int tid = threadIdx.x, lane = tid & 63;
  for (int item = blockIdx.x; item < MT * 3; item += gridDim.x) {
    const int row = item / 3, sec = item % 3, ch = sec * 1024 + tid * 4;
    const bool is_p = row < MPR; const int tt = is_p ? row : ((row - MPR) & 63); const int b = is_p ? 0 : ((row - MPR) >> 6);
    float acc[4] = {0.f, 0.f, 0.f, 0.f};
#pragma unroll
    for (int i = 0; i < 4; ++i) {
      const int pt = tt + i;
      float4 w = *(const float4*)(cw + i * 3072 + ch); float x[4];
      if (pt >= 3) { uint2 u = *(const uint2*)(qkv + (size_t)(row + i - 3) * 3072 + ch);
        x[0] = bf2f(u.x & 0xffff); x[1] = bf2f(u.x >> 16); x[2] = bf2f(u.y & 0xffff); x[3] = bf2f(u.y >> 16); }
      else if (!is_p) { float4 s = *(const float4*)(cst + ((size_t)b * 3 + pt) * 3072 + ch); x[0] = s.x; x[1] = s.y; x[2] = s.z; x[3] = s.w; }
      else { x[0] = x[1] = x[2] = x[3] = 0.f; }
      acc[0] += x[0] * w.x; acc[1] += x[1] * w.y; acc[2] += x[2] * w.z; acc[3] += x[3] * w.w;
    }
#pragma unroll
    for (int e = 0; e < 4; ++e) acc[e] = silu(acc[e]);
    if (sec < 2) {
      float ss = acc[0] * acc[0] + acc[1] * acc[1] + acc[2] * acc[2] + acc[3] * acc[3];
#pragma unroll
      for (int o = 16; o > 0; o >>= 1) ss += __shfl_xor(ss, o);
      float r = rsqrtf(ss + 1e-6f) * (sec == 0 ? 0.08838834764831845f : 1.f);
#pragma unroll
      for (int e = 0; e < 4; ++e) acc[e] *= r;
    }
    (void)lane;
    *(uint2*)(slot(p, 5 + sec) + (size_t)row * 1024 + tid * 4) = make_uint2(pack2(acc[0], acc[1]), pack2(acc[2], acc[3]));
  }
}

DEVI void mm_strip(const bf16* At, const bf16* Bt, f32x4 (&acc)[4], int wave, int lane) {
  const int lr = lane & 15, quad = lane >> 4;
#pragma unroll
  for (int ks = 0; ks < 2; ++ks) {
    bf16x8 a = *(const bf16x8*)(At + (wave * 16 + lr) * 72 + ks * 32 + quad * 8);
#pragma unroll
    for (int nb = 0; nb < 4; ++nb) {
      bf16x8 b = *(const bf16x8*)(Bt + (nb * 16 + lr) * 72 + ks * 32 + quad * 8);
      acc[nb] = __builtin_amdgcn_mfma_f32_16x16x32_bf16(a, b, acc[nb], 0, 0, 0);
    }
  }
}
DEVI void zero4(f32x4 (&a)[4]) {
#pragma unroll
  for (int i = 0; i < 4; ++i) a[i] = (f32x4){0.f, 0.f, 0.f, 0.f};
}

template <int CW> DEVI size_t cont_off(int r, int s, int LD) { const int idx = r * 64 + s; return (size_t)(idx / CW) * LD + (idx % CW); }

template <int TYPE>
DEVI void phase_prep(const P& p, int j, char* smem) {
  constexpr int NH = TYPE == 0 ? 16 : (TYPE == 1 ? 4 : 8);
  constexpr int DK = TYPE == 0 ? 64 : 128;
  constexpr int DV = TYPE == 0 ? 64 : (TYPE == 1 ? 256 : 128);
  constexpr bool LOW = TYPE != 1;
  constexpr int KT = 256 / DK, TPT = 64 / KT, DKH = DK / 64, DVH = DV / 64;
  constexpr int LDQ = TYPE == 1 ? 512 : 1024;
  bf16* X0 = (bf16*)smem; bf16* X1 = X0 + 4608; bf16* Y0 = X1 + 4608; bf16* Y1 = Y0 + 4608;
  float* Lb = (float*)smem;
  bf16* LkT = (bf16*)(smem + 16384); bf16* Ak = LkT + 4608; bf16* nAb = Ak + 4608;
  bf16* M1 = (bf16*)smem;
  bf16* Tt = (bf16*)(smem + 44032); bf16* St1 = Tt + 4608; bf16* St2 = St1 + 4608;
  if (TYPE == 1) { Y0 = (bf16*)(smem + 9216); Ak = (bf16*)(smem + 18432); St1 = (bf16*)(smem + 27648); }
  float* lgL = (float*)(smem + 36864);
  float* tot = (float*)(smem + 71680);
  float* sc_beta = (float*)(smem + 73728);
  float* sc_eg = sc_beta + 64; float* sc_lg = sc_eg + 64; float* sc_g = sc_lg + 64;

  bf16 *Aq, *Akk, *Av, *Ald = nullptr, *Aa = nullptr, *Oq, *Okt, *Ovt, *Ow = nullptr, *Obt = nullptr, *Ool, *Ou0 = nullptr;
  if (TYPE == 0) { Aq = slot(p, 5); Akk = slot(p, 6); Av = slot(p, 7); Ald = slot(p, 2); Aa = slot(p, 3);
    Oq = Aq; Okt = Akk; Ovt = Av; Ow = Ald; Obt = Aa; Ool = slot(p, 0); Ou0 = slot(p, 1); }
  else if (TYPE == 1) { Aq = slot(p, 1); Akk = slot(p, 1) + (size_t)MT * 512; Av = slot(p, 2); Oq = Aq; Okt = Akk; Ovt = Av; Ool = slot(p, 4); }
  else { Aq = slot(p, 5); Akk = slot(p, 6); Av = slot(p, 7); Oq = Aq; Okt = Akk; Ovt = Av; Ow = slot(p, 1); Obt = slot(p, 2); Ool = slot(p, 3); Ou0 = slot(p, 0); }
  float* sm = (float*)(PWS + WS_SM);
  float* gam = (float*)(PWS + WS_GAM);

  for (int item = blockIdx.x; item < NCHUNK * NH; item += gridDim.x) {
    const int c = item / NH, h = item % NH;
    const size_t rb = (size_t)c * 64;
    int tid = threadIdx.x; asm volatile("" : "+v"(tid));
    const int lane = tid & 63, wave = tid >> 6, lr = lane & 15, quad = lane >> 4;
    const int k = tid % DK, tg = tid / DK;
    const int vv = tid & 63, tgv = tid >> 6;
    unsigned qP[TPT / 2], ktP[TPT / 2], kapP[(TYPE == 0) ? TPT / 2 : 1], bvP[(TYPE == 0) ? TPT / 2 : 1];
    float lg[(TYPE == 0) ? TPT : 1], ldv[(TYPE == 0) ? TPT : 1];
    unsigned vP[DVH][8];
    auto lo16 = [](unsigned w) { return __uint_as_float(w << 16); };
    auto hi16 = [](unsigned w) { return __uint_as_float(w & 0xffff0000u); };
#define GETP(arr, e) (((e) & 1) ? hi16(arr[(e) >> 1]) : lo16(arr[(e) >> 1]))
#pragma unroll
    for (int vh = 0; vh < DVH; ++vh)
#pragma unroll
      for (int e = 0; e < 8; ++e) {
        const bf16 a = Av[(rb + tgv * 16 + 2 * e) * 1024 + h * DV + vh * 64 + vv], b = Av[(rb + tgv * 16 + 2 * e + 1) * 1024 + h * DV + vh * 64 + vv];
        vP[vh][e] = (unsigned)a | ((unsigned)b << 16);
        asm volatile("" : "+v"(vP[vh][e]));
      }
    if constexpr (TYPE == 2) {
      if (tid < 64) {
        const float a_log = PIN(36)[h], dtb = PIN(37)[h];
        const float braw = sm[(rb + tid) * 16 + h], araw = sm[(rb + tid) * 16 + 8 + h];
        const float gt = -__expf(a_log) * softplus(araw + dtb);
        sc_beta[tid] = sigm(braw); sc_eg[tid] = __expf(gt); sc_g[tid] = gt;
        float cs = gt;
#pragma unroll
        for (int o = 1; o < 64; o <<= 1) { float n = __shfl_up(cs, o); if (lane >= o) cs += n; }
        sc_lg[tid] = cs;
      }
      __syncthreads();
    }
    if constexpr (TYPE == 0) {
      const float k_k = PIN(21)[j * 1024 + h * 64 + k], k_a = PIN(22)[j * 1024 + h * 64 + k], r_k = PIN(23)[j * 1024 + h * 64 + k];
      float run = 0.f;
#pragma unroll
      for (int e2 = 0; e2 < TPT / 2; ++e2) {
        float qq[2], ka[2], kq[2], bq[2];
#pragma unroll
        for (int u = 0; u < 2; ++u) {
          const int e = e2 * 2 + u;
          const size_t o = (rb + tg * TPT + e) * 1024 + h * 64 + k;
          const float r = bf2f(Aq[o]), kr = bf2f(Akk[o]), av = bf2f(Aa[o]), l = bf2f(Ald[o]);
          const float kk = kr * k_k;
          const float inv = rsqrtf(fmaxf(wsum(kk * kk), 1e-24f));
          qq[u] = r; ka[u] = kk * inv; kq[u] = kr * (1.f + (av - 1.f) * k_a); bq[u] = ka[u] * av; ldv[e] = l;
          const float bo = wsum(r * kq[u] * r_k);
          if (lane == 0) sm[(rb + tg * TPT + e) * 16 + h] = bo;
          run += l; lg[e] = run;
        }
        qP[e2] = pack2(qq[0], qq[1]); kapP[e2] = pack2(ka[0], ka[1]); ktP[e2] = pack2(kq[0], kq[1]); bvP[e2] = pack2(bq[0], bq[1]);
        asm volatile("" : "+v"(qP[e2]), "+v"(kapP[e2]), "+v"(ktP[e2]), "+v"(bvP[e2]));
      }
      tot[tg * 128 + k] = run;
    } else if constexpr (TYPE == 1) {
      float w2[16];
#pragma unroll
      for (int i = 0; i < 16; ++i) w2[i] = PIN(30)[i * 512 + h * 128 + k];
      const float ba = PIN(31)[h * 128 + k];
      float run = 0.f;
#pragma unroll
      for (int e = 0; e < TPT; ++e) {
        const size_t row = rb + tg * TPT + e;
        float s = ba;
#pragma unroll
        for (int i = 0; i < 16; ++i) s += sm[row * 16 + i] * w2[i];
        const float gk = (fminf(s, 0.f) - log1pf(__expf(-fabsf(s)))) * (1.f / 16.f);
        run += gk; lgL[(tg * TPT + e) * 128 + k] = run;
        __builtin_amdgcn_sched_barrier(0);
      }
#pragma unroll
      for (int e2 = 0; e2 < TPT / 2; ++e2) {
        const size_t row = rb + tg * TPT + 2 * e2;
        qP[e2] = (unsigned)Aq[row * 512 + h * 128 + k] | ((unsigned)Aq[(row + 1) * 512 + h * 128 + k] << 16);
        ktP[e2] = (unsigned)Akk[row * 512 + h * 128 + k] | ((unsigned)Akk[(row + 1) * 512 + h * 128 + k] << 16);
        asm volatile("" : "+v"(qP[e2]), "+v"(ktP[e2]));
      }
      tot[tg * 128 + k] = run;
    } else {
#pragma unroll
      for (int e2 = 0; e2 < TPT / 2; ++e2) {
        const size_t o = (rb + tg * TPT + 2 * e2) * 1024 + h * 128 + k;
        qP[e2] = (unsigned)Aq[o] | ((unsigned)Aq[o + 1024] << 16);
        ktP[e2] = (unsigned)Akk[o] | ((unsigned)Akk[o + 1024] << 16);
        asm volatile("" : "+v"(qP[e2]), "+v"(ktP[e2]));
      }
    }
    __syncthreads();
    float lgC;
    if constexpr (TYPE == 2) { lgC = sc_lg[63]; }
    else {
      float off = 0.f, all = 0.f;
#pragma unroll
      for (int g2 = 0; g2 < KT; ++g2) { const float tv = tot[g2 * 128 + k]; all += tv; if (g2 < tg) off += tv; }
      if constexpr (TYPE == 0) {
#pragma unroll
        for (int e = 0; e < TPT; ++e) lg[e] += off;
      } else {
#pragma unroll
        for (int e = 0; e < TPT; ++e) lgL[(tg * TPT + e) * 128 + k] += off;
      }
      lgC = all;
    }
#define QV(e) GETP(qP, e)
#define LGV(e, t) ((TYPE == 2) ? sc_lg[t] : ((TYPE == 1) ? lgL[(t) * 128 + k] : lg[(TYPE == 0) ? (e) : 0]))
#define LPREV(e, t) ((TYPE == 0) ? (lg[(TYPE == 0) ? (e) : 0] - ldv[(TYPE == 0) ? (e) : 0]) : (sc_lg[t] - sc_g[t]))
#define KTV(e, t) ((TYPE == 2) ? (sc_beta[t] * GETP(ktP, e)) : GETP(ktP, e))
#define KAPV(e, t) ((TYPE == 2) ? GETP(ktP, e) : GETP(kapP, (TYPE == 0) ? (e) : 0))
#define BVV(e, t) ((TYPE == 2) ? (sc_beta[t] * sc_eg[t] * GETP(ktP, e)) : GETP(bvP, (TYPE == 0) ? (e) : 0))
    f32x4 sacc[LOW ? 4 : 1][4];
#pragma unroll
    for (int a = 0; a < (LOW ? 4 : 1); ++a) zero4(sacc[a]);
#pragma unroll
    for (int kh = 0; kh < DKH; ++kh) {
      if (k / 64 == kh) {
        const int kk = k & 63;
#pragma unroll
        for (int e = 0; e < TPT; ++e) {
          const int t = tg * TPT + e;
          if constexpr (TYPE == 2) {
            X0[t * 72 + kk] = f2bf(QV(e)); Y0[t * 72 + kk] = f2bf(KTV(e, t));
            X1[t * 72 + kk] = f2bf(KAPV(e, t)); Y1[t * 72 + kk] = f2bf(BVV(e, t));
          } else {
            const float lgt = LGV(e, t);
            const float el = __expf(lgt), eml = __expf(-lgt);
            X0[t * 72 + kk] = f2bf(QV(e) * el);
            Y0[t * 72 + kk] = f2bf(KTV(e, t) * eml);
            if constexpr (LOW) {
              X1[t * 72 + kk] = f2bf(KAPV(e, t) * __expf(LPREV(e, t)));
              Y1[t * 72 + kk] = f2bf(BVV(e, t) * eml);
            }
          }
          __builtin_amdgcn_sched_barrier(0);
        }
      }
      __syncthreads();
      mm_strip(X0, Y0, sacc[0], wave, lane);
      if constexpr (LOW) { mm_strip(X0, Y1, sacc[1], wave, lane); mm_strip(X1, Y0, sacc[2], wave, lane); mm_strip(X1, Y1, sacc[3], wave, lane); }
      __syncthreads();
    }
#pragma unroll
    for (int nb = 0; nb < 4; ++nb)
#pragma unroll
      for (int jj = 0; jj < 4; ++jj) {
        const int t = wave * 16 + quad * 4 + jj, s = nb * 16 + lr;
        float da = 1.f, dl = 1.f;
        if constexpr (TYPE == 2) { const float dd = sc_lg[t] - sc_lg[s]; da = __expf(fminf(dd, 0.f)); dl = __expf(fminf(dd - sc_g[t], 0.f)); }
        Ak[t * 72 + s] = f2bf(s <= t ? sacc[0][nb][jj] * da : 0.f);
        if constexpr (LOW) {
          nAb[t * 72 + s] = f2bf(s <= t ? -sacc[1][nb][jj] * da : 0.f);
          LkT[s * 72 + t] = f2bf(s < t ? sacc[2][nb][jj] * dl : 0.f);
          Lb[t * 64 + (s & 3) * 16 + (s >> 2)] = s < t ? sacc[3][nb][jj] * dl : 0.f;
        }
      }
    __syncthreads();
    f32x4 acc[4];
    if constexpr (LOW) {
      {
        const int q = lane & 3, jc = wave * 16 + (lane >> 2);
        float xr[16];
#pragma unroll
        for (int i = 0; i < 16; ++i) xr[i] = 0.f;
#pragma unroll
        for (int t = 0; t < 64; ++t) {
          float s = 0.f;
          const float* Lr = Lb + t * 64 + q * 16;
#pragma unroll
          for (int i = 0; i < (t + 3) / 4; ++i) s += Lr[i] * xr[i];
          s += __shfl_xor(s, 1); s += __shfl_xor(s, 2);
          s = ((t == jc) ? 1.f : 0.f) - s;
          xr[t >> 2] = (q == (t & 3)) ? s : xr[t >> 2];
          if (q == 0) Tt[t * 72 + jc] = f2bf(s);
          __builtin_amdgcn_sched_barrier(0);
        }
      }
      __syncthreads();
      zero4(acc); mm_strip(Tt, LkT, acc, wave, lane);
#pragma unroll
      for (int nb = 0; nb < 4; ++nb)
#pragma unroll
        for (int jj = 0; jj < 4; ++jj) M1[(wave * 16 + quad * 4 + jj) * 72 + nb * 16 + lr] = f2bf(acc[nb][jj]);
      __syncthreads();
    }
#pragma unroll
    for (int vh = 0; vh < DVH; ++vh) {
#pragma unroll
      for (int e = 0; e < 8; ++e) *(unsigned*)(St1 + vv * 72 + tgv * 16 + 2 * e) = vP[vh][e];
      __syncthreads();
      if constexpr (LOW) {
        zero4(acc); mm_strip(M1, St1, acc, wave, lane);
#pragma unroll
        for (int nb = 0; nb < 4; ++nb)
#pragma unroll
          for (int jj = 0; jj < 4; ++jj) {
            const int t = wave * 16 + quad * 4 + jj, col = nb * 16 + lr; const bf16 u = f2bf(acc[nb][jj]);
            St2[col * 72 + t] = u;
          }
#pragma unroll
        for (int nb = 0; nb < 4; ++nb)
          *(uint2*)(Ou0 + (((((size_t)c * NH + h) * (DV / 16) + vh * 4 + nb) * 4 + wave) * 64 + lane) * 4) = make_uint2(pack2(acc[nb][0], acc[nb][1]), pack2(acc[nb][2], acc[nb][3]));
        __syncthreads();
      }
      zero4(acc); mm_strip(Ak, St1, acc, wave, lane);
      if constexpr (LOW) mm_strip(nAb, St2, acc, wave, lane);
#pragma unroll
      for (int nb = 0; nb < 4; ++nb)
        *(uint2*)(Ool + (((((size_t)c * NH + h) * (DV / 16) + vh * 4 + nb) * 4 + wave) * 64 + lane) * 4) = make_uint2(pack2(acc[nb][0], acc[nb][1]), pack2(acc[nb][2], acc[nb][3]));
      __syncthreads();
    }
    if constexpr (LOW) {
#pragma unroll
      for (int kh = 0; kh < DKH; ++kh) {
        if (k / 64 == kh) {
          const int kk = k & 63;
#pragma unroll
          for (int e = 0; e < TPT; ++e) {
            const int t = tg * TPT + e;
            St1[kk * 72 + t] = f2bf(KAPV(e, t) * __expf(LPREV(e, t)));
            LkT[t * 72 + kk] = f2bf(QV(e) * __expf(LGV(e, t)));
            __builtin_amdgcn_sched_barrier(0);
          }
        }
        __syncthreads();
        zero4(acc); mm_strip(Tt, St1, acc, wave, lane);
#pragma unroll
        for (int nb = 0; nb < 4; ++nb)
#pragma unroll
          for (int jj = 0; jj < 4; ++jj) {
            const int t = wave * 16 + quad * 4 + jj, col = nb * 16 + lr; const bf16 u = f2bf(acc[nb][jj]);
            St2[col * 72 + t] = u;
            Ow[(rb + t) * 1024 + h * DK + kh * 64 + col] = u;
          }
        __syncthreads();
        zero4(acc); mm_strip(nAb, St2, acc, wave, lane);
#pragma unroll
        for (int nb = 0; nb < 4; ++nb)
#pragma unroll
          for (int jj = 0; jj < 4; ++jj) {
            const int t = wave * 16 + quad * 4 + jj, col = nb * 16 + lr;
            Oq[(rb + t) * LDQ + h * DK + kh * 64 + col] = f2bf(acc[nb][jj] + bf2f(LkT[t * 72 + col]));
          }
        __syncthreads();
      }
    } else {
#pragma unroll
      for (int e = 0; e < TPT; ++e) { Oq[(rb + tg * TPT + e) * LDQ + h * DK + k] = f2bf(QV(e) * __expf(LGV(e, tg * TPT + e))); __builtin_amdgcn_sched_barrier(0); }
    }
    {
      unsigned wk[TPT / 2], wb[LOW ? TPT / 2 : 1];
#pragma unroll
      for (int e = 0; e < TPT; e += 2) {
        const int t0 = tg * TPT + e;
        const float d0 = __expf(lgC - LGV(e, t0)), d1 = __expf(lgC - LGV(e + 1, t0 + 1));
        wk[e / 2] = pack2(KTV(e, t0) * d0, KTV(e + 1, t0 + 1) * d1);
        if constexpr (LOW) wb[e / 2] = pack2(BVV(e, t0) * d0, BVV(e + 1, t0 + 1) * d1);
        __builtin_amdgcn_sched_barrier(0);
      }
      const size_t co = rb * LDQ + h * DK + cont_off<DK>(k, tg * TPT, LDQ);
#pragma unroll
      for (int e = 0; e < TPT / 8; ++e) {
        *(uint4*)(Okt + co + e * 8) = make_uint4(wk[e * 4], wk[e * 4 + 1], wk[e * 4 + 2], wk[e * 4 + 3]);
        if constexpr (LOW) *(uint4*)(Obt + co + e * 8) = make_uint4(wb[e * 4], wb[e * 4 + 1], wb[e * 4 + 2], wb[e * 4 + 3]);
      }
#pragma unroll
      for (int vh = 0; vh < DVH; ++vh) {
        const unsigned* wv = vP[vh];
        const size_t vo = rb * 1024 + h * DV + cont_off<DV>(vh * 64 + vv, tgv * 16, 1024);
        *(uint4*)(Ovt + vo) = make_uint4(wv[0], wv[1], wv[2], wv[3]);
        *(uint4*)(Ovt + vo + 8) = make_uint4(wv[4], wv[5], wv[6], wv[7]);
      }
      if (tg == 0) gam[((size_t)c * NH + h) * DK + k] = __expf(lgC);
    }
    __syncthreads();
  }
}

template <int TYPE>
DEVI void phase_seq(const P& p, int j) {
  constexpr int NH = TYPE == 0 ? 16 : (TYPE == 1 ? 4 : 8);
  constexpr int DK = TYPE == 0 ? 64 : 128;
  constexpr int DV = TYPE == 0 ? 64 : (TYPE == 1 ? 256 : 128);
  constexpr bool LOW = TYPE != 1;
  constexpr int NVB = DV / 16, MB = DK / 16, KS = DK / 32;
  constexpr int LDQ = TYPE == 1 ? 512 : 1024;
  constexpr int IPS = NH * NVB;
  const int lane = threadIdx.x & 63, wave = threadIdx.x >> 6, lr = lane & 15, quad = lane >> 4;
  const bf16 *Qp, *Kt, *Vt, *Wp = nullptr, *Bt = nullptr, *U0 = nullptr; bf16* Ol;
  if (TYPE == 0) { Qp = slot(p, 5); Kt = slot(p, 6); Vt = slot(p, 7); Wp = slot(p, 2); Bt = slot(p, 3); Ol = slot(p, 0); U0 = slot(p, 1); }
  else if (TYPE == 1) { Qp = slot(p, 1); Kt = slot(p, 1) + (size_t)MT * 512; Vt = slot(p, 2); Ol = slot(p, 4); }
  else { Qp = slot(p, 5); Kt = slot(p, 6); Vt = slot(p, 7); Wp = slot(p, 1); Bt = slot(p, 2); Ol = slot(p, 3); U0 = slot(p, 0); }
  const float* gam = (const float*)(PWS + WS_GAM);
  const int nitems = 33 * IPS;
  for (int item = wave * gridDim.x + blockIdx.x; item < nitems; item += gridDim.x * 4) {
    const int seq = item / IPS, rem = item % IPS, h = rem / NVB, vb = rem % NVB;
    const int c0 = seq == 0 ? 0 : NPCH + seq - 1, nc = seq == 0 ? NPCH : 1;
    const int vcol = vb * 16 + lr;
    f32x4 H[MB];
    if (seq == 0) {
#pragma unroll
      for (int m = 0; m < MB; ++m) H[m] = (f32x4){0.f, 0.f, 0.f, 0.f};
    } else {
      const int b = seq - 1;
      if (TYPE == 0) {
        const float* S = PIN(3) + (((size_t)j * NSS + b) * 16 + h) * 4096 + (size_t)vcol * 64;
#pragma unroll
        for (int m = 0; m < MB; ++m) { float4 v = *(const float4*)(S + m * 16 + quad * 4); H[m] = (f32x4){v.x, v.y, v.z, v.w}; }
      } else {
        const float* S = PIN(TYPE == 1 ? 4 : 6) + ((size_t)b * NH + h) * DK * DV + vcol;
#pragma unroll
        for (int m = 0; m < MB; ++m)
#pragma unroll
          for (int jj = 0; jj < 4; ++jj) H[m][jj] = S[(size_t)(m * 16 + quad * 4 + jj) * DV];
      }
    }
    unsigned tsink = 0;
    for (int c = c0; c < c0 + nc; ++c) {
      const size_t rb = (size_t)c * 64;
      int ln = threadIdx.x & 63; asm volatile("" : "+v"(ln));
      const int lr = ln & 15, quad = ln >> 4, vcol = vb * 16 + lr;
      const bf16* qb = Qp + rb * LDQ + h * DK;
      const bf16* wb = LOW ? Wp + rb * 1024 + h * DK : nullptr;
      const bf16* kb = Kt + rb * LDQ + h * DK;
      const bf16* bb = LOW ? Bt + rb * 1024 + h * DK : nullptr;
      const bf16* vtb = Vt + rb * 1024 + h * DV;
      const size_t fo = ((((size_t)c * NH + h) * NVB + vb) * 4) * 256 + ln * 4;
      const float* gp = gam + ((size_t)c * NH + h) * DK + quad * 4;
      bf16x8 hb[KS];
#pragma unroll
      for (int ks = 0; ks < KS; ++ks) {
        const u32x4 hw = {pack2(H[2 * ks][0], H[2 * ks][1]), pack2(H[2 * ks][2], H[2 * ks][3]), pack2(H[2 * ks + 1][0], H[2 * ks + 1][1]), pack2(H[2 * ks + 1][2], H[2 * ks + 1][3])};
        hb[ks] = __builtin_bit_cast(bf16x8, hw);
      }
      uint2 oin[4], uin[4]; bf16x8 qa[4][KS], wa[LOW ? 4 : 1][KS];
      bf16x8 vbop[2], kfr[MB][2], bfr[LOW ? MB : 1][2]; float4 gv[MB];
#define LOAD_A(tb) do { oin[tb] = *(const uint2*)(Ol + fo + (tb) * 256); if constexpr (LOW) uin[tb] = *(const uint2*)(U0 + fo + (tb) * 256); \
        _Pragma("unroll") for (int ks = 0; ks < KS; ++ks) { const int off_ = ((tb) * 16 + lr) * LDQ + ks * 32 + quad * 4; \
          bf16x4 lo_ = *(const bf16x4*)(qb + off_), hi_ = *(const bf16x4*)(qb + off_ + 16); qa[tb][ks] = __builtin_shufflevector(lo_, hi_, 0, 1, 2, 3, 4, 5, 6, 7); \
          if constexpr (LOW) { const int ow_ = ((tb) * 16 + lr) * 1024 + ks * 32 + quad * 4; bf16x4 wl_ = *(const bf16x4*)(wb + ow_), wh_ = *(const bf16x4*)(wb + ow_ + 16); \
            wa[tb][ks] = __builtin_shufflevector(wl_, wh_, 0, 1, 2, 3, 4, 5, 6, 7); } } } while (0)
#define COMP_A(tb) do { f32x4 o_, u_; \
        o_ = (f32x4){bf2f(oin[tb].x & 0xffff), bf2f(oin[tb].x >> 16), bf2f(oin[tb].y & 0xffff), bf2f(oin[tb].y >> 16)}; \
        if constexpr (LOW) u_ = (f32x4){bf2f(uin[tb].x & 0xffff), bf2f(uin[tb].x >> 16), bf2f(uin[tb].y & 0xffff), bf2f(uin[tb].y >> 16)}; \
        _Pragma("unroll") for (int ks = 0; ks < KS; ++ks) { o_ = __builtin_amdgcn_mfma_f32_16x16x32_bf16(qa[tb][ks], hb[ks], o_, 0, 0, 0); \
          if constexpr (LOW) u_ = __builtin_amdgcn_mfma_f32_16x16x32_bf16(wa[tb][ks], hb[ks], u_, 0, 0, 0); } \
        *(uint2*)(Ol + fo + (tb) * 256) = make_uint2(pack2(o_[0], o_[1]), pack2(o_[2], o_[3])); \
        if constexpr (LOW) U[tb] = u_; } while (0)
#define LOAD_B(m) do { gv[m] = *(const float4*)(gp + (m) * 16); const int krow_ = (m) * 16 + lr; \
        _Pragma("unroll") for (int ks = 0; ks < 2; ++ks) { kfr[m][ks] = *(const bf16x8*)(kb + cont_off<DK>(krow_, ks * 32 + quad * 8, LDQ)); \
          if constexpr (LOW) { bf16x4 lo_ = *(const bf16x4*)(bb + cont_off<DK>(krow_, ks * 32 + quad * 4, 1024)); \
            bf16x4 hi_ = *(const bf16x4*)(bb + cont_off<DK>(krow_, ks * 32 + 16 + quad * 4, 1024)); bfr[m][ks] = __builtin_shufflevector(lo_, hi_, 0, 1, 2, 3, 4, 5, 6, 7); } } } while (0)
#define COMP_B(m) do { f32x4 hn_ = (f32x4){H[m][0] * gv[m].x, H[m][1] * gv[m].y, H[m][2] * gv[m].z, H[m][3] * gv[m].w}; \
        _Pragma("unroll") for (int ks = 0; ks < 2; ++ks) { hn_ = __builtin_amdgcn_mfma_f32_16x16x32_bf16(kfr[m][ks], vbop[ks], hn_, 0, 0, 0); \
          if constexpr (LOW) hn_ = __builtin_amdgcn_mfma_f32_16x16x32_bf16(bfr[m][ks], ubop[ks], hn_, 0, 0, 0); } \
        H[m] = hn_; } while (0)
      f32x4 U[4];
      constexpr int PF = 3;
      constexpr int LPR = DK / 64;
      unsigned tv[LPR * 4 + 1];
#pragma unroll
      for (int i = 0; i < LPR * 4 + 1; ++i) tv[i] = 0;
      if (c + PF < c0 + nc) {
        const size_t rb2 = (size_t)(c + PF) * 64;
#pragma unroll
        for (int i = 0; i < LPR; ++i) {
          const int li = i * 64 + ln; const size_t ro = (size_t)(li / LPR), co = (size_t)(li % LPR) * 64;
          tv[i * 4 + 0] = *(const unsigned*)(Qp + (rb2 + ro) * LDQ + h * DK + co);
          tv[i * 4 + 1] = *(const unsigned*)(Kt + (rb2 + ro) * LDQ + h * DK + co);
          if constexpr (LOW) { tv[i * 4 + 2] = *(const unsigned*)(Wp + (rb2 + ro) * 1024 + h * DK + co); tv[i * 4 + 3] = *(const unsigned*)(Bt + (rb2 + ro) * 1024 + h * DK + co); }
        }
        {
          const size_t fo2 = ((((size_t)(c + PF) * NH + h) * NVB + vb) * 4) * 256;
          const unsigned* tp;
          if (ln < 16) tp = (const unsigned*)(Ol + fo2 + ln * 64);
          else if (LOW && ln < 32) tp = (const unsigned*)(U0 + fo2 + (ln - 16) * 64);
          else if (ln < 48) tp = (const unsigned*)(Vt + rb2 * 1024 + h * DV + cont_off<DV>(vb * 16 + (ln & 15), 0, 1024));
          else tp = (const unsigned*)(gam + ((size_t)(c + PF) * NH + h) * DK + ((ln - 48) & (DK / 32 - 1)) * 32);
          tv[LPR * 4] = *tp;
        }
      }
      LOAD_A(0); LOAD_A(1); LOAD_A(2); LOAD_A(3);
#pragma unroll
      for (int ks = 0; ks < 2; ++ks) vbop[ks] = *(const bf16x8*)(vtb + cont_off<DV>(vcol, ks * 32 + quad * 8, 1024));
#pragma unroll
      for (int m = 0; m < MB; ++m) LOAD_B(m);
      __builtin_amdgcn_sched_barrier(0);
      COMP_A(0); COMP_A(1); COMP_A(2); COMP_A(3);
      bf16x8 ubop[2];
      if constexpr (LOW) {
#pragma unroll
        for (int ks = 0; ks < 2; ++ks) {
          const u32x4 uw = {pack2(-U[2 * ks][0], -U[2 * ks][1]), pack2(-U[2 * ks][2], -U[2 * ks][3]), pack2(-U[2 * ks + 1][0], -U[2 * ks + 1][1]), pack2(-U[2 * ks + 1][2], -U[2 * ks + 1][3])};
          ubop[ks] = __builtin_bit_cast(bf16x8, uw);
        }
      }
#pragma unroll
      for (int m = 0; m < MB; ++m) COMP_B(m);
      __builtin_amdgcn_sched_barrier(0);
#pragma unroll
      for (int i = 0; i < LPR * 4 + 1; ++i) tsink ^= tv[i];
#undef LOAD_A
#undef COMP_A
#undef LOAD_B
#undef COMP_B
    }
    if (tsink == 0x9e3779b9u) ((unsigned*)(PWS + WS_TOTAL - 64))[0] = tsink;
    if (TYPE == 0) {
      float* S = POUT + (seq == 0 ? O_AWKV_P + ((size_t)j * 16 + h) * 4096 : O_AWKV_S + (((size_t)j * NSS + (seq - 1)) * 16 + h) * 4096) + (size_t)vcol * 64;
#pragma unroll
      for (int m = 0; m < MB; ++m) *(float4*)(S + m * 16 + quad * 4) = make_float4(H[m][0], H[m][1], H[m][2], H[m][3]);
    } else {
      const size_t ob = TYPE == 1 ? (seq == 0 ? O_BKV_P : O_BKV_S + (size_t)(seq - 1) * NH * DK * DV)
                                  : (seq == 0 ? O_CKV_P : O_CKV_S + (size_t)(seq - 1) * NH * DK * DV);
      float* S = POUT + ob + (size_t)h * DK * DV + vcol;
#pragma unroll
      for (int m = 0; m < MB; ++m)
#pragma unroll
        for (int jj = 0; jj < 4; ++jj) S[(size_t)(m * 16 + quad * 4 + jj) * DV] = H[m][jj];
    }
  }
}

template <int TYPE>
DEVI void phase_seq2(const P& p, int j, char* smem) {
  constexpr int NH = TYPE == 0 ? 16 : (TYPE == 1 ? 4 : 8);
  constexpr int DK = TYPE == 0 ? 64 : 128;
  constexpr int DV = TYPE == 0 ? 64 : (TYPE == 1 ? 256 : 128);
  constexpr bool LOW = TYPE != 1;
  constexpr int NVB = DV / 16, MB = DK / 16, KS = DK / 32, NG = NVB / 4, BIPS = NH * NG;
  constexpr int LDQ = TYPE == 1 ? 512 : 1024;
  constexpr int NOP = LOW ? 4 : 2, RS = DK + 8, OPSZ = 64 * RS, PPR = DK / 8;
  constexpr int PPO = 64 * PPR / 256;
  constexpr int PF = 4;
  bf16* L = (bf16*)smem;
  const int tid = threadIdx.x, lane = tid & 63, wave = tid >> 6, lr = lane & 15, quad = lane >> 4;
  const bf16 *Qp, *Kt, *Vt, *Wp = nullptr, *Bt = nullptr, *U0 = nullptr; bf16* Ol;
  if (TYPE == 0) { Qp = slot(p, 5); Kt = slot(p, 6); Vt = slot(p, 7); Wp = slot(p, 2); Bt = slot(p, 3); Ol = slot(p, 0); U0 = slot(p, 1); }
  else if (TYPE == 1) { Qp = slot(p, 1); Kt = slot(p, 1) + (size_t)MT * 512; Vt = slot(p, 2); Ol = slot(p, 4); }
  else { Qp = slot(p, 5); Kt = slot(p, 6); Vt = slot(p, 7); Wp = slot(p, 1); Bt = slot(p, 2); Ol = slot(p, 3); U0 = slot(p, 0); }
  const float* gam = (const float*)(PWS + WS_GAM);
  unsigned tsink = 0;
  for (int bitem = blockIdx.x; bitem < 33 * BIPS; bitem += gridDim.x) {
    const int seq = bitem / BIPS, rem = bitem % BIPS, h = rem / NG, vb = (rem % NG) * 4 + wave;
    const int c0 = seq == 0 ? 0 : NPCH + seq - 1, nc = seq == 0 ? NPCH : 1;
    const int vcol = vb * 16 + lr;
    f32x4 H[MB];
    if (seq == 0) {
#pragma unroll
      for (int m = 0; m < MB; ++m) H[m] = (f32x4){0.f, 0.f, 0.f, 0.f};
    } else {
      const int b = seq - 1;
      if (TYPE == 0) {
        const float* S = PIN(3) + (((size_t)j * NSS + b) * 16 + h) * 4096 + (size_t)vcol * 64;
#pragma unroll
        for (int m = 0; m < MB; ++m) { float4 v = *(const float4*)(S + m * 16 + quad * 4); H[m] = (f32x4){v.x, v.y, v.z, v.w}; }
      } else {
        const float* S = PIN(TYPE == 1 ? 4 : 6) + ((size_t)b * NH + h) * DK * DV + vcol;
#pragma unroll
        for (int m = 0; m < MB; ++m)
#pragma unroll
          for (int jj = 0; jj < 4; ++jj) H[m][jj] = S[(size_t)(m * 16 + quad * 4 + jj) * DV];
      }
    }
    u32x4 preA[NOP * PPO], preB[NOP * PPO]; u32x2 poA[4], poB[4], puA[4], puB[4]; bf16x8 pvA[2], pvB[2]; f32x4 pgA[MB], pgB[MB];
    auto issue_sh = [&](int cc, u32x4 (&pre)[NOP * PPO]) {
      const size_t rb_ = (size_t)cc * 64; int tl_ = threadIdx.x; asm volatile("" : "+v"(tl_));
#pragma unroll
      for (int i_ = 0; i_ < PPO; ++i_) { const int w_ = tl_ + 256 * i_; const size_t r_ = rb_ + w_ / PPR; const int c8_ = (w_ % PPR) * 8;
        pre[0 * PPO + i_] = *(const u32x4*)(Qp + r_ * LDQ + h * DK + c8_);
        pre[1 * PPO + i_] = *(const u32x4*)(Kt + r_ * LDQ + h * DK + c8_);
        if constexpr (LOW) { pre[2 * PPO + i_] = *(const u32x4*)(Wp + r_ * 1024 + h * DK + c8_); pre[3 * PPO + i_] = *(const u32x4*)(Bt + r_ * 1024 + h * DK + c8_); } }
    };
    auto issue_pr = [&](int cc, u32x2 (&p_o)[4], u32x2 (&p_u)[4], bf16x8 (&p_v)[2], f32x4 (&p_g)[MB]) {
      const size_t rb_ = (size_t)cc * 64; int tl_ = threadIdx.x; asm volatile("" : "+v"(tl_));
      const int lane = tl_ & 63, lr = lane & 15, quad = lane >> 4, vcol = vb * 16 + lr;
      const size_t fo_ = ((((size_t)cc * NH + h) * NVB + vb) * 4) * 256 + lane * 4;
#pragma unroll
      for (int tb_ = 0; tb_ < 4; ++tb_) { p_o[tb_] = *(const u32x2*)(Ol + fo_ + tb_ * 256); if constexpr (LOW) p_u[tb_] = *(const u32x2*)(U0 + fo_ + tb_ * 256); }
#pragma unroll
      for (int ks_ = 0; ks_ < 2; ++ks_) p_v[ks_] = *(const bf16x8*)(Vt + rb_ * 1024 + h * DV + cont_off<DV>(vcol, ks_ * 32 + quad * 8, 1024));
#pragma unroll
      for (int m_ = 0; m_ < MB; ++m_) p_g[m_] = *(const f32x4*)(gam + ((size_t)cc * NH + h) * DK + m_ * 16 + quad * 4);
    };
    const int cend = c0 + nc;
    auto step = [&](int c, u32x4 (&pre)[NOP * PPO], u32x2 (&p_o)[4], u32x2 (&p_u)[4], bf16x8 (&p_v)[2], f32x4 (&p_g)[MB]) {
#pragma unroll
      for (int o = 0; o < NOP; ++o)
#pragma unroll
        for (int i = 0; i < PPO; ++i) { const int w = tid + 256 * i; *(u32x4*)(L + o * OPSZ + (w / PPR) * RS + (w % PPR) * 8) = pre[o * PPO + i]; }
      __syncthreads();
      if (c + 2 < cend) issue_sh(c + 2, pre);
      unsigned tv[NOP * DK / 128 + 1];
#pragma unroll
      for (int i = 0; i < NOP * DK / 128 + 1; ++i) tv[i] = 0;
      if (false && c + PF < cend) {
        const size_t rb2 = (size_t)(c + PF) * 64;
        if (DK == 128 || tid < 128) {
          const int li = (DK == 128) ? tid : tid; const size_t ro = li / (DK / 64) % 64; const int co = (li % (DK / 64)) * 64;
          const int half = (DK == 128) ? (tid >> 7) : (tid >> 6);
          if (half == 0) { tv[0] = *(const unsigned*)(Qp + (rb2 + ro) * LDQ + h * DK + co); if constexpr (LOW) tv[1] = *(const unsigned*)(Wp + (rb2 + ro) * 1024 + h * DK + co); }
          else { tv[0] = *(const unsigned*)(Kt + (rb2 + ro) * LDQ + h * DK + co); if constexpr (LOW) tv[1] = *(const unsigned*)(Bt + (rb2 + ro) * 1024 + h * DK + co); }
        }
        {
          const size_t fo2 = ((((size_t)(c + PF) * NH + h) * NVB + vb) * 4) * 256;
          const unsigned* tp;
          if (lane < 16) tp = (const unsigned*)(Ol + fo2 + lane * 64);
          else if (LOW && lane < 32) tp = (const unsigned*)(U0 + fo2 + (lane - 16) * 64);
          else if (lane < 48) tp = (const unsigned*)(Vt + rb2 * 1024 + h * DV + cont_off<DV>(vb * 16 + (lane & 15), 0, 1024));
          else tp = (const unsigned*)(gam + ((size_t)(c + PF) * NH + h) * DK + ((lane - 48) & (DK / 32 - 1)) * 32);
          tv[NOP * DK / 128] = *tp;
        }
      }
      bf16x8 hb[KS];
#pragma unroll
      for (int ks = 0; ks < KS; ++ks) {
        const u32x4 hw = {pack2(H[2 * ks][0], H[2 * ks][1]), pack2(H[2 * ks][2], H[2 * ks][3]), pack2(H[2 * ks + 1][0], H[2 * ks + 1][1]), pack2(H[2 * ks + 1][2], H[2 * ks + 1][3])};
        hb[ks] = __builtin_bit_cast(bf16x8, hw);
      }
      const size_t fo = ((((size_t)c * NH + h) * NVB + vb) * 4) * 256 + lane * 4;
      f32x4 U[4];
#pragma unroll
      for (int tb = 0; tb < 4; ++tb) {
        f32x4 o_ = (f32x4){bf2f(p_o[tb].x & 0xffff), bf2f(p_o[tb].x >> 16), bf2f(p_o[tb].y & 0xffff), bf2f(p_o[tb].y >> 16)}, u_;
        if constexpr (LOW) u_ = (f32x4){bf2f(p_u[tb].x & 0xffff), bf2f(p_u[tb].x >> 16), bf2f(p_u[tb].y & 0xffff), bf2f(p_u[tb].y >> 16)};
#pragma unroll
        for (int ks = 0; ks < KS; ++ks) {
          const bf16* qp = L + 0 * OPSZ + (tb * 16 + lr) * RS + ks * 32 + quad * 4;
          bf16x4 lo = *(const bf16x4*)qp, hi = *(const bf16x4*)(qp + 16);
          o_ = __builtin_amdgcn_mfma_f32_16x16x32_bf16(__builtin_shufflevector(lo, hi, 0, 1, 2, 3, 4, 5, 6, 7), hb[ks], o_, 0, 0, 0);
          if constexpr (LOW) {
            const bf16* wp = L + 2 * OPSZ + (tb * 16 + lr) * RS + ks * 32 + quad * 4;
            bf16x4 wl = *(const bf16x4*)wp, wh = *(const bf16x4*)(wp + 16);
            u_ = __builtin_amdgcn_mfma_f32_16x16x32_bf16(__builtin_shufflevector(wl, wh, 0, 1, 2, 3, 4, 5, 6, 7), hb[ks], u_, 0, 0, 0);
          }
        }
        *(u32x2*)(Ol + fo + tb * 256) = (u32x2){pack2(o_[0], o_[1]), pack2(o_[2], o_[3])};
        if constexpr (LOW) U[tb] = u_;
      }
      bf16x8 ubop[2];
      if constexpr (LOW) {
#pragma unroll
        for (int ks = 0; ks < 2; ++ks) {
          const u32x4 uw = {pack2(-U[2 * ks][0], -U[2 * ks][1]), pack2(-U[2 * ks][2], -U[2 * ks][3]), pack2(-U[2 * ks + 1][0], -U[2 * ks + 1][1]), pack2(-U[2 * ks + 1][2], -U[2 * ks + 1][3])};
          ubop[ks] = __builtin_bit_cast(bf16x8, uw);
        }
      }
#pragma unroll
      for (int m = 0; m < MB; ++m) {
        f32x4 hn = (f32x4){H[m][0] * p_g[m][0], H[m][1] * p_g[m][1], H[m][2] * p_g[m][2], H[m][3] * p_g[m][3]};
        const int krow = m * 16 + lr;
#pragma unroll
        for (int ks = 0; ks < 2; ++ks) {
          const int i1 = krow * 64 + ks * 32 + quad * 8;
          bf16x8 a = *(const bf16x8*)(L + 1 * OPSZ + (i1 / DK) * RS + (i1 % DK));
          hn = __builtin_amdgcn_mfma_f32_16x16x32_bf16(a, p_v[ks], hn, 0, 0, 0);
          if constexpr (LOW) {
            const int i2 = krow * 64 + ks * 32 + quad * 4, i3 = i2 + 16;
            bf16x4 lo = *(const bf16x4*)(L + 3 * OPSZ + (i2 / DK) * RS + (i2 % DK)), hi = *(const bf16x4*)(L + 3 * OPSZ + (i3 / DK) * RS + (i3 % DK));
            hn = __builtin_amdgcn_mfma_f32_16x16x32_bf16(__builtin_shufflevector(lo, hi, 0, 1, 2, 3, 4, 5, 6, 7), ubop[ks], hn, 0, 0, 0);
          }
        }
        H[m] = hn;
      }
#pragma unroll
      for (int i = 0; i < NOP * DK / 128 + 1; ++i) tsink ^= tv[i];
      if (c + 2 < cend) issue_pr(c + 2, p_o, p_u, p_v, p_g);
      __syncthreads();
    };
    issue_sh(c0, preA); issue_pr(c0, poA, puA, pvA, pgA);
    if (nc > 1) { issue_sh(c0 + 1, preB); issue_pr(c0 + 1, poB, puB, pvB, pgB); }
    for (int c = c0; c < cend; c += 2) { step(c, preA, poA, puA, pvA, pgA); if (c + 1 < cend) step(c + 1, preB, poB, puB, pvB, pgB); }
    if (TYPE == 0) {
      float* S = POUT + (seq == 0 ? O_AWKV_P + ((size_t)j * 16 + h) * 4096 : O_AWKV_S + (((size_t)j * NSS + (seq - 1)) * 16 + h) * 4096) + (size_t)vcol * 64;
#pragma unroll
      for (int m = 0; m < MB; ++m) *(float4*)(S + m * 16 + quad * 4) = make_float4(H[m][0], H[m][1], H[m][2], H[m][3]);
    } else {
      const size_t ob = TYPE == 1 ? (seq == 0 ? O_BKV_P : O_BKV_S + (size_t)(seq - 1) * NH * DK * DV)
                                  : (seq == 0 ? O_CKV_P : O_CKV_S + (size_t)(seq - 1) * NH * DK * DV);
      float* S = POUT + ob + (size_t)h * DK * DV + vcol;
#pragma unroll
      for (int m = 0; m < MB; ++m)
#pragma unroll
        for (int jj = 0; jj < 4; ++jj) S[(size_t)(m * 16 + quad * 4 + jj) * DV] = H[m][jj];
    }
  }
  if (tsink == 0x9e3779b9u) ((unsigned*)(PWS + WS_TOTAL - 64))[0] = tsink;
}

template <int TYPE>
DEVI void phase_post(const P& p, int j, char* smem) {
  constexpr int NH = TYPE == 0 ? 16 : (TYPE == 1 ? 4 : 8);
  constexpr int DV = TYPE == 0 ? 64 : (TYPE == 1 ? 256 : 128);
  constexpr int CPT = DV / 8;
  bf16* vt = (bf16*)smem;
  bf16* ot = (bf16*)(smem + 9216);
  const bf16* O = slot(p, TYPE == 0 ? 0 : (TYPE == 1 ? 4 : 3));
  const bf16* G = slot(p, TYPE == 0 ? 4 : (TYPE == 1 ? 3 : 4));
  bf16* og = slot(p, TYPE == 1 ? 0 : 1);
  const float* sm = (const float*)(PWS + WS_SM);
  for (int item = blockIdx.x; item < NCHUNK * NH; item += gridDim.x) {
    const int c = item / NH, h = item % NH; const size_t rb = (size_t)c * 64;
    int tid = threadIdx.x; asm volatile("" : "+v"(tid));
    const int part = tid & 7;
    if constexpr (TYPE == 0) {
      const bf16* V = slot(p, 7) + rb * 1024 + h * 64;
      const int r = tid >> 2, q4 = (tid & 3) * 16;
      *(uint4*)(vt + r * 72 + q4) = *(const uint4*)(V + (size_t)r * 1024 + q4);
      *(uint4*)(vt + r * 72 + q4 + 8) = *(const uint4*)(V + (size_t)r * 1024 + q4 + 8);
      __syncthreads();
    }
    {
      const uint4* srcp = (const uint4*)(O + ((size_t)c * NH + h) * 64 * DV);
#pragma unroll
      for (int i = 0; i < DV / 32; ++i) *(uint4*)(ot + (size_t)(i * 256 + tid) * 8) = srcp[i * 256 + tid];
      __syncthreads();
    }
#pragma unroll 1
    for (int pass = 0; pass < 2; ++pass) {
      const int t = pass * 32 + (tid >> 3);
      const size_t base = (rb + t) * 1024 + h * DV + part * CPT;
      float o[CPT];
#pragma unroll
      for (int e = 0; e < CPT; ++e) {
        const int v = part * CPT + e;
        o[e] = bf2f(ot[(((v >> 4) * 4 + (t >> 4)) * 64 + ((t & 15) >> 2) * 16 + (v & 15)) * 4 + (t & 3)]);
      }
      float s1 = 0.f, s2 = 0.f;
#pragma unroll
      for (int e = 0; e < CPT; ++e) { s1 += o[e]; s2 += o[e] * o[e]; }
      s1 += __shfl_xor(s1, 1); s1 += __shfl_xor(s1, 2); s1 += __shfl_xor(s1, 4);
      s2 += __shfl_xor(s2, 1); s2 += __shfl_xor(s2, 2); s2 += __shfl_xor(s2, 4);
      if constexpr (TYPE == 0) {
        const float mean = s1 * (1.f / 64.f); float var = s2 * (1.f / 64.f) - mean * mean; var = fmaxf(var, 0.f);
        const float rs = rsqrtf(var + 64e-5f); const float bonus = sm[(rb + t) * 16 + h];
        const float* lw = PIN(26) + j * 1024 + h * 64 + part * CPT; const float* lb = PIN(27) + j * 1024 + h * 64 + part * CPT;
#pragma unroll
        for (int e = 0; e < CPT; ++e) {
          const float vv = bf2f(vt[(part * CPT + e) * 72 + t]);
          o[e] = (o[e] - mean) * rs * lw[e] + lb[e] + bonus * vv;
        }
      } else {
        const float rs = rsqrtf(s2 * (1.f / DV) + 1e-6f);
        const float* on = PIN(TYPE == 1 ? 32 : 38) + part * CPT;
#pragma unroll
        for (int e = 0; e < CPT; ++e) o[e] = o[e] * rs * on[e];
      }
#pragma unroll
      for (int e = 0; e < CPT; e += 8) {
        uint4 u = *(const uint4*)(G + base + e);
        const unsigned w[4] = {u.x, u.y, u.z, u.w}; unsigned ow[4];
#pragma unroll
        for (int i = 0; i < 4; ++i) {
          float g0 = bf2f(w[i] & 0xffff), g1 = bf2f(w[i] >> 16);
          if constexpr (TYPE != 0) { g0 = silu(g0); g1 = silu(g1); }
          ow[i] = pack2(o[e + 2 * i] * g0, o[e + 2 * i + 1] * g1);
        }
        *(uint4*)(og + base + e) = make_uint4(ow[0], ow[1], ow[2], ow[3]);
      }
    }
    __syncthreads();
  }
}

#ifndef DISMASK
#define DISMASK 0
#endif
#define EN(b) (!((DISMASK >> (b)) & 1))
#define GSYNC() do { asm volatile("s_waitcnt vmcnt(0)" ::: "memory"); grid.sync(); } while (0)
__global__ void __launch_bounds__(256, 1) fwd_megakernel(P p) {
  extern __shared__ __attribute__((aligned(16))) char smem[];
  cg::grid_group grid = cg::this_grid();
  bf16* wreg = (bf16*)(PWS + WS_W);
  bf16 *wfin = wreg + W_FIN, *wfout = wreg + W_FOUT, *wmix = wreg + W_MIX;
  float* sm = (float*)(PWS + WS_SM);
  for (int layer = 0; layer < 4; ++layer) {
    const int type = layer % 3, j = layer / 3;
    int tb = 0;
    if (type == 0) phase_norm<0>(p, layer, j, layer == 0, layer == 0);
    else phase_norm<1>(p, layer, j, false, false);
    conv_job(CvFfnIn{PIN(10) + (size_t)layer * 1024 * 2 * FF}, wfin, 1024, 2 * FF, 1024, tb, smem);
    conv_job(CvPlain{PIN(11) + (size_t)layer * FF * 1024, 1024, 1024}, wfout, FF, 1024, FF, tb, smem);
    if (type == 0) {
      for (int i = 0; i < 3; ++i) conv_job(CvPlain{PIN(24) + ((size_t)j * 3 + i) * 1048576, 1024, 1024}, wmix + (size_t)i * 1048576, 1024, 1024, 1024, tb, smem);
      conv_job(CvLora1{PIN(14) + (size_t)j * 65536, PIN(17) + (size_t)j * 65536, PIN(19) + (size_t)j * 131072, PIN(12) + (size_t)j * 6144}, wmix + 3145728, 2048, 256, 2048, tb, smem);
      conv_job(CvPlain{PIN(15) + (size_t)j * 65536, 1024, 1024}, wmix + 3670016, 64, 1024, 64, tb, smem);
      conv_job(CvPlain{PIN(18) + (size_t)j * 65536, 1024, 1024}, wmix + 3735552, 64, 1024, 64, tb, smem);
      conv_job(CvPlain{PIN(20) + (size_t)j * 131072, 1024, 1024}, wmix + 3801088, 128, 1024, 128, tb, smem);
      conv_job(CvPlain{PIN(25) + (size_t)j * 1048576, 1024, 1024}, wmix + 3932160, 1024, 1024, 1024, tb, smem);
    } else if (type == 1) {
      conv_job(CvGlaIn{PIN(28), PIN(29)}, wmix, 1024, 3200, 1024, tb, smem);
      conv_job(CvPlain{PIN(33), 1024, 1024}, wmix + 3276800, 1024, 1024, 1024, tb, smem);
    } else {
      conv_job(CvPlain{PIN(34), 4112, 4112}, wmix, 1024, 4224, 1024, tb, smem);
      conv_job(CvPlain{PIN(39), 1024, 1024}, wmix + 4325376, 1024, 1024, 1024, tb, smem);
    }
    GSYNC();
    tb = 0;
    const bf16* wo;
    if (type == 0) {
      for (int i = 0; i < 3; ++i)
        gemm_job(GemmDesc{slot(p, 2 + i), nullptr, 1024, 1024, wmix + (size_t)i * 1048576, 1024, 144, 8, 1024}, EpiStore{slot(p, 5 + i), 1024, 1.f}, tb, smem);
      gemm_job(GemmDesc{slot(p, 0), slot(p, 1), 1024, 1024, wmix + 3145728, 2048, 144, 2, 2048}, EpiLora1{(bf16*)(PWS + WS_L1)}, tb, smem);
      GSYNC();
      tb = 0;
      const bf16* l1 = (const bf16*)(PWS + WS_L1);
      gemm_job(GemmDesc{l1, nullptr, 256, 64, wmix + 3670016, 64, 144, 8, 64}, EpiLd{slot(p, 2), PIN(13) + j * 1024}, tb, smem);
      gemm_job(GemmDesc{l1 + 64, nullptr, 256, 64, wmix + 3735552, 64, 144, 8, 64}, EpiSig{slot(p, 3), PIN(16) + j * 1024}, tb, smem);
      gemm_job(GemmDesc{l1 + 128, nullptr, 256, 128, wmix + 3801088, 128, 144, 8, 128}, EpiStore{slot(p, 4), 1024, 1.f}, tb, smem);
      GSYNC();
      if (EN(2)) phase_prep<0>(p, j, smem);
      GSYNC();
      if (EN(5)) phase_seq2<0>(p, j, smem);
      GSYNC();
      if (EN(8)) phase_post<0>(p, j, smem);
      wo = wmix + 3932160;
    } else if (type == 1) {
      gemm_job(GemmDesc{slot(p, 0), nullptr, 1024, 1024, wmix, 1024, 144, 25, 1024},
               EpiGlaIn{slot(p, 1), slot(p, 1) + (size_t)MT * 512, slot(p, 2), slot(p, 3), sm}, tb, smem);
      GSYNC();
      if (EN(3)) phase_prep<1>(p, j, smem);
      GSYNC();
      if (EN(6)) phase_seq2<1>(p, j, smem);
      GSYNC();
      if (EN(8)) phase_post<1>(p, j, smem);
      wo = wmix + 3276800;
    } else {
      gemm_job(GemmDesc{slot(p, 0), nullptr, 1024, 1024, wmix, 1024, 144, 33, 1024},
               EpiGdnIn{slot(p, 1), slot(p, 4), sm, POUT}, tb, smem);
      GSYNC();
      if (EN(9)) phase_gdn_conv(p);
      GSYNC();
      if (EN(4)) phase_prep<2>(p, j, smem);
      GSYNC();
      if (EN(7)) phase_seq2<2>(p, j, smem);
      GSYNC();
      if (EN(8)) phase_post<2>(p, j, smem);
      wo = wmix + 4325376;
    }
    GSYNC();
    tb = 0;
    gemm_job(GemmDesc{slot(p, type == 1 ? 0 : 1), nullptr, 1024, 1024, wo, 1024, 144, 8, 1024}, EpiAcc{POUT}, tb, smem);
    GSYNC();
    phase_rms(POUT, PIN(8) + layer * 1024, slot(p, 0), nullptr);
    GSYNC();
    tb = 0;
    gemm_job(GemmDesc{slot(p, 0), nullptr, 1024, 1024, wfin, 1024, 144, 44, 1024}, EpiSwiglu{slot(p, 1)}, tb, smem);
    GSYNC();
    tb = 0;
    gemm_job(GemmDesc{slot(p, 1), nullptr, FF, FF, wfout, FF, 144, 8, FF}, EpiAcc{POUT}, tb, smem);
    GSYNC();
  }
  phase_rms(POUT, PIN(9), nullptr, POUT);
}

extern "C" void kernel_launch(void* const* d_in, const int* in_sizes, int n_in, void* d_out, int out_size,
                              void* d_ws, size_t ws_size, hipStream_t stream) {
  if (n_in < 40 || ws_size < WS_TOTAL) { fprintf(stderr, "bad args: n_in %d ws %zu need %zu\n", n_in, ws_size, (size_t)WS_TOTAL); return; }
  static int grid_blocks = 0;
  if (!grid_blocks) {
    int dev = 0, cus = 0, per_cu = 0;
    hipGetDevice(&dev);
    hipDeviceGetAttribute(&cus, hipDeviceAttributeMultiprocessorCount, dev);
    hipFuncSetAttribute((const void*)fwd_megakernel, hipFuncAttributeMaxDynamicSharedMemorySize, LDS_BYTES);
    hipOccupancyMaxActiveBlocksPerMultiprocessor(&per_cu, (const void*)fwd_megakernel, 256, LDS_BYTES);
    if (per_cu > 2) per_cu = 2;
    if (per_cu < 1) per_cu = 1;
    grid_blocks = cus * per_cu;
  }
  P p{};
  for (int i = 0; i < 40; ++i) p.in[i] = (const float*)d_in[i];
  p.out = (float*)d_out; p.ws = (char*)d_ws;
  void* args[] = {&p};
  hipError_t e = hipLaunchCooperativeKernel((const void*)fwd_megakernel, dim3(grid_blocks), dim3(256), args, LDS_BYTES, stream);
  if (e != hipSuccess) fprintf(stderr, "cooperative launch failed: %s (grid %d)\n", hipGetErrorString(e), grid_blocks);
}
```

```cpp
#include <hip/hip_runtime.h>
#include <hip/hip_cooperative_groups.h>
#include <cstdio>
#include <cstdint>
namespace cg = cooperative_groups;

typedef unsigned short bf16;
typedef __attribute__((ext_vector_type(8))) short bf16x8;
typedef __attribute__((ext_vector_type(4))) short bf16x4;
typedef __attribute__((ext_vector_type(4))) float f32x4;
typedef __attribute__((ext_vector_type(4))) unsigned u32x4;
typedef __attribute__((ext_vector_type(2))) unsigned u32x2;

#define DEVI __device__ __forceinline__

constexpr int Dm = 1024, FF = 2816, MT = 18432, MPR = 16384, NSS = 32, NCHUNK = 288, NPCH = 256;
constexpr size_t SLOT = (size_t)MT * 1024 * 2;
constexpr size_t WS_L1 = 8 * SLOT;
constexpr size_t WS_SM = WS_L1 + (size_t)MT * 256 * 2;
constexpr size_t WS_GAM = WS_SM + (size_t)MT * 16 * 4;
constexpr size_t WS_W = WS_GAM + (size_t)NCHUNK * 1024 * 4;
constexpr size_t W_FIN = 0, W_FOUT = 5767168, W_MIX = 8650752;
constexpr size_t WS_SINK = WS_W + (size_t)14200000 * 2 - 64;
constexpr size_t WS_BAR = WS_W + (size_t)14200000 * 2;
constexpr size_t WS_TOTAL = WS_BAR + 16384;
constexpr int LDS_BYTES = 77824;

constexpr size_t O_ASH_P = 18874368, O_AWKV_P = O_ASH_P + 2048, O_BKV_P = O_AWKV_P + 131072,
                 O_CCONV_P = O_BKV_P + 131072, O_CKV_P = O_CCONV_P + 9216, O_ASH_S = O_CKV_P + 131072,
                 O_AWKV_S = O_ASH_S + 65536, O_BKV_S = O_AWKV_S + 4194304, O_CCONV_S = O_BKV_S + 4194304,
                 O_CKV_S = O_CCONV_S + 294912;

struct P { const float* in[40]; float* out; char* ws; };
typedef const __attribute__((address_space(4))) char* kptr_t;
typedef const float* cfp_t; typedef float* fp_t; typedef char* cp_t;
DEVI kptr_t kbase() { kptr_t b = (kptr_t)__builtin_amdgcn_kernarg_segment_ptr(); asm volatile("" : "+s"(b)); return b; }
#define PIN(i) (*(const __attribute__((address_space(4))) cfp_t*)(kbase() + 8 * (i)))
#define POUT (*(const __attribute__((address_space(4))) fp_t*)(kbase() + 320))
#define PWS (*(const __attribute__((address_space(4))) cp_t*)(kbase() + 328))

typedef __attribute__((ext_vector_type(2))) float f32x2;
typedef __attribute__((ext_vector_type(2))) __bf16 bf16x2v;
DEVI unsigned pack2(float a, float b) { f32x2 v = {a, b}; bf16x2v r = __builtin_convertvector(v, bf16x2v); return __builtin_bit_cast(unsigned, r); }
DEVI bf16 f2bf(float f) { return (bf16)(pack2(f, 0.f) & 0xffffu); }
DEVI float bf2f(bf16 h) { return __uint_as_float(((unsigned)h) << 16); }
DEVI float wsum(float v) {
#pragma unroll
  for (int o = 32; o > 0; o >>= 1) v += __shfl_xor(v, o);
  return v;
}
DEVI float sigm(float x) { return 1.f / (1.f + __expf(-x)); }
DEVI float silu(float x) { return x * sigm(x); }
DEVI float softplus(float x) { return x > 20.f ? x : log1pf(__expf(x)); }
DEVI bf16* slot(const P& p, int i) { return (bf16*)(PWS + (size_t)i * SLOT); }

struct GemmDesc { const bf16* A; const bf16* A2; int lda; int ksplit; const bf16* Bt; int ldb; int tiles_m; int tiles_n; int K; };

template <class Epi>
DEVI void gemm_tile(const GemmDesc& g, int mt, int nt, Epi& epi, char* smem) {
  const int tid = threadIdx.x, lane = tid & 63, wave = tid >> 6;
  const int wm = wave >> 1, wn = wave & 1, lr = lane & 15, quad = lane >> 4;
  bf16* sA = (bf16*)smem;
  bf16* sB = sA + 2 * 8192;
  f32x4 acc[4][4];
#pragma unroll
  for (int i = 0; i < 4; ++i)
#pragma unroll
    for (int j = 0; j < 4; ++j) acc[i][j] = (f32x4){0.f, 0.f, 0.f, 0.f};
  const int m0 = mt * 128, n0 = nt * 128;
  const int r0 = tid >> 3, c0 = tid & 7;
  const size_t aoff = (size_t)(m0 + r0) * g.lda + c0 * 8;
  const bf16* bp = g.Bt + (size_t)(n0 + r0) * g.ldb + c0 * 8;
  const int soff = r0 * 64 + ((c0 ^ (r0 & 7)) << 3);
#define GL1(i_, RA, RB) RA##i_ = *(const u32x4*)(base_ + (size_t)(32 * i_) * g.lda); RB##i_ = *(const u32x4*)(bp + k0_ + (size_t)(32 * i_) * g.ldb);
#define GLOAD(kt_, RA, RB) do { const int k0_ = (kt_) << 6; \
    const bf16* base_ = ((k0_ < g.ksplit) ? (g.A + k0_) : (g.A2 + (k0_ - g.ksplit))) + aoff; \
    GL1(0, RA, RB) GL1(1, RA, RB) GL1(2, RA, RB) GL1(3, RA, RB) } while (0)
#define LS1(buf_, i_, RA, RB) *(u32x4*)(sA + (buf_) * 8192 + soff + i_ * 2048) = RA##i_; *(u32x4*)(sB + (buf_) * 8192 + soff + i_ * 2048) = RB##i_;
#define LSTORE(buf_, RA, RB) do { LS1(buf_, 0, RA, RB) LS1(buf_, 1, RA, RB) LS1(buf_, 2, RA, RB) LS1(buf_, 3, RA, RB) } while (0)
#define GSTEP(kt_, RA, RB) do { const int buf_ = (kt_) & 1; \
    const bf16* a_ = sA + buf_ * 8192 + (wm * 64 + lr) * 64; const bf16* b_ = sB + buf_ * 8192 + (wn * 64 + lr) * 64; \
    _Pragma("unroll") for (int ks_ = 0; ks_ < 2; ++ks_) { \
      const int co_ = (((ks_ * 4 + quad) ^ (lr & 7)) << 3); bf16x8 af_[4], bf_[4]; \
      _Pragma("unroll") for (int i_ = 0; i_ < 4; ++i_) { af_[i_] = *(const bf16x8*)(a_ + i_ * 1024 + co_); bf_[i_] = *(const bf16x8*)(b_ + i_ * 1024 + co_); } \
      _Pragma("unroll") for (int i_ = 0; i_ < 4; ++i_) _Pragma("unroll") for (int j_ = 0; j_ < 4; ++j_) \
        acc[i_][j_] = __builtin_amdgcn_mfma_f32_16x16x32_bf16(af_[i_], bf_[j_], acc[i_][j_], 0, 0, 0); } \
    if ((kt_) + 1 < nk) { LSTORE(buf_ ^ 1, RA, RB); if ((kt_) + 3 < nk) GLOAD((kt_) + 3, RA, RB); } \
    __syncthreads(); } while (0)
  const int nk = g.K >> 6;
  u32x4 pa0, pa1, pa2, pa3, pb0, pb1, pb2, pb3, qa0, qa1, qa2, qa3, qb0, qb1, qb2, qb3;
  qa0 = qa1 = qa2 = qa3 = qb0 = qb1 = qb2 = qb3 = (u32x4){0u, 0u, 0u, 0u};
  GLOAD(0, pa, pb);
  if (nk > 1) GLOAD(1, qa, qb);
  LSTORE(0, pa, pb);
  if (nk > 2) GLOAD(2, pa, pb);
  __syncthreads();
  for (int kt = 0; kt < nk; kt += 2) { GSTEP(kt, qa, qb); if (kt + 1 < nk) GSTEP(kt + 1, pa, pb); }
#pragma unroll
  for (int i = 0; i < 4; ++i) {
#pragma unroll
    for (int jj = 0; jj < 4; ++jj) {
      const int row = m0 + wm * 64 + i * 16 + quad * 4 + jj;
      if constexpr (Epi::PAIR) {
#pragma unroll
        for (int j = 0; j < 4; j += 2) {
          const int nn = n0 + wn * 64 + j * 16;
          epi.pair(row, (nn >> 5) * 16 + lr, acc[i][j][jj], acc[i][j + 1][jj]);
        }
      } else {
#pragma unroll
        for (int j = 0; j < 4; ++j) epi(row, n0 + wn * 64 + j * 16 + lr, acc[i][j][jj]);
      }
    }
  }
}

template <class Epi>
DEVI void gemm_job(const GemmDesc& g, Epi epi, int& tbase, char* smem) {
  const int ntiles = g.tiles_m * g.tiles_n, G = gridDim.x;
  const int first = tbase + (((int)blockIdx.x - tbase % G) + G) % G;
  const int width = 8 * g.tiles_n;
  for (int t = first; t < tbase + ntiles; t += G) {
    const int lt = t - tbase;
    const int grp = lt / width, rem = lt % width;
    gemm_tile(g, grp * 8 + (rem & 7), rem >> 3, epi, smem);
  }
  tbase += ntiles;
}

struct EpiStore { static constexpr bool PAIR = false; bf16* C; int ldc; float sc;
  DEVI void operator()(int r, int c, float v) { C[(size_t)r * ldc + c] = f2bf(v * sc); } };
struct EpiLora1 { static constexpr bool PAIR = false; bf16* C;
  DEVI void operator()(int r, int c, float v) { float o = c < 64 ? tanhf(v) : (c < 128 ? v : sigm(v)); C[(size_t)r * 256 + c] = f2bf(o); } };
struct EpiLd { static constexpr bool PAIR = false; bf16* C; const float* w0;
  DEVI void operator()(int r, int c, float v) { float x = w0[c] + v; float lr_ = -softplus(-x) - 0.5f; C[(size_t)r * 1024 + c] = f2bf(-__expf(lr_)); } };
struct EpiSig { static constexpr bool PAIR = false; bf16* C; const float* a0;
  DEVI void operator()(int r, int c, float v) { C[(size_t)r * 1024 + c] = f2bf(sigm(a0[c] + v)); } };
struct EpiAcc { static constexpr bool PAIR = false; float* X;
  DEVI void operator()(int r, int c, float v) { X[(size_t)r * 1024 + c] += v; } };
struct EpiSwiglu { static constexpr bool PAIR = true; bf16* C;
  DEVI void pair(int r, int c, float gt, float up) { C[(size_t)r * FF + c] = f2bf(silu(gt) * up); } };
struct EpiGlaIn { static constexpr bool PAIR = false; bf16 *q, *k, *v, *gate; float* sm;
  DEVI void operator()(int r, int c, float x) {
    if (c < 512) q[(size_t)r * 512 + c] = f2bf(x * 0.08838834764831845f);
    else if (c < 1024) k[(size_t)r * 512 + c - 512] = f2bf(x);
    else if (c < 2048) v[(size_t)r * 1024 + c - 1024] = f2bf(x);
    else if (c < 3072) gate[(size_t)r * 1024 + c - 2048] = f2bf(x);
    else if (c < 3088) sm[(size_t)r * 16 + c - 3072] = x;
  } };
struct EpiGdnIn { static constexpr bool PAIR = false; bf16 *qkv, *z; float* sm; float* out;
  DEVI void operator()(int r, int c, float x) {
    if (c < 3072) {
      qkv[(size_t)r * 3072 + c] = f2bf(x);
      if (r >= MPR - 3) {
        if (r < MPR) out[O_CCONV_P + (size_t)(r - (MPR - 3)) * 3072 + c] = x;
        else { int tt = (r - MPR) & 63; if (tt >= 61) out[O_CCONV_S + ((size_t)((r - MPR) >> 6) * 3 + (tt - 61)) * 3072 + c] = x; }
      }
    } else if (c < 4096) z[(size_t)r * 1024 + c - 3072] = f2bf(x);
    else if (c < 4112) sm[(size_t)r * 16 + c - 4096] = x;
  } };

template <class F>
DEVI void conv_job(F f, bf16* dst, int ldo, int Nd, int Kd, int& tbase, char* smem) {
  float* tile = (float*)smem;
  const int tn = Nd >> 6, tk = Kd >> 6, ntiles = tn * tk, G = gridDim.x, tid = threadIdx.x;
  const int first = tbase + (((int)blockIdx.x - tbase % G) + G) % G;
  for (int t = first; t < tbase + ntiles; t += G) {
    const int lt = t - tbase, n0 = (lt % tn) << 6, k0 = (lt / tn) << 6;
    const int i = tid >> 4, j4 = (tid & 15) << 2;
#pragma unroll
    for (int r = 0; r < 4; ++r) {
      float4 v = f(k0 + i + 16 * r, n0 + j4);
      float* d = tile + (i + 16 * r) * 65 + j4; d[0] = v.x; d[1] = v.y; d[2] = v.z; d[3] = v.w;
    }
    __syncthreads();
    const int jn = tid >> 2, iq = (tid & 3) << 4;
    unsigned w[8];
#pragma unroll
    for (int e = 0; e < 8; ++e) w[e] = pack2(tile[(iq + 2 * e) * 65 + jn], tile[(iq + 2 * e + 1) * 65 + jn]);
    uint4* o = (uint4*)(dst + (size_t)(n0 + jn) * ldo + k0 + iq);
    o[0] = make_uint4(w[0], w[1], w[2], w[3]); o[1] = make_uint4(w[4], w[5], w[6], w[7]);
    __syncthreads();
  }
  tbase += ntiles;
}
struct CvPlain { const float* W; int ld; int nsrc;
  DEVI float4 operator()(int k, int n) const { return n < nsrc ? *(const float4*)(W + (size_t)k * ld + n) : make_float4(0, 0, 0, 0); } };
struct CvFfnIn { const float* W;
  DEVI float4 operator()(int k, int n) const { int blk = n >> 5, w = n & 31; int src = (w < 16) ? blk * 16 + w : FF + blk * 16 + (w - 16);
    return *(const float4*)(W + (size_t)k * (2 * FF) + src); } };
struct CvLora1 { const float *w1, *a1, *g1, *mu;
  DEVI float4 operator()(int k, int n) const {
    int kk = k & 1023; float4 v; float m;
    if (n < 64) { v = *(const float4*)(w1 + kk * 64 + n); m = mu[1 * 1024 + kk]; }
    else if (n < 128) { v = *(const float4*)(a1 + kk * 64 + n - 64); m = mu[4 * 1024 + kk]; }
    else { v = *(const float4*)(g1 + kk * 128 + n - 128); m = mu[5 * 1024 + kk]; }
    float s = (k < 1024) ? (1.f - m) : m;
    return make_float4(v.x * s, v.y * s, v.z * s, v.w * s); } };
struct CvGlaIn { const float *win, *wa1;
  DEVI float4 operator()(int k, int n) const {
    if (n < 3072) return *(const float4*)(win + (size_t)k * 3072 + n);
    if (n < 3088) return *(const float4*)(wa1 + k * 16 + n - 3072);
    return make_float4(0, 0, 0, 0); } };

template <int TYPE>
DEVI void phase_norm(const P& p, int layer, int j, bool from_input, bool copy_x) {
  const int lane = threadIdx.x & 63, wave = threadIdx.x >> 6;
  const float* g = PIN(7) + layer * 1024;
  float* xres = POUT;
  bf16 *h = slot(p, 0), *hs = slot(p, 1), *xr = slot(p, 2), *xk = slot(p, 3), *xv = slot(p, 4);
  const float* mu = PIN(12) + (size_t)j * 6 * 1024;
  for (int row = blockIdx.x * 4 + wave; row < MT; row += gridDim.x * 4) {
    auto src = [&](int r) -> const float* {
      if (from_input) return r < MPR ? PIN(0) + (size_t)r * 1024 : PIN(1) + (size_t)(r - MPR) * 1024;
      return xres + (size_t)r * 1024; };
    const float* xp = src(row);
    float4 xv4[4]; float ss = 0.f;
#pragma unroll
    for (int i = 0; i < 4; ++i) { xv4[i] = *(const float4*)(xp + i * 256 + lane * 4); ss += xv4[i].x * xv4[i].x + xv4[i].y * xv4[i].y + xv4[i].z * xv4[i].z + xv4[i].w * xv4[i].w; }
    ss = wsum(ss);
    const float rstd = rsqrtf(ss * (1.f / 1024.f) + 1e-6f);
    if (copy_x) {
#pragma unroll
      for (int i = 0; i < 4; ++i) *(float4*)(xres + (size_t)row * 1024 + i * 256 + lane * 4) = xv4[i];
    }
    float hv[16];
#pragma unroll
    for (int i = 0; i < 4; ++i) { float4 gg = *(const float4*)(g + i * 256 + lane * 4);
      hv[i * 4 + 0] = xv4[i].x * rstd * gg.x; hv[i * 4 + 1] = xv4[i].y * rstd * gg.y; hv[i * 4 + 2] = xv4[i].z * rstd * gg.z; hv[i * 4 + 3] = xv4[i].w * rstd * gg.w; }
#pragma unroll
    for (int i = 0; i < 4; ++i) *(uint2*)(h + (size_t)row * 1024 + i * 256 + lane * 4) = make_uint2(pack2(hv[i * 4], hv[i * 4 + 1]), pack2(hv[i * 4 + 2], hv[i * 4 + 3]));
    if constexpr (TYPE == 0) {
      const bool is_p = row < MPR; const int tt = is_p ? row : ((row - MPR) & 63); const int b = is_p ? 0 : ((row - MPR) >> 6);
      float hp[16];
      if (tt == 0) {
        if (is_p) {
#pragma unroll
          for (int i = 0; i < 16; ++i) hp[i] = 0.f;
        } else {
          const float* sp = PIN(2) + ((size_t)j * NSS + b) * 1024;
#pragma unroll
          for (int i = 0; i < 4; ++i) { float4 v = *(const float4*)(sp + i * 256 + lane * 4); hp[i * 4] = v.x; hp[i * 4 + 1] = v.y; hp[i * 4 + 2] = v.z; hp[i * 4 + 3] = v.w; }
        }
      } else {
        const float* pp = src(row - 1); float4 pv[4]; float s2 = 0.f;
#pragma unroll
        for (int i = 0; i < 4; ++i) { pv[i] = *(const float4*)(pp + i * 256 + lane * 4); s2 += pv[i].x * pv[i].x + pv[i].y * pv[i].y + pv[i].z * pv[i].z + pv[i].w * pv[i].w; }
        s2 = wsum(s2); const float r2 = rsqrtf(s2 * (1.f / 1024.f) + 1e-6f);
#pragma unroll
        for (int i = 0; i < 4; ++i) { float4 gg = *(const float4*)(g + i * 256 + lane * 4);
          hp[i * 4] = pv[i].x * r2 * gg.x; hp[i * 4 + 1] = pv[i].y * r2 * gg.y; hp[i * 4 + 2] = pv[i].z * r2 * gg.z; hp[i * 4 + 3] = pv[i].w * r2 * gg.w; }
      }
#pragma unroll
      for (int i = 0; i < 4; ++i) {
        const int col = i * 256 + lane * 4; const size_t o = (size_t)row * 1024 + col;
        float4 m0 = *(const float4*)(mu + 0 * 1024 + col), m2 = *(const float4*)(mu + 2 * 1024 + col), m3 = *(const float4*)(mu + 3 * 1024 + col);
        const float mm0[4] = {m0.x, m0.y, m0.z, m0.w}, mm2[4] = {m2.x, m2.y, m2.z, m2.w}, mm3[4] = {m3.x, m3.y, m3.z, m3.w};
        float a[4], bb[4], c[4];
#pragma unroll
        for (int e = 0; e < 4; ++e) { float hh = hv[i * 4 + e], xx = hp[i * 4 + e] - hh; a[e] = hh + xx * mm0[e]; bb[e] = hh + xx * mm2[e]; c[e] = hh + xx * mm3[e]; }
        *(uint2*)(hs + o) = make_uint2(pack2(hp[i * 4], hp[i * 4 + 1]), pack2(hp[i * 4 + 2], hp[i * 4 + 3]));
        *(uint2*)(xr + o) = make_uint2(pack2(a[0], a[1]), pack2(a[2], a[3]));
        *(uint2*)(xk + o) = make_uint2(pack2(bb[0], bb[1]), pack2(bb[2], bb[3]));
        *(uint2*)(xv + o) = make_uint2(pack2(c[0], c[1]), pack2(c[2], c[3]));
      }
      if (is_p ? (row == MPR - 1) : (tt == 63)) {
        float* o = POUT + (is_p ? O_ASH_P + (size_t)j * 1024 : O_ASH_S + ((size_t)j * NSS + b) * 1024);
#pragma unroll
        for (int i = 0; i < 4; ++i) *(float4*)(o + i * 256 + lane * 4) = make_float4(hv[i * 4], hv[i * 4 + 1], hv[i * 4 + 2], hv[i * 4 + 3]);
      }
    }
  }
}

DEVI void phase_rms(const float* x, const float* g, bf16* dst, float* fdst) {
  const int lane = threadIdx.x & 63, wave = threadIdx.x >> 6;
  for (int row = blockIdx.x * 4 + wave; row < MT; row += gridDim.x * 4) {
    const float* xp = x + (size_t)row * 1024; float4 v[4]; float ss = 0.f;
#pragma unroll
    for (int i = 0; i < 4; ++i) { v[i] = *(const float4*)(xp + i * 256 + lane * 4); ss += v[i].x * v[i].x + v[i].y * v[i].y + v[i].z * v[i].z + v[i].w * v[i].w; }
    ss = wsum(ss); const float r = rsqrtf(ss * (1.f / 1024.f) + 1e-6f);
#pragma unroll
    for (int i = 0; i < 4; ++i) { float4 gg = *(const float4*)(g + i * 256 + lane * 4);
      float a = v[i].x * r * gg.x, b = v[i].y * r * gg.y, c = v[i].z * r * gg.z, d = v[i].w * r * gg.w;
      if (dst) *(uint2*)(dst + (size_t)row * 1024 + i * 256 + lane * 4) = make_uint2(pack2(a, b), pack2(c, d));
      else *(float4*)(fdst + (size_t)row * 1024 + i * 256 + lane * 4) = make_float4(a, b, c, d); }
  }
}

DEVI void phase_gdn_conv(const P& p) {
  const bf16* qkv = slot(p, 1); const float* cw = PIN(35); const float* cst = PIN(5);
  const int tid = threadIdx.x, lane = tid & 63;
  for (int item = blockIdx.x; item < MT * 3; item += gridDim.x) {
    const int row = item / 3, sec = item % 3, ch = sec * 1024 + tid * 4;
    const bool is_p = row < MPR; const int tt = is_p ? row : ((row - MPR) & 63); const int b = is_p ? 0 : ((row - MPR) >> 6);
    float acc[4] = {0.f, 0.f, 0.f, 0.f};
#pragma unroll
    for (int i = 0; i < 4; ++i) {
      const int pt = tt + i;
      float4 w = *(const float4*)(cw + i * 3072 + ch); float x[4];
      if (pt >= 3) { uint2 u = *(const uint2*)(qkv + (size_t)(row + i - 3) * 3072 + ch);
        x[0] = bf2f(u.x & 0xffff); x[1] = bf2f(u.x >> 16); x[2] = bf2f(u.y & 0xffff); x[3] = bf2f(u.y >> 16); }
      else if (!is_p) { float4 s = *(const float4*)(cst + ((size_t)b * 3 + pt) * 3072 + ch); x[0] = s.x; x[1] = s.y; x[2] = s.z; x[3] = s.w; }
      else { x[0] = x[1] = x[2] = x[3] = 0.f; }
      acc[0] += x[0] * w.x; acc[1] += x[1] * w.y; acc[2] += x[2] * w.z; acc[3] += x[3] * w.w;
    }
#pragma unroll
    for (int e = 0; e < 4; ++e) acc[e] = silu(acc[e]);
    if (sec < 2) {
      float ss = acc[0] * acc[0] + acc[1] * acc[1] + acc[2] * acc[2] + acc[3] * acc[3];
#pragma unroll
      for (int o = 16; o > 0; o >>= 1) ss += __shfl_xor(ss, o);
      float r = rsqrtf(ss + 1e-6f) * (sec == 0 ? 0.08838834764831845f : 1.f);
#pragma unroll
      for (int e = 0; e < 4; ++e) acc[e] *= r;
    }
    (void)lane;
    *(uint2*)(slot(p, 5 + sec) + (size_t)row * 1024 + tid * 4) = make_uint2(pack2(acc[0], acc[1]), pack2(acc[2], acc[3]));
  }
}

DEVI void mm_strip(const bf16* At, const bf16* Bt, f32x4 (&acc)[4], int wave, int lane) {
  const int lr = lane & 15, quad = lane >> 4;
#pragma unroll
  for (int ks = 0; ks < 2; ++ks) {
    bf16x8 a = *(const bf16x8*)(At + (wave * 16 + lr) * 72 + ks * 32 + quad * 8);
#pragma unroll
    for (int nb = 0; nb < 4; ++nb) {
      bf16x8 b = *(const bf16x8*)(Bt + (nb * 16 + lr) * 72 + ks * 32 + quad * 8);
      acc[nb] = __builtin_amdgcn_mfma_f32_16x16x32_bf16(a, b, acc[nb], 0, 0, 0);
    }
  }
}
DEVI void zero4(f32x4 (&a)[4]) {
#pragma unroll
  for (int i = 0; i < 4; ++i) a[i] = (f32x4){0.f, 0.f, 0.f, 0.f};
}

template <int CW> DEVI size_t cont_off(int r, int s, int LD) { const int idx = r * 64 + s; return (size_t)(idx / CW) * LD + (idx % CW); }

template <int TYPE>
DEVI void phase_prep(const P& p, int j, char* smem) {
  constexpr int NH = TYPE == 0 ? 16 : (TYPE == 1 ? 4 : 8);
  constexpr int DK = TYPE == 0 ? 64 : 128;
  constexpr int DV = TYPE == 0 ? 64 : (TYPE == 1 ? 256 : 128);
  constexpr bool LOW = TYPE != 1;
  constexpr int KT = 256 / DK, TPT = 64 / KT, DKH = DK / 64, DVH = DV / 64;
  constexpr int LDQ = TYPE == 1 ? 512 : 1024;
  bf16* X0 = (bf16*)smem; bf16* X1 = X0 + 4608; bf16* Y0 = X1 + 4608; bf16* Y1 = Y0 + 4608;
  float* Lb = (float*)smem;
  bf16* LkT = (bf16*)(smem + 16384); bf16* Ak = LkT + 4608; bf16* nAb = Ak + 4608;
  bf16* M1 = (bf16*)smem;
  bf16* Tt = (bf16*)(smem + 44032); bf16* St1 = Tt + 4608; bf16* St2 = St1 + 4608;
  if (TYPE == 1) { Y0 = (bf16*)(smem + 9216); Ak = (bf16*)(smem + 18432); St1 = (bf16*)(smem + 27648); }
  float* lgL = (float*)(smem + 36864);
  float* tot = (float*)(smem + 71680);
  float* sc_beta = (float*)(smem + 73728);
  float* sc_eg = sc_beta + 64; float* sc_lg = sc_eg + 64; float* sc_g = sc_lg + 64;

  bf16 *Aq, *Akk, *Av, *Ald = nullptr, *Aa = nullptr, *Oq, *Okt, *Ovt, *Ow = nullptr, *Obt = nullptr, *Ool, *Ou0 = nullptr;
  if (TYPE == 0) { Aq = slot(p, 5); Akk = slot(p, 6); Av = slot(p, 7); Ald = slot(p, 2); Aa = slot(p, 3);
    Oq = Aq; Okt = Akk; Ovt = Av; Ow = Ald; Obt = Aa; Ool = slot(p, 0); Ou0 = slot(p, 1); }
  else if (TYPE == 1) { Aq = slot(p, 1); Akk = slot(p, 1) + (size_t)MT * 512; Av = slot(p, 2); Oq = Aq; Okt = Akk; Ovt = Av; Ool = slot(p, 4); }
  else { Aq = slot(p, 5); Akk = slot(p, 6); Av = slot(p, 7); Oq = Aq; Okt = Akk; Ovt = Av; Ow = slot(p, 1); Obt = slot(p, 2); Ool = slot(p, 3); Ou0 = slot(p, 0); }
  float* sm = (float*)(PWS + WS_SM);
  float* gam = (float*)(PWS + WS_GAM);

  for (int item = blockIdx.x; item < NCHUNK * NH; item += gridDim.x) {
    const int c = item / NH, h = item % NH;
    const size_t rb = (size_t)c * 64;
    int tid = threadIdx.x; asm volatile("" : "+v"(tid));
    const int lane = tid & 63, wave = tid >> 6, lr = lane & 15, quad = lane >> 4;
    const int k = tid % DK, tg = tid / DK;
    const int vv = tid & 63, tgv = tid >> 6;
    unsigned qP[TPT / 2], ktP[TPT / 2], kapP[(TYPE == 0) ? TPT / 2 : 1], bvP[(TYPE == 0) ? TPT / 2 : 1];
    float lg[(TYPE == 0) ? TPT : 1], ldv[(TYPE == 0) ? TPT : 1];
    unsigned vP[DVH][8];
    auto lo16 = [](unsigned w) { return __uint_as_float(w << 16); };
    auto hi16 = [](unsigned w) { return __uint_as_float(w & 0xffff0000u); };
#define GETP(arr, e) (((e) & 1) ? hi16(arr[(e) >> 1]) : lo16(arr[(e) >> 1]))
#pragma unroll
    for (int vh = 0; vh < DVH; ++vh)
#pragma unroll
      for (int e = 0; e < 8; ++e) {
        const bf16 a = Av[(rb + tgv * 16 + 2 * e) * 1024 + h * DV + vh * 64 + vv], b = Av[(rb + tgv * 16 + 2 * e + 1) * 1024 + h * DV + vh * 64 + vv];
        vP[vh][e] = (unsigned)a | ((unsigned)b << 16);
        asm volatile("" : "+v"(vP[vh][e]));
      }
    if constexpr (TYPE == 2) {
      if (tid < 64) {
        const float a_log = PIN(36)[h], dtb = PIN(37)[h];
        const float braw = sm[(rb + tid) * 16 + h], araw = sm[(rb + tid) * 16 + 8 + h];
        const float gt = -__expf(a_log) * softplus(araw + dtb);
        sc_beta[tid] = sigm(braw); sc_eg[tid] = __expf(gt); sc_g[tid] = gt;
        float cs = gt;
#pragma unroll
        for (int o = 1; o < 64; o <<= 1) { float n = __shfl_up(cs, o); if (lane >= o) cs += n; }
        sc_lg[tid] = cs;
      }
      __syncthreads();
    }
    if constexpr (TYPE == 0) {
      const float k_k = PIN(21)[j * 1024 + h * 64 + k], k_a = PIN(22)[j * 1024 + h * 64 + k], r_k = PIN(23)[j * 1024 + h * 64 + k];
      float run = 0.f;
#pragma unroll
      for (int e2 = 0; e2 < TPT / 2; ++e2) {
        float qq[2], ka[2], kq[2], bq[2];
#pragma unroll
        for (int u = 0; u < 2; ++u) {
          const int e = e2 * 2 + u;
          const size_t o = (rb + tg * TPT + e) * 1024 + h * 64 + k;
          const float r = bf2f(Aq[o]), kr = bf2f(Akk[o]), av = bf2f(Aa[o]), l = bf2f(Ald[o]);
          const float kk = kr * k_k;
          const float inv = rsqrtf(fmaxf(wsum(kk * kk), 1e-24f));
          qq[u] = r; ka[u] = kk * inv; kq[u] = kr * (1.f + (av - 1.f) * k_a); bq[u] = ka[u] * av; ldv[e] = l;
          const float bo = wsum(r * kq[u] * r_k);
          if (lane == 0) sm[(rb + tg * TPT + e) * 16 + h] = bo;
          run += l; lg[e] = run;
        }
        qP[e2] = pack2(qq[0], qq[1]); kapP[e2] = pack2(ka[0], ka[1]); ktP[e2] = pack2(kq[0], kq[1]); bvP[e2] = pack2(bq[0], bq[1]);
        asm volatile("" : "+v"(qP[e2]), "+v"(kapP[e2]), "+v"(ktP[e2]), "+v"(bvP[e2]));
      }
      tot[tg * 128 + k] = run;
    } else if constexpr (TYPE == 1) {
      float w2[16];
#pragma unroll
      for (int i = 0; i < 16; ++i) w2[i] = PIN(30)[i * 512 + h * 128 + k];
      const float ba = PIN(31)[h * 128 + k];
      float run = 0.f;
#pragma unroll
      for (int e = 0; e < TPT; ++e) {
        const size_t row = rb + tg * TPT + e;
        float s = ba;
#pragma unroll
        for (int i = 0; i < 16; ++i) s += sm[row * 16 + i] * w2[i];
        const float gk = (fminf(s, 0.f) - log1pf(__expf(-fabsf(s)))) * (1.f / 16.f);
        run += gk; lgL[(tg * TPT + e) * 128 + k] = run;
        __builtin_amdgcn_sched_barrier(0);
      }
#pragma unroll
      for (int e2 = 0; e2 < TPT / 2; ++e2) {
        const size_t row = rb + tg * TPT + 2 * e2;
        qP[e2] = (unsigned)Aq[row * 512 + h * 128 + k] | ((unsigned)Aq[(row + 1) * 512 + h * 128 + k] << 16);
        ktP[e2] = (unsigned)Akk[row * 512 + h * 128 + k] | ((unsigned)Akk[(row + 1) * 512 + h * 128 + k] << 16);
        asm volatile("" : "+v"(qP[e2]), "+v"(ktP[e2]));
      }
      tot[tg * 128 + k] = run;
    } else {
#pragma unroll
      for (int e2 = 0; e2 < TPT / 2; ++e2) {
        const size_t o = (rb + tg * TPT + 2 * e2) * 1024 + h * 128 + k;
        qP[e2] = (unsigned)Aq[o] | ((unsigned)Aq[o + 1024] << 16);
        ktP[e2] = (unsigned)Akk[o] | ((unsigned)Akk[o + 1024] << 16);
        asm volatile("" : "+v"(qP[e2]), "+v"(ktP[e2]));
      }
    }
    __syncthreads();
    float lgC;
    if constexpr (TYPE == 2) { lgC = sc_lg[63]; }
    else {
      float off = 0.f, all = 0.f;
#pragma unroll
      for (int g2 = 0; g2 < KT; ++g2) { const float tv = tot[g2 * 128 + k]; all += tv; if (g2 < tg) off += tv; }
      if constexpr (TYPE == 0) {
#pragma unroll
        for (int e = 0; e < TPT; ++e) lg[e] += off;
      } else {
#pragma unroll
        for (int e = 0; e < TPT; ++e) lgL[(tg * TPT + e) * 128 + k] += off;
      }
      lgC = all;
    }
#define QV(e) GETP(qP, e)
#define LGV(e, t) ((TYPE == 2) ? sc_lg[t] : ((TYPE == 1) ? lgL[(t) * 128 + k] : lg[(TYPE == 0) ? (e) : 0]))
#define LPREV(e, t) ((TYPE == 0) ? (lg[(TYPE == 0) ? (e) : 0] - ldv[(TYPE == 0) ? (e) : 0]) : (sc_lg[t] - sc_g[t]))
#define KTV(e, t) ((TYPE == 2) ? (sc_beta[t] * GETP(ktP, e)) : GETP(ktP, e))
#define KAPV(e, t) ((TYPE == 2) ? GETP(ktP, e) : GETP(kapP, (TYPE == 0) ? (e) : 0))
#define BVV(e, t) ((TYPE == 2) ? (sc_beta[t] * sc_eg[t] * GETP(ktP, e)) : GETP(bvP, (TYPE == 0) ? (e) : 0))
    f32x4 sacc[LOW ? 4 : 1][4];
#pragma unroll
    for (int a = 0; a < (LOW ? 4 : 1); ++a) zero4(sacc[a]);
#pragma unroll
    for (int kh = 0; kh < DKH; ++kh) {
      if (k / 64 == kh) {
        const int kk = k & 63;
#pragma unroll
        for (int e = 0; e < TPT; ++e) {
          const int t = tg * TPT + e;
          if constexpr (TYPE == 2) {
            X0[t * 72 + kk] = f2bf(QV(e)); Y0[t * 72 + kk] = f2bf(KTV(e, t));
            X1[t * 72 + kk] = f2bf(KAPV(e, t)); Y1[t * 72 + kk] = f2bf(BVV(e, t));
          } else {
            const float lgt = LGV(e, t);
            const float el = __expf(lgt), eml = __expf(-lgt);
            X0[t * 72 + kk] = f2bf(QV(e) * el);
            Y0[t * 72 + kk] = f2bf(KTV(e, t) * eml);
            if constexpr (LOW) {
              X1[t * 72 + kk] = f2bf(KAPV(e, t) * __expf(LPREV(e, t)));
              Y1[t * 72 + kk] = f2bf(BVV(e, t) * eml);
            }
          }
          __builtin_amdgcn_sched_barrier(0);
        }
      }
      __syncthreads();
      mm_strip(X0, Y0, sacc[0], wave, lane);
      if constexpr (LOW) { mm_strip(X0, Y1, sacc[1], wave, lane); mm_strip(X1, Y0, sacc[2], wave, lane); mm_strip(X1, Y1, sacc[3], wave, lane); }
      __syncthreads();
    }
#pragma unroll
    for (int nb = 0; nb < 4; ++nb)
#pragma unroll
      for (int jj = 0; jj < 4; ++jj) {
        const int t = wave * 16 + quad * 4 + jj, s = nb * 16 + lr;
        float da = 1.f, dl = 1.f;
        if constexpr (TYPE == 2) { const float dd = sc_lg[t] - sc_lg[s]; da = __expf(fminf(dd, 0.f)); dl = __expf(fminf(dd - sc_g[t], 0.f)); }
        Ak[t * 72 + s] = f2bf(s <= t ? sacc[0][nb][jj] * da : 0.f);
        if constexpr (LOW) {
          nAb[t * 72 + s] = f2bf(s <= t ? -sacc[1][nb][jj] * da : 0.f);
          LkT[s * 72 + t] = f2bf(s < t ? sacc[2][nb][jj] * dl : 0.f);
          Lb[t * 64 + (s & 3) * 16 + (s >> 2)] = s < t ? sacc[3][nb][jj] * dl : 0.f;
        }
      }
    __syncthreads();
    f32x4 acc[4];
    if constexpr (LOW) {
      {
        const int q = lane & 3, jc = wave * 16 + (lane >> 2);
        float xr[16];
#pragma unroll
        for (int i = 0; i < 16; ++i) xr[i] = 0.f;
#pragma unroll
        for (int t = 0; t < 64; ++t) {
          float s = 0.f;
          const float* Lr = Lb + t * 64 + q * 16;
#pragma unroll
          for (int i = 0; i < (t + 3) / 4; ++i) s += Lr[i] * xr[i];
          s += __shfl_xor(s, 1); s += __shfl_xor(s, 2);
          s = ((t == jc) ? 1.f : 0.f) - s;
          xr[t >> 2] = (q == (t & 3)) ? s : xr[t >> 2];
          if (q == 0) Tt[t * 72 + jc] = f2bf(s);
          __builtin_amdgcn_sched_barrier(0);
        }
      }
      __syncthreads();
      zero4(acc); mm_strip(Tt, LkT, acc, wave, lane);
#pragma unroll
      for (int nb = 0; nb < 4; ++nb)
#pragma unroll
        for (int jj = 0; jj < 4; ++jj) M1[(wave * 16 + quad * 4 + jj) * 72 + nb * 16 + lr] = f2bf(acc[nb][jj]);
      __syncthreads();
    }
#pragma unroll
    for (int vh = 0; vh < DVH; ++vh) {
#pragma unroll
      for (int e = 0; e < 8; ++e) *(unsigned*)(St1 + vv * 72 + tgv * 16 + 2 * e) = vP[vh][e];
      __syncthreads();
      if constexpr (LOW) {
        zero4(acc); mm_strip(M1, St1, acc, wave, lane);
#pragma unroll
        for (int nb = 0; nb < 4; ++nb)
#pragma unroll
          for (int jj = 0; jj < 4; ++jj) {
            const int t = wave * 16 + quad * 4 + jj, col = nb * 16 + lr; const bf16 u = f2bf(acc[nb][jj]);
            St2[col * 72 + t] = u;
          }
#pragma unroll
        for (int nb = 0; nb < 4; ++nb)
          *(uint2*)(Ou0 + (((((size_t)c * NH + h) * (DV / 16) + vh * 4 + nb) * 4 + wave) * 64 + lane) * 4) = make_uint2(pack2(acc[nb][0], acc[nb][1]), pack2(acc[nb][2], acc[nb][3]));
        __syncthreads();
      }
      zero4(acc); mm_strip(Ak, St1, acc, wave, lane);
      if constexpr (LOW) mm_strip(nAb, St2, acc, wave, lane);
#pragma unroll
      for (int nb = 0; nb < 4; ++nb)
        *(uint2*)(Ool + (((((size_t)c * NH + h) * (DV / 16) + vh * 4 + nb) * 4 + wave) * 64 + lane) * 4) = make_uint2(pack2(acc[nb][0], acc[nb][1]), pack2(acc[nb][2], acc[nb][3]));
      __syncthreads();
    }
    if constexpr (LOW) {
#pragma unroll
      for (int kh = 0; kh < DKH; ++kh) {
        if (k / 64 == kh) {
          const int kk = k & 63;
#pragma unroll
          for (int e = 0; e < TPT; ++e) {
            const int t = tg * TPT + e;
            St1[kk * 72 + t] = f2bf(KAPV(e, t) * __expf(LPREV(e, t)));
            LkT[t * 72 + kk] = f2bf(QV(e) * __expf(LGV(e, t)));
            __builtin_amdgcn_sched_barrier(0);
          }
        }
        __syncthreads();
        zero4(acc); mm_strip(Tt, St1, acc, wave, lane);
#pragma unroll
        for (int nb = 0; nb < 4; ++nb)
#pragma unroll
          for (int jj = 0; jj < 4; ++jj) {
            const int t = wave * 16 + quad * 4 + jj, col = nb * 16 + lr; const bf16 u = f2bf(acc[nb][jj]);
            St2[col * 72 + t] = u;
            Ow[(rb + t) * 1024 + h * DK + kh * 64 + col] = u;
          }
        __syncthreads();
        zero4(acc); mm_strip(nAb, St2, acc, wave, lane);
#pragma unroll
        for (int nb = 0; nb < 4; ++nb)
#pragma unroll
          for (int jj = 0; jj < 4; ++jj) {
            const int t = wave * 16 + quad * 4 + jj, col = nb * 16 + lr;
            Oq[(rb + t) * LDQ + h * DK + kh * 64 + col] = f2bf(acc[nb][jj] + bf2f(LkT[t * 72 + col]));
          }
        __syncthreads();
      }
    } else {
#pragma unroll
      for (int e = 0; e < TPT; ++e) { Oq[(rb + tg * TPT + e) * LDQ + h * DK + k] = f2bf(QV(e) * __expf(LGV(e, tg * TPT + e))); __builtin_amdgcn_sched_barrier(0); }
    }
    {
      unsigned wk[TPT / 2], wb[LOW ? TPT / 2 : 1];
#pragma unroll
      for (int e = 0; e < TPT; e += 2) {
        const int t0 = tg * TPT + e;
        const float d0 = __expf(lgC - LGV(e, t0)), d1 = __expf(lgC - LGV(e + 1, t0 + 1));
        wk[e / 2] = pack2(KTV(e, t0) * d0, KTV(e + 1, t0 + 1) * d1);
        if constexpr (LOW) wb[e / 2] = pack2(BVV(e, t0) * d0, BVV(e + 1, t0 + 1) * d1);
        __builtin_amdgcn_sched_barrier(0);
      }
      const size_t co = rb * LDQ + h * DK + cont_off<DK>(k, tg * TPT, LDQ);
#pragma unroll
      for (int e = 0; e < TPT / 8; ++e) {
        *(uint4*)(Okt + co + e * 8) = make_uint4(wk[e * 4], wk[e * 4 + 1], wk[e * 4 + 2], wk[e * 4 + 3]);
        if constexpr (LOW) *(uint4*)(Obt + co + e * 8) = make_uint4(wb[e * 4], wb[e * 4 + 1], wb[e * 4 + 2], wb[e * 4 + 3]);
      }
#pragma unroll
      for (int vh = 0; vh < DVH; ++vh) {
        const unsigned* wv = vP[vh];
        const size_t vo = rb * 1024 + h * DV + cont_off<DV>(vh * 64 + vv, tgv * 16, 1024);
        *(uint4*)(Ovt + vo) = make_uint4(wv[0], wv[1], wv[2], wv[3]);
        *(uint4*)(Ovt + vo + 8) = make_uint4(wv[4], wv[5], wv[6], wv[7]);
      }
      if (tg == 0) gam[((size_t)c * NH + h) * DK + k] = __expf(lgC);
    }
    __syncthreads();
  }
}

template <int TYPE>
DEVI void phase_seq(const P& p, int j) {
  constexpr int NH = TYPE == 0 ? 16 : (TYPE == 1 ? 4 : 8);
  constexpr int DK = TYPE == 0 ? 64 : 128;
  constexpr int DV = TYPE == 0 ? 64 : (TYPE == 1 ? 256 : 128);
  constexpr bool LOW = TYPE != 1;
  constexpr int NVB = DV / 16, MB = DK / 16, KS = DK / 32;
  constexpr int LDQ = TYPE == 1 ? 512 : 1024;
  constexpr int IPS = NH * NVB;
  const int lane = threadIdx.x & 63, wave = threadIdx.x >> 6, lr = lane & 15, quad = lane >> 4;
  const bf16 *Qp, *Kt, *Vt, *Wp = nullptr, *Bt = nullptr, *U0 = nullptr; bf16* Ol;
  if (TYPE == 0) { Qp = slot(p, 5); Kt = slot(p, 6); Vt = slot(p, 7); Wp = slot(p, 2); Bt = slot(p, 3); Ol = slot(p, 0); U0 = slot(p, 1); }
  else if (TYPE == 1) { Qp = slot(p, 1); Kt = slot(p, 1) + (size_t)MT * 512; Vt = slot(p, 2); Ol = slot(p, 4); }
  else { Qp = slot(p, 5); Kt = slot(p, 6); Vt = slot(p, 7); Wp = slot(p, 1); Bt = slot(p, 2); Ol = slot(p, 3); U0 = slot(p, 0); }
  const float* gam = (const float*)(PWS + WS_GAM);
  const int nitems = 33 * IPS;
  for (int item = wave * gridDim.x + blockIdx.x; item < nitems; item += gridDim.x * 4) {
    const int seq = item / IPS, rem = item % IPS, h = rem / NVB, vb = rem % NVB;
    const int c0 = seq == 0 ? 0 : NPCH + seq - 1, nc = seq == 0 ? NPCH : 1;
    const int vcol = vb * 16 + lr;
    f32x4 H[MB];
    if (seq == 0) {
#pragma unroll
      for (int m = 0; m < MB; ++m) H[m] = (f32x4){0.f, 0.f, 0.f, 0.f};
    } else {
      const int b = seq - 1;
      if (TYPE == 0) {
        const float* S = PIN(3) + (((size_t)j * NSS + b) * 16 + h) * 4096 + (size_t)vcol * 64;
#pragma unroll
        for (int m = 0; m < MB; ++m) { float4 v = *(const float4*)(S + m * 16 + quad * 4); H[m] = (f32x4){v.x, v.y, v.z, v.w}; }
      } else {
        const float* S = PIN(TYPE == 1 ? 4 : 6) + ((size_t)b * NH + h) * DK * DV + vcol;
#pragma unroll
        for (int m = 0; m < MB; ++m)
#pragma unroll
          for (int jj = 0; jj < 4; ++jj) H[m][jj] = S[(size_t)(m * 16 + quad * 4 + jj) * DV];
      }
    }
    unsigned tsink = 0;
    for (int c = c0; c < c0 + nc; ++c) {
      const size_t rb = (size_t)c * 64;
      int ln = threadIdx.x & 63; asm volatile("" : "+v"(ln));
      const int lr = ln & 15, quad = ln >> 4, vcol = vb * 16 + lr;
      const bf16* qb = Qp + rb * LDQ + h * DK;
      const bf16* wb = LOW ? Wp + rb * 1024 + h * DK : nullptr;
      const bf16* kb = Kt + rb * LDQ + h * DK;
      const bf16* bb = LOW ? Bt + rb * 1024 + h * DK : nullptr;
      const bf16* vtb = Vt + rb * 1024 + h * DV;
      const size_t fo = ((((size_t)c * NH + h) * NVB + vb) * 4) * 256 + ln * 4;
      const float* gp = gam + ((size_t)c * NH + h) * DK + quad * 4;
      bf16x8 hb[KS];
#pragma unroll
      for (int ks = 0; ks < KS; ++ks) {
        const u32x4 hw = {pack2(H[2 * ks][0], H[2 * ks][1]), pack2(H[2 * ks][2], H[2 * ks][3]), pack2(H[2 * ks + 1][0], H[2 * ks + 1][1]), pack2(H[2 * ks + 1][2], H[2 * ks + 1][3])};
        hb[ks] = __builtin_bit_cast(bf16x8, hw);
      }
      uint2 oin[4], uin[4]; bf16x8 qa[4][KS], wa[LOW ? 4 : 1][KS];
      bf16x8 vbop[2], kfr[MB][2], bfr[LOW ? MB : 1][2]; float4 gv[MB];
#define LOAD_A(tb) do { oin[tb] = *(const uint2*)(Ol + fo + (tb) * 256); if constexpr (LOW) uin[tb] = *(const uint2*)(U0 + fo + (tb) * 256); \
        _Pragma("unroll") for (int ks = 0; ks < KS; ++ks) { const int off_ = ((tb) * 16 + lr) * LDQ + ks * 32 + quad * 4; \
          bf16x4 lo_ = *(const bf16x4*)(qb + off_), hi_ = *(const bf16x4*)(qb + off_ + 16); qa[tb][ks] = __builtin_shufflevector(lo_, hi_, 0, 1, 2, 3, 4, 5, 6, 7); \
          if constexpr (LOW) { const int ow_ = ((tb) * 16 + lr) * 1024 + ks * 32 + quad * 4; bf16x4 wl_ = *(const bf16x4*)(wb + ow_), wh_ = *(const bf16x4*)(wb + ow_ + 16); \
            wa[tb][ks] = __builtin_shufflevector(wl_, wh_, 0, 1, 2, 3, 4, 5, 6, 7); } } } while (0)
#define COMP_A(tb) do { f32x4 o_, u_; \
        o_ = (f32x4){bf2f(oin[tb].x & 0xffff), bf2f(oin[tb].x >> 16), bf2f(oin[tb].y & 0xffff), bf2f(oin[tb].y >> 16)}; \
        if constexpr (LOW) u_ = (f32x4){bf2f(uin[tb].x & 0xffff), bf2f(uin[tb].x >> 16), bf2f(uin[tb].y & 0xffff), bf2f(uin[tb].y >> 16)}; \
        _Pragma("unroll") for (int ks = 0; ks < KS; ++ks) { o_ = __builtin_amdgcn_mfma_f32_16x16x32_bf16(qa[tb][ks], hb[ks], o_, 0, 0, 0); \
          if constexpr (LOW) u_ = __builtin_amdgcn_mfma_f32_16x16x32_bf16(wa[tb][ks], hb[ks], u_, 0, 0, 0); } \
        *(uint2*)(Ol + fo + (tb) * 256) = make_uint2(pack2(o_[0], o_[1]), pack2(o_[2], o_[3])); \
        if constexpr (LOW) U[tb] = u_; } while (0)
#define LOAD_B(m) do { gv[m] = *(const float4*)(gp + (m) * 16); const int krow_ = (m) * 16 + lr; \
        _Pragma("unroll") for (int ks = 0; ks < 2; ++ks) { kfr[m][ks] = *(const bf16x8*)(kb + cont_off<DK>(krow_, ks * 32 + quad * 8, LDQ)); \
          if constexpr (LOW) { bf16x4 lo_ = *(const bf16x4*)(bb + cont_off<DK>(krow_, ks * 32 + quad * 4, 1024)); \
            bf16x4 hi_ = *(const bf16x4*)(bb + cont_off<DK>(krow_, ks * 32 + 16 + quad * 4, 1024)); bfr[m][ks] = __builtin_shufflevector(lo_, hi_, 0, 1, 2, 3, 4, 5, 6, 7); } } } while (0)
#define COMP_B(m) do { f32x4 hn_ = (f32x4){H[m][0] * gv[m].x, H[m][1] * gv[m].y, H[m][2] * gv[m].z, H[m][3] * gv[m].w}; \
        _Pragma("unroll") for (int ks = 0; ks < 2; ++ks) { hn_ = __builtin_amdgcn_mfma_f32_16x16x32_bf16(kfr[m][ks], vbop[ks], hn_, 0, 0, 0); \
          if constexpr (LOW) hn_ = __builtin_amdgcn_mfma_f32_16x16x32_bf16(bfr[m][ks], ubop[ks], hn_, 0, 0, 0); } \
        H[m] = hn_; } while (0)
      f32x4 U[4];
      constexpr int PF = 3;
      constexpr int LPR = DK / 64;
      unsigned tv[LPR * 4 + 1];
#pragma unroll
      for (int i = 0; i < LPR * 4 + 1; ++i) tv[i] = 0;
      if (c + PF < c0 + nc) {
        const size_t rb2 = (size_t)(c + PF) * 64;
#pragma unroll
        for (int i = 0; i < LPR; ++i) {
          const int li = i * 64 + ln; const size_t ro = (size_t)(li / LPR), co = (size_t)(li % LPR) * 64;
          tv[i * 4 + 0] = *(const unsigned*)(Qp + (rb2 + ro) * LDQ + h * DK + co);
          tv[i * 4 + 1] = *(const unsigned*)(Kt + (rb2 + ro) * LDQ + h * DK + co);
          if constexpr (LOW) { tv[i * 4 + 2] = *(const unsigned*)(Wp + (rb2 + ro) * 1024 + h * DK + co); tv[i * 4 + 3] = *(const unsigned*)(Bt + (rb2 + ro) * 1024 + h * DK + co); }
        }
        {
          const size_t fo2 = ((((size_t)(c + PF) * NH + h) * NVB + vb) * 4) * 256;
          const unsigned* tp;
          if (ln < 16) tp = (const unsigned*)(Ol + fo2 + ln * 64);
          else if (LOW && ln < 32) tp = (const unsigned*)(U0 + fo2 + (ln - 16) * 64);
          else if (ln < 48) tp = (const unsigned*)(Vt + rb2 * 1024 + h * DV + cont_off<DV>(vb * 16 + (ln & 15), 0, 1024));
          else tp = (const unsigned*)(gam + ((size_t)(c + PF) * NH + h) * DK + ((ln - 48) & (DK / 32 - 1)) * 32);
          tv[LPR * 4] = *tp;
        }
      }
      LOAD_A(0); LOAD_A(1); LOAD_A(2); LOAD_A(3);
#pragma unroll
      for (int ks = 0; ks < 2; ++ks) vbop[ks] = *(const bf16x8*)(vtb + cont_off<DV>(vcol, ks * 32 + quad * 8, 1024));
#pragma unroll
      for (int m = 0; m < MB; ++m) LOAD_B(m);
      __builtin_amdgcn_sched_barrier(0);
      COMP_A(0); COMP_A(1); COMP_A(2); COMP_A(3);
      bf16x8 ubop[2];
      if constexpr (LOW) {
#pragma unroll
        for (int ks = 0; ks < 2; ++ks) {
          const u32x4 uw = {pack2(-U[2 * ks][0], -U[2 * ks][1]), pack2(-U[2 * ks][2], -U[2 * ks][3]), pack2(-U[2 * ks + 1][0], -U[2 * ks + 1][1]), pack2(-U[2 * ks + 1][2], -U[2 * ks + 1][3])};
          ubop[ks] = __builtin_bit_cast(bf16x8, uw);
        }
      }
#pragma unroll
      for (int m = 0; m < MB; ++m) COMP_B(m);
      __builtin_amdgcn_sched_barrier(0);
#pragma unroll
      for (int i = 0; i < LPR * 4 + 1; ++i) tsink ^= tv[i];
#undef LOAD_A
#undef COMP_A
#undef LOAD_B
#undef COMP_B
    }
    if (tsink == 0x9e3779b9u) ((unsigned*)(PWS + WS_SINK))[0] = tsink;
    if (TYPE == 0) {
      float* S = POUT + (seq == 0 ? O_AWKV_P + ((size_t)j * 16 + h) * 4096 : O_AWKV_S + (((size_t)j * NSS + (seq - 1)) * 16 + h) * 4096) + (size_t)vcol * 64;
#pragma unroll
      for (int m = 0; m < MB; ++m) *(float4*)(S + m * 16 + quad * 4) = make_float4(H[m][0], H[m][1], H[m][2], H[m][3]);
    } else {
      const size_t ob = TYPE == 1 ? (seq == 0 ? O_BKV_P : O_BKV_S + (size_t)(seq - 1) * NH * DK * DV)
                                  : (seq == 0 ? O_CKV_P : O_CKV_S + (size_t)(seq - 1) * NH * DK * DV);
      float* S = POUT + ob + (size_t)h * DK * DV + vcol;
#pragma unroll
      for (int m = 0; m < MB; ++m)
#pragma unroll
        for (int jj = 0; jj < 4; ++jj) S[(size_t)(m * 16 + quad * 4 + jj) * DV] = H[m][jj];
    }
  }
}

template <int TYPE>
DEVI void phase_seq2(const P& p, int j, char* smem) {
  constexpr int NH = TYPE == 0 ? 16 : (TYPE == 1 ? 4 : 8);
  constexpr int DK = TYPE == 0 ? 64 : 128;
  constexpr int DV = TYPE == 0 ? 64 : (TYPE == 1 ? 256 : 128);
  constexpr bool LOW = TYPE != 1;
  constexpr int NVB = DV / 16, MB = DK / 16, KS = DK / 32, NG = NVB / 4, BIPS = NH * NG;
  constexpr int LDQ = TYPE == 1 ? 512 : 1024;
  constexpr int NOP = LOW ? 4 : 2, RS = DK + 8, OPSZ = 64 * RS, PPR = DK / 8;
  constexpr int PPO = 64 * PPR / 256;
  constexpr int PF = 4;
  bf16* L = (bf16*)smem;
  const int tid = threadIdx.x, lane = tid & 63, wave = tid >> 6, lr = lane & 15, quad = lane >> 4;
  const bf16 *Qp, *Kt, *Vt, *Wp = nullptr, *Bt = nullptr, *U0 = nullptr; bf16* Ol;
  if (TYPE == 0) { Qp = slot(p, 5); Kt = slot(p, 6); Vt = slot(p, 7); Wp = slot(p, 2); Bt = slot(p, 3); Ol = slot(p, 0); U0 = slot(p, 1); }
  else if (TYPE == 1) { Qp = slot(p, 1); Kt = slot(p, 1) + (size_t)MT * 512; Vt = slot(p, 2); Ol = slot(p, 4); }
  else { Qp = slot(p, 5); Kt = slot(p, 6); Vt = slot(p, 7); Wp = slot(p, 1); Bt = slot(p, 2); Ol = slot(p, 3); U0 = slot(p, 0); }
  const float* gam = (const float*)(PWS + WS_GAM);
  unsigned tsink = 0;
  for (int bitem = blockIdx.x; bitem < 33 * BIPS; bitem += gridDim.x) {
    const int seq = bitem / BIPS, rem = bitem % BIPS, h = rem / NG, vb = (rem % NG) * 4 + wave;
    const int c0 = seq == 0 ? 0 : NPCH + seq - 1, nc = seq == 0 ? NPCH : 1;
    const int vcol = vb * 16 + lr;
    f32x4 H[MB];
    if (seq == 0) {
#pragma unroll
      for (int m = 0; m < MB; ++m) H[m] = (f32x4){0.f, 0.f, 0.f, 0.f};
    } else {
      const int b = seq - 1;
      if (TYPE == 0) {
        const float* S = PIN(3) + (((size_t)j * NSS + b) * 16 + h) * 4096 + (size_t)vcol * 64;
#pragma unroll
        for (int m = 0; m < MB; ++m) { float4 v = *(const float4*)(S + m * 16 + quad * 4); H[m] = (f32x4){v.x, v.y, v.z, v.w}; }
      } else {
        const float* S = PIN(TYPE == 1 ? 4 : 6) + ((size_t)b * NH + h) * DK * DV + vcol;
#pragma unroll
        for (int m = 0; m < MB; ++m)
#pragma unroll
          for (int jj = 0; jj < 4; ++jj) H[m][jj] = S[(size_t)(m * 16 + quad * 4 + jj) * DV];
      }
    }
    u32x4 preA[NOP * PPO], preB[NOP * PPO]; u32x2 poA[4], poB[4], puA[4], puB[4]; bf16x8 pvA[2], pvB[2]; f32x4 pgA[MB], pgB[MB];
    auto issue_sh = [&](int cc, u32x4 (&pre)[NOP * PPO]) {
      const size_t rb_ = (size_t)cc * 64; int tl_ = threadIdx.x; asm volatile("" : "+v"(tl_));
#pragma unroll
      for (int i_ = 0; i_ < PPO; ++i_) { const int w_ = tl_ + 256 * i_; const size_t r_ = rb_ + w_ / PPR; const int c8_ = (w_ % PPR) * 8;
        pre[0 * PPO + i_] = *(const u32x4*)(Qp + r_ * LDQ + h * DK + c8_);
        pre[1 * PPO + i_] = *(const u32x4*)(Kt + r_ * LDQ + h * DK + c8_);
        if constexpr (LOW) { pre[2 * PPO + i_] = *(const u32x4*)(Wp + r_ * 1024 + h * DK + c8_); pre[3 * PPO + i_] = *(const u32x4*)(Bt + r_ * 1024 + h * DK + c8_); } }
    };
    auto issue_pr = [&](int cc, u32x2 (&p_o)[4], u32x2 (&p_u)[4], bf16x8 (&p_v)[2], f32x4 (&p_g)[MB]) {
      const size_t rb_ = (size_t)cc * 64; int tl_ = threadIdx.x; asm volatile("" : "+v"(tl_));
      const int lane = tl_ & 63, lr = lane & 15, quad = lane >> 4, vcol = vb * 16 + lr;
      const size_t fo_ = ((((size_t)cc * NH + h) * NVB + vb) * 4) * 256 + lane * 4;
#pragma unroll
      for (int tb_ = 0; tb_ < 4; ++tb_) { p_o[tb_] = *(const u32x2*)(Ol + fo_ + tb_ * 256); if constexpr (LOW) p_u[tb_] = *(const u32x2*)(U0 + fo_ + tb_ * 256); }
#pragma unroll
      for (int ks_ = 0; ks_ < 2; ++ks_) p_v[ks_] = *(const bf16x8*)(Vt + rb_ * 1024 + h * DV + cont_off<DV>(vcol, ks_ * 32 + quad * 8, 1024));
#pragma unroll
      for (int m_ = 0; m_ < MB; ++m_) p_g[m_] = *(const f32x4*)(gam + ((size_t)cc * NH + h) * DK + m_ * 16 + quad * 4);
    };
    const int cend = c0 + nc;
    auto step = [&](int c, u32x4 (&pre)[NOP * PPO], u32x2 (&p_o)[4], u32x2 (&p_u)[4], bf16x8 (&p_v)[2], f32x4 (&p_g)[MB]) {
#pragma unroll
      for (int o = 0; o < NOP; ++o)
#pragma unroll
        for (int i = 0; i < PPO; ++i) { const int w = tid + 256 * i; *(u32x4*)(L + o * OPSZ + (w / PPR) * RS + (w % PPR) * 8) = pre[o * PPO + i]; }
      __syncthreads();
      if (c + 2 < cend) issue_sh(c + 2, pre);
      unsigned tv[NOP * DK / 128 + 1];
#pragma unroll
      for (int i = 0; i < NOP * DK / 128 + 1; ++i) tv[i] = 0;
      if (false && c + PF < cend) {
        const size_t rb2 = (size_t)(c + PF) * 64;
        if (DK == 128 || tid < 128) {
          const int li = (DK == 128) ? tid : tid; const size_t ro = li / (DK / 64) % 64; const int co = (li % (DK / 64)) * 64;
          const int half = (DK == 128) ? (tid >> 7) : (tid >> 6);
          if (half == 0) { tv[0] = *(const unsigned*)(Qp + (rb2 + ro) * LDQ + h * DK + co); if constexpr (LOW) tv[1] = *(const unsigned*)(Wp + (rb2 + ro) * 1024 + h * DK + co); }
          else { tv[0] = *(const unsigned*)(Kt + (rb2 + ro) * LDQ + h * DK + co); if constexpr (LOW) tv[1] = *(const unsigned*)(Bt + (rb2 + ro) * 1024 + h * DK + co); }
        }
        {
          const size_t fo2 = ((((size_t)(c + PF) * NH + h) * NVB + vb) * 4) * 256;
          const unsigned* tp;
          if (lane < 16) tp = (const unsigned*)(Ol + fo2 + lane * 64);
          else if (LOW && lane < 32) tp = (const unsigned*)(U0 + fo2 + (lane - 16) * 64);
          else if (lane < 48) tp = (const unsigned*)(Vt + rb2 * 1024 + h * DV + cont_off<DV>(vb * 16 + (lane & 15), 0, 1024));
          else tp = (const unsigned*)(gam + ((size_t)(c + PF) * NH + h) * DK + ((lane - 48) & (DK / 32 - 1)) * 32);
          tv[NOP * DK / 128] = *tp;
        }
      }
      bf16x8 hb[KS];
#pragma unroll
      for (int ks = 0; ks < KS; ++ks) {
        const u32x4 hw = {pack2(H[2 * ks][0], H[2 * ks][1]), pack2(H[2 * ks][2], H[2 * ks][3]), pack2(H[2 * ks + 1][0], H[2 * ks + 1][1]), pack2(H[2 * ks + 1][2], H[2 * ks + 1][3])};
        hb[ks] = __builtin_bit_cast(bf16x8, hw);
      }
      const size_t fo = ((((size_t)c * NH + h) * NVB + vb) * 4) * 256 + lane * 4;
      f32x4 U[4];
#pragma unroll
      for (int tb = 0; tb < 4; ++tb) {
        f32x4 o_ = (f32x4){bf2f(p_o[tb].x & 0xffff), bf2f(p_o[tb].x >> 16), bf2f(p_o[tb].y & 0xffff), bf2f(p_o[tb].y >> 16)}, u_;
        if constexpr (LOW) u_ = (f32x4){bf2f(p_u[tb].x & 0xffff), bf2f(p_u[tb].x >> 16), bf2f(p_u[tb].y & 0xffff), bf2f(p_u[tb].y >> 16)};
#pragma unroll
        for (int ks = 0; ks < KS; ++ks) {
          const bf16* qp = L + 0 * OPSZ + (tb * 16 + lr) * RS + ks * 32 + quad * 4;
          bf16x4 lo = *(const bf16x4*)qp, hi = *(const bf16x4*)(qp + 16);
          o_ = __builtin_amdgcn_mfma_f32_16x16x32_bf16(__builtin_shufflevector(lo, hi, 0, 1, 2, 3, 4, 5, 6, 7), hb[ks], o_, 0, 0, 0);
          if constexpr (LOW) {
            const bf16* wp = L + 2 * OPSZ + (tb * 16 + lr) * RS + ks * 32 + quad * 4;
            bf16x4 wl = *(const bf16x4*)wp, wh = *(const bf16x4*)(wp + 16);
            u_ = __builtin_amdgcn_mfma_f32_16x16x32_bf16(__builtin_shufflevector(wl, wh, 0, 1, 2, 3, 4, 5, 6, 7), hb[ks], u_, 0, 0, 0);
          }
        }
        *(u32x2*)(Ol + fo + tb * 256) = (u32x2){pack2(o_[0], o_[1]), pack2(o_[2], o_[3])};
        if constexpr (LOW) U[tb] = u_;
      }
      bf16x8 ubop[2];
      if constexpr (LOW) {
#pragma unroll
        for (int ks = 0; ks < 2; ++ks) {
          const u32x4 uw = {pack2(-U[2 * ks][0], -U[2 * ks][1]), pack2(-U[2 * ks][2], -U[2 * ks][3]), pack2(-U[2 * ks + 1][0], -U[2 * ks + 1][1]), pack2(-U[2 * ks + 1][2], -U[2 * ks + 1][3])};
          ubop[ks] = __builtin_bit_cast(bf16x8, uw);
        }
      }
#pragma unroll
      for (int m = 0; m < MB; ++m) {
        f32x4 hn = (f32x4){H[m][0] * p_g[m][0], H[m][1] * p_g[m][1], H[m][2] * p_g[m][2], H[m][3] * p_g[m][3]};
        const int krow = m * 16 + lr;
#pragma unroll
        for (int ks = 0; ks < 2; ++ks) {
          const int i1 = krow * 64 + ks * 32 + quad * 8;
          bf16x8 a = *(const bf16x8*)(L + 1 * OPSZ + (i1 / DK) * RS + (i1 % DK));
          hn = __builtin_amdgcn_mfma_f32_16x16x32_bf16(a, p_v[ks], hn, 0, 0, 0);
          if constexpr (LOW) {
            const int i2 = krow * 64 + ks * 32 + quad * 4, i3 = i2 + 16;
            bf16x4 lo = *(const bf16x4*)(L + 3 * OPSZ + (i2 / DK) * RS + (i2 % DK)), hi = *(const bf16x4*)(L + 3 * OPSZ + (i3 / DK) * RS + (i3 % DK));
            hn = __builtin_amdgcn_mfma_f32_16x16x32_bf16(__builtin_shufflevector(lo, hi, 0, 1, 2, 3, 4, 5, 6, 7), ubop[ks], hn, 0, 0, 0);
          }
        }
        H[m] = hn;
      }
#pragma unroll
      for (int i = 0; i < NOP * DK / 128 + 1; ++i) tsink ^= tv[i];
      if (c + 2 < cend) issue_pr(c + 2, p_o, p_u, p_v, p_g);
      __syncthreads();
    };
    issue_sh(c0, preA); issue_pr(c0, poA, puA, pvA, pgA);
    if (nc > 1) { issue_sh(c0 + 1, preB); issue_pr(c0 + 1, poB, puB, pvB, pgB); }
    for (int c = c0; c < cend; c += 2) { step(c, preA, poA, puA, pvA, pgA); if (c + 1 < cend) step(c + 1, preB, poB, puB, pvB, pgB); }
    if (TYPE == 0) {
      float* S = POUT + (seq == 0 ? O_AWKV_P + ((size_t)j * 16 + h) * 4096 : O_AWKV_S + (((size_t)j * NSS + (seq - 1)) * 16 + h) * 4096) + (size_t)vcol * 64;
#pragma unroll
      for (int m = 0; m < MB; ++m) *(float4*)(S + m * 16 + quad * 4) = make_float4(H[m][0], H[m][1], H[m][2], H[m][3]);
    } else {
      const size_t ob = TYPE == 1 ? (seq == 0 ? O_BKV_P : O_BKV_S + (size_t)(seq - 1) * NH * DK * DV)
                                  : (seq == 0 ? O_CKV_P : O_CKV_S + (size_t)(seq - 1) * NH * DK * DV);
      float* S = POUT + ob + (size_t)h * DK * DV + vcol;
#pragma unroll
      for (int m = 0; m < MB; ++m)
#pragma unroll
        for (int jj = 0; jj < 4; ++jj) S[(size_t)(m * 16 + quad * 4 + jj) * DV] = H[m][jj];
    }
  }
  if (tsink == 0x9e3779b9u) ((unsigned*)(PWS + WS_SINK))[0] = tsink;
}

template <int TYPE>
DEVI void phase_post(const P& p, int j, char* smem) {
  constexpr int NH = TYPE == 0 ? 16 : (TYPE == 1 ? 4 : 8);
  constexpr int DV = TYPE == 0 ? 64 : (TYPE == 1 ? 256 : 128);
  constexpr int CPT = DV / 8;
  bf16* vt = (bf16*)smem;
  bf16* ot = (bf16*)(smem + 9216);
  const bf16* O = slot(p, TYPE == 0 ? 0 : (TYPE == 1 ? 4 : 3));
  const bf16* G = slot(p, TYPE == 0 ? 4 : (TYPE == 1 ? 3 : 4));
  bf16* og = slot(p, TYPE == 1 ? 0 : 1);
  const float* sm = (const float*)(PWS + WS_SM);
  for (int item = blockIdx.x; item < NCHUNK * NH; item += gridDim.x) {
    const int c = item / NH, h = item % NH; const size_t rb = (size_t)c * 64;
    int tid = threadIdx.x; asm volatile("" : "+v"(tid));
    const int part = tid & 7;
    if constexpr (TYPE == 0) {
      const bf16* V = slot(p, 7) + rb * 1024 + h * 64;
      const int r = tid >> 2, q4 = (tid & 3) * 16;
      *(uint4*)(vt + r * 72 + q4) = *(const uint4*)(V + (size_t)r * 1024 + q4);
      *(uint4*)(vt + r * 72 + q4 + 8) = *(const uint4*)(V + (size_t)r * 1024 + q4 + 8);
      __syncthreads();
    }
    {
      const uint4* srcp = (const uint4*)(O + ((size_t)c * NH + h) * 64 * DV);
#pragma unroll
      for (int i = 0; i < DV / 32; ++i) *(uint4*)(ot + (size_t)(i * 256 + tid) * 8) = srcp[i * 256 + tid];
      __syncthreads();
    }
#pragma unroll 1
    for (int pass = 0; pass < 2; ++pass) {
      const int t = pass * 32 + (tid >> 3);
      const size_t base = (rb + t) * 1024 + h * DV + part * CPT;
      float o[CPT];
#pragma unroll
      for (int e = 0; e < CPT; ++e) {
        const int v = part * CPT + e;
        o[e] = bf2f(ot[(((v >> 4) * 4 + (t >> 4)) * 64 + ((t & 15) >> 2) * 16 + (v & 15)) * 4 + (t & 3)]);
      }
      float s1 = 0.f, s2 = 0.f;
#pragma unroll
      for (int e = 0; e < CPT; ++e) { s1 += o[e]; s2 += o[e] * o[e]; }
      s1 += __shfl_xor(s1, 1); s1 += __shfl_xor(s1, 2); s1 += __shfl_xor(s1, 4);
      s2 += __shfl_xor(s2, 1); s2 += __shfl_xor(s2, 2); s2 += __shfl_xor(s2, 4);
      if constexpr (TYPE == 0) {
        const float mean = s1 * (1.f / 64.f); float var = s2 * (1.f / 64.f) - mean * mean; var = fmaxf(var, 0.f);
        const float rs = rsqrtf(var + 64e-5f); const float bonus = sm[(rb + t) * 16 + h];
        const float* lw = PIN(26) + j * 1024 + h * 64 + part * CPT; const float* lb = PIN(27) + j * 1024 + h * 64 + part * CPT;
#pragma unroll
        for (int e = 0; e < CPT; ++e) {
          const float vv = bf2f(vt[(part * CPT + e) * 72 + t]);
          o[e] = (o[e] - mean) * rs * lw[e] + lb[e] + bonus * vv;
        }
      } else {
        const float rs = rsqrtf(s2 * (1.f / DV) + 1e-6f);
        const float* on = PIN(TYPE == 1 ? 32 : 38) + part * CPT;
#pragma unroll
        for (int e = 0; e < CPT; ++e) o[e] = o[e] * rs * on[e];
      }
#pragma unroll
      for (int e = 0; e < CPT; e += 8) {
        uint4 u = *(const uint4*)(G + base + e);
        const unsigned w[4] = {u.x, u.y, u.z, u.w}; unsigned ow[4];
#pragma unroll
        for (int i = 0; i < 4; ++i) {
          float g0 = bf2f(w[i] & 0xffff), g1 = bf2f(w[i] >> 16);
          if constexpr (TYPE != 0) { g0 = silu(g0); g1 = silu(g1); }
          ow[i] = pack2(o[e + 2 * i] * g0, o[e + 2 * i + 1] * g1);
        }
        *(uint4*)(og + base + e) = make_uint4(ow[0], ow[1], ow[2], ow[3]);
      }
    }
    __syncthreads();
  }
}


#define XB_TMO      128
#define XB_XCNT(j)  (256  + 64 * (j))
#define XB_XSUB(j)  (1280 + 64 * (j))
#define XB_XGEN(j)  (2304 + 64 * (j))
#define XB_TOP      3328
#define XB_TOPGEN   3392
#define XCD_BAR_WORDS 3456
#define XB_SPIN_CAP (1u << 18)
#define LAS __attribute__((address_space(3)))
DEVI unsigned xb_ld(unsigned* p)              { return __hip_atomic_load(p, __ATOMIC_RELAXED, __HIP_MEMORY_SCOPE_AGENT); }
DEVI unsigned xb_add(unsigned* p, unsigned v) { return __hip_atomic_fetch_add(p, v, __ATOMIC_RELAXED, __HIP_MEMORY_SCOPE_AGENT); }
DEVI unsigned xb_xcc_id() { return (unsigned)__builtin_amdgcn_s_getreg((3 << 11) | 20) & 0xFu; }
#define XB_SPIN(cond, bar) do { unsigned _sp = 0; while (cond) { __builtin_amdgcn_s_sleep(1); \
    if ((++_sp & 255u) == 0u) { if (xb_ld(&(bar)[XB_TMO])) break; if (_sp > XB_SPIN_CAP) { atomicAdd(&(bar)[XB_TMO], 1u); break; } } } } while (0)
struct XcdBarrier { unsigned* bar; unsigned x; volatile LAS unsigned* st; };
DEVI XcdBarrier xcd_barrier_post(unsigned* bar, volatile LAS unsigned* st) {
  XcdBarrier b; b.bar = bar; b.x = xb_xcc_id(); b.st = st;
  if (threadIdx.x == 0) (void)xb_add(&bar[XB_XCNT(b.x)], 1u);
  return b;
}
DEVI void xcd_barrier_complete(unsigned* bar, unsigned x, unsigned& nloc, unsigned& nx) {
  const unsigned G = gridDim.x * gridDim.y * gridDim.z;
  unsigned sum, cnt, mine, sp = 0u;
  for (;;) {
    sum = 0u; cnt = 0u; mine = 0u;
#pragma unroll
    for (unsigned j = 0; j < 16; ++j) { const unsigned c = xb_ld(&bar[XB_XCNT(j)]); sum += c; cnt += (c > 0u) ? 1u : 0u; mine = (j == x) ? c : mine; }
    if (sum == G) break;
    __builtin_amdgcn_s_sleep(1);
    if ((++sp & 255u) == 0u) { if (xb_ld(&bar[XB_TMO])) break; if (sp > XB_SPIN_CAP) { atomicAdd(&bar[XB_TMO], 1u); break; } }
  }
  nloc = mine > 0u ? mine : 1u; nx = cnt > 0u ? cnt : 1u;
}
DEVI void xcd_barrier(const XcdBarrier& b) {
  asm volatile("s_waitcnt vmcnt(0)" ::: "memory");
  __syncthreads();
  if (threadIdx.x == 0) {
    unsigned* bar = b.bar;
    __builtin_amdgcn_s_waitcnt(0);
    unsigned nloc = b.st[0], nx = b.st[1];
    if (nloc == 0u) { xcd_barrier_complete(bar, b.x, nloc, nx); b.st[0] = nloc; b.st[1] = nx; }
    const unsigned old = xb_add(&bar[XB_XSUB(b.x)], 1u);
    const unsigned gen = old / nloc;
    if (old + 1u == (gen + 1u) * nloc) {
      __builtin_amdgcn_fence(__ATOMIC_RELEASE, "agent");
      asm volatile("s_waitcnt vmcnt(0)" ::: "memory");
      const unsigned og = xb_add(&bar[XB_TOP], 1u);
      const unsigned tg = og / nx;
      if (og + 1u == (tg + 1u) * nx) xb_add(&bar[XB_TOPGEN], 1u);
      else XB_SPIN(xb_ld(&bar[XB_TOPGEN]) == tg, bar);
      __builtin_amdgcn_fence(__ATOMIC_ACQUIRE, "agent");
      xb_add(&bar[XB_XGEN(b.x)], 1u);
      asm volatile("s_waitcnt vmcnt(0)" ::: "memory");
    } else {
      XB_SPIN(xb_ld(&bar[XB_XGEN(b.x)]) == gen, bar);
      __builtin_amdgcn_fence(__ATOMIC_ACQUIRE, "agent");
      asm volatile("s_waitcnt vmcnt(0)" ::: "memory");
    }
  }
  __syncthreads();
}

#ifndef DISMASK
#define DISMASK 0
#endif
#define EN(b) (!((DISMASK >> (b)) & 1))
#define GSYNC() xcd_barrier(xb)
#define GSYNC_CG() do { asm volatile("s_waitcnt vmcnt(0)" ::: "memory"); grid.sync(); } while (0)
__global__ void __launch_bounds__(256, 1) fwd_megakernel(P p) {
  extern __shared__ __attribute__((aligned(16))) char smem[];
  cg::grid_group grid = cg::this_grid();
  volatile LAS unsigned* xst = (volatile LAS unsigned*)(smem + LDS_BYTES - 16);
  if (threadIdx.x == 0) { xst[0] = 0u; xst[1] = 0u; }
  __syncthreads();
  const XcdBarrier xb = xcd_barrier_post((unsigned*)(PWS + WS_BAR), xst);
  bf16* wreg = (bf16*)(PWS + WS_W);
  bf16 *wfin = wreg + W_FIN, *wfout = wreg + W_FOUT, *wmix = wreg + W_MIX;
  float* sm = (float*)(PWS + WS_SM);
  for (int layer = 0; layer < 4; ++layer) {
    const int type = layer % 3, j = layer / 3;
    int tb = 0;
    if (type == 0) phase_norm<0>(p, layer, j, layer == 0, layer == 0);
    else phase_norm<1>(p, layer, j, false, false);
    conv_job(CvFfnIn{PIN(10) + (size_t)layer * 1024 * 2 * FF}, wfin, 1024, 2 * FF, 1024, tb, smem);
    conv_job(CvPlain{PIN(11) + (size_t)layer * FF * 1024, 1024, 1024}, wfout, FF, 1024, FF, tb, smem);
    if (type == 0) {
      for (int i = 0; i < 3; ++i) conv_job(CvPlain{PIN(24) + ((size_t)j * 3 + i) * 1048576, 1024, 1024}, wmix + (size_t)i * 1048576, 1024, 1024, 1024, tb, smem);
      conv_job(CvLora1{PIN(14) + (size_t)j * 65536, PIN(17) + (size_t)j * 65536, PIN(19) + (size_t)j * 131072, PIN(12) + (size_t)j * 6144}, wmix + 3145728, 2048, 256, 2048, tb, smem);
      conv_job(CvPlain{PIN(15) + (size_t)j * 65536, 1024, 1024}, wmix + 3670016, 64, 1024, 64, tb, smem);
      conv_job(CvPlain{PIN(18) + (size_t)j * 65536, 1024, 1024}, wmix + 3735552, 64, 1024, 64, tb, smem);
      conv_job(CvPlain{PIN(20) + (size_t)j * 131072, 1024, 1024}, wmix + 3801088, 128, 1024, 128, tb, smem);
      conv_job(CvPlain{PIN(25) + (size_t)j * 1048576, 1024, 1024}, wmix + 3932160, 1024, 1024, 1024, tb, smem);
    } else if (type == 1) {
      conv_job(CvGlaIn{PIN(28), PIN(29)}, wmix, 1024, 3200, 1024, tb, smem);
      conv_job(CvPlain{PIN(33), 1024, 1024}, wmix + 3276800, 1024, 1024, 1024, tb, smem);
    } else {
      conv_job(CvPlain{PIN(34), 4112, 4112}, wmix, 1024, 4224, 1024, tb, smem);
      conv_job(CvPlain{PIN(39), 1024, 1024}, wmix + 4325376, 1024, 1024, 1024, tb, smem);
    }
    GSYNC();
    tb = 0;
    const bf16* wo;
    if (type == 0) {
      for (int i = 0; i < 3; ++i)
        gemm_job(GemmDesc{slot(p, 2 + i), nullptr, 1024, 1024, wmix + (size_t)i * 1048576, 1024, 144, 8, 1024}, EpiStore{slot(p, 5 + i), 1024, 1.f}, tb, smem);
      gemm_job(GemmDesc{slot(p, 0), slot(p, 1), 1024, 1024, wmix + 3145728, 2048, 144, 2, 2048}, EpiLora1{(bf16*)(PWS + WS_L1)}, tb, smem);
      GSYNC();
      tb = 0;
      const bf16* l1 = (const bf16*)(PWS + WS_L1);
      gemm_job(GemmDesc{l1, nullptr, 256, 64, wmix + 3670016, 64, 144, 8, 64}, EpiLd{slot(p, 2), PIN(13) + j * 1024}, tb, smem);
      gemm_job(GemmDesc{l1 + 64, nullptr, 256, 64, wmix + 3735552, 64, 144, 8, 64}, EpiSig{slot(p, 3), PIN(16) + j * 1024}, tb, smem);
      gemm_job(GemmDesc{l1 + 128, nullptr, 256, 128, wmix + 3801088, 128, 144, 8, 128}, EpiStore{slot(p, 4), 1024, 1.f}, tb, smem);
      GSYNC();
      if (EN(2)) phase_prep<0>(p, j, smem);
      GSYNC();
      if (EN(5)) phase_seq2<0>(p, j, smem);
      GSYNC();
      if (EN(8)) phase_post<0>(p, j, smem);
      wo = wmix + 3932160;
    } else if (type == 1) {
      gemm_job(GemmDesc{slot(p, 0), nullptr, 1024, 1024, wmix, 1024, 144, 25, 1024},
               EpiGlaIn{slot(p, 1), slot(p, 1) + (size_t)MT * 512, slot(p, 2), slot(p, 3), sm}, tb, smem);
      GSYNC();
      if (EN(3)) phase_prep<1>(p, j, smem);
      GSYNC();
      if (EN(6)) phase_seq2<1>(p, j, smem);
      GSYNC();
      if (EN(8)) phase_post<1>(p, j, smem);
      wo = wmix + 3276800;
    } else {
      gemm_job(GemmDesc{slot(p, 0), nullptr, 1024, 1024, wmix, 1024, 144, 33, 1024},
               EpiGdnIn{slot(p, 1), slot(p, 4), sm, POUT}, tb, smem);
      GSYNC();
      if (EN(9)) phase_gdn_conv(p);
      GSYNC();
      if (EN(4)) phase_prep<2>(p, j, smem);
      GSYNC();
      if (EN(7)) phase_seq2<2>(p, j, smem);
      GSYNC();
      if (EN(8)) phase_post<2>(p, j, smem);
      wo = wmix + 4325376;
    }
    GSYNC();
    tb = 0;
    gemm_job(GemmDesc{slot(p, type == 1 ? 0 : 1), nullptr, 1024, 1024, wo, 1024, 144, 8, 1024}, EpiAcc{POUT}, tb, smem);
    GSYNC();
    phase_rms(POUT, PIN(8) + layer * 1024, slot(p, 0), nullptr);
    GSYNC();
    tb = 0;
    gemm_job(GemmDesc{slot(p, 0), nullptr, 1024, 1024, wfin, 1024, 144, 44, 1024}, EpiSwiglu{slot(p, 1)}, tb, smem);
    GSYNC();
    tb = 0;
    gemm_job(GemmDesc{slot(p, 1), nullptr, FF, FF, wfout, FF, 144, 8, FF}, EpiAcc{POUT}, tb, smem);
    if (layer == 3) GSYNC_CG(); else GSYNC();
  }
  phase_rms(POUT, PIN(9), nullptr, POUT);
}

extern "C" void kernel_launch(void* const* d_in, const int* in_sizes, int n_in, void* d_out, int out_size,
                              void* d_ws, size_t ws_size, hipStream_t stream) {
  if (n_in < 40 || ws_size < WS_TOTAL) { fprintf(stderr, "bad args: n_in %d ws %zu need %zu\n", n_in, ws_size, (size_t)WS_TOTAL); return; }
  static int grid_blocks = 0;
  if (!grid_blocks) {
    int dev = 0, cus = 0, per_cu = 0;
    hipGetDevice(&dev);
    hipDeviceGetAttribute(&cus, hipDeviceAttributeMultiprocessorCount, dev);
    hipFuncSetAttribute((const void*)fwd_megakernel, hipFuncAttributeMaxDynamicSharedMemorySize, LDS_BYTES);
    hipOccupancyMaxActiveBlocksPerMultiprocessor(&per_cu, (const void*)fwd_megakernel, 256, LDS_BYTES);
    if (per_cu > 1) per_cu = 1;
    if (per_cu < 1) per_cu = 1;
    grid_blocks = cus * per_cu;
  }
  hipMemsetAsync((char*)d_ws + WS_BAR, 0, 16384, stream);
  P p{};
  for (int i = 0; i < 40; ++i) p.in[i] = (const float*)d_in[i];
  p.out = (float*)d_out; p.ws = (char*)d_ws;
  void* args[] = {&p};
  hipError_t e = hipLaunchCooperativeKernel((const void*)fwd_megakernel, dim3(grid_blocks), dim3(256), args, LDS_BYTES, stream);
  if (e != hipSuccess) fprintf(stderr, "cooperative launch failed: %s (grid %d)\n", hipGetErrorString(e), grid_blocks);
}
```

```cpp
#include <hip/hip_runtime.h>
#include <hip/hip_cooperative_groups.h>
#include <cstdio>
#include <cstdint>
namespace cg = cooperative_groups;

typedef unsigned short bf16;
typedef __attribute__((ext_vector_type(8))) short bf16x8;
typedef __attribute__((ext_vector_type(4))) short bf16x4;
typedef __attribute__((ext_vector_type(4))) float f32x4;
typedef __attribute__((ext_vector_type(4))) unsigned u32x4;
typedef __attribute__((ext_vector_type(2))) unsigned u32x2;

#define DEVI __device__ __forceinline__

constexpr int Dm = 1024, FF = 2816, MT = 18432, MPR = 16384, NSS = 32, NCHUNK = 288, NPCH = 256;
constexpr size_t SLOT = (size_t)MT * 1024 * 2;
constexpr size_t WS_L1 = 8 * SLOT;
constexpr size_t WS_SM = WS_L1 + (size_t)MT * 256 * 2;
constexpr size_t WS_GAM = WS_SM + (size_t)MT * 16 * 4;
constexpr size_t WS_W = WS_GAM + (size_t)NCHUNK * 1024 * 4;
constexpr size_t W_FIN = 0, W_FOUT = 5767168, W_MIX = 8650752;
constexpr size_t WS_SINK = WS_W + (size_t)14200000 * 2 - 64;
constexpr size_t WS_BAR = WS_W + (size_t)14200000 * 2;
constexpr size_t WS_TOTAL = WS_BAR + 16384;
constexpr int LDS_BYTES = 77824;

constexpr size_t O_ASH_P = 18874368, O_AWKV_P = O_ASH_P + 2048, O_BKV_P = O_AWKV_P + 131072,
                 O_CCONV_P = O_BKV_P + 131072, O_CKV_P = O_CCONV_P + 9216, O_ASH_S = O_CKV_P + 131072,
                 O_AWKV_S = O_ASH_S + 65536, O_BKV_S = O_AWKV_S + 4194304, O_CCONV_S = O_BKV_S + 4194304,
                 O_CKV_S = O_CCONV_S + 294912;

struct P { const float* in[40]; float* out; char* ws; };
typedef const __attribute__((address_space(4))) char* kptr_t;
typedef const float* cfp_t; typedef float* fp_t; typedef char* cp_t;
DEVI kptr_t kbase() { kptr_t b = (kptr_t)__builtin_amdgcn_kernarg_segment_ptr(); asm volatile("" : "+s"(b)); return b; }
#define PIN(i) (*(const __attribute__((address_space(4))) cfp_t*)(kbase() + 8 * (i)))
#define POUT (*(const __attribute__((address_space(4))) fp_t*)(kbase() + 320))
#define PWS (*(const __attribute__((address_space(4))) cp_t*)(kbase() + 328))

typedef __attribute__((ext_vector_type(2))) float f32x2;
typedef __attribute__((ext_vector_type(2))) __bf16 bf16x2v;
DEVI unsigned pack2(float a, float b) { f32x2 v = {a, b}; bf16x2v r = __builtin_convertvector(v, bf16x2v); return __builtin_bit_cast(unsigned, r); }
DEVI bf16 f2bf(float f) { return (bf16)(pack2(f, 0.f) & 0xffffu); }
DEVI float bf2f(bf16 h) { return __uint_as_float(((unsigned)h) << 16); }
DEVI float wsum(float v) {
#pragma unroll
  for (int o = 32; o > 0; o >>= 1) v += __shfl_xor(v, o);
  return v;
}
DEVI float sigm(float x) { return 1.f / (1.f + __expf(-x)); }
DEVI float silu(float x) { return x * sigm(x); }
DEVI float softplus(float x) { return x > 20.f ? x : log1pf(__expf(x)); }
DEVI bf16* slot(const P& p, int i) { return (bf16*)(PWS + (size_t)i * SLOT); }

struct GemmDesc { const bf16* A; const bf16* A2; int lda; int ksplit; const bf16* Bt; int ldb; int tiles_m; int tiles_n; int K; };

template <class Epi>
DEVI void gemm_tile(const GemmDesc& g, int mt, int nt, Epi& epi, char* smem) {
  const int tid = threadIdx.x, lane = tid & 63, wave = tid >> 6;
  const int wm = wave >> 1, wn = wave & 1, lr = lane & 15, quad = lane >> 4;
  bf16* sA = (bf16*)smem;
  bf16* sB = sA + 2 * 8192;
  f32x4 acc[4][4];
#pragma unroll
  for (int i = 0; i < 4; ++i)
#pragma unroll
    for (int j = 0; j < 4; ++j) acc[i][j] = (f32x4){0.f, 0.f, 0.f, 0.f};
  const int m0 = mt * 128, n0 = nt * 128;
  const int r0 = tid >> 3, c0 = tid & 7;
  const size_t aoff = (size_t)(m0 + r0) * g.lda + c0 * 8;
  const bf16* bp = g.Bt + (size_t)(n0 + r0) * g.ldb + c0 * 8;
  const int soff = r0 * 64 + ((c0 ^ (r0 & 7)) << 3);
#define GL1(i_, RA, RB) RA##i_ = *(const u32x4*)(base_ + (size_t)(32 * i_) * g.lda); RB##i_ = *(const u32x4*)(bp + k0_ + (size_t)(32 * i_) * g.ldb);
#define GLOAD(kt_, RA, RB) do { const int k0_ = (kt_) << 6; \
    const bf16* base_ = ((k0_ < g.ksplit) ? (g.A + k0_) : (g.A2 + (k0_ - g.ksplit))) + aoff; \
    GL1(0, RA, RB) GL1(1, RA, RB) GL1(2, RA, RB) GL1(3, RA, RB) } while (0)
#define LS1(buf_, i_, RA, RB) *(u32x4*)(sA + (buf_) * 8192 + soff + i_ * 2048) = RA##i_; *(u32x4*)(sB + (buf_) * 8192 + soff + i_ * 2048) = RB##i_;
#define LSTORE(buf_, RA, RB) do { LS1(buf_, 0, RA, RB) LS1(buf_, 1, RA, RB) LS1(buf_, 2, RA, RB) LS1(buf_, 3, RA, RB) } while (0)
#define GSTEP(kt_, RA, RB) do { const int buf_ = (kt_) & 1; \
    const bf16* a_ = sA + buf_ * 8192 + (wm * 64 + lr) * 64; const bf16* b_ = sB + buf_ * 8192 + (wn * 64 + lr) * 64; \
    _Pragma("unroll") for (int ks_ = 0; ks_ < 2; ++ks_) { \
      const int co_ = (((ks_ * 4 + quad) ^ (lr & 7)) << 3); bf16x8 af_[4], bf_[4]; \
      _Pragma("unroll") for (int i_ = 0; i_ < 4; ++i_) { af_[i_] = *(const bf16x8*)(a_ + i_ * 1024 + co_); bf_[i_] = *(const bf16x8*)(b_ + i_ * 1024 + co_); } \
      _Pragma("unroll") for (int i_ = 0; i_ < 4; ++i_) _Pragma("unroll") for (int j_ = 0; j_ < 4; ++j_) \
        acc[i_][j_] = __builtin_amdgcn_mfma_f32_16x16x32_bf16(af_[i_], bf_[j_], acc[i_][j_], 0, 0, 0); } \
    if ((kt_) + 1 < nk) { LSTORE(buf_ ^ 1, RA, RB); if ((kt_) + 3 < nk) GLOAD((kt_) + 3, RA, RB); } \
    __syncthreads(); } while (0)
  const int nk = g.K >> 6;
  u32x4 pa0, pa1, pa2, pa3, pb0, pb1, pb2, pb3, qa0, qa1, qa2, qa3, qb0, qb1, qb2, qb3;
  qa0 = qa1 = qa2 = qa3 = qb0 = qb1 = qb2 = qb3 = (u32x4){0u, 0u, 0u, 0u};
  GLOAD(0, pa, pb);
  if (nk > 1) GLOAD(1, qa, qb);
  LSTORE(0, pa, pb);
  if (nk > 2) GLOAD(2, pa, pb);
  __syncthreads();
  for (int kt = 0; kt < nk; kt += 2) { GSTEP(kt, qa, qb); if (kt + 1 < nk) GSTEP(kt + 1, pa, pb); }
#pragma unroll
  for (int i = 0; i < 4; ++i) {
#pragma unroll
    for (int jj = 0; jj < 4; ++jj) {
      const int row = m0 + wm * 64 + i * 16 + quad * 4 + jj;
      if constexpr (Epi::PAIR) {
#pragma unroll
        for (int j = 0; j < 4; j += 2) {
          const int nn = n0 + wn * 64 + j * 16;
          epi.pair(row, (nn >> 5) * 16 + lr, acc[i][j][jj], acc[i][j + 1][jj]);
        }
      } else {
#pragma unroll
        for (int j = 0; j < 4; ++j) epi(row, n0 + wn * 64 + j * 16 + lr, acc[i][j][jj]);
      }
    }
  }
}

template <class Epi>
DEVI void gemm_job(const GemmDesc& g, Epi epi, int& tbase, char* smem) {
  const int ntiles = g.tiles_m * g.tiles_n, G = gridDim.x;
  const int first = tbase + (((int)blockIdx.x - tbase % G) + G) % G;
  const int width = 8 * g.tiles_n;
  for (int t = first; t < tbase + ntiles; t += G) {
    const int lt = t - tbase;
    const int grp = lt / width, rem = lt % width;
    gemm_tile(g, grp * 8 + (rem & 7), rem >> 3, epi, smem);
  }
  tbase += ntiles;
}

struct EpiStore { static constexpr bool PAIR = false; bf16* C; int ldc; float sc;
  DEVI void operator()(int r, int c, float v) { C[(size_t)r * ldc + c] = f2bf(v * sc); } };
struct EpiLora1 { static constexpr bool PAIR = false; bf16* C;
  DEVI void operator()(int r, int c, float v) { float o = c < 64 ? tanhf(v) : (c < 128 ? v : sigm(v)); C[(size_t)r * 256 + c] = f2bf(o); } };
struct EpiLd { static constexpr bool PAIR = false; bf16* C; const float* w0;
  DEVI void operator()(int r, int c, float v) { float x = w0[c] + v; float lr_ = -softplus(-x) - 0.5f; C[(size_t)r * 1024 + c] = f2bf(-__expf(lr_)); } };
struct EpiSig { static constexpr bool PAIR = false; bf16* C; const float* a0;
  DEVI void operator()(int r, int c, float v) { C[(size_t)r * 1024 + c] = f2bf(sigm(a0[c] + v)); } };
struct EpiAcc { static constexpr bool PAIR = false; float* X;
  DEVI void operator()(int r, int c, float v) { X[(size_t)r * 1024 + c] += v; } };
struct EpiSwiglu { static constexpr bool PAIR = true; bf16* C;
  DEVI void pair(int r, int c, float gt, float up) { C[(size_t)r * FF + c] = f2bf(silu(gt) * up); } };
struct EpiGlaIn { static constexpr bool PAIR = false; bf16 *q, *k, *v, *gate; float* sm;
  DEVI void operator()(int r, int c, float x) {
    if (c < 512) q[(size_t)r * 512 + c] = f2bf(x * 0.08838834764831845f);
    else if (c < 1024) k[(size_t)r * 512 + c - 512] = f2bf(x);
    else if (c < 2048) v[(size_t)r * 1024 + c - 1024] = f2bf(x);
    else if (c < 3072) gate[(size_t)r * 1024 + c - 2048] = f2bf(x);
    else if (c < 3088) sm[(size_t)r * 16 + c - 3072] = x;
  } };
struct EpiGdnIn { static constexpr bool PAIR = false; bf16 *qkv, *z; float* sm; float* out;
  DEVI void operator()(int r, int c, float x) {
    if (c < 3072) {
      qkv[(size_t)r * 3072 + c] = f2bf(x);
      if (r >= MPR - 3) {
        if (r < MPR) out[O_CCONV_P + (size_t)(r - (MPR - 3)) * 3072 + c] = x;
        else { int tt = (r - MPR) & 63; if (tt >= 61) out[O_CCONV_S + ((size_t)((r - MPR) >> 6) * 3 + (tt - 61)) * 3072 + c] = x; }
      }
    } else if (c < 4096) z[(size_t)r * 1024 + c - 3072] = f2bf(x);
    else if (c < 4112) sm[(size_t)r * 16 + c - 4096] = x;
  } };

template <class F>
DEVI void conv_job(F f, bf16* dst, int ldo, int Nd, int Kd, int& tbase, char* smem) {
  float* tile = (float*)smem;
  const int tn = Nd >> 6, tk = Kd >> 6, ntiles = tn * tk, G = gridDim.x, tid = threadIdx.x;
  const int first = tbase + (((int)blockIdx.x - tbase % G) + G) % G;
  for (int t = first; t < tbase + ntiles; t += G) {
    const int lt = t - tbase, n0 = (lt % tn) << 6, k0 = (lt / tn) << 6;
    const int i = tid >> 4, j4 = (tid & 15) << 2;
#pragma unroll
    for (int r = 0; r < 4; ++r) {
      float4 v = f(k0 + i + 16 * r, n0 + j4);
      float* d = tile + (i + 16 * r) * 65 + j4; d[0] = v.x; d[1] = v.y; d[2] = v.z; d[3] = v.w;
    }
    __syncthreads();
    const int jn = tid >> 2, iq = (tid & 3) << 4;
    unsigned w[8];
#pragma unroll
    for (int e = 0; e < 8; ++e) w[e] = pack2(tile[(iq + 2 * e) * 65 + jn], tile[(iq + 2 * e + 1) * 65 + jn]);
    uint4* o = (uint4*)(dst + (size_t)(n0 + jn) * ldo + k0 + iq);
    o[0] = make_uint4(w[0], w[1], w[2], w[3]); o[1] = make_uint4(w[4], w[5], w[6], w[7]);
    __syncthreads();
  }
  tbase += ntiles;
}
struct CvPlain { const float* W; int ld; int nsrc;
  DEVI float4 operator()(int k, int n) const { return n < nsrc ? *(const float4*)(W + (size_t)k * ld + n) : make_float4(0, 0, 0, 0); } };
struct CvFfnIn { const float* W;
  DEVI float4 operator()(int k, int n) const { int blk = n >> 5, w = n & 31; int src = (w < 16) ? blk * 16 + w : FF + blk * 16 + (w - 16);
    return *(const float4*)(W + (size_t)k * (2 * FF) + src); } };
struct CvLora1 { const float *w1, *a1, *g1, *mu;
  DEVI float4 operator()(int k, int n) const {
    int kk = k & 1023; float4 v; float m;
    if (n < 64) { v = *(const float4*)(w1 + kk * 64 + n); m = mu[1 * 1024 + kk]; }
    else if (n < 128) { v = *(const float4*)(a1 + kk * 64 + n - 64); m = mu[4 * 1024 + kk]; }
    else { v = *(const float4*)(g1 + kk * 128 + n - 128); m = mu[5 * 1024 + kk]; }
    float s = (k < 1024) ? (1.f - m) : m;
    return make_float4(v.x * s, v.y * s, v.z * s, v.w * s); } };
struct CvGlaIn { const float *win, *wa1;
  DEVI float4 operator()(int k, int n) const {
    if (n < 3072) return *(const float4*)(win + (size_t)k * 3072 + n);
    if (n < 3088) return *(const float4*)(wa1 + k * 16 + n - 3072);
    return make_float4(0, 0, 0, 0); } };

template <int TYPE>
DEVI void phase_norm(const P& p, int layer, int j, bool from_input, bool copy_x) {
  const int lane = threadIdx.x & 63, wave = threadIdx.x >> 6;
  const float* g = PIN(7) + layer * 1024;
  float* xres = POUT;
  bf16 *h = slot(p, 0), *hs = slot(p, 1), *xr = slot(p, 2), *xk = slot(p, 3), *xv = slot(p, 4);
  const float* mu = PIN(12) + (size_t)j * 6 * 1024;
  for (int row = blockIdx.x * 4 + wave; row < MT; row += gridDim.x * 4) {
    auto src = [&](int r) -> const float* {
      if (from_input) return r < MPR ? PIN(0) + (size_t)r * 1024 : PIN(1) + (size_t)(r - MPR) * 1024;
      return xres + (size_t)r * 1024; };
    const float* xp = src(row);
    float4 xv4[4]; float ss = 0.f;
#pragma unroll
    for (int i = 0; i < 4; ++i) { xv4[i] = *(const float4*)(xp + i * 256 + lane * 4); ss += xv4[i].x * xv4[i].x + xv4[i].y * xv4[i].y + xv4[i].z * xv4[i].z + xv4[i].w * xv4[i].w; }
    ss = wsum(ss);
    const float rstd = rsqrtf(ss * (1.f / 1024.f) + 1e-6f);
    if (copy_x) {
#pragma unroll
      for (int i = 0; i < 4; ++i) *(float4*)(xres + (size_t)row * 1024 + i * 256 + lane * 4) = xv4[i];
    }
    float hv[16];
#pragma unroll
    for (int i = 0; i < 4; ++i) { float4 gg = *(const float4*)(g + i * 256 + lane * 4);
      hv[i * 4 + 0] = xv4[i].x * rstd * gg.x; hv[i * 4 + 1] = xv4[i].y * rstd * gg.y; hv[i * 4 + 2] = xv4[i].z * rstd * gg.z; hv[i * 4 + 3] = xv4[i].w * rstd * gg.w; }
#pragma unroll
    for (int i = 0; i < 4; ++i) *(uint2*)(h + (size_t)row * 1024 + i * 256 + lane * 4) = make_uint2(pack2(hv[i * 4], hv[i * 4 + 1]), pack2(hv[i * 4 + 2], hv[i * 4 + 3]));
    if constexpr (TYPE == 0) {
      const bool is_p = row < MPR; const int tt = is_p ? row : ((row - MPR) & 63); const int b = is_p ? 0 : ((row - MPR) >> 6);
      float hp[16];
      if (tt == 0) {
        if (is_p) {
#pragma unroll
          for (int i = 0; i < 16; ++i) hp[i] = 0.f;
        } else {
          const float* sp = PIN(2) + ((size_t)j * NSS + b) * 1024;
#pragma unroll
          for (int i = 0; i < 4; ++i) { float4 v = *(const float4*)(sp + i * 256 + lane * 4); hp[i * 4] = v.x; hp[i * 4 + 1] = v.y; hp[i * 4 + 2] = v.z; hp[i * 4 + 3] = v.w; }
        }
      } else {
        const float* pp = src(row - 1); float4 pv[4]; float s2 = 0.f;
#pragma unroll
        for (int i = 0; i < 4; ++i) { pv[i] = *(const float4*)(pp + i * 256 + lane * 4); s2 += pv[i].x * pv[i].x + pv[i].y * pv[i].y + pv[i].z * pv[i].z + pv[i].w * pv[i].w; }
        s2 = wsum(s2); const float r2 = rsqrtf(s2 * (1.f / 1024.f) + 1e-6f);
#pragma unroll
        for (int i = 0; i < 4; ++i) { float4 gg = *(const float4*)(g + i * 256 + lane * 4);
          hp[i * 4] = pv[i].x * r2 * gg.x; hp[i * 4 + 1] = pv[i].y * r2 * gg.y; hp[i * 4 + 2] = pv[i].z * r2 * gg.z; hp[i * 4 + 3] = pv[i].w * r2 * gg.w; }
      }
#pragma unroll
      for (int i = 0; i < 4; ++i) {
        const int col = i * 256 + lane * 4; const size_t o = (size_t)row * 1024 + col;
        float4 m0 = *(const float4*)(mu + 0 * 1024 + col), m2 = *(const float4*)(mu + 2 * 1024 + col), m3 = *(const float4*)(mu + 3 * 1024 + col);
        const float mm0[4] = {m0.x, m0.y, m0.z, m0.w}, mm2[4] = {m2.x, m2.y, m2.z, m2.w}, mm3[4] = {m3.x, m3.y, m3.z, m3.w};
        float a[4], bb[4], c[4];
#pragma unroll
        for (int e = 0; e < 4; ++e) { float hh = hv[i * 4 + e], xx = hp[i * 4 + e] - hh; a[e] = hh + xx * mm0[e]; bb[e] = hh + xx * mm2[e]; c[e] = hh + xx * mm3[e]; }
        *(uint2*)(hs + o) = make_uint2(pack2(hp[i * 4], hp[i * 4 + 1]), pack2(hp[i * 4 + 2], hp[i * 4 + 3]));
        *(uint2*)(xr + o) = make_uint2(pack2(a[0], a[1]), pack2(a[2], a[3]));
        *(uint2*)(xk + o) = make_uint2(pack2(bb[0], bb[1]), pack2(bb[2], bb[3]));
        *(uint2*)(xv + o) = make_uint2(pack2(c[0], c[1]), pack2(c[2], c[3]));
      }
      if (is_p ? (row == MPR - 1) : (tt == 63)) {
        float* o = POUT + (is_p ? O_ASH_P + (size_t)j * 1024 : O_ASH_S + ((size_t)j * NSS + b) * 1024);
#pragma unroll
        for (int i = 0; i < 4; ++i) *(float4*)(o + i * 256 + lane * 4) = make_float4(hv[i * 4], hv[i * 4 + 1], hv[i * 4 + 2], hv[i * 4 + 3]);
      }
    }
  }
}

DEVI void phase_rms(const float* x, const float* g, bf16* dst, float* fdst) {
  const int lane = threadIdx.x & 63, wave = threadIdx.x >> 6;
  const int nw = gridDim.x * 4;
  for (int row = blockIdx.x * 4 + wave; row < MT; row += 2 * nw) {
    const int row2 = row + nw; const bool has2 = row2 < MT;
    float4 v[4], v2[4]; float ss = 0.f, ss2 = 0.f;
#pragma unroll
    for (int i = 0; i < 4; ++i) v[i] = *(const float4*)(x + (size_t)row * 1024 + i * 256 + lane * 4);
    if (has2) {
#pragma unroll
      for (int i = 0; i < 4; ++i) v2[i] = *(const float4*)(x + (size_t)row2 * 1024 + i * 256 + lane * 4);
    } else {
#pragma unroll
      for (int i = 0; i < 4; ++i) v2[i] = make_float4(0.f, 0.f, 0.f, 0.f);
    }
#pragma unroll
    for (int i = 0; i < 4; ++i) { ss += v[i].x * v[i].x + v[i].y * v[i].y + v[i].z * v[i].z + v[i].w * v[i].w; ss2 += v2[i].x * v2[i].x + v2[i].y * v2[i].y + v2[i].z * v2[i].z + v2[i].w * v2[i].w; }
    ss = wsum(ss); ss2 = wsum(ss2);
    const float r = rsqrtf(ss * (1.f / 1024.f) + 1e-6f), r2 = rsqrtf(ss2 * (1.f / 1024.f) + 1e-6f);
#pragma unroll
    for (int i = 0; i < 4; ++i) { float4 gg = *(const float4*)(g + i * 256 + lane * 4);
      { float a = v[i].x * r * gg.x, b = v[i].y * r * gg.y, c = v[i].z * r * gg.z, d = v[i].w * r * gg.w;
        if (dst) *(uint2*)(dst + (size_t)row * 1024 + i * 256 + lane * 4) = make_uint2(pack2(a, b), pack2(c, d));
        else *(float4*)(fdst + (size_t)row * 1024 + i * 256 + lane * 4) = make_float4(a, b, c, d); }
      if (has2) { float a = v2[i].x * r2 * gg.x, b = v2[i].y * r2 * gg.y, c = v2[i].z * r2 * gg.z, d = v2[i].w * r2 * gg.w;
        if (dst) *(uint2*)(dst + (size_t)row2 * 1024 + i * 256 + lane * 4) = make_uint2(pack2(a, b), pack2(c, d));
        else *(float4*)(fdst + (size_t)row2 * 1024 + i * 256 + lane * 4) = make_float4(a, b, c, d); }
    }
  }
}

DEVI void phase_gdn_conv(const P& p) {
  const bf16* qkv = slot(p, 1); const float* cw = PIN(35); const float* cst = PIN(5);
  const int tid = threadIdx.x;
  for (int item = blockIdx.x; item < (MT / 8) * 3; item += gridDim.x) {
    const int row0 = (item / 3) * 8, sec = item % 3, ch = sec * 1024 + tid * 4;
    const bool is_p = row0 < MPR; const int tt0 = is_p ? row0 : ((row0 - MPR) & 63); const int b = is_p ? 0 : ((row0 - MPR) >> 6);
    float x[11][4];
#pragma unroll
    for (int i = 0; i < 11; ++i) {
      const int pt = tt0 + i;
      if (pt >= 3) { uint2 u = *(const uint2*)(qkv + (size_t)(row0 + i - 3) * 3072 + ch);
        x[i][0] = bf2f(u.x & 0xffff); x[i][1] = bf2f(u.x >> 16); x[i][2] = bf2f(u.y & 0xffff); x[i][3] = bf2f(u.y >> 16); }
      else if (!is_p) { float4 s = *(const float4*)(cst + ((size_t)b * 3 + pt) * 3072 + ch); x[i][0] = s.x; x[i][1] = s.y; x[i][2] = s.z; x[i][3] = s.w; }
      else { x[i][0] = x[i][1] = x[i][2] = x[i][3] = 0.f; }
    }
    float w[4][4];
#pragma unroll
    for (int i = 0; i < 4; ++i) { float4 ww = *(const float4*)(cw + i * 3072 + ch); w[i][0] = ww.x; w[i][1] = ww.y; w[i][2] = ww.z; w[i][3] = ww.w; }
#pragma unroll
    for (int o = 0; o < 8; ++o) {
      float acc[4];
#pragma unroll
      for (int e = 0; e < 4; ++e) { acc[e] = x[o][e] * w[0][e] + x[o + 1][e] * w[1][e] + x[o + 2][e] * w[2][e] + x[o + 3][e] * w[3][e]; acc[e] = silu(acc[e]); }
      if (sec < 2) {
        float ss = acc[0] * acc[0] + acc[1] * acc[1] + acc[2] * acc[2] + acc[3] * acc[3];
#pragma unroll
        for (int sft = 16; sft > 0; sft >>= 1) ss += __shfl_xor(ss, sft);
        const float r = rsqrtf(ss + 1e-6f) * (sec == 0 ? 0.08838834764831845f : 1.f);
#pragma unroll
        for (int e = 0; e < 4; ++e) acc[e] *= r;
      }
      *(uint2*)(slot(p, 5 + sec) + (size_t)(row0 + o) * 1024 + tid * 4) = make_uint2(pack2(acc[0], acc[1]), pack2(acc[2], acc[3]));
    }
  }
}

DEVI void mm_strip(const bf16* At, const bf16* Bt, f32x4 (&acc)[4], int wave, int lane) {
  const int lr = lane & 15, quad = lane >> 4;
#pragma unroll
  for (int ks = 0; ks < 2; ++ks) {
    bf16x8 a = *(const bf16x8*)(At + (wave * 16 + lr) * 72 + ks * 32 + quad * 8);
#pragma unroll
    for (int nb = 0; nb < 4; ++nb) {
      bf16x8 b = *(const bf16x8*)(Bt + (nb * 16 + lr) * 72 + ks * 32 + quad * 8);
      acc[nb] = __builtin_amdgcn_mfma_f32_16x16x32_bf16(a, b, acc[nb], 0, 0, 0);
    }
  }
}
DEVI void zero4(f32x4 (&a)[4]) {
#pragma unroll
  for (int i = 0; i < 4; ++i) a[i] = (f32x4){0.f, 0.f, 0.f, 0.f};
}

template <int CW> DEVI size_t cont_off(int r, int s, int LD) { const int idx = r * 64 + s; return (size_t)(idx / CW) * LD + (idx % CW); }

template <int TYPE>
DEVI void phase_prep(const P& p, int j, char* smem) {
  constexpr int NH = TYPE == 0 ? 16 : (TYPE == 1 ? 4 : 8);
  constexpr int DK = TYPE == 0 ? 64 : 128;
  constexpr int DV = TYPE == 0 ? 64 : (TYPE == 1 ? 256 : 128);
  constexpr bool LOW = TYPE != 1;
  constexpr int KT = 256 / DK, TPT = 64 / KT, DKH = DK / 64, DVH = DV / 64;
  constexpr int LDQ = TYPE == 1 ? 512 : 1024;
  bf16* X0 = (bf16*)smem; bf16* X1 = X0 + 4608; bf16* Y0 = X1 + 4608; bf16* Y1 = Y0 + 4608;
  float* Lb = (float*)smem;
  bf16* LkT = (bf16*)(smem + 16384); bf16* Ak = LkT + 4608; bf16* nAb = Ak + 4608;
  bf16* M1 = (bf16*)smem;
  bf16* Tt = (bf16*)(smem + 44032); bf16* St1 = Tt + 4608; bf16* St2 = St1 + 4608;
  if (TYPE == 1) { Y0 = (bf16*)(smem + 9216); Ak = (bf16*)(smem + 18432); St1 = (bf16*)(smem + 27648); }
  float* lgL = (float*)(smem + 36864);
  float* tot = (float*)(smem + 71680);
  float* sc_beta = (float*)(smem + 73728);
  float* sc_eg = sc_beta + 64; float* sc_lg = sc_eg + 64; float* sc_g = sc_lg + 64;

  bf16 *Aq, *Akk, *Av, *Ald = nullptr, *Aa = nullptr, *Oq, *Okt, *Ovt, *Ow = nullptr, *Obt = nullptr, *Ool, *Ou0 = nullptr;
  if (TYPE == 0) { Aq = slot(p, 5); Akk = slot(p, 6); Av = slot(p, 7); Ald = slot(p, 2); Aa = slot(p, 3);
    Oq = Aq; Okt = Akk; Ovt = Av; Ow = Ald; Obt = Aa; Ool = slot(p, 0); Ou0 = slot(p, 1); }
  else if (TYPE == 1) { Aq = slot(p, 1); Akk = slot(p, 1) + (size_t)MT * 512; Av = slot(p, 2); Oq = Aq; Okt = Akk; Ovt = Av; Ool = slot(p, 4); }
  else { Aq = slot(p, 5); Akk = slot(p, 6); Av = slot(p, 7); Oq = Aq; Okt = Akk; Ovt = Av; Ow = slot(p, 1); Obt = slot(p, 2); Ool = slot(p, 3); Ou0 = slot(p, 0); }
  float* sm = (float*)(PWS + WS_SM);
  float* gam = (float*)(PWS + WS_GAM);

  for (int item = blockIdx.x; item < NCHUNK * NH; item += gridDim.x) {
    const int c = item / NH, h = item % NH;
    const size_t rb = (size_t)c * 64;
    int tid = threadIdx.x; asm volatile("" : "+v"(tid));
    const int lane = tid & 63, wave = tid >> 6, lr = lane & 15, quad = lane >> 4;
    const int k = tid % DK, tg = tid / DK;
    const int vv = tid & 63, tgv = tid >> 6;
    unsigned qP[TPT / 2], ktP[TPT / 2], kapP[(TYPE == 0) ? TPT / 2 : 1], bvP[(TYPE == 0) ? TPT / 2 : 1];
    float lg[(TYPE == 0) ? TPT : 1], ldv[(TYPE == 0) ? TPT : 1];
    unsigned vP[DVH][8];
    auto lo16 = [](unsigned w) { return __uint_as_float(w << 16); };
    auto hi16 = [](unsigned w) { return __uint_as_float(w & 0xffff0000u); };
#define GETP(arr, e) (((e) & 1) ? hi16(arr[(e) >> 1]) : lo16(arr[(e) >> 1]))
#pragma unroll
    for (int vh = 0; vh < DVH; ++vh) {
      bf16 va[16];
#pragma unroll
      for (int e = 0; e < 16; ++e) va[e] = Av[(rb + tgv * 16 + e) * 1024 + h * DV + vh * 64 + vv];
#pragma unroll
      for (int e = 0; e < 8; ++e) { vP[vh][e] = (unsigned)va[2 * e] | ((unsigned)va[2 * e + 1] << 16); asm volatile("" : "+v"(vP[vh][e])); }
    }
    if constexpr (TYPE == 2) {
      if (tid < 64) {
        const float a_log = PIN(36)[h], dtb = PIN(37)[h];
        const float braw = sm[(rb + tid) * 16 + h], araw = sm[(rb + tid) * 16 + 8 + h];
        const float gt = -__expf(a_log) * softplus(araw + dtb);
        sc_beta[tid] = sigm(braw); sc_eg[tid] = __expf(gt); sc_g[tid] = gt;
        float cs = gt;
#pragma unroll
        for (int o = 1; o < 64; o <<= 1) { float n = __shfl_up(cs, o); if (lane >= o) cs += n; }
        sc_lg[tid] = cs;
      }
      __syncthreads();
    }
    if constexpr (TYPE == 0) {
      const float k_k = PIN(21)[j * 1024 + h * 64 + k], k_a = PIN(22)[j * 1024 + h * 64 + k], r_k = PIN(23)[j * 1024 + h * 64 + k];
      float run = 0.f;
      bf16 rr[TPT], rk[TPT], ra[TPT], rl[TPT];
#pragma unroll
      for (int e = 0; e < TPT; ++e) {
        const size_t o = (rb + tg * TPT + e) * 1024 + h * 64 + k;
        rr[e] = Aq[o]; rk[e] = Akk[o]; ra[e] = Aa[o]; rl[e] = Ald[o];
      }
#pragma unroll
      for (int e2 = 0; e2 < TPT / 2; ++e2) {
        float qq[2], ka[2], kq[2], bq[2];
#pragma unroll
        for (int u = 0; u < 2; ++u) {
          const int e = e2 * 2 + u;
          const float r = bf2f(rr[e]), kr = bf2f(rk[e]), av = bf2f(ra[e]), l = bf2f(rl[e]);
          const float kk = kr * k_k;
          const float inv = rsqrtf(fmaxf(wsum(kk * kk), 1e-24f));
          qq[u] = r; ka[u] = kk * inv; kq[u] = kr * (1.f + (av - 1.f) * k_a); bq[u] = ka[u] * av; ldv[e] = l;
          const float bo = wsum(r * kq[u] * r_k);
          if (lane == 0) sm[(rb + tg * TPT + e) * 16 + h] = bo;
          run += l; lg[e] = run;
        }
        qP[e2] = pack2(qq[0], qq[1]); kapP[e2] = pack2(ka[0], ka[1]); ktP[e2] = pack2(kq[0], kq[1]); bvP[e2] = pack2(bq[0], bq[1]);
        asm volatile("" : "+v"(qP[e2]), "+v"(kapP[e2]), "+v"(ktP[e2]), "+v"(bvP[e2]));
      }
      tot[tg * 128 + k] = run;
    } else if constexpr (TYPE == 1) {
      float w2[16];
#pragma unroll
      for (int i = 0; i < 16; ++i) w2[i] = PIN(30)[i * 512 + h * 128 + k];
      const float ba = PIN(31)[h * 128 + k];
      float* a1s = (float*)(smem + 69632);
      (void)a1s;
      bf16 rq[TPT], rk[TPT];
#pragma unroll
      for (int e = 0; e < TPT; ++e) { const size_t row = rb + tg * TPT + e; rq[e] = Aq[row * 512 + h * 128 + k]; rk[e] = Akk[row * 512 + h * 128 + k]; }
      float4 ar[TPT][4];
      float run = 0.f;
#pragma unroll
      for (int e = 0; e < TPT; e += 4) {
#pragma unroll
        for (int u = 0; u < 4; ++u)
#pragma unroll
          for (int q4 = 0; q4 < 4; ++q4) ar[e + u][q4] = *(const float4*)(sm + (rb + tg * TPT + e + u) * 16 + q4 * 4);
#pragma unroll
        for (int u = 0; u < 4; ++u) {
          float s = ba;
#pragma unroll
          for (int q4 = 0; q4 < 4; ++q4) { const float4 a4 = ar[e + u][q4]; s += a4.x * w2[q4 * 4] + a4.y * w2[q4 * 4 + 1] + a4.z * w2[q4 * 4 + 2] + a4.w * w2[q4 * 4 + 3]; }
          const float gk = (fminf(s, 0.f) - log1pf(__expf(-fabsf(s)))) * (1.f / 16.f);
          run += gk; lgL[(tg * TPT + e + u) * 128 + k] = run;
        }
      }
#pragma unroll
      for (int e2 = 0; e2 < TPT / 2; ++e2) {
        qP[e2] = (unsigned)rq[2 * e2] | ((unsigned)rq[2 * e2 + 1] << 16);
        ktP[e2] = (unsigned)rk[2 * e2] | ((unsigned)rk[2 * e2 + 1] << 16);
        asm volatile("" : "+v"(qP[e2]), "+v"(ktP[e2]));
      }
      tot[tg * 128 + k] = run;
    } else {
      bf16 rq[TPT], rk[TPT];
#pragma unroll
      for (int e = 0; e < TPT; ++e) { const size_t o = (rb + tg * TPT + e) * 1024 + h * 128 + k; rq[e] = Aq[o]; rk[e] = Akk[o]; }
#pragma unroll
      for (int e2 = 0; e2 < TPT / 2; ++e2) {
        qP[e2] = (unsigned)rq[2 * e2] | ((unsigned)rq[2 * e2 + 1] << 16);
        ktP[e2] = (unsigned)rk[2 * e2] | ((unsigned)rk[2 * e2 + 1] << 16);
        asm volatile("" : "+v"(qP[e2]), "+v"(ktP[e2]));
      }
    }
    __syncthreads();
    float lgC;
    if constexpr (TYPE == 2) { lgC = sc_lg[63]; }
    else {
      float off = 0.f, all = 0.f;
#pragma unroll
      for (int g2 = 0; g2 < KT; ++g2) { const float tv = tot[g2 * 128 + k]; all += tv; if (g2 < tg) off += tv; }
      if constexpr (TYPE == 0) {
#pragma unroll
        for (int e = 0; e < TPT; ++e) lg[e] += off;
      } else {
#pragma unroll
        for (int e = 0; e < TPT; ++e) lgL[(tg * TPT + e) * 128 + k] += off;
      }
      lgC = all;
    }
#define QV(e) GETP(qP, e)
#define LGV(e, t) ((TYPE == 2) ? sc_lg[t] : ((TYPE == 1) ? lgL[(t) * 128 + k] : lg[(TYPE == 0) ? (e) : 0]))
#define LPREV(e, t) ((TYPE == 0) ? (lg[(TYPE == 0) ? (e) : 0] - ldv[(TYPE == 0) ? (e) : 0]) : (sc_lg[t] - sc_g[t]))
#define KTV(e, t) ((TYPE == 2) ? (sc_beta[t] * GETP(ktP, e)) : GETP(ktP, e))
#define KAPV(e, t) ((TYPE == 2) ? GETP(ktP, e) : GETP(kapP, (TYPE == 0) ? (e) : 0))
#define BVV(e, t) ((TYPE == 2) ? (sc_beta[t] * sc_eg[t] * GETP(ktP, e)) : GETP(bvP, (TYPE == 0) ? (e) : 0))
    f32x4 sacc[LOW ? 4 : 1][4];
#pragma unroll
    for (int a = 0; a < (LOW ? 4 : 1); ++a) zero4(sacc[a]);
#pragma unroll
    for (int kh = 0; kh < DKH; ++kh) {
      if (k / 64 == kh) {
        const int kk = k & 63;
#pragma unroll
        for (int e = 0; e < TPT; ++e) {
          const int t = tg * TPT + e;
          if constexpr (TYPE == 2) {
            X0[t * 72 + kk] = f2bf(QV(e)); Y0[t * 72 + kk] = f2bf(KTV(e, t));
            X1[t * 72 + kk] = f2bf(KAPV(e, t)); Y1[t * 72 + kk] = f2bf(BVV(e, t));
          } else {
            const float lgt = LGV(e, t);
            const float el = __expf(lgt), eml = __expf(-lgt);
            X0[t * 72 + kk] = f2bf(QV(e) * el);
            Y0[t * 72 + kk] = f2bf(KTV(e, t) * eml);
            if constexpr (LOW) {
              X1[t * 72 + kk] = f2bf(KAPV(e, t) * __expf(LPREV(e, t)));
              Y1[t * 72 + kk] = f2bf(BVV(e, t) * eml);
            }
          }
        }
      }
      __syncthreads();
      mm_strip(X0, Y0, sacc[0], wave, lane);
      if constexpr (LOW) { mm_strip(X0, Y1, sacc[1], wave, lane); mm_strip(X1, Y0, sacc[2], wave, lane); mm_strip(X1, Y1, sacc[3], wave, lane); }
      __syncthreads();
    }
#pragma unroll
    for (int nb = 0; nb < 4; ++nb)
#pragma unroll
      for (int jj = 0; jj < 4; ++jj) {
        const int t = wave * 16 + quad * 4 + jj, s = nb * 16 + lr;
        float da = 1.f, dl = 1.f;
        if constexpr (TYPE == 2) { const float dd = sc_lg[t] - sc_lg[s]; da = __expf(fminf(dd, 0.f)); dl = __expf(fminf(dd - sc_g[t], 0.f)); }
        Ak[t * 72 + s] = f2bf(s <= t ? sacc[0][nb][jj] * da : 0.f);
        if constexpr (LOW) {
          nAb[t * 72 + s] = f2bf(s <= t ? -sacc[1][nb][jj] * da : 0.f);
          LkT[s * 72 + t] = f2bf(s < t ? sacc[2][nb][jj] * dl : 0.f);
          Lb[t * 64 + (s & 3) * 16 + (s >> 2)] = s < t ? sacc[3][nb][jj] * dl : 0.f;
        }
      }
    __syncthreads();
    f32x4 acc[4];
    if constexpr (LOW) {
      {
        const int q = lane & 3, jc = wave * 16 + (lane >> 2);
        float xr[16];
#pragma unroll
        for (int i = 0; i < 16; ++i) xr[i] = 0.f;
#pragma unroll
        for (int t = 0; t < 64; ++t) {
          float s = 0.f, s2 = 0.f;
          const float* Lr = Lb + t * 64 + q * 16;
#pragma unroll
          for (int i = 0; i < (t + 3) / 4; ++i) { if (i & 1) s2 += Lr[i] * xr[i]; else s += Lr[i] * xr[i]; }
          s += s2;
          s += __shfl_xor(s, 1); s += __shfl_xor(s, 2);
          s = ((t == jc) ? 1.f : 0.f) - s;
          xr[t >> 2] = (q == (t & 3)) ? s : xr[t >> 2];
          if (q == 0) Tt[t * 72 + jc] = f2bf(s);
        }
      }
      __syncthreads();
      zero4(acc); mm_strip(Tt, LkT, acc, wave, lane);
#pragma unroll
      for (int nb = 0; nb < 4; ++nb)
#pragma unroll
        for (int jj = 0; jj < 4; ++jj) M1[(wave * 16 + quad * 4 + jj) * 72 + nb * 16 + lr] = f2bf(acc[nb][jj]);
      __syncthreads();
    }
#pragma unroll
    for (int vh = 0; vh < DVH; ++vh) {
#pragma unroll
      for (int e = 0; e < 8; ++e) *(unsigned*)(St1 + vv * 72 + tgv * 16 + 2 * e) = vP[vh][e];
      __syncthreads();
      if constexpr (LOW) {
        zero4(acc); mm_strip(M1, St1, acc, wave, lane);
#pragma unroll
        for (int nb = 0; nb < 4; ++nb)
#pragma unroll
          for (int jj = 0; jj < 4; ++jj) {
            const int t = wave * 16 + quad * 4 + jj, col = nb * 16 + lr; const bf16 u = f2bf(acc[nb][jj]);
            St2[col * 72 + t] = u;
          }
#pragma unroll
        for (int nb = 0; nb < 4; ++nb)
          *(uint2*)(Ou0 + (((((size_t)c * NH + h) * (DV / 16) + vh * 4 + nb) * 4 + wave) * 64 + lane) * 4) = make_uint2(pack2(acc[nb][0], acc[nb][1]), pack2(acc[nb][2], acc[nb][3]));
        __syncthreads();
      }
      zero4(acc); mm_strip(Ak, St1, acc, wave, lane);
      if constexpr (LOW) mm_strip(nAb, St2, acc, wave, lane);
#pragma unroll
      for (int nb = 0; nb < 4; ++nb)
        *(uint2*)(Ool + (((((size_t)c * NH + h) * (DV / 16) + vh * 4 + nb) * 4 + wave) * 64 + lane) * 4) = make_uint2(pack2(acc[nb][0], acc[nb][1]), pack2(acc[nb][2], acc[nb][3]));
      __syncthreads();
    }
    if constexpr (LOW) {
#pragma unroll
      for (int kh = 0; kh < DKH; ++kh) {
        if (k / 64 == kh) {
          const int kk = k & 63;
#pragma unroll
          for (int e = 0; e < TPT; ++e) {
            const int t = tg * TPT + e;
            St1[kk * 72 + t] = f2bf(KAPV(e, t) * __expf(LPREV(e, t)));
            LkT[t * 72 + kk] = f2bf(QV(e) * __expf(LGV(e, t)));
            }
        }
        __syncthreads();
        zero4(acc); mm_strip(Tt, St1, acc, wave, lane);
#pragma unroll
        for (int nb = 0; nb < 4; ++nb)
#pragma unroll
          for (int jj = 0; jj < 4; ++jj) {
            const int t = wave * 16 + quad * 4 + jj, col = nb * 16 + lr; const bf16 u = f2bf(acc[nb][jj]);
            St2[col * 72 + t] = u;
            Ow[(rb + t) * 1024 + h * DK + kh * 64 + col] = u;
          }
        __syncthreads();
        zero4(acc); mm_strip(nAb, St2, acc, wave, lane);
#pragma unroll
        for (int nb = 0; nb < 4; ++nb)
#pragma unroll
          for (int jj = 0; jj < 4; ++jj) {
            const int t = wave * 16 + quad * 4 + jj, col = nb * 16 + lr;
            Oq[(rb + t) * LDQ + h * DK + kh * 64 + col] = f2bf(acc[nb][jj] + bf2f(LkT[t * 72 + col]));
          }
        __syncthreads();
      }
    } else {
#pragma unroll
      for (int e = 0; e < TPT; ++e) { Oq[(rb + tg * TPT + e) * LDQ + h * DK + k] = f2bf(QV(e) * __expf(LGV(e, tg * TPT + e))); }
    }
    {
      unsigned wk[TPT / 2], wb[LOW ? TPT / 2 : 1];
#pragma unroll
      for (int e = 0; e < TPT; e += 2) {
        const int t0 = tg * TPT + e;
        const float d0 = __expf(lgC - LGV(e, t0)), d1 = __expf(lgC - LGV(e + 1, t0 + 1));
        wk[e / 2] = pack2(KTV(e, t0) * d0, KTV(e + 1, t0 + 1) * d1);
        if constexpr (LOW) wb[e / 2] = pack2(BVV(e, t0) * d0, BVV(e + 1, t0 + 1) * d1);
      }
      const size_t co = rb * LDQ + h * DK + cont_off<DK>(k, tg * TPT, LDQ);
#pragma unroll
      for (int e = 0; e < TPT / 8; ++e) {
        *(uint4*)(Okt + co + e * 8) = make_uint4(wk[e * 4], wk[e * 4 + 1], wk[e * 4 + 2], wk[e * 4 + 3]);
        if constexpr (LOW) *(uint4*)(Obt + co + e * 8) = make_uint4(wb[e * 4], wb[e * 4 + 1], wb[e * 4 + 2], wb[e * 4 + 3]);
      }
#pragma unroll
      for (int vh = 0; vh < DVH; ++vh) {
        const unsigned* wv = vP[vh];
        const size_t vo = rb * 1024 + h * DV + cont_off<DV>(vh * 64 + vv, tgv * 16, 1024);
        *(uint4*)(Ovt + vo) = make_uint4(wv[0], wv[1], wv[2], wv[3]);
        *(uint4*)(Ovt + vo + 8) = make_uint4(wv[4], wv[5], wv[6], wv[7]);
      }
      if (tg == 0) gam[((size_t)c * NH + h) * DK + k] = __expf(lgC);
    }
    __syncthreads();
  }
}

template <int TYPE>
DEVI void phase_seq(const P& p, int j) {
  constexpr int NH = TYPE == 0 ? 16 : (TYPE == 1 ? 4 : 8);
  constexpr int DK = TYPE == 0 ? 64 : 128;
  constexpr int DV = TYPE == 0 ? 64 : (TYPE == 1 ? 256 : 128);
  constexpr bool LOW = TYPE != 1;
  constexpr int NVB = DV / 16, MB = DK / 16, KS = DK / 32;
  constexpr int LDQ = TYPE == 1 ? 512 : 1024;
  constexpr int IPS = NH * NVB;
  const int lane = threadIdx.x & 63, wave = threadIdx.x >> 6, lr = lane & 15, quad = lane >> 4;
  const bf16 *Qp, *Kt, *Vt, *Wp = nullptr, *Bt = nullptr, *U0 = nullptr; bf16* Ol;
  if (TYPE == 0) { Qp = slot(p, 5); Kt = slot(p, 6); Vt = slot(p, 7); Wp = slot(p, 2); Bt = slot(p, 3); Ol = slot(p, 0); U0 = slot(p, 1); }
  else if (TYPE == 1) { Qp = slot(p, 1); Kt = slot(p, 1) + (size_t)MT * 512; Vt = slot(p, 2); Ol = slot(p, 4); }
  else { Qp = slot(p, 5); Kt = slot(p, 6); Vt = slot(p, 7); Wp = slot(p, 1); Bt = slot(p, 2); Ol = slot(p, 3); U0 = slot(p, 0); }
  const float* gam = (const float*)(PWS + WS_GAM);
  const int nitems = 33 * IPS;
  for (int item = wave * gridDim.x + blockIdx.x; item < nitems; item += gridDim.x * 4) {
    const int seq = item / IPS, rem = item % IPS, h = rem / NVB, vb = rem % NVB;
    const int c0 = seq == 0 ? 0 : NPCH + seq - 1, nc = seq == 0 ? NPCH : 1;
    const int vcol = vb * 16 + lr;
    f32x4 H[MB];
    if (seq == 0) {
#pragma unroll
      for (int m = 0; m < MB; ++m) H[m] = (f32x4){0.f, 0.f, 0.f, 0.f};
    } else {
      const int b = seq - 1;
      if (TYPE == 0) {
        const float* S = PIN(3) + (((size_t)j * NSS + b) * 16 + h) * 4096 + (size_t)vcol * 64;
#pragma unroll
        for (int m = 0; m < MB; ++m) { float4 v = *(const float4*)(S + m * 16 + quad * 4); H[m] = (f32x4){v.x, v.y, v.z, v.w}; }
      } else {
        const float* S = PIN(TYPE == 1 ? 4 : 6) + ((size_t)b * NH + h) * DK * DV + vcol;
#pragma unroll
        for (int m = 0; m < MB; ++m)
#pragma unroll
          for (int jj = 0; jj < 4; ++jj) H[m][jj] = S[(size_t)(m * 16 + quad * 4 + jj) * DV];
      }
    }
    unsigned tsink = 0;
    for (int c = c0; c < c0 + nc; ++c) {
      const size_t rb = (size_t)c * 64;
      int ln = threadIdx.x & 63; asm volatile("" : "+v"(ln));
      const int lr = ln & 15, quad = ln >> 4, vcol = vb * 16 + lr;
      const bf16* qb = Qp + rb * LDQ + h * DK;
      const bf16* wb = LOW ? Wp + rb * 1024 + h * DK : nullptr;
      const bf16* kb = Kt + rb * LDQ + h * DK;
      const bf16* bb = LOW ? Bt + rb * 1024 + h * DK : nullptr;
      const bf16* vtb = Vt + rb * 1024 + h * DV;
      const size_t fo = ((((size_t)c * NH + h) * NVB + vb) * 4) * 256 + ln * 4;
      const float* gp = gam + ((size_t)c * NH + h) * DK + quad * 4;
      bf16x8 hb[KS];
#pragma unroll
      for (int ks = 0; ks < KS; ++ks) {
        const u32x4 hw = {pack2(H[2 * ks][0], H[2 * ks][1]), pack2(H[2 * ks][2], H[2 * ks][3]), pack2(H[2 * ks + 1][0], H[2 * ks + 1][1]), pack2(H[2 * ks + 1][2], H[2 * ks + 1][3])};
        hb[ks] = __builtin_bit_cast(bf16x8, hw);
      }
      uint2 oin[4], uin[4]; bf16x8 qa[4][KS], wa[LOW ? 4 : 1][KS];
      bf16x8 vbop[2], kfr[MB][2], bfr[LOW ? MB : 1][2]; float4 gv[MB];
#define LOAD_A(tb) do { oin[tb] = *(const uint2*)(Ol + fo + (tb) * 256); if constexpr (LOW) uin[tb] = *(const uint2*)(U0 + fo + (tb) * 256); \
        _Pragma("unroll") for (int ks = 0; ks < KS; ++ks) { const int off_ = ((tb) * 16 + lr) * LDQ + ks * 32 + quad * 4; \
          bf16x4 lo_ = *(const bf16x4*)(qb + off_), hi_ = *(const bf16x4*)(qb + off_ + 16); qa[tb][ks] = __builtin_shufflevector(lo_, hi_, 0, 1, 2, 3, 4, 5, 6, 7); \
          if constexpr (LOW) { const int ow_ = ((tb) * 16 + lr) * 1024 + ks * 32 + quad * 4; bf16x4 wl_ = *(const bf16x4*)(wb + ow_), wh_ = *(const bf16x4*)(wb + ow_ + 16); \
            wa[tb][ks] = __builtin_shufflevector(wl_, wh_, 0, 1, 2, 3, 4, 5, 6, 7); } } } while (0)
#define COMP_A(tb) do { f32x4 o_, u_; \
        o_ = (f32x4){bf2f(oin[tb].x & 0xffff), bf2f(oin[tb].x >> 16), bf2f(oin[tb].y & 0xffff), bf2f(oin[tb].y >> 16)}; \
        if constexpr (LOW) u_ = (f32x4){bf2f(uin[tb].x & 0xffff), bf2f(uin[tb].x >> 16), bf2f(uin[tb].y & 0xffff), bf2f(uin[tb].y >> 16)}; \
        _Pragma("unroll") for (int ks = 0; ks < KS; ++ks) { o_ = __builtin_amdgcn_mfma_f32_16x16x32_bf16(qa[tb][ks], hb[ks], o_, 0, 0, 0); \
          if constexpr (LOW) u_ = __builtin_amdgcn_mfma_f32_16x16x32_bf16(wa[tb][ks], hb[ks], u_, 0, 0, 0); } \
        *(uint2*)(Ol + fo + (tb) * 256) = make_uint2(pack2(o_[0], o_[1]), pack2(o_[2], o_[3])); \
        if constexpr (LOW) U[tb] = u_; } while (0)
#define LOAD_B(m) do { gv[m] = *(const float4*)(gp + (m) * 16); const int krow_ = (m) * 16 + lr; \
        _Pragma("unroll") for (int ks = 0; ks < 2; ++ks) { kfr[m][ks] = *(const bf16x8*)(kb + cont_off<DK>(krow_, ks * 32 + quad * 8, LDQ)); \
          if constexpr (LOW) { bf16x4 lo_ = *(const bf16x4*)(bb + cont_off<DK>(krow_, ks * 32 + quad * 4, 1024)); \
            bf16x4 hi_ = *(const bf16x4*)(bb + cont_off<DK>(krow_, ks * 32 + 16 + quad * 4, 1024)); bfr[m][ks] = __builtin_shufflevector(lo_, hi_, 0, 1, 2, 3, 4, 5, 6, 7); } } } while (0)
#define COMP_B(m) do { f32x4 hn_ = (f32x4){H[m][0] * gv[m].x, H[m][1] * gv[m].y, H[m][2] * gv[m].z, H[m][3] * gv[m].w}; \
        _Pragma("unroll") for (int ks = 0; ks < 2; ++ks) { hn_ = __builtin_amdgcn_mfma_f32_16x16x32_bf16(kfr[m][ks], vbop[ks], hn_, 0, 0, 0); \
          if constexpr (LOW) hn_ = __builtin_amdgcn_mfma_f32_16x16x32_bf16(bfr[m][ks], ubop[ks], hn_, 0, 0, 0); } \
        H[m] = hn_; } while (0)
      f32x4 U[4];
      constexpr int PF = 3;
      constexpr int LPR = DK / 64;
      unsigned tv[LPR * 4 + 1];
#pragma unroll
      for (int i = 0; i < LPR * 4 + 1; ++i) tv[i] = 0;
      if (c + PF < c0 + nc) {
        const size_t rb2 = (size_t)(c + PF) * 64;
#pragma unroll
        for (int i = 0; i < LPR; ++i) {
          const int li = i * 64 + ln; const size_t ro = (size_t)(li / LPR), co = (size_t)(li % LPR) * 64;
          tv[i * 4 + 0] = *(const unsigned*)(Qp + (rb2 + ro) * LDQ + h * DK + co);
          tv[i * 4 + 1] = *(const unsigned*)(Kt + (rb2 + ro) * LDQ + h * DK + co);
          if constexpr (LOW) { tv[i * 4 + 2] = *(const unsigned*)(Wp + (rb2 + ro) * 1024 + h * DK + co); tv[i * 4 + 3] = *(const unsigned*)(Bt + (rb2 + ro) * 1024 + h * DK + co); }
        }
        {
          const size_t fo2 = ((((size_t)(c + PF) * NH + h) * NVB + vb) * 4) * 256;
          const unsigned* tp;
          if (ln < 16) tp = (const unsigned*)(Ol + fo2 + ln * 64);
          else if (LOW && ln < 32) tp = (const unsigned*)(U0 + fo2 + (ln - 16) * 64);
          else if (ln < 48) tp = (const unsigned*)(Vt + rb2 * 1024 + h * DV + cont_off<DV>(vb * 16 + (ln & 15), 0, 1024));
          else tp = (const unsigned*)(gam + ((size_t)(c + PF) * NH + h) * DK + ((ln - 48) & (DK / 32 - 1)) * 32);
          tv[LPR * 4] = *tp;
        }
      }
      LOAD_A(0); LOAD_A(1); LOAD_A(2); LOAD_A(3);
#pragma unroll
      for (int ks = 0; ks < 2; ++ks) vbop[ks] = *(const bf16x8*)(vtb + cont_off<DV>(vcol, ks * 32 + quad * 8, 1024));
#pragma unroll
      for (int m = 0; m < MB; ++m) LOAD_B(m);
      __builtin_amdgcn_sched_barrier(0);
      COMP_A(0); COMP_A(1); COMP_A(2); COMP_A(3);
      bf16x8 ubop[2];
      if constexpr (LOW) {
#pragma unroll
        for (int ks = 0; ks < 2; ++ks) {
          const u32x4 uw = {pack2(-U[2 * ks][0], -U[2 * ks][1]), pack2(-U[2 * ks][2], -U[2 * ks][3]), pack2(-U[2 * ks + 1][0], -U[2 * ks + 1][1]), pack2(-U[2 * ks + 1][2], -U[2 * ks + 1][3])};
          ubop[ks] = __builtin_bit_cast(bf16x8, uw);
        }
      }
#pragma unroll
      for (int m = 0; m < MB; ++m) COMP_B(m);
      __builtin_amdgcn_sched_barrier(0);
#pragma unroll
      for (int i = 0; i < LPR * 4 + 1; ++i) tsink ^= tv[i];
#undef LOAD_A
#undef COMP_A
#undef LOAD_B
#undef COMP_B
    }
    if (tsink == 0x9e3779b9u) ((unsigned*)(PWS + WS_SINK))[0] = tsink;
    if (TYPE == 0) {
      float* S = POUT + (seq == 0 ? O_AWKV_P + ((size_t)j * 16 + h) * 4096 : O_AWKV_S + (((size_t)j * NSS + (seq - 1)) * 16 + h) * 4096) + (size_t)vcol * 64;
#pragma unroll
      for (int m = 0; m < MB; ++m) *(float4*)(S + m * 16 + quad * 4) = make_float4(H[m][0], H[m][1], H[m][2], H[m][3]);
    } else {
      const size_t ob = TYPE == 1 ? (seq == 0 ? O_BKV_P : O_BKV_S + (size_t)(seq - 1) * NH * DK * DV)
                                  : (seq == 0 ? O_CKV_P : O_CKV_S + (size_t)(seq - 1) * NH * DK * DV);
      float* S = POUT + ob + (size_t)h * DK * DV + vcol;
#pragma unroll
      for (int m = 0; m < MB; ++m)
#pragma unroll
        for (int jj = 0; jj < 4; ++jj) S[(size_t)(m * 16 + quad * 4 + jj) * DV] = H[m][jj];
    }
  }
}

template <int TYPE>
DEVI void phase_seq2(const P& p, int j, char* smem) {
  constexpr int NH = TYPE == 0 ? 16 : (TYPE == 1 ? 4 : 8);
  constexpr int DK = TYPE == 0 ? 64 : 128;
  constexpr int DV = TYPE == 0 ? 64 : (TYPE == 1 ? 256 : 128);
  constexpr bool LOW = TYPE != 1;
  constexpr int NVB = DV / 16, MB = DK / 16, KS = DK / 32, NG = NVB / 4, BIPS = NH * NG;
  constexpr int LDQ = TYPE == 1 ? 512 : 1024;
  constexpr int NOP = LOW ? 4 : 2, RS = DK + 8, OPSZ = 64 * RS, PPR = DK / 8;
  constexpr int PPO = 64 * PPR / 256;
  constexpr int PF = 4;
  bf16* L = (bf16*)smem;
  const int tid = threadIdx.x, lane = tid & 63, wave = tid >> 6, lr = lane & 15, quad = lane >> 4;
  const bf16 *Qp, *Kt, *Vt, *Wp = nullptr, *Bt = nullptr, *U0 = nullptr; bf16* Ol;
  if (TYPE == 0) { Qp = slot(p, 5); Kt = slot(p, 6); Vt = slot(p, 7); Wp = slot(p, 2); Bt = slot(p, 3); Ol = slot(p, 0); U0 = slot(p, 1); }
  else if (TYPE == 1) { Qp = slot(p, 1); Kt = slot(p, 1) + (size_t)MT * 512; Vt = slot(p, 2); Ol = slot(p, 4); }
  else { Qp = slot(p, 5); Kt = slot(p, 6); Vt = slot(p, 7); Wp = slot(p, 1); Bt = slot(p, 2); Ol = slot(p, 3); U0 = slot(p, 0); }
  const float* gam = (const float*)(PWS + WS_GAM);
  unsigned tsink = 0;
  for (int bitem = blockIdx.x; bitem < 33 * BIPS; bitem += gridDim.x) {
    const int seq = bitem / BIPS, rem = bitem % BIPS, h = rem / NG, vb = (rem % NG) * 4 + wave;
    const int c0 = seq == 0 ? 0 : NPCH + seq - 1, nc = seq == 0 ? NPCH : 1;
    const int vcol = vb * 16 + lr;
    f32x4 H[MB];
    if (seq == 0) {
#pragma unroll
      for (int m = 0; m < MB; ++m) H[m] = (f32x4){0.f, 0.f, 0.f, 0.f};
    } else {
      const int b = seq - 1;
      if (TYPE == 0) {
        const float* S = PIN(3) + (((size_t)j * NSS + b) * 16 + h) * 4096 + (size_t)vcol * 64;
#pragma unroll
        for (int m = 0; m < MB; ++m) { float4 v = *(const float4*)(S + m * 16 + quad * 4); H[m] = (f32x4){v.x, v.y, v.z, v.w}; }
      } else {
        const float* S = PIN(TYPE == 1 ? 4 : 6) + ((size_t)b * NH + h) * DK * DV + vcol;
#pragma unroll
        for (int m = 0; m < MB; ++m)
#pragma unroll
          for (int jj = 0; jj < 4; ++jj) H[m][jj] = S[(size_t)(m * 16 + quad * 4 + jj) * DV];
      }
    }
    u32x4 preA[NOP * PPO], preB[NOP * PPO]; u32x2 poA[4], poB[4], puA[4], puB[4]; bf16x8 pvA[2], pvB[2]; f32x4 pgA[MB], pgB[MB];
    auto issue_sh = [&](int cc, u32x4 (&pre)[NOP * PPO]) {
      const size_t rb_ = (size_t)cc * 64; int tl_ = threadIdx.x; asm volatile("" : "+v"(tl_));
#pragma unroll
      for (int i_ = 0; i_ < PPO; ++i_) { const int w_ = tl_ + 256 * i_; const size_t r_ = rb_ + w_ / PPR; const int c8_ = (w_ % PPR) * 8;
        pre[0 * PPO + i_] = *(const u32x4*)(Qp + r_ * LDQ + h * DK + c8_);
        pre[1 * PPO + i_] = *(const u32x4*)(Kt + r_ * LDQ + h * DK + c8_);
        if constexpr (LOW) { pre[2 * PPO + i_] = *(const u32x4*)(Wp + r_ * 1024 + h * DK + c8_); pre[3 * PPO + i_] = *(const u32x4*)(Bt + r_ * 1024 + h * DK + c8_); } }
    };
    auto issue_pr = [&](int cc, u32x2 (&p_o)[4], u32x2 (&p_u)[4], bf16x8 (&p_v)[2], f32x4 (&p_g)[MB]) {
      const size_t rb_ = (size_t)cc * 64; int tl_ = threadIdx.x; asm volatile("" : "+v"(tl_));
      const int lane = tl_ & 63, lr = lane & 15, quad = lane >> 4, vcol = vb * 16 + lr;
      const size_t fo_ = ((((size_t)cc * NH + h) * NVB + vb) * 4) * 256 + lane * 4;
#pragma unroll
      for (int tb_ = 0; tb_ < 4; ++tb_) { p_o[tb_] = *(const u32x2*)(Ol + fo_ + tb_ * 256); if constexpr (LOW) p_u[tb_] = *(const u32x2*)(U0 + fo_ + tb_ * 256); }
#pragma unroll
      for (int ks_ = 0; ks_ < 2; ++ks_) p_v[ks_] = *(const bf16x8*)(Vt + rb_ * 1024 + h * DV + cont_off<DV>(vcol, ks_ * 32 + quad * 8, 1024));
#pragma unroll
      for (int m_ = 0; m_ < MB; ++m_) p_g[m_] = *(const f32x4*)(gam + ((size_t)cc * NH + h) * DK + m_ * 16 + quad * 4);
    };
    const int cend = c0 + nc;
    auto step = [&](int c, u32x4 (&pre)[NOP * PPO], u32x2 (&p_o)[4], u32x2 (&p_u)[4], bf16x8 (&p_v)[2], f32x4 (&p_g)[MB]) {
#pragma unroll
      for (int o = 0; o < NOP; ++o)
#pragma unroll
        for (int i = 0; i < PPO; ++i) { const int w = tid + 256 * i; *(u32x4*)(L + o * OPSZ + (w / PPR) * RS + (w % PPR) * 8) = pre[o * PPO + i]; }
      __syncthreads();
      if (c + 2 < cend) issue_sh(c + 2, pre);
      unsigned tv[NOP * DK / 128 + 1];
#pragma unroll
      for (int i = 0; i < NOP * DK / 128 + 1; ++i) tv[i] = 0;
      if (false && c + PF < cend) {
        const size_t rb2 = (size_t)(c + PF) * 64;
        if (DK == 128 || tid < 128) {
          const int li = (DK == 128) ? tid : tid; const size_t ro = li / (DK / 64) % 64; const int co = (li % (DK / 64)) * 64;
          const int half = (DK == 128) ? (tid >> 7) : (tid >> 6);
          if (half == 0) { tv[0] = *(const unsigned*)(Qp + (rb2 + ro) * LDQ + h * DK + co); if constexpr (LOW) tv[1] = *(const unsigned*)(Wp + (rb2 + ro) * 1024 + h * DK + co); }
          else { tv[0] = *(const unsigned*)(Kt + (rb2 + ro) * LDQ + h * DK + co); if constexpr (LOW) tv[1] = *(const unsigned*)(Bt + (rb2 + ro) * 1024 + h * DK + co); }
        }
        {
          const size_t fo2 = ((((size_t)(c + PF) * NH + h) * NVB + vb) * 4) * 256;
          const unsigned* tp;
          if (lane < 16) tp = (const unsigned*)(Ol + fo2 + lane * 64);
          else if (LOW && lane < 32) tp = (const unsigned*)(U0 + fo2 + (lane - 16) * 64);
          else if (lane < 48) tp = (const unsigned*)(Vt + rb2 * 1024 + h * DV + cont_off<DV>(vb * 16 + (lane & 15), 0, 1024));
          else tp = (const unsigned*)(gam + ((size_t)(c + PF) * NH + h) * DK + ((lane - 48) & (DK / 32 - 1)) * 32);
          tv[NOP * DK / 128] = *tp;
        }
      }
      bf16x8 hb[KS];
#pragma unroll
      for (int ks = 0; ks < KS; ++ks) {
        const u32x4 hw = {pack2(H[2 * ks][0], H[2 * ks][1]), pack2(H[2 * ks][2], H[2 * ks][3]), pack2(H[2 * ks + 1][0], H[2 * ks + 1][1]), pack2(H[2 * ks + 1][2], H[2 * ks + 1][3])};
        hb[ks] = __builtin_bit_cast(bf16x8, hw);
      }
      const size_t fo = ((((size_t)c * NH + h) * NVB + vb) * 4) * 256 + lane * 4;
      f32x4 U[4];
#pragma unroll
      for (int tb = 0; tb < 4; ++tb) {
        f32x4 o_ = (f32x4){bf2f(p_o[tb].x & 0xffff), bf2f(p_o[tb].x >> 16), bf2f(p_o[tb].y & 0xffff), bf2f(p_o[tb].y >> 16)}, u_;
        if constexpr (LOW) u_ = (f32x4){bf2f(p_u[tb].x & 0xffff), bf2f(p_u[tb].x >> 16), bf2f(p_u[tb].y & 0xffff), bf2f(p_u[tb].y >> 16)};
#pragma unroll
        for (int ks = 0; ks < KS; ++ks) {
          const bf16* qp = L + 0 * OPSZ + (tb * 16 + lr) * RS + ks * 32 + quad * 4;
          bf16x4 lo = *(const bf16x4*)qp, hi = *(const bf16x4*)(qp + 16);
          o_ = __builtin_amdgcn_mfma_f32_16x16x32_bf16(__builtin_shufflevector(lo, hi, 0, 1, 2, 3, 4, 5, 6, 7), hb[ks], o_, 0, 0, 0);
          if constexpr (LOW) {
            const bf16* wp = L + 2 * OPSZ + (tb * 16 + lr) * RS + ks * 32 + quad * 4;
            bf16x4 wl = *(const bf16x4*)wp, wh = *(const bf16x4*)(wp + 16);
            u_ = __builtin_amdgcn_mfma_f32_16x16x32_bf16(__builtin_shufflevector(wl, wh, 0, 1, 2, 3, 4, 5, 6, 7), hb[ks], u_, 0, 0, 0);
          }
        }
        *(u32x2*)(Ol + fo + tb * 256) = (u32x2){pack2(o_[0], o_[1]), pack2(o_[2], o_[3])};
        if constexpr (LOW) U[tb] = u_;
      }
      bf16x8 ubop[2];
      if constexpr (LOW) {
#pragma unroll
        for (int ks = 0; ks < 2; ++ks) {
          const u32x4 uw = {pack2(-U[2 * ks][0], -U[2 * ks][1]), pack2(-U[2 * ks][2], -U[2 * ks][3]), pack2(-U[2 * ks + 1][0], -U[2 * ks + 1][1]), pack2(-U[2 * ks + 1][2], -U[2 * ks + 1][3])};
          ubop[ks] = __builtin_bit_cast(bf16x8, uw);
        }
      }
#pragma unroll
      for (int m = 0; m < MB; ++m) {
        f32x4 hn = (f32x4){H[m][0] * p_g[m][0], H[m][1] * p_g[m][1], H[m][2] * p_g[m][2], H[m][3] * p_g[m][3]};
        const int krow = m * 16 + lr;
#pragma unroll
        for (int ks = 0; ks < 2; ++ks) {
          const int i1 = krow * 64 + ks * 32 + quad * 8;
          bf16x8 a = *(const bf16x8*)(L + 1 * OPSZ + (i1 / DK) * RS + (i1 % DK));
          hn = __builtin_amdgcn_mfma_f32_16x16x32_bf16(a, p_v[ks], hn, 0, 0, 0);
          if constexpr (LOW) {
            const int i2 = krow * 64 + ks * 32 + quad * 4, i3 = i2 + 16;
            bf16x4 lo = *(const bf16x4*)(L + 3 * OPSZ + (i2 / DK) * RS + (i2 % DK)), hi = *(const bf16x4*)(L + 3 * OPSZ + (i3 / DK) * RS + (i3 % DK));
            hn = __builtin_amdgcn_mfma_f32_16x16x32_bf16(__builtin_shufflevector(lo, hi, 0, 1, 2, 3, 4, 5, 6, 7), ubop[ks], hn, 0, 0, 0);
          }
        }
        H[m] = hn;
      }
#pragma unroll
      for (int i = 0; i < NOP * DK / 128 + 1; ++i) tsink ^= tv[i];
      if (c + 2 < cend) issue_pr(c + 2, p_o, p_u, p_v, p_g);
      __syncthreads();
    };
    issue_sh(c0, preA); issue_pr(c0, poA, puA, pvA, pgA);
    if (nc > 1) { issue_sh(c0 + 1, preB); issue_pr(c0 + 1, poB, puB, pvB, pgB); }
    for (int c = c0; c < cend; c += 2) { step(c, preA, poA, puA, pvA, pgA); if (c + 1 < cend) step(c + 1, preB, poB, puB, pvB, pgB); }
    if (TYPE == 0) {
      float* S = POUT + (seq == 0 ? O_AWKV_P + ((size_t)j * 16 + h) * 4096 : O_AWKV_S + (((size_t)j * NSS + (seq - 1)) * 16 + h) * 4096) + (size_t)vcol * 64;
#pragma unroll
      for (int m = 0; m < MB; ++m) *(float4*)(S + m * 16 + quad * 4) = make_float4(H[m][0], H[m][1], H[m][2], H[m][3]);
    } else {
      const size_t ob = TYPE == 1 ? (seq == 0 ? O_BKV_P : O_BKV_S + (size_t)(seq - 1) * NH * DK * DV)
                                  : (seq == 0 ? O_CKV_P : O_CKV_S + (size_t)(seq - 1) * NH * DK * DV);
      float* S = POUT + ob + (size_t)h * DK * DV + vcol;
#pragma unroll
      for (int m = 0; m < MB; ++m)
#pragma unroll
        for (int jj = 0; jj < 4; ++jj) S[(size_t)(m * 16 + quad * 4 + jj) * DV] = H[m][jj];
    }
  }
  if (tsink == 0x9e3779b9u) ((unsigned*)(PWS + WS_SINK))[0] = tsink;
}

template <int TYPE>
DEVI void phase_post(const P& p, int j, char* smem) {
  constexpr int NH = TYPE == 0 ? 16 : (TYPE == 1 ? 4 : 8);
  constexpr int DV = TYPE == 0 ? 64 : (TYPE == 1 ? 256 : 128);
  constexpr int CPT = DV / 8;
  bf16* vt = (bf16*)smem;
  bf16* ot = (bf16*)(smem + 9216);
  const bf16* O = slot(p, TYPE == 0 ? 0 : (TYPE == 1 ? 4 : 3));
  const bf16* G = slot(p, TYPE == 0 ? 4 : (TYPE == 1 ? 3 : 4));
  bf16* og = slot(p, TYPE == 1 ? 0 : 1);
  const float* sm = (const float*)(PWS + WS_SM);
  for (int item = blockIdx.x; item < NCHUNK * NH; item += gridDim.x) {
    const int c = item / NH, h = item % NH; const size_t rb = (size_t)c * 64;
    int tid = threadIdx.x; asm volatile("" : "+v"(tid));
    const int part = tid & 7;
    if constexpr (TYPE == 0) {
      const bf16* V = slot(p, 7) + rb * 1024 + h * 64;
      const int r = tid >> 2, q4 = (tid & 3) * 16;
      *(uint4*)(vt + r * 72 + q4) = *(const uint4*)(V + (size_t)r * 1024 + q4);
      *(uint4*)(vt + r * 72 + q4 + 8) = *(const uint4*)(V + (size_t)r * 1024 + q4 + 8);
      __syncthreads();
    }
    {
      const uint4* srcp = (const uint4*)(O + ((size_t)c * NH + h) * 64 * DV);
#pragma unroll
      for (int i = 0; i < DV / 32; ++i) *(uint4*)(ot + (size_t)(i * 256 + tid) * 8) = srcp[i * 256 + tid];
      __syncthreads();
    }
#pragma unroll 1
    for (int pass = 0; pass < 2; ++pass) {
      const int t = pass * 32 + (tid >> 3);
      const size_t base = (rb + t) * 1024 + h * DV + part * CPT;
      float o[CPT];
#pragma unroll
      for (int e = 0; e < CPT; ++e) {
        const int v = part * CPT + e;
        o[e] = bf2f(ot[(((v >> 4) * 4 + (t >> 4)) * 64 + ((t & 15) >> 2) * 16 + (v & 15)) * 4 + (t & 3)]);
      }
      float s1 = 0.f, s2 = 0.f;
#pragma unroll
      for (int e = 0; e < CPT; ++e) { s1 += o[e]; s2 += o[e] * o[e]; }
      s1 += __shfl_xor(s1, 1); s1 += __shfl_xor(s1, 2); s1 += __shfl_xor(s1, 4);
      s2 += __shfl_xor(s2, 1); s2 += __shfl_xor(s2, 2); s2 += __shfl_xor(s2, 4);
      if constexpr (TYPE == 0) {
        const float mean = s1 * (1.f / 64.f); float var = s2 * (1.f / 64.f) - mean * mean; var = fmaxf(var, 0.f);
        const float rs = rsqrtf(var + 64e-5f); const float bonus = sm[(rb + t) * 16 + h];
        const float* lw = PIN(26) + j * 1024 + h * 64 + part * CPT; const float* lb = PIN(27) + j * 1024 + h * 64 + part * CPT;
#pragma unroll
        for (int e = 0; e < CPT; ++e) {
          const float vv = bf2f(vt[(part * CPT + e) * 72 + t]);
          o[e] = (o[e] - mean) * rs * lw[e] + lb[e] + bonus * vv;
        }
      } else {
        const float rs = rsqrtf(s2 * (1.f / DV) + 1e-6f);
        const float* on = PIN(TYPE == 1 ? 32 : 38) + part * CPT;
#pragma unroll
        for (int e = 0; e < CPT; ++e) o[e] = o[e] * rs * on[e];
      }
#pragma unroll
      for (int e = 0; e < CPT; e += 8) {
        uint4 u = *(const uint4*)(G + base + e);
        const unsigned w[4] = {u.x, u.y, u.z, u.w}; unsigned ow[4];
#pragma unroll
        for (int i = 0; i < 4; ++i) {
          float g0 = bf2f(w[i] & 0xffff), g1 = bf2f(w[i] >> 16);
          if constexpr (TYPE != 0) { g0 = silu(g0); g1 = silu(g1); }
          ow[i] = pack2(o[e + 2 * i] * g0, o[e + 2 * i + 1] * g1);
        }
        *(uint4*)(og + base + e) = make_uint4(ow[0], ow[1], ow[2], ow[3]);
      }
    }
    __syncthreads();
  }
}


#define XB_TMO      128
#define XB_XCNT(j)  (256  + 64 * (j))
#define XB_XSUB(j)  (1280 + 64 * (j))
#define XB_XGEN(j)  (2304 + 64 * (j))
#define XB_TOP      3328
#define XB_TOPGEN   3392
#define XCD_BAR_WORDS 3456
#define XB_SPIN_CAP (1u << 18)
#define LAS __attribute__((address_space(3)))
DEVI unsigned xb_ld(unsigned* p)              { return __hip_atomic_load(p, __ATOMIC_RELAXED, __HIP_MEMORY_SCOPE_AGENT); }
DEVI unsigned xb_add(unsigned* p, unsigned v) { return __hip_atomic_fetch_add(p, v, __ATOMIC_RELAXED, __HIP_MEMORY_SCOPE_AGENT); }
DEVI unsigned xb_xcc_id() { return (unsigned)__builtin_amdgcn_s_getreg((3 << 11) | 20) & 0xFu; }
#define XB_SPIN(cond, bar) do { unsigned _sp = 0; while (cond) { __builtin_amdgcn_s_sleep(1); \
    if ((++_sp & 255u) == 0u) { if (xb_ld(&(bar)[XB_TMO])) break; if (_sp > XB_SPIN_CAP) { atomicAdd(&(bar)[XB_TMO], 1u); break; } } } } while (0)
struct XcdBarrier { unsigned* bar; unsigned x; volatile LAS unsigned* st; };
DEVI XcdBarrier xcd_barrier_post(unsigned* bar, volatile LAS unsigned* st) {
  XcdBarrier b; b.bar = bar; b.x = xb_xcc_id(); b.st = st;
  if (threadIdx.x == 0) (void)xb_add(&bar[XB_XCNT(b.x)], 1u);
  return b;
}
DEVI void xcd_barrier_complete(unsigned* bar, unsigned x, unsigned& nloc, unsigned& nx) {
  const unsigned G = gridDim.x * gridDim.y * gridDim.z;
  unsigned sum, cnt, mine, sp = 0u;
  for (;;) {
    sum = 0u; cnt = 0u; mine = 0u;
#pragma unroll
    for (unsigned j = 0; j < 16; ++j) { const unsigned c = xb_ld(&bar[XB_XCNT(j)]); sum += c; cnt += (c > 0u) ? 1u : 0u; mine = (j == x) ? c : mine; }
    if (sum == G) break;
    __builtin_amdgcn_s_sleep(1);
    if ((++sp & 255u) == 0u) { if (xb_ld(&bar[XB_TMO])) break; if (sp > XB_SPIN_CAP) { atomicAdd(&bar[XB_TMO], 1u); break; } }
  }
  nloc = mine > 0u ? mine : 1u; nx = cnt > 0u ? cnt : 1u;
}
DEVI void xcd_barrier(const XcdBarrier& b) {
  asm volatile("s_waitcnt vmcnt(0)" ::: "memory");
  __syncthreads();
  if (threadIdx.x == 0) {
    unsigned* bar = b.bar;
    __builtin_amdgcn_s_waitcnt(0);
    unsigned nloc = b.st[0], nx = b.st[1];
    if (nloc == 0u) { xcd_barrier_complete(bar, b.x, nloc, nx); b.st[0] = nloc; b.st[1] = nx; }
    const unsigned old = xb_add(&bar[XB_XSUB(b.x)], 1u);
    const unsigned gen = old / nloc;
    if (old + 1u == (gen + 1u) * nloc) {
      __builtin_amdgcn_fence(__ATOMIC_RELEASE, "agent");
      asm volatile("s_waitcnt vmcnt(0)" ::: "memory");
      const unsigned og = xb_add(&bar[XB_TOP], 1u);
      const unsigned tg = og / nx;
      if (og + 1u == (tg + 1u) * nx) xb_add(&bar[XB_TOPGEN], 1u);
      else XB_SPIN(xb_ld(&bar[XB_TOPGEN]) == tg, bar);
      __builtin_amdgcn_fence(__ATOMIC_ACQUIRE, "agent");
      xb_add(&bar[XB_XGEN(b.x)], 1u);
      asm volatile("s_waitcnt vmcnt(0)" ::: "memory");
    } else {
      XB_SPIN(xb_ld(&bar[XB_XGEN(b.x)]) == gen, bar);
      __builtin_amdgcn_fence(__ATOMIC_ACQUIRE, "agent");
      asm volatile("s_waitcnt vmcnt(0)" ::: "memory");
    }
  }
  __syncthreads();
}

#ifndef DISMASK
#define DISMASK 0
#endif
#define EN(b) (!((DISMASK >> (b)) & 1))
#define GSYNC() xcd_barrier(xb)
#define GSYNC_CG() do { asm volatile("s_waitcnt vmcnt(0)" ::: "memory"); grid.sync(); } while (0)
__global__ void __launch_bounds__(256, 1) fwd_megakernel(P p) {
  extern __shared__ __attribute__((aligned(16))) char smem[];
  cg::grid_group grid = cg::this_grid();
  volatile LAS unsigned* xst = (volatile LAS unsigned*)(smem + LDS_BYTES - 16);
  if (threadIdx.x == 0) { xst[0] = 0u; xst[1] = 0u; }
  __syncthreads();
  const XcdBarrier xb = xcd_barrier_post((unsigned*)(PWS + WS_BAR), xst);
  bf16* wreg = (bf16*)(PWS + WS_W);
  bf16 *wfin = wreg + W_FIN, *wfout = wreg + W_FOUT, *wmix = wreg + W_MIX;
  float* sm = (float*)(PWS + WS_SM);
  for (int layer = 0; layer < 4; ++layer) {
    const int type = layer % 3, j = layer / 3;
    int tb = 0;
    if (type == 0) phase_norm<0>(p, layer, j, layer == 0, layer == 0);
    else phase_norm<1>(p, layer, j, false, false);
    conv_job(CvFfnIn{PIN(10) + (size_t)layer * 1024 * 2 * FF}, wfin, 1024, 2 * FF, 1024, tb, smem);
    conv_job(CvPlain{PIN(11) + (size_t)layer * FF * 1024, 1024, 1024}, wfout, FF, 1024, FF, tb, smem);
    if (type == 0) {
      for (int i = 0; i < 3; ++i) conv_job(CvPlain{PIN(24) + ((size_t)j * 3 + i) * 1048576, 1024, 1024}, wmix + (size_t)i * 1048576, 1024, 1024, 1024, tb, smem);
      conv_job(CvLora1{PIN(14) + (size_t)j * 65536, PIN(17) + (size_t)j * 65536, PIN(19) + (size_t)j * 131072, PIN(12) + (size_t)j * 6144}, wmix + 3145728, 2048, 256, 2048, tb, smem);
      conv_job(CvPlain{PIN(15) + (size_t)j * 65536, 1024, 1024}, wmix + 3670016, 64, 1024, 64, tb, smem);
      conv_job(CvPlain{PIN(18) + (size_t)j * 65536, 1024, 1024}, wmix + 3735552, 64, 1024, 64, tb, smem);
      conv_job(CvPlain{PIN(20) + (size_t)j * 131072, 1024, 1024}, wmix + 3801088, 128, 1024, 128, tb, smem);
      conv_job(CvPlain{PIN(25) + (size_t)j * 1048576, 1024, 1024}, wmix + 3932160, 1024, 1024, 1024, tb, smem);
    } else if (type == 1) {
      conv_job(CvGlaIn{PIN(28), PIN(29)}, wmix, 1024, 3200, 1024, tb, smem);
      conv_job(CvPlain{PIN(33), 1024, 1024}, wmix + 3276800, 1024, 1024, 1024, tb, smem);
    } else {
      conv_job(CvPlain{PIN(34), 4112, 4112}, wmix, 1024, 4224, 1024, tb, smem);
      conv_job(CvPlain{PIN(39), 1024, 1024}, wmix + 4325376, 1024, 1024, 1024, tb, smem);
    }
    GSYNC();
    tb = 0;
    const bf16* wo;
    if (type == 0) {
      for (int i = 0; i < 3; ++i)
        gemm_job(GemmDesc{slot(p, 2 + i), nullptr, 1024, 1024, wmix + (size_t)i * 1048576, 1024, 144, 8, 1024}, EpiStore{slot(p, 5 + i), 1024, 1.f}, tb, smem);
      gemm_job(GemmDesc{slot(p, 0), slot(p, 1), 1024, 1024, wmix + 3145728, 2048, 144, 2, 2048}, EpiLora1{(bf16*)(PWS + WS_L1)}, tb, smem);
      GSYNC();
      tb = 0;
      const bf16* l1 = (const bf16*)(PWS + WS_L1);
      gemm_job(GemmDesc{l1, nullptr, 256, 64, wmix + 3670016, 64, 144, 8, 64}, EpiLd{slot(p, 2), PIN(13) + j * 1024}, tb, smem);
      gemm_job(GemmDesc{l1 + 64, nullptr, 256, 64, wmix + 3735552, 64, 144, 8, 64}, EpiSig{slot(p, 3), PIN(16) + j * 1024}, tb, smem);
      gemm_job(GemmDesc{l1 + 128, nullptr, 256, 128, wmix + 3801088, 128, 144, 8, 128}, EpiStore{slot(p, 4), 1024, 1.f}, tb, smem);
      GSYNC();
      if (EN(2)) phase_prep<0>(p, j, smem);
      GSYNC();
      if (EN(5)) phase_seq2<0>(p, j, smem);
      GSYNC();
      if (EN(8)) phase_post<0>(p, j, smem);
      wo = wmix + 3932160;
    } else if (type == 1) {
      gemm_job(GemmDesc{slot(p, 0), nullptr, 1024, 1024, wmix, 1024, 144, 25, 1024},
               EpiGlaIn{slot(p, 1), slot(p, 1) + (size_t)MT * 512, slot(p, 2), slot(p, 3), sm}, tb, smem);
      GSYNC();
      if (EN(3)) phase_prep<1>(p, j, smem);
      GSYNC();
      if (EN(6)) phase_seq2<1>(p, j, smem);
      GSYNC();
      if (EN(8)) phase_post<1>(p, j, smem);
      wo = wmix + 3276800;
    } else {
      gemm_job(GemmDesc{slot(p, 0), nullptr, 1024, 1024, wmix, 1024, 144, 33, 1024},
               EpiGdnIn{slot(p, 1), slot(p, 4), sm, POUT}, tb, smem);
      GSYNC();
      if (EN(9)) phase_gdn_conv(p);
      GSYNC();
      if (EN(4)) phase_prep<2>(p, j, smem);
      GSYNC();
      if (EN(7)) phase_seq2<2>(p, j, smem);
      GSYNC();
      if (EN(8)) phase_post<2>(p, j, smem);
      wo = wmix + 4325376;
    }
    GSYNC();
    tb = 0;
    gemm_job(GemmDesc{slot(p, type == 1 ? 0 : 1), nullptr, 1024, 1024, wo, 1024, 144, 8, 1024}, EpiAcc{POUT}, tb, smem);
    GSYNC();
    phase_rms(POUT, PIN(8) + layer * 1024, slot(p, 0), nullptr);
    GSYNC();
    tb = 0;
    gemm_job(GemmDesc{slot(p, 0), nullptr, 1024, 1024, wfin, 1024, 144, 44, 1024}, EpiSwiglu{slot(p, 1)}, tb, smem);
    GSYNC();
    tb = 0;
    gemm_job(GemmDesc{slot(p, 1), nullptr, FF, FF, wfout, FF, 144, 8, FF}, EpiAcc{POUT}, tb, smem);
    if (layer == 3) GSYNC_CG(); else GSYNC();
  }
  phase_rms(POUT, PIN(9), nullptr, POUT);
}

extern "C" void kernel_launch(void* const* d_in, const int* in_sizes, int n_in, void* d_out, int out_size,
                              void* d_ws, size_t ws_size, hipStream_t stream) {
  if (n_in < 40 || ws_size < WS_TOTAL) { fprintf(stderr, "bad args: n_in %d ws %zu need %zu\n", n_in, ws_size, (size_t)WS_TOTAL); return; }
  static int grid_blocks = 0;
  if (!grid_blocks) {
    int dev = 0, cus = 0, per_cu = 0;
    hipGetDevice(&dev);
    hipDeviceGetAttribute(&cus, hipDeviceAttributeMultiprocessorCount, dev);
    hipFuncSetAttribute((const void*)fwd_megakernel, hipFuncAttributeMaxDynamicSharedMemorySize, LDS_BYTES);
    hipOccupancyMaxActiveBlocksPerMultiprocessor(&per_cu, (const void*)fwd_megakernel, 256, LDS_BYTES);
    if (per_cu > 1) per_cu = 1;
    if (per_cu < 1) per_cu = 1;
    grid_blocks = cus * per_cu;
  }
  hipMemsetAsync((char*)d_ws + WS_BAR, 0, 16384, stream);
  P p{};
  for (int i = 0; i < 40; ++i) p.in[i] = (const float*)d_in[i];
  p.out = (float*)d_out; p.ws = (char*)d_ws;
  void* args[] = {&p};
  hipError_t e = hipLaunchCooperativeKernel((const void*)fwd_megakernel, dim3(grid_blocks), dim3(256), args, LDS_BYTES, stream);
  if (e != hipSuccess) fprintf(stderr, "cooperative launch failed: %s (grid %d)\n", hipGetErrorString(e), grid_blocks);
}
```

```cpp
#include <hip/hip_runtime.h>
#include <hip/hip_cooperative_groups.h>
#include <cstdio>
#include <cstdint>
namespace cg = cooperative_groups;

typedef unsigned short bf16;
typedef __attribute__((ext_vector_type(8))) short bf16x8;
typedef __attribute__((ext_vector_type(4))) short bf16x4;
typedef __attribute__((ext_vector_type(4))) float f32x4;
typedef __attribute__((ext_vector_type(4))) unsigned u32x4;
typedef __attribute__((ext_vector_type(2))) unsigned u32x2;

#define DEVI __device__ __forceinline__

constexpr int Dm = 1024, FF = 2816, MT = 18432, MPR = 16384, NSS = 32, NCHUNK = 288, NPCH = 256;
constexpr size_t SLOT = (size_t)MT * 1024 * 2;
constexpr size_t WS_L1 = 8 * SLOT;
constexpr size_t WS_SM = WS_L1 + (size_t)MT * 256 * 2;
constexpr size_t WS_GAM = WS_SM + (size_t)MT * 16 * 4;
constexpr size_t WS_W = WS_GAM + (size_t)NCHUNK * 1024 * 4;
constexpr size_t W_FIN = 0, W_FOUT = 5767168, W_MIX = 8650752;
constexpr size_t WS_SINK = WS_W + (size_t)14200000 * 2 - 64;
constexpr size_t WS_BAR = WS_W + (size_t)14200000 * 2;
constexpr size_t WS_TOTAL = WS_BAR + 16384;
constexpr int LDS_BYTES = 77824;

constexpr size_t O_ASH_P = 18874368, O_AWKV_P = O_ASH_P + 2048, O_BKV_P = O_AWKV_P + 131072,
                 O_CCONV_P = O_BKV_P + 131072, O_CKV_P = O_CCONV_P + 9216, O_ASH_S = O_CKV_P + 131072,
                 O_AWKV_S = O_ASH_S + 65536, O_BKV_S = O_AWKV_S + 4194304, O_CCONV_S = O_BKV_S + 4194304,
                 O_CKV_S = O_CCONV_S + 294912;

struct P { const float* in[40]; float* out; char* ws; };
typedef const __attribute__((address_space(4))) char* kptr_t;
typedef const float* cfp_t; typedef float* fp_t; typedef char* cp_t;
DEVI kptr_t kbase() { kptr_t b = (kptr_t)__builtin_amdgcn_kernarg_segment_ptr(); asm volatile("" : "+s"(b)); return b; }
#define PIN(i) (*(const __attribute__((address_space(4))) cfp_t*)(kbase() + 8 * (i)))
#define POUT (*(const __attribute__((address_space(4))) fp_t*)(kbase() + 320))
#define PWS (*(const __attribute__((address_space(4))) cp_t*)(kbase() + 328))

typedef __attribute__((ext_vector_type(2))) float f32x2;
typedef __attribute__((ext_vector_type(2))) __bf16 bf16x2v;
DEVI unsigned pack2(float a, float b) { f32x2 v = {a, b}; bf16x2v r = __builtin_convertvector(v, bf16x2v); return __builtin_bit_cast(unsigned, r); }
DEVI bf16 f2bf(float f) { return (bf16)(pack2(f, 0.f) & 0xffffu); }
DEVI float bf2f(bf16 h) { return __uint_as_float(((unsigned)h) << 16); }
DEVI float wsum(float v) {
#pragma unroll
  for (int o = 32; o > 0; o >>= 1) v += __shfl_xor(v, o);
  return v;
}
DEVI float sigm(float x) { return 1.f / (1.f + __expf(-x)); }
DEVI float silu(float x) { return x * sigm(x); }
DEVI float softplus(float x) { return x > 20.f ? x : log1pf(__expf(x)); }
DEVI bf16* slot(const P& p, int i) { return (bf16*)(PWS + (size_t)i * SLOT); }

struct GemmDesc { const bf16* A; const bf16* A2; int lda; int ksplit; const bf16* Bt; int ldb; int tiles_m; int tiles_n; int K; };

template <class Epi>
DEVI void gemm_tile(const GemmDesc& g, int mt, int nt, Epi& epi, char* smem) {
  const int tid = threadIdx.x, lane = tid & 63, wave = tid >> 6;
  const int wm = wave >> 1, wn = wave & 1, lr = lane & 15, quad = lane >> 4;
  bf16* sA = (bf16*)smem;
  bf16* sB = sA + 2 * 8192;
  f32x4 acc[4][4];
#pragma unroll
  for (int i = 0; i < 4; ++i)
#pragma unroll
    for (int j = 0; j < 4; ++j) acc[i][j] = (f32x4){0.f, 0.f, 0.f, 0.f};
  const int m0 = mt * 128, n0 = nt * 128;
  const int r0 = tid >> 3, c0 = tid & 7;
  const size_t aoff = (size_t)(m0 + r0) * g.lda + c0 * 8;
  const bf16* bp = g.Bt + (size_t)(n0 + r0) * g.ldb + c0 * 8;
  const int soff = r0 * 64 + ((c0 ^ (r0 & 7)) << 3);
#define GL1(i_, RA, RB) RA##i_ = *(const u32x4*)(base_ + (size_t)(32 * i_) * g.lda); RB##i_ = *(const u32x4*)(bp + k0_ + (size_t)(32 * i_) * g.ldb);
#define GLOAD(kt_, RA, RB) do { const int k0_ = (kt_) << 6; \
    const bf16* base_ = ((k0_ < g.ksplit) ? (g.A + k0_) : (g.A2 + (k0_ - g.ksplit))) + aoff; \
    GL1(0, RA, RB) GL1(1, RA, RB) GL1(2, RA, RB) GL1(3, RA, RB) } while (0)
#define LS1(buf_, i_, RA, RB) *(u32x4*)(sA + (buf_) * 8192 + soff + i_ * 2048) = RA##i_; *(u32x4*)(sB + (buf_) * 8192 + soff + i_ * 2048) = RB##i_;
#define LSTORE(buf_, RA, RB) do { LS1(buf_, 0, RA, RB) LS1(buf_, 1, RA, RB) LS1(buf_, 2, RA, RB) LS1(buf_, 3, RA, RB) } while (0)
#define GSTEP(kt_, RA, RB) do { const int buf_ = (kt_) & 1; \
    const bf16* a_ = sA + buf_ * 8192 + (wm * 64 + lr) * 64; const bf16* b_ = sB + buf_ * 8192 + (wn * 64 + lr) * 64; \
    _Pragma("unroll") for (int ks_ = 0; ks_ < 2; ++ks_) { \
      const int co_ = (((ks_ * 4 + quad) ^ (lr & 7)) << 3); bf16x8 af_[4], bf_[4]; \
      _Pragma("unroll") for (int i_ = 0; i_ < 4; ++i_) { af_[i_] = *(const bf16x8*)(a_ + i_ * 1024 + co_); bf_[i_] = *(const bf16x8*)(b_ + i_ * 1024 + co_); } \
      _Pragma("unroll") for (int i_ = 0; i_ < 4; ++i_) _Pragma("unroll") for (int j_ = 0; j_ < 4; ++j_) \
        acc[i_][j_] = __builtin_amdgcn_mfma_f32_16x16x32_bf16(af_[i_], bf_[j_], acc[i_][j_], 0, 0, 0); } \
    if ((kt_) + 1 < nk) { LSTORE(buf_ ^ 1, RA, RB); if ((kt_) + 3 < nk) GLOAD((kt_) + 3, RA, RB); } \
    __syncthreads(); } while (0)
  const int nk = g.K >> 6;
  u32x4 pa0, pa1, pa2, pa3, pb0, pb1, pb2, pb3, qa0, qa1, qa2, qa3, qb0, qb1, qb2, qb3;
  qa0 = qa1 = qa2 = qa3 = qb0 = qb1 = qb2 = qb3 = (u32x4){0u, 0u, 0u, 0u};
  GLOAD(0, pa, pb);
  if (nk > 1) GLOAD(1, qa, qb);
  LSTORE(0, pa, pb);
  if (nk > 2) GLOAD(2, pa, pb);
  __syncthreads();
  for (int kt = 0; kt < nk; kt += 2) { GSTEP(kt, qa, qb); if (kt + 1 < nk) GSTEP(kt + 1, pa, pb); }
#pragma unroll
  for (int i = 0; i < 4; ++i) {
#pragma unroll
    for (int jj = 0; jj < 4; ++jj) {
      const int row = m0 + wm * 64 + i * 16 + quad * 4 + jj;
      if constexpr (Epi::PAIR) {
#pragma unroll
        for (int j = 0; j < 4; j += 2) {
          const int nn = n0 + wn * 64 + j * 16;
          epi.pair(row, (nn >> 5) * 16 + lr, acc[i][j][jj], acc[i][j + 1][jj]);
        }
      } else {
#pragma unroll
        for (int j = 0; j < 4; ++j) epi(row, n0 + wn * 64 + j * 16 + lr, acc[i][j][jj]);
      }
    }
  }
}

template <class Epi>
DEVI void gemm_job(const GemmDesc& g, Epi epi, int& tbase, char* smem) {
  const int ntiles = g.tiles_m * g.tiles_n, G = gridDim.x;
  const int first = tbase + (((int)blockIdx.x - tbase % G) + G) % G;
  const int width = 8 * g.tiles_n;
  for (int t = first; t < tbase + ntiles; t += G) {
    const int lt = t - tbase;
    const int grp = lt / width, rem = lt % width;
    gemm_tile(g, grp * 8 + (rem & 7), rem >> 3, epi, smem);
  }
  tbase += ntiles;
}

struct EpiStore { static constexpr bool PAIR = false; bf16* C; int ldc; float sc;
  DEVI void operator()(int r, int c, float v) { C[(size_t)r * ldc + c] = f2bf(v * sc); } };
struct EpiLora1 { static constexpr bool PAIR = false; bf16* C;
  DEVI void operator()(int r, int c, float v) { float o = c < 64 ? tanhf(v) : (c < 128 ? v : sigm(v)); C[(size_t)r * 256 + c] = f2bf(o); } };
struct EpiLd { static constexpr bool PAIR = false; bf16* C; const float* w0;
  DEVI void operator()(int r, int c, float v) { float x = w0[c] + v; float lr_ = -softplus(-x) - 0.5f; C[(size_t)r * 1024 + c] = f2bf(-__expf(lr_)); } };
struct EpiSig { static constexpr bool PAIR = false; bf16* C; const float* a0;
  DEVI void operator()(int r, int c, float v) { C[(size_t)r * 1024 + c] = f2bf(sigm(a0[c] + v)); } };
struct EpiAcc { static constexpr bool PAIR = false; float* X;
  DEVI void operator()(int r, int c, float v) { X[(size_t)r * 1024 + c] += v; } };
struct EpiSwiglu { static constexpr bool PAIR = true; bf16* C;
  DEVI void pair(int r, int c, float gt, float up) { C[(size_t)r * FF + c] = f2bf(silu(gt) * up); } };
struct EpiGlaIn { static constexpr bool PAIR = false; bf16 *q, *k, *v, *gate; float* sm;
  DEVI void operator()(int r, int c, float x) {
    if (c < 512) q[(size_t)r * 512 + c] = f2bf(x * 0.08838834764831845f);
    else if (c < 1024) k[(size_t)r * 512 + c - 512] = f2bf(x);
    else if (c < 2048) v[(size_t)r * 1024 + c - 1024] = f2bf(x);
    else if (c < 3072) gate[(size_t)r * 1024 + c - 2048] = f2bf(x);
    else if (c < 3088) sm[(size_t)r * 16 + c - 3072] = x;
  } };
struct EpiGdnIn { static constexpr bool PAIR = false; bf16 *qkv, *z; float* sm; float* out;
  DEVI void operator()(int r, int c, float x) {
    if (c < 3072) {
      qkv[(size_t)r * 3072 + c] = f2bf(x);
      if (r >= MPR - 3) {
        if (r < MPR) out[O_CCONV_P + (size_t)(r - (MPR - 3)) * 3072 + c] = x;
        else { int tt = (r - MPR) & 63; if (tt >= 61) out[O_CCONV_S + ((size_t)((r - MPR) >> 6) * 3 + (tt - 61)) * 3072 + c] = x; }
      }
    } else if (c < 4096) z[(size_t)r * 1024 + c - 3072] = f2bf(x);
    else if (c < 4112) sm[(size_t)r * 16 + c - 4096] = x;
  } };

template <class F>
DEVI void conv_job(F f, bf16* dst, int ldo, int Nd, int Kd, int& tbase, char* smem) {
  float* tile = (float*)smem;
  const int tn = Nd >> 6, tk = Kd >> 6, ntiles = tn * tk, G = gridDim.x, tid = threadIdx.x;
  const int first = tbase + (((int)blockIdx.x - tbase % G) + G) % G;
  for (int t = first; t < tbase + ntiles; t += G) {
    const int lt = t - tbase, n0 = (lt % tn) << 6, k0 = (lt / tn) << 6;
    const int i = tid >> 4, j4 = (tid & 15) << 2;
#pragma unroll
    for (int r = 0; r < 4; ++r) {
      float4 v = f(k0 + i + 16 * r, n0 + j4);
      float* d = tile + (i + 16 * r) * 65 + j4; d[0] = v.x; d[1] = v.y; d[2] = v.z; d[3] = v.w;
    }
    __syncthreads();
    const int jn = tid >> 2, iq = (tid & 3) << 4;
    unsigned w[8];
#pragma unroll
    for (int e = 0; e < 8; ++e) w[e] = pack2(tile[(iq + 2 * e) * 65 + jn], tile[(iq + 2 * e + 1) * 65 + jn]);
    uint4* o = (uint4*)(dst + (size_t)(n0 + jn) * ldo + k0 + iq);
    o[0] = make_uint4(w[0], w[1], w[2], w[3]); o[1] = make_uint4(w[4], w[5], w[6], w[7]);
    __syncthreads();
  }
  tbase += ntiles;
}
struct CvPlain { const float* W; int ld; int nsrc;
  DEVI float4 operator()(int k, int n) const { return n < nsrc ? *(const float4*)(W + (size_t)k * ld + n) : make_float4(0, 0, 0, 0); } };
struct CvFfnIn { const float* W;
  DEVI float4 operator()(int k, int n) const { int blk = n >> 5, w = n & 31; int src = (w < 16) ? blk * 16 + w : FF + blk * 16 + (w - 16);
    return *(const float4*)(W + (size_t)k * (2 * FF) + src); } };
struct CvLora1 { const float *w1, *a1, *g1, *mu;
  DEVI float4 operator()(int k, int n) const {
    int kk = k & 1023; float4 v; float m;
    if (n < 64) { v = *(const float4*)(w1 + kk * 64 + n); m = mu[1 * 1024 + kk]; }
    else if (n < 128) { v = *(const float4*)(a1 + kk * 64 + n - 64); m = mu[4 * 1024 + kk]; }
    else { v = *(const float4*)(g1 + kk * 128 + n - 128); m = mu[5 * 1024 + kk]; }
    float s = (k < 1024) ? (1.f - m) : m;
    return make_float4(v.x * s, v.y * s, v.z * s, v.w * s); } };
struct CvGlaIn { const float *win, *wa1;
  DEVI float4 operator()(int k, int n) const {
    if (n < 3072) return *(const float4*)(win + (size_t)k * 3072 + n);
    if (n < 3088) return *(const float4*)(wa1 + k * 16 + n - 3072);
    return make_float4(0, 0, 0, 0); } };

template <int TYPE>
DEVI void phase_norm(const P& p, int layer, int j, bool from_input, bool copy_x) {
  const int lane = threadIdx.x & 63, wave = threadIdx.x >> 6;
  const float* g = PIN(7) + layer * 1024;
  float* xres = POUT;
  bf16 *h = slot(p, 0), *hs = slot(p, 1), *xr = slot(p, 2), *xk = slot(p, 3), *xv = slot(p, 4);
  const float* mu = PIN(12) + (size_t)j * 6 * 1024;
  for (int row = blockIdx.x * 4 + wave; row < MT; row += gridDim.x * 4) {
    auto src = [&](int r) -> const float* {
      if (from_input) return r < MPR ? PIN(0) + (size_t)r * 1024 : PIN(1) + (size_t)(r - MPR) * 1024;
      return xres + (size_t)r * 1024; };
    const float* xp = src(row);
    float4 xv4[4]; float ss = 0.f;
#pragma unroll
    for (int i = 0; i < 4; ++i) { xv4[i] = *(const float4*)(xp + i * 256 + lane * 4); ss += xv4[i].x * xv4[i].x + xv4[i].y * xv4[i].y + xv4[i].z * xv4[i].z + xv4[i].w * xv4[i].w; }
    ss = wsum(ss);
    const float rstd = rsqrtf(ss * (1.f / 1024.f) + 1e-6f);
    if (copy_x) {
#pragma unroll
      for (int i = 0; i < 4; ++i) *(float4*)(xres + (size_t)row * 1024 + i * 256 + lane * 4) = xv4[i];
    }
    float hv[16];
#pragma unroll
    for (int i = 0; i < 4; ++i) { float4 gg = *(const float4*)(g + i * 256 + lane * 4);
      hv[i * 4 + 0] = xv4[i].x * rstd * gg.x; hv[i * 4 + 1] = xv4[i].y * rstd * gg.y; hv[i * 4 + 2] = xv4[i].z * rstd * gg.z; hv[i * 4 + 3] = xv4[i].w * rstd * gg.w; }
#pragma unroll
    for (int i = 0; i < 4; ++i) *(uint2*)(h + (size_t)row * 1024 + i * 256 + lane * 4) = make_uint2(pack2(hv[i * 4], hv[i * 4 + 1]), pack2(hv[i * 4 + 2], hv[i * 4 + 3]));
    if constexpr (TYPE == 0) {
      const bool is_p = row < MPR; const int tt = is_p ? row : ((row - MPR) & 63); const int b = is_p ? 0 : ((row - MPR) >> 6);
      float hp[16];
      if (tt == 0) {
        if (is_p) {
#pragma unroll
          for (int i = 0; i < 16; ++i) hp[i] = 0.f;
        } else {
          const float* sp = PIN(2) + ((size_t)j * NSS + b) * 1024;
#pragma unroll
          for (int i = 0; i < 4; ++i) { float4 v = *(const float4*)(sp + i * 256 + lane * 4); hp[i * 4] = v.x; hp[i * 4 + 1] = v.y; hp[i * 4 + 2] = v.z; hp[i * 4 + 3] = v.w; }
        }
      } else {
        const float* pp = src(row - 1); float4 pv[4]; float s2 = 0.f;
#pragma unroll
        for (int i = 0; i < 4; ++i) { pv[i] = *(const float4*)(pp + i * 256 + lane * 4); s2 += pv[i].x * pv[i].x + pv[i].y * pv[i].y + pv[i].z * pv[i].z + pv[i].w * pv[i].w; }
        s2 = wsum(s2); const float r2 = rsqrtf(s2 * (1.f / 1024.f) + 1e-6f);
#pragma unroll
        for (int i = 0; i < 4; ++i) { float4 gg = *(const float4*)(g + i * 256 + lane * 4);
          hp[i * 4] = pv[i].x * r2 * gg.x; hp[i * 4 + 1] = pv[i].y * r2 * gg.y; hp[i * 4 + 2] = pv[i].z * r2 * gg.z; hp[i * 4 + 3] = pv[i].w * r2 * gg.w; }
      }
#pragma unroll
      for (int i = 0; i < 4; ++i) {
        const int col = i * 256 + lane * 4; const size_t o = (size_t)row * 1024 + col;
        float4 m0 = *(const float4*)(mu + 0 * 1024 + col), m2 = *(const float4*)(mu + 2 * 1024 + col), m3 = *(const float4*)(mu + 3 * 1024 + col);
        const float mm0[4] = {m0.x, m0.y, m0.z, m0.w}, mm2[4] = {m2.x, m2.y, m2.z, m2.w}, mm3[4] = {m3.x, m3.y, m3.z, m3.w};
        float a[4], bb[4], c[4];
#pragma unroll
        for (int e = 0; e < 4; ++e) { float hh = hv[i * 4 + e], xx = hp[i * 4 + e] - hh; a[e] = hh + xx * mm0[e]; bb[e] = hh + xx * mm2[e]; c[e] = hh + xx * mm3[e]; }
        *(uint2*)(hs + o) = make_uint2(pack2(hp[i * 4], hp[i * 4 + 1]), pack2(hp[i * 4 + 2], hp[i * 4 + 3]));
        *(uint2*)(xr + o) = make_uint2(pack2(a[0], a[1]), pack2(a[2], a[3]));
        *(uint2*)(xk + o) = make_uint2(pack2(bb[0], bb[1]), pack2(bb[2], bb[3]));
        *(uint2*)(xv + o) = make_uint2(pack2(c[0], c[1]), pack2(c[2], c[3]));
      }
      if (is_p ? (row == MPR - 1) : (tt == 63)) {
        float* o = POUT + (is_p ? O_ASH_P + (size_t)j * 1024 : O_ASH_S + ((size_t)j * NSS + b) * 1024);
#pragma unroll
        for (int i = 0; i < 4; ++i) *(float4*)(o + i * 256 + lane * 4) = make_float4(hv[i * 4], hv[i * 4 + 1], hv[i * 4 + 2], hv[i * 4 + 3]);
      }
    }
  }
}

DEVI void phase_rms(const float* x, const float* g, bf16* dst, float* fdst) {
  const int lane = threadIdx.x & 63, wave = threadIdx.x >> 6;
  const int nw = gridDim.x * 4;
  for (int row = blockIdx.x * 4 + wave; row < MT; row += 2 * nw) {
    const int row2 = row + nw; const bool has2 = row2 < MT;
    float4 v[4], v2[4]; float ss = 0.f, ss2 = 0.f;
#pragma unroll
    for (int i = 0; i < 4; ++i) v[i] = *(const float4*)(x + (size_t)row * 1024 + i * 256 + lane * 4);
    if (has2) {
#pragma unroll
      for (int i = 0; i < 4; ++i) v2[i] = *(const float4*)(x + (size_t)row2 * 1024 + i * 256 + lane * 4);
    } else {
#pragma unroll
      for (int i = 0; i < 4; ++i) v2[i] = make_float4(0.f, 0.f, 0.f, 0.f);
    }
#pragma unroll
    for (int i = 0; i < 4; ++i) { ss += v[i].x * v[i].x + v[i].y * v[i].y + v[i].z * v[i].z + v[i].w * v[i].w; ss2 += v2[i].x * v2[i].x + v2[i].y * v2[i].y + v2[i].z * v2[i].z + v2[i].w * v2[i].w; }
    ss = wsum(ss); ss2 = wsum(ss2);
    const float r = rsqrtf(ss * (1.f / 1024.f) + 1e-6f), r2 = rsqrtf(ss2 * (1.f / 1024.f) + 1e-6f);
#pragma unroll
    for (int i = 0; i < 4; ++i) { float4 gg = *(const float4*)(g + i * 256 + lane * 4);
      { float a = v[i].x * r * gg.x, b = v[i].y * r * gg.y, c = v[i].z * r * gg.z, d = v[i].w * r * gg.w;
        if (dst) *(uint2*)(dst + (size_t)row * 1024 + i * 256 + lane * 4) = make_uint2(pack2(a, b), pack2(c, d));
        else *(float4*)(fdst + (size_t)row * 1024 + i * 256 + lane * 4) = make_float4(a, b, c, d); }
      if (has2) { float a = v2[i].x * r2 * gg.x, b = v2[i].y * r2 * gg.y, c = v2[i].z * r2 * gg.z, d = v2[i].w * r2 * gg.w;
        if (dst) *(uint2*)(dst + (size_t)row2 * 1024 + i * 256 + lane * 4) = make_uint2(pack2(a, b), pack2(c, d));
        else *(float4*)(fdst + (size_t)row2 * 1024 + i * 256 + lane * 4) = make_float4(a, b, c, d); }
    }
  }
}

DEVI void phase_gdn_conv(const P& p) {
  const bf16* qkv = slot(p, 1); const float* cw = PIN(35); const float* cst = PIN(5);
  const int tid = threadIdx.x;
  for (int item = blockIdx.x; item < (MT / 8) * 3; item += gridDim.x) {
    const int row0 = (item / 3) * 8, sec = item % 3, ch = sec * 1024 + tid * 4;
    const bool is_p = row0 < MPR; const int tt0 = is_p ? row0 : ((row0 - MPR) & 63); const int b = is_p ? 0 : ((row0 - MPR) >> 6);
    float x[11][4];
#pragma unroll
    for (int i = 0; i < 11; ++i) {
      const int pt = tt0 + i;
      if (pt >= 3) { uint2 u = *(const uint2*)(qkv + (size_t)(row0 + i - 3) * 3072 + ch);
        x[i][0] = bf2f(u.x & 0xffff); x[i][1] = bf2f(u.x >> 16); x[i][2] = bf2f(u.y & 0xffff); x[i][3] = bf2f(u.y >> 16); }
      else if (!is_p) { float4 s = *(const float4*)(cst + ((size_t)b * 3 + pt) * 3072 + ch); x[i][0] = s.x; x[i][1] = s.y; x[i][2] = s.z; x[i][3] = s.w; }
      else { x[i][0] = x[i][1] = x[i][2] = x[i][3] = 0.f; }
    }
    float w[4][4];
#pragma unroll
    for (int i = 0; i < 4; ++i) { float4 ww = *(const float4*)(cw + i * 3072 + ch); w[i][0] = ww.x; w[i][1] = ww.y; w[i][2] = ww.z; w[i][3] = ww.w; }
#pragma unroll
    for (int o = 0; o < 8; ++o) {
      float acc[4];
#pragma unroll
      for (int e = 0; e < 4; ++e) { acc[e] = x[o][e] * w[0][e] + x[o + 1][e] * w[1][e] + x[o + 2][e] * w[2][e] + x[o + 3][e] * w[3][e]; acc[e] = silu(acc[e]); }
      if (sec < 2) {
        float ss = acc[0] * acc[0] + acc[1] * acc[1] + acc[2] * acc[2] + acc[3] * acc[3];
#pragma unroll
        for (int sft = 16; sft > 0; sft >>= 1) ss += __shfl_xor(ss, sft);
        const float r = rsqrtf(ss + 1e-6f) * (sec == 0 ? 0.08838834764831845f : 1.f);
#pragma unroll
        for (int e = 0; e < 4; ++e) acc[e] *= r;
      }
      *(uint2*)(slot(p, 5 + sec) + (size_t)(row0 + o) * 1024 + tid * 4) = make_uint2(pack2(acc[0], acc[1]), pack2(acc[2], acc[3]));
    }
  }
}

DEVI void mm_strip(const bf16* At, const bf16* Bt, f32x4 (&acc)[4], int wave, int lane) {
  const int lr = lane & 15, quad = lane >> 4;
#pragma unroll
  for (int ks = 0; ks < 2; ++ks) {
    bf16x8 a = *(const bf16x8*)(At + (wave * 16 + lr) * 72 + ks * 32 + quad * 8);
#pragma unroll
    for (int nb = 0; nb < 4; ++nb) {
      bf16x8 b = *(const bf16x8*)(Bt + (nb * 16 + lr) * 72 + ks * 32 + quad * 8);
      acc[nb] = __builtin_amdgcn_mfma_f32_16x16x32_bf16(a, b, acc[nb], 0, 0, 0);
    }
  }
}
DEVI void zero4(f32x4 (&a)[4]) {
#pragma unroll
  for (int i = 0; i < 4; ++i) a[i] = (f32x4){0.f, 0.f, 0.f, 0.f};
}

DEVI int perm32(int x) { return (x & ~31) | (((x >> 2) & 3) << 3) | (((x >> 4) & 1) << 2) | (x & 3); }
template <int CW> DEVI size_t cont_off(int r, int s, int LD) { const int idx = r * 64 + s; return (size_t)(idx / CW) * LD + (idx % CW); }

template <int TYPE>
DEVI void phase_prep(const P& p, int j, char* smem) {
  constexpr int NH = TYPE == 0 ? 16 : (TYPE == 1 ? 4 : 8);
  constexpr int DK = TYPE == 0 ? 64 : 128;
  constexpr int DV = TYPE == 0 ? 64 : (TYPE == 1 ? 256 : 128);
  constexpr bool LOW = TYPE != 1;
  constexpr int KT = 256 / DK, TPT = 64 / KT, DKH = DK / 64, DVH = DV / 64;
  constexpr int LDQ = TYPE == 1 ? 512 : 1024;
  bf16* X0 = (bf16*)smem; bf16* X1 = X0 + 4608; bf16* Y0 = X1 + 4608; bf16* Y1 = Y0 + 4608;
  float* Lb = (float*)smem;
  bf16* LkT = (bf16*)(smem + 16384); bf16* Ak = LkT + 4608; bf16* nAb = Ak + 4608;
  bf16* M1 = (bf16*)smem;
  bf16* Tt = (bf16*)(smem + 44032); bf16* St1 = Tt + 4608; bf16* St2 = St1 + 4608;
  if (TYPE == 1) { Y0 = (bf16*)(smem + 9216); Ak = (bf16*)(smem + 18432); St1 = (bf16*)(smem + 27648); }
  float* lgL = (float*)(smem + 36864);
  float* tot = (float*)(smem + 71680);
  float* sc_beta = (float*)(smem + 73728);
  float* sc_eg = sc_beta + 64; float* sc_lg = sc_eg + 64; float* sc_g = sc_lg + 64;

  bf16 *Aq, *Akk, *Av, *Ald = nullptr, *Aa = nullptr, *Oq, *Okt, *Ovt, *Ow = nullptr, *Obt = nullptr, *Ool, *Ou0 = nullptr;
  if (TYPE == 0) { Aq = slot(p, 5); Akk = slot(p, 6); Av = slot(p, 7); Ald = slot(p, 2); Aa = slot(p, 3);
    Oq = Aq; Okt = Akk; Ovt = Av; Ow = Ald; Obt = Aa; Ool = slot(p, 0); Ou0 = slot(p, 1); }
  else if (TYPE == 1) { Aq = slot(p, 1); Akk = slot(p, 1) + (size_t)MT * 512; Av = slot(p, 2); Oq = Aq; Okt = Akk; Ovt = Av; Ool = slot(p, 4); }
  else { Aq = slot(p, 5); Akk = slot(p, 6); Av = slot(p, 7); Oq = Aq; Okt = Akk; Ovt = Av; Ow = slot(p, 1); Obt = slot(p, 2); Ool = slot(p, 3); Ou0 = slot(p, 0); }
  float* sm = (float*)(PWS + WS_SM);
  float* gam = (float*)(PWS + WS_GAM);

  for (int item = blockIdx.x; item < NCHUNK * NH; item += gridDim.x) {
    const int c = item / NH, h = item % NH;
    const size_t rb = (size_t)c * 64;
    int tid = threadIdx.x; asm volatile("" : "+v"(tid));
    const int lane = tid & 63, wave = tid >> 6, lr = lane & 15, quad = lane >> 4;
    const int k = tid % DK, tg = tid / DK;
    const int vv = tid & 63, tgv = tid >> 6;
    unsigned qP[TPT / 2], ktP[TPT / 2], kapP[(TYPE == 0) ? TPT / 2 : 1], bvP[(TYPE == 0) ? TPT / 2 : 1];
    float lg[(TYPE == 0) ? TPT : 1], ldv[(TYPE == 0) ? TPT : 1];
    unsigned vP[DVH][8];
    auto lo16 = [](unsigned w) { return __uint_as_float(w << 16); };
    auto hi16 = [](unsigned w) { return __uint_as_float(w & 0xffff0000u); };
#define GETP(arr, e) (((e) & 1) ? hi16(arr[(e) >> 1]) : lo16(arr[(e) >> 1]))
#pragma unroll
    for (int vh = 0; vh < DVH; ++vh) {
      bf16 va[16];
#pragma unroll
      for (int e = 0; e < 16; ++e) va[e] = Av[(rb + tgv * 16 + e) * 1024 + h * DV + vh * 64 + vv];
#pragma unroll
      for (int e = 0; e < 8; ++e) { vP[vh][e] = (unsigned)va[2 * e] | ((unsigned)va[2 * e + 1] << 16); asm volatile("" : "+v"(vP[vh][e])); }
    }
    if constexpr (TYPE == 2) {
      if (tid < 64) {
        const float a_log = PIN(36)[h], dtb = PIN(37)[h];
        const float braw = sm[(rb + tid) * 16 + h], araw = sm[(rb + tid) * 16 + 8 + h];
        const float gt = -__expf(a_log) * softplus(araw + dtb);
        sc_beta[tid] = sigm(braw); sc_eg[tid] = __expf(gt); sc_g[tid] = gt;
        float cs = gt;
#pragma unroll
        for (int o = 1; o < 64; o <<= 1) { float n = __shfl_up(cs, o); if (lane >= o) cs += n; }
        sc_lg[tid] = cs;
      }
      __syncthreads();
    }
    if constexpr (TYPE == 0) {
      const float k_k = PIN(21)[j * 1024 + h * 64 + k], k_a = PIN(22)[j * 1024 + h * 64 + k], r_k = PIN(23)[j * 1024 + h * 64 + k];
      float run = 0.f;
      bf16 rr[TPT], rk[TPT], ra[TPT], rl[TPT];
#pragma unroll
      for (int e = 0; e < TPT; ++e) {
        const size_t o = (rb + tg * TPT + e) * 1024 + h * 64 + k;
        rr[e] = Aq[o]; rk[e] = Akk[o]; ra[e] = Aa[o]; rl[e] = Ald[o];
      }
#pragma unroll
      for (int e2 = 0; e2 < TPT / 2; ++e2) {
        float qq[2], ka[2], kq[2], bq[2];
#pragma unroll
        for (int u = 0; u < 2; ++u) {
          const int e = e2 * 2 + u;
          const float r = bf2f(rr[e]), kr = bf2f(rk[e]), av = bf2f(ra[e]), l = bf2f(rl[e]);
          const float kk = kr * k_k;
          const float inv = rsqrtf(fmaxf(wsum(kk * kk), 1e-24f));
          qq[u] = r; ka[u] = kk * inv; kq[u] = kr * (1.f + (av - 1.f) * k_a); bq[u] = ka[u] * av; ldv[e] = l;
          const float bo = wsum(r * kq[u] * r_k);
          if (lane == 0) sm[(rb + tg * TPT + e) * 16 + h] = bo;
          run += l; lg[e] = run;
        }
        qP[e2] = pack2(qq[0], qq[1]); kapP[e2] = pack2(ka[0], ka[1]); ktP[e2] = pack2(kq[0], kq[1]); bvP[e2] = pack2(bq[0], bq[1]);
        asm volatile("" : "+v"(qP[e2]), "+v"(kapP[e2]), "+v"(ktP[e2]), "+v"(bvP[e2]));
      }
      tot[tg * 128 + k] = run;
    } else if constexpr (TYPE == 1) {
      float w2[16];
#pragma unroll
      for (int i = 0; i < 16; ++i) w2[i] = PIN(30)[i * 512 + h * 128 + k];
      const float ba = PIN(31)[h * 128 + k];
      float* a1s = (float*)(smem + 69632);
      (void)a1s;
      bf16 rq[TPT], rk[TPT];
#pragma unroll
      for (int e = 0; e < TPT; ++e) { const size_t row = rb + tg * TPT + e; rq[e] = Aq[row * 512 + h * 128 + k]; rk[e] = Akk[row * 512 + h * 128 + k]; }
      float4 ar[TPT][4];
      float run = 0.f;
#pragma unroll
      for (int e = 0; e < TPT; e += 4) {
#pragma unroll
        for (int u = 0; u < 4; ++u)
#pragma unroll
          for (int q4 = 0; q4 < 4; ++q4) ar[e + u][q4] = *(const float4*)(sm + (rb + tg * TPT + e + u) * 16 + q4 * 4);
#pragma unroll
        for (int u = 0; u < 4; ++u) {
          float s = ba;
#pragma unroll
          for (int q4 = 0; q4 < 4; ++q4) { const float4 a4 = ar[e + u][q4]; s += a4.x * w2[q4 * 4] + a4.y * w2[q4 * 4 + 1] + a4.z * w2[q4 * 4 + 2] + a4.w * w2[q4 * 4 + 3]; }
          const float gk = (fminf(s, 0.f) - log1pf(__expf(-fabsf(s)))) * (1.f / 16.f);
          run += gk; lgL[(tg * TPT + e + u) * 128 + k] = run;
        }
      }
#pragma unroll
      for (int e2 = 0; e2 < TPT / 2; ++e2) {
        qP[e2] = (unsigned)rq[2 * e2] | ((unsigned)rq[2 * e2 + 1] << 16);
        ktP[e2] = (unsigned)rk[2 * e2] | ((unsigned)rk[2 * e2 + 1] << 16);
        asm volatile("" : "+v"(qP[e2]), "+v"(ktP[e2]));
      }
      tot[tg * 128 + k] = run;
    } else {
      bf16 rq[TPT], rk[TPT];
#pragma unroll
      for (int e = 0; e < TPT; ++e) { const size_t o = (rb + tg * TPT + e) * 1024 + h * 128 + k; rq[e] = Aq[o]; rk[e] = Akk[o]; }
#pragma unroll
      for (int e2 = 0; e2 < TPT / 2; ++e2) {
        qP[e2] = (unsigned)rq[2 * e2] | ((unsigned)rq[2 * e2 + 1] << 16);
        ktP[e2] = (unsigned)rk[2 * e2] | ((unsigned)rk[2 * e2 + 1] << 16);
        asm volatile("" : "+v"(qP[e2]), "+v"(ktP[e2]));
      }
    }
    __syncthreads();
    float lgC;
    if constexpr (TYPE == 2) { lgC = sc_lg[63]; }
    else {
      float off = 0.f, all = 0.f;
#pragma unroll
      for (int g2 = 0; g2 < KT; ++g2) { const float tv = tot[g2 * 128 + k]; all += tv; if (g2 < tg) off += tv; }
      if constexpr (TYPE == 0) {
#pragma unroll
        for (int e = 0; e < TPT; ++e) lg[e] += off;
      } else {
#pragma unroll
        for (int e = 0; e < TPT; ++e) lgL[(tg * TPT + e) * 128 + k] += off;
      }
      lgC = all;
    }
#define QV(e) GETP(qP, e)
#define LGV(e, t) ((TYPE == 2) ? sc_lg[t] : ((TYPE == 1) ? lgL[(t) * 128 + k] : lg[(TYPE == 0) ? (e) : 0]))
#define LPREV(e, t) ((TYPE == 0) ? (lg[(TYPE == 0) ? (e) : 0] - ldv[(TYPE == 0) ? (e) : 0]) : (sc_lg[t] - sc_g[t]))
#define KTV(e, t) ((TYPE == 2) ? (sc_beta[t] * GETP(ktP, e)) : GETP(ktP, e))
#define KAPV(e, t) ((TYPE == 2) ? GETP(ktP, e) : GETP(kapP, (TYPE == 0) ? (e) : 0))
#define BVV(e, t) ((TYPE == 2) ? (sc_beta[t] * sc_eg[t] * GETP(ktP, e)) : GETP(bvP, (TYPE == 0) ? (e) : 0))
    f32x4 sacc[LOW ? 4 : 1][4];
#pragma unroll
    for (int a = 0; a < (LOW ? 4 : 1); ++a) zero4(sacc[a]);
#pragma unroll
    for (int kh = 0; kh < DKH; ++kh) {
      if (k / 64 == kh) {
        const int kk = k & 63;
#pragma unroll
        for (int e = 0; e < TPT; ++e) {
          const int t = tg * TPT + e;
          if constexpr (TYPE == 2) {
            X0[t * 72 + kk] = f2bf(QV(e)); Y0[t * 72 + kk] = f2bf(KTV(e, t));
            X1[t * 72 + kk] = f2bf(KAPV(e, t)); Y1[t * 72 + kk] = f2bf(BVV(e, t));
          } else {
            const float lgt = LGV(e, t);
            const float el = __expf(lgt), eml = __expf(-lgt);
            X0[t * 72 + kk] = f2bf(QV(e) * el);
            Y0[t * 72 + kk] = f2bf(KTV(e, t) * eml);
            if constexpr (LOW) {
              X1[t * 72 + kk] = f2bf(KAPV(e, t) * __expf(LPREV(e, t)));
              Y1[t * 72 + kk] = f2bf(BVV(e, t) * eml);
            }
          }
        }
      }
      __syncthreads();
      mm_strip(X0, Y0, sacc[0], wave, lane);
      if constexpr (LOW) { mm_strip(X0, Y1, sacc[1], wave, lane); mm_strip(X1, Y0, sacc[2], wave, lane); mm_strip(X1, Y1, sacc[3], wave, lane); }
      __syncthreads();
    }
#pragma unroll
    for (int nb = 0; nb < 4; ++nb)
#pragma unroll
      for (int jj = 0; jj < 4; ++jj) {
        const int t = wave * 16 + quad * 4 + jj, s = nb * 16 + lr;
        float da = 1.f, dl = 1.f;
        if constexpr (TYPE == 2) { const float dd = sc_lg[t] - sc_lg[s]; da = __expf(fminf(dd, 0.f)); dl = __expf(fminf(dd - sc_g[t], 0.f)); }
        Ak[t * 72 + s] = f2bf(s <= t ? sacc[0][nb][jj] * da : 0.f);
        if constexpr (LOW) {
          nAb[t * 72 + s] = f2bf(s <= t ? -sacc[1][nb][jj] * da : 0.f);
          LkT[s * 72 + t] = f2bf(s < t ? sacc[2][nb][jj] * dl : 0.f);
          Lb[t * 64 + (s & 3) * 16 + (s >> 2)] = s < t ? sacc[3][nb][jj] * dl : 0.f;
        }
      }
    __syncthreads();
    f32x4 acc[4];
    if constexpr (LOW) {
      {
        const int q = lane & 3, jc = wave * 16 + (lane >> 2);
        float xr[16];
#pragma unroll
        for (int i = 0; i < 16; ++i) xr[i] = 0.f;
#pragma unroll
        for (int t = 0; t < 64; ++t) {
          float s = 0.f, s2 = 0.f;
          const float* Lr = Lb + t * 64 + q * 16;
#pragma unroll
          for (int i = 0; i < (t + 3) / 4; ++i) { if (i & 1) s2 += Lr[i] * xr[i]; else s += Lr[i] * xr[i]; }
          s += s2;
          s += __shfl_xor(s, 1); s += __shfl_xor(s, 2);
          s = ((t == jc) ? 1.f : 0.f) - s;
          xr[t >> 2] = (q == (t & 3)) ? s : xr[t >> 2];
          if (q == 0) Tt[t * 72 + jc] = f2bf(s);
        }
      }
      __syncthreads();
      zero4(acc); mm_strip(Tt, LkT, acc, wave, lane);
#pragma unroll
      for (int nb = 0; nb < 4; ++nb)
#pragma unroll
        for (int jj = 0; jj < 4; ++jj) M1[(wave * 16 + quad * 4 + jj) * 72 + nb * 16 + lr] = f2bf(acc[nb][jj]);
      __syncthreads();
    }
#pragma unroll
    for (int vh = 0; vh < DVH; ++vh) {
#pragma unroll
      for (int e = 0; e < 8; ++e) *(unsigned*)(St1 + vv * 72 + tgv * 16 + 2 * e) = vP[vh][e];
      __syncthreads();
      if constexpr (LOW) {
        zero4(acc); mm_strip(M1, St1, acc, wave, lane);
#pragma unroll
        for (int nb = 0; nb < 4; ++nb)
#pragma unroll
          for (int jj = 0; jj < 4; ++jj) {
            const int t = wave * 16 + quad * 4 + jj, col = nb * 16 + lr; const bf16 u = f2bf(acc[nb][jj]);
            St2[col * 72 + t] = u;
          }
#pragma unroll
        for (int nb = 0; nb < 4; ++nb)
          *(uint2*)(Ou0 + (((((size_t)c * NH + h) * (DV / 16) + vh * 4 + nb) * 4 + wave) * 64 + lane) * 4) = make_uint2(pack2(acc[nb][0], acc[nb][1]), pack2(acc[nb][2], acc[nb][3]));
        __syncthreads();
      }
      zero4(acc); mm_strip(Ak, St1, acc, wave, lane);
      if constexpr (LOW) mm_strip(nAb, St2, acc, wave, lane);
#pragma unroll
      for (int nb = 0; nb < 4; ++nb)
        *(uint2*)(Ool + (((((size_t)c * NH + h) * (DV / 16) + vh * 4 + nb) * 4 + wave) * 64 + lane) * 4) = make_uint2(pack2(acc[nb][0], acc[nb][1]), pack2(acc[nb][2], acc[nb][3]));
      __syncthreads();
    }
    if constexpr (LOW) {
#pragma unroll
      for (int kh = 0; kh < DKH; ++kh) {
        if (k / 64 == kh) {
          const int kk = k & 63;
#pragma unroll
          for (int e = 0; e < TPT; ++e) {
            const int t = tg * TPT + e;
            St1[kk * 72 + t] = f2bf(KAPV(e, t) * __expf(LPREV(e, t)));
            LkT[t * 72 + kk] = f2bf(QV(e) * __expf(LGV(e, t)));
            }
        }
        __syncthreads();
        zero4(acc); mm_strip(Tt, St1, acc, wave, lane);
#pragma unroll
        for (int nb = 0; nb < 4; ++nb)
#pragma unroll
          for (int jj = 0; jj < 4; ++jj) {
            const int t = wave * 16 + quad * 4 + jj, col = nb * 16 + lr; const bf16 u = f2bf(acc[nb][jj]);
            St2[col * 72 + t] = u;
            Ow[(rb + t) * 1024 + h * DK + perm32(kh * 64 + col)] = u;
          }
        __syncthreads();
        zero4(acc); mm_strip(nAb, St2, acc, wave, lane);
#pragma unroll
        for (int nb = 0; nb < 4; ++nb)
#pragma unroll
          for (int jj = 0; jj < 4; ++jj) {
            const int t = wave * 16 + quad * 4 + jj, col = nb * 16 + lr;
            Oq[(rb + t) * LDQ + h * DK + perm32(kh * 64 + col)] = f2bf(acc[nb][jj] + bf2f(LkT[t * 72 + col]));
          }
        __syncthreads();
      }
    } else {
#pragma unroll
      for (int e = 0; e < TPT; ++e) { Oq[(rb + tg * TPT + e) * LDQ + h * DK + perm32(k)] = f2bf(QV(e) * __expf(LGV(e, tg * TPT + e))); }
    }
    {
      unsigned wk[TPT / 2], wb[LOW ? TPT / 2 : 1];
#pragma unroll
      for (int e = 0; e < TPT; e += 2) {
        const int t0 = tg * TPT + e;
        const float d0 = __expf(lgC - LGV(e, t0)), d1 = __expf(lgC - LGV(e + 1, t0 + 1));
        wk[e / 2] = pack2(KTV(e, t0) * d0, KTV(e + 1, t0 + 1) * d1);
        if constexpr (LOW) wb[e / 2] = pack2(BVV(e, t0) * d0, BVV(e + 1, t0 + 1) * d1);
      }
      const size_t co = rb * LDQ + h * DK + cont_off<DK>(k, tg * TPT, LDQ);
#pragma unroll
      for (int e = 0; e < TPT / 8; ++e) {
        *(uint4*)(Okt + co + e * 8) = make_uint4(wk[e * 4], wk[e * 4 + 1], wk[e * 4 + 2], wk[e * 4 + 3]);
        if constexpr (LOW) {
#pragma unroll
          for (int g4 = 0; g4 < 2; ++g4) {
            const int s0 = tg * TPT + e * 8 + g4 * 4;
            *(uint2*)(Obt + rb * 1024 + h * DK + cont_off<DK>(k, perm32(s0), 1024)) = make_uint2(wb[e * 4 + g4 * 2], wb[e * 4 + g4 * 2 + 1]);
          }
        }
      }
#pragma unroll
      for (int vh = 0; vh < DVH; ++vh) {
        const unsigned* wv = vP[vh];
        const size_t vo = rb * 1024 + h * DV + cont_off<DV>(vh * 64 + vv, tgv * 16, 1024);
        *(uint4*)(Ovt + vo) = make_uint4(wv[0], wv[1], wv[2], wv[3]);
        *(uint4*)(Ovt + vo + 8) = make_uint4(wv[4], wv[5], wv[6], wv[7]);
      }
      if (tg == 0) gam[((size_t)c * NH + h) * DK + k] = __expf(lgC);
    }
    __syncthreads();
  }
}

template <int TYPE>
DEVI void phase_seq(const P& p, int j) {
  constexpr int NH = TYPE == 0 ? 16 : (TYPE == 1 ? 4 : 8);
  constexpr int DK = TYPE == 0 ? 64 : 128;
  constexpr int DV = TYPE == 0 ? 64 : (TYPE == 1 ? 256 : 128);
  constexpr bool LOW = TYPE != 1;
  constexpr int NVB = DV / 16, MB = DK / 16, KS = DK / 32;
  constexpr int LDQ = TYPE == 1 ? 512 : 1024;
  constexpr int IPS = NH * NVB;
  const int lane = threadIdx.x & 63, wave = threadIdx.x >> 6, lr = lane & 15, quad = lane >> 4;
  const bf16 *Qp, *Kt, *Vt, *Wp = nullptr, *Bt = nullptr, *U0 = nullptr; bf16* Ol;
  if (TYPE == 0) { Qp = slot(p, 5); Kt = slot(p, 6); Vt = slot(p, 7); Wp = slot(p, 2); Bt = slot(p, 3); Ol = slot(p, 0); U0 = slot(p, 1); }
  else if (TYPE == 1) { Qp = slot(p, 1); Kt = slot(p, 1) + (size_t)MT * 512; Vt = slot(p, 2); Ol = slot(p, 4); }
  else { Qp = slot(p, 5); Kt = slot(p, 6); Vt = slot(p, 7); Wp = slot(p, 1); Bt = slot(p, 2); Ol = slot(p, 3); U0 = slot(p, 0); }
  const float* gam = (const float*)(PWS + WS_GAM);
  const int nitems = 33 * IPS;
  for (int item = wave * gridDim.x + blockIdx.x; item < nitems; item += gridDim.x * 4) {
    const int seq = item / IPS, rem = item % IPS, h = rem / NVB, vb = rem % NVB;
    const int c0 = seq == 0 ? 0 : NPCH + seq - 1, nc = seq == 0 ? NPCH : 1;
    const int vcol = vb * 16 + lr;
    f32x4 H[MB];
    if (seq == 0) {
#pragma unroll
      for (int m = 0; m < MB; ++m) H[m] = (f32x4){0.f, 0.f, 0.f, 0.f};
    } else {
      const int b = seq - 1;
      if (TYPE == 0) {
        const float* S = PIN(3) + (((size_t)j * NSS + b) * 16 + h) * 4096 + (size_t)vcol * 64;
#pragma unroll
        for (int m = 0; m < MB; ++m) { float4 v = *(const float4*)(S + m * 16 + quad * 4); H[m] = (f32x4){v.x, v.y, v.z, v.w}; }
      } else {
        const float* S = PIN(TYPE == 1 ? 4 : 6) + ((size_t)b * NH + h) * DK * DV + vcol;
#pragma unroll
        for (int m = 0; m < MB; ++m)
#pragma unroll
          for (int jj = 0; jj < 4; ++jj) H[m][jj] = S[(size_t)(m * 16 + quad * 4 + jj) * DV];
      }
    }
    unsigned tsink = 0;
    for (int c = c0; c < c0 + nc; ++c) {
      const size_t rb = (size_t)c * 64;
      int ln = threadIdx.x & 63; asm volatile("" : "+v"(ln));
      const int lr = ln & 15, quad = ln >> 4, vcol = vb * 16 + lr;
      const bf16* qb = Qp + rb * LDQ + h * DK;
      const bf16* wb = LOW ? Wp + rb * 1024 + h * DK : nullptr;
      const bf16* kb = Kt + rb * LDQ + h * DK;
      const bf16* bb = LOW ? Bt + rb * 1024 + h * DK : nullptr;
      const bf16* vtb = Vt + rb * 1024 + h * DV;
      const size_t fo = ((((size_t)c * NH + h) * NVB + vb) * 4) * 256 + ln * 4;
      const float* gp = gam + ((size_t)c * NH + h) * DK + quad * 4;
      bf16x8 hb[KS];
#pragma unroll
      for (int ks = 0; ks < KS; ++ks) {
        const u32x4 hw = {pack2(H[2 * ks][0], H[2 * ks][1]), pack2(H[2 * ks][2], H[2 * ks][3]), pack2(H[2 * ks + 1][0], H[2 * ks + 1][1]), pack2(H[2 * ks + 1][2], H[2 * ks + 1][3])};
        hb[ks] = __builtin_bit_cast(bf16x8, hw);
      }
      uint2 oin[4], uin[4]; bf16x8 qa[4][KS], wa[LOW ? 4 : 1][KS];
      bf16x8 vbop[2], kfr[MB][2], bfr[LOW ? MB : 1][2]; float4 gv[MB];
#define LOAD_A(tb) do { oin[tb] = *(const uint2*)(Ol + fo + (tb) * 256); if constexpr (LOW) uin[tb] = *(const uint2*)(U0 + fo + (tb) * 256); \
        _Pragma("unroll") for (int ks = 0; ks < KS; ++ks) { const int off_ = ((tb) * 16 + lr) * LDQ + ks * 32 + quad * 4; \
          bf16x4 lo_ = *(const bf16x4*)(qb + off_), hi_ = *(const bf16x4*)(qb + off_ + 16); qa[tb][ks] = __builtin_shufflevector(lo_, hi_, 0, 1, 2, 3, 4, 5, 6, 7); \
          if constexpr (LOW) { const int ow_ = ((tb) * 16 + lr) * 1024 + ks * 32 + quad * 4; bf16x4 wl_ = *(const bf16x4*)(wb + ow_), wh_ = *(const bf16x4*)(wb + ow_ + 16); \
            wa[tb][ks] = __builtin_shufflevector(wl_, wh_, 0, 1, 2, 3, 4, 5, 6, 7); } } } while (0)
#define COMP_A(tb) do { f32x4 o_, u_; \
        o_ = (f32x4){bf2f(oin[tb].x & 0xffff), bf2f(oin[tb].x >> 16), bf2f(oin[tb].y & 0xffff), bf2f(oin[tb].y >> 16)}; \
        if constexpr (LOW) u_ = (f32x4){bf2f(uin[tb].x & 0xffff), bf2f(uin[tb].x >> 16), bf2f(uin[tb].y & 0xffff), bf2f(uin[tb].y >> 16)}; \
        _Pragma("unroll") for (int ks = 0; ks < KS; ++ks) { o_ = __builtin_amdgcn_mfma_f32_16x16x32_bf16(qa[tb][ks], hb[ks], o_, 0, 0, 0); \
          if constexpr (LOW) u_ = __builtin_amdgcn_mfma_f32_16x16x32_bf16(wa[tb][ks], hb[ks], u_, 0, 0, 0); } \
        *(uint2*)(Ol + fo + (tb) * 256) = make_uint2(pack2(o_[0], o_[1]), pack2(o_[2], o_[3])); \
        if constexpr (LOW) U[tb] = u_; } while (0)
#define LOAD_B(m) do { gv[m] = *(const float4*)(gp + (m) * 16); const int krow_ = (m) * 16 + lr; \
        _Pragma("unroll") for (int ks = 0; ks < 2; ++ks) { kfr[m][ks] = *(const bf16x8*)(kb + cont_off<DK>(krow_, ks * 32 + quad * 8, LDQ)); \
          if constexpr (LOW) { bf16x4 lo_ = *(const bf16x4*)(bb + cont_off<DK>(krow_, ks * 32 + quad * 4, 1024)); \
            bf16x4 hi_ = *(const bf16x4*)(bb + cont_off<DK>(krow_, ks * 32 + 16 + quad * 4, 1024)); bfr[m][ks] = __builtin_shufflevector(lo_, hi_, 0, 1, 2, 3, 4, 5, 6, 7); } } } while (0)
#define COMP_B(m) do { f32x4 hn_ = (f32x4){H[m][0] * gv[m].x, H[m][1] * gv[m].y, H[m][2] * gv[m].z, H[m][3] * gv[m].w}; \
        _Pragma("unroll") for (int ks = 0; ks < 2; ++ks) { hn_ = __builtin_amdgcn_mfma_f32_16x16x32_bf16(kfr[m][ks], vbop[ks], hn_, 0, 0, 0); \
          if constexpr (LOW) hn_ = __builtin_amdgcn_mfma_f32_16x16x32_bf16(bfr[m][ks], ubop[ks], hn_, 0, 0, 0); } \
        H[m] = hn_; } while (0)
      f32x4 U[4];
      constexpr int PF = 3;
      constexpr int LPR = DK / 64;
      unsigned tv[LPR * 4 + 1];
#pragma unroll
      for (int i = 0; i < LPR * 4 + 1; ++i) tv[i] = 0;
      if (c + PF < c0 + nc) {
        const size_t rb2 = (size_t)(c + PF) * 64;
#pragma unroll
        for (int i = 0; i < LPR; ++i) {
          const int li = i * 64 + ln; const size_t ro = (size_t)(li / LPR), co = (size_t)(li % LPR) * 64;
          tv[i * 4 + 0] = *(const unsigned*)(Qp + (rb2 + ro) * LDQ + h * DK + co);
          tv[i * 4 + 1] = *(const unsigned*)(Kt + (rb2 + ro) * LDQ + h * DK + co);
          if constexpr (LOW) { tv[i * 4 + 2] = *(const unsigned*)(Wp + (rb2 + ro) * 1024 + h * DK + co); tv[i * 4 + 3] = *(const unsigned*)(Bt + (rb2 + ro) * 1024 + h * DK + co); }
        }
        {
          const size_t fo2 = ((((size_t)(c + PF) * NH + h) * NVB + vb) * 4) * 256;
          const unsigned* tp;
          if (ln < 16) tp = (const unsigned*)(Ol + fo2 + ln * 64);
          else if (LOW && ln < 32) tp = (const unsigned*)(U0 + fo2 + (ln - 16) * 64);
          else if (ln < 48) tp = (const unsigned*)(Vt + rb2 * 1024 + h * DV + cont_off<DV>(vb * 16 + (ln & 15), 0, 1024));
          else tp = (const unsigned*)(gam + ((size_t)(c + PF) * NH + h) * DK + ((ln - 48) & (DK / 32 - 1)) * 32);
          tv[LPR * 4] = *tp;
        }
      }
      LOAD_A(0); LOAD_A(1); LOAD_A(2); LOAD_A(3);
#pragma unroll
      for (int ks = 0; ks < 2; ++ks) vbop[ks] = *(const bf16x8*)(vtb + cont_off<DV>(vcol, ks * 32 + quad * 8, 1024));
#pragma unroll
      for (int m = 0; m < MB; ++m) LOAD_B(m);
      __builtin_amdgcn_sched_barrier(0);
      COMP_A(0); COMP_A(1); COMP_A(2); COMP_A(3);
      bf16x8 ubop[2];
      if constexpr (LOW) {
#pragma unroll
        for (int ks = 0; ks < 2; ++ks) {
          const u32x4 uw = {pack2(-U[2 * ks][0], -U[2 * ks][1]), pack2(-U[2 * ks][2], -U[2 * ks][3]), pack2(-U[2 * ks + 1][0], -U[2 * ks + 1][1]), pack2(-U[2 * ks + 1][2], -U[2 * ks + 1][3])};
          ubop[ks] = __builtin_bit_cast(bf16x8, uw);
        }
      }
#pragma unroll
      for (int m = 0; m < MB; ++m) COMP_B(m);
      __builtin_amdgcn_sched_barrier(0);
#pragma unroll
      for (int i = 0; i < LPR * 4 + 1; ++i) tsink ^= tv[i];
#undef LOAD_A
#undef COMP_A
#undef LOAD_B
#undef COMP_B
    }
    if (tsink == 0x9e3779b9u) ((unsigned*)(PWS + WS_SINK))[0] = tsink;
    if (TYPE == 0) {
      float* S = POUT + (seq == 0 ? O_AWKV_P + ((size_t)j * 16 + h) * 4096 : O_AWKV_S + (((size_t)j * NSS + (seq - 1)) * 16 + h) * 4096) + (size_t)vcol * 64;
#pragma unroll
      for (int m = 0; m < MB; ++m) *(float4*)(S + m * 16 + quad * 4) = make_float4(H[m][0], H[m][1], H[m][2], H[m][3]);
    } else {
      const size_t ob = TYPE == 1 ? (seq == 0 ? O_BKV_P : O_BKV_S + (size_t)(seq - 1) * NH * DK * DV)
                                  : (seq == 0 ? O_CKV_P : O_CKV_S + (size_t)(seq - 1) * NH * DK * DV);
      float* S = POUT + ob + (size_t)h * DK * DV + vcol;
#pragma unroll
      for (int m = 0; m < MB; ++m)
#pragma unroll
        for (int jj = 0; jj < 4; ++jj) S[(size_t)(m * 16 + quad * 4 + jj) * DV] = H[m][jj];
    }
  }
}

template <int TYPE>
DEVI void phase_seq2(const P& p, int j, char* smem) {
  constexpr int NH = TYPE == 0 ? 16 : (TYPE == 1 ? 4 : 8);
  constexpr int DK = TYPE == 0 ? 64 : 128;
  constexpr int DV = TYPE == 0 ? 64 : (TYPE == 1 ? 256 : 128);
  constexpr bool LOW = TYPE != 1;
  constexpr int NVB = DV / 16, MB = DK / 16, KS = DK / 32, NG = NVB / 4, BIPS = NH * NG;
  constexpr int LDQ = TYPE == 1 ? 512 : 1024;
  constexpr int NOP = LOW ? 4 : 2, RS = DK + 8, OPSZ = 64 * RS, PPR = DK / 8;
  constexpr int PPO = 64 * PPR / 256;
  constexpr int PF = 4;
  bf16* L = (bf16*)smem;
  const int tid = threadIdx.x, lane = tid & 63, wave = tid >> 6, lr = lane & 15, quad = lane >> 4;
  const bf16 *Qp, *Kt, *Vt, *Wp = nullptr, *Bt = nullptr, *U0 = nullptr; bf16* Ol;
  if (TYPE == 0) { Qp = slot(p, 5); Kt = slot(p, 6); Vt = slot(p, 7); Wp = slot(p, 2); Bt = slot(p, 3); Ol = slot(p, 0); U0 = slot(p, 1); }
  else if (TYPE == 1) { Qp = slot(p, 1); Kt = slot(p, 1) + (size_t)MT * 512; Vt = slot(p, 2); Ol = slot(p, 4); }
  else { Qp = slot(p, 5); Kt = slot(p, 6); Vt = slot(p, 7); Wp = slot(p, 1); Bt = slot(p, 2); Ol = slot(p, 3); U0 = slot(p, 0); }
  const float* gam = (const float*)(PWS + WS_GAM);
  unsigned tsink = 0;
  for (int bitem = blockIdx.x; bitem < 33 * BIPS; bitem += gridDim.x) {
    const int seq = bitem / BIPS, rem = bitem % BIPS, h = rem / NG, vb = (rem % NG) * 4 + wave;
    const int c0 = seq == 0 ? 0 : NPCH + seq - 1, nc = seq == 0 ? NPCH : 1;
    const int vcol = vb * 16 + lr;
    f32x4 H[MB];
    if (seq == 0) {
#pragma unroll
      for (int m = 0; m < MB; ++m) H[m] = (f32x4){0.f, 0.f, 0.f, 0.f};
    } else {
      const int b = seq - 1;
      if (TYPE == 0) {
        const float* S = PIN(3) + (((size_t)j * NSS + b) * 16 + h) * 4096 + (size_t)vcol * 64;
#pragma unroll
        for (int m = 0; m < MB; ++m) { float4 v = *(const float4*)(S + m * 16 + quad * 4); H[m] = (f32x4){v.x, v.y, v.z, v.w}; }
      } else {
        const float* S = PIN(TYPE == 1 ? 4 : 6) + ((size_t)b * NH + h) * DK * DV + vcol;
#pragma unroll
        for (int m = 0; m < MB; ++m)
#pragma unroll
          for (int jj = 0; jj < 4; ++jj) H[m][jj] = S[(size_t)(m * 16 + quad * 4 + jj) * DV];
      }
    }
    u32x4 preA[NOP * PPO], preB[NOP * PPO]; u32x2 poA[4], poB[4], puA[4], puB[4]; bf16x8 pvA[2], pvB[2]; f32x4 pgA[MB], pgB[MB];
    auto issue_sh = [&](int cc, u32x4 (&pre)[NOP * PPO]) {
      const size_t rb_ = (size_t)cc * 64; int tl_ = threadIdx.x; asm volatile("" : "+v"(tl_));
#pragma unroll
      for (int i_ = 0; i_ < PPO; ++i_) { const int w_ = tl_ + 256 * i_; const size_t r_ = rb_ + w_ / PPR; const int c8_ = (w_ % PPR) * 8;
        pre[0 * PPO + i_] = *(const u32x4*)(Qp + r_ * LDQ + h * DK + c8_);
        pre[1 * PPO + i_] = *(const u32x4*)(Kt + r_ * LDQ + h * DK + c8_);
        if constexpr (LOW) { pre[2 * PPO + i_] = *(const u32x4*)(Wp + r_ * 1024 + h * DK + c8_); pre[3 * PPO + i_] = *(const u32x4*)(Bt + r_ * 1024 + h * DK + c8_); } }
    };
    auto issue_pr = [&](int cc, u32x2 (&p_o)[4], u32x2 (&p_u)[4], bf16x8 (&p_v)[2], f32x4 (&p_g)[MB]) {
      const size_t rb_ = (size_t)cc * 64; int tl_ = threadIdx.x; asm volatile("" : "+v"(tl_));
      const int lane = tl_ & 63, lr = lane & 15, quad = lane >> 4, vcol = vb * 16 + lr;
      const size_t fo_ = ((((size_t)cc * NH + h) * NVB + vb) * 4) * 256 + lane * 4;
#pragma unroll
      for (int tb_ = 0; tb_ < 4; ++tb_) { p_o[tb_] = *(const u32x2*)(Ol + fo_ + tb_ * 256); if constexpr (LOW) p_u[tb_] = *(const u32x2*)(U0 + fo_ + tb_ * 256); }
#pragma unroll
      for (int ks_ = 0; ks_ < 2; ++ks_) p_v[ks_] = *(const bf16x8*)(Vt + rb_ * 1024 + h * DV + cont_off<DV>(vcol, ks_ * 32 + quad * 8, 1024));
#pragma unroll
      for (int m_ = 0; m_ < MB; ++m_) p_g[m_] = *(const f32x4*)(gam + ((size_t)cc * NH + h) * DK + m_ * 16 + quad * 4);
    };
    const int cend = c0 + nc;
    auto step = [&](int c, u32x4 (&pre)[NOP * PPO], u32x2 (&p_o)[4], u32x2 (&p_u)[4], bf16x8 (&p_v)[2], f32x4 (&p_g)[MB]) {
#pragma unroll
      for (int o = 0; o < NOP; ++o)
#pragma unroll
        for (int i = 0; i < PPO; ++i) { const int w = tid + 256 * i; *(u32x4*)(L + o * OPSZ + (w / PPR) * RS + (w % PPR) * 8) = pre[o * PPO + i]; }
      __syncthreads();
      if (c + 2 < cend) issue_sh(c + 2, pre);
      unsigned tv[NOP * DK / 128 + 1];
#pragma unroll
      for (int i = 0; i < NOP * DK / 128 + 1; ++i) tv[i] = 0;
      if (false && c + PF < cend) {
        const size_t rb2 = (size_t)(c + PF) * 64;
        if (DK == 128 || tid < 128) {
          const int li = (DK == 128) ? tid : tid; const size_t ro = li / (DK / 64) % 64; const int co = (li % (DK / 64)) * 64;
          const int half = (DK == 128) ? (tid >> 7) : (tid >> 6);
          if (half == 0) { tv[0] = *(const unsigned*)(Qp + (rb2 + ro) * LDQ + h * DK + co); if constexpr (LOW) tv[1] = *(const unsigned*)(Wp + (rb2 + ro) * 1024 + h * DK + co); }
          else { tv[0] = *(const unsigned*)(Kt + (rb2 + ro) * LDQ + h * DK + co); if constexpr (LOW) tv[1] = *(const unsigned*)(Bt + (rb2 + ro) * 1024 + h * DK + co); }
        }
        {
          const size_t fo2 = ((((size_t)(c + PF) * NH + h) * NVB + vb) * 4) * 256;
          const unsigned* tp;
          if (lane < 16) tp = (const unsigned*)(Ol + fo2 + lane * 64);
          else if (LOW && lane < 32) tp = (const unsigned*)(U0 + fo2 + (lane - 16) * 64);
          else if (lane < 48) tp = (const unsigned*)(Vt + rb2 * 1024 + h * DV + cont_off<DV>(vb * 16 + (lane & 15), 0, 1024));
          else tp = (const unsigned*)(gam + ((size_t)(c + PF) * NH + h) * DK + ((lane - 48) & (DK / 32 - 1)) * 32);
          tv[NOP * DK / 128] = *tp;
        }
      }
      bf16x8 hb[KS];
#pragma unroll
      for (int ks = 0; ks < KS; ++ks) {
        const u32x4 hw = {pack2(H[2 * ks][0], H[2 * ks][1]), pack2(H[2 * ks][2], H[2 * ks][3]), pack2(H[2 * ks + 1][0], H[2 * ks + 1][1]), pack2(H[2 * ks + 1][2], H[2 * ks + 1][3])};
        hb[ks] = __builtin_bit_cast(bf16x8, hw);
      }
      const size_t fo = ((((size_t)c * NH + h) * NVB + vb) * 4) * 256 + lane * 4;
      f32x4 U[4];
#pragma unroll
      for (int tb = 0; tb < 4; ++tb) {
        f32x4 o_ = (f32x4){bf2f(p_o[tb].x & 0xffff), bf2f(p_o[tb].x >> 16), bf2f(p_o[tb].y & 0xffff), bf2f(p_o[tb].y >> 16)}, u_;
        if constexpr (LOW) u_ = (f32x4){bf2f(p_u[tb].x & 0xffff), bf2f(p_u[tb].x >> 16), bf2f(p_u[tb].y & 0xffff), bf2f(p_u[tb].y >> 16)};
#pragma unroll
        for (int ks = 0; ks < KS; ++ks) {
          o_ = __builtin_amdgcn_mfma_f32_16x16x32_bf16(*(const bf16x8*)(L + 0 * OPSZ + (tb * 16 + lr) * RS + ks * 32 + quad * 8), hb[ks], o_, 0, 0, 0);
          if constexpr (LOW) u_ = __builtin_amdgcn_mfma_f32_16x16x32_bf16(*(const bf16x8*)(L + 2 * OPSZ + (tb * 16 + lr) * RS + ks * 32 + quad * 8), hb[ks], u_, 0, 0, 0);
        }
        *(u32x2*)(Ol + fo + tb * 256) = (u32x2){pack2(o_[0], o_[1]), pack2(o_[2], o_[3])};
        if constexpr (LOW) U[tb] = u_;
      }
      bf16x8 ubop[2];
      if constexpr (LOW) {
#pragma unroll
        for (int ks = 0; ks < 2; ++ks) {
          const u32x4 uw = {pack2(-U[2 * ks][0], -U[2 * ks][1]), pack2(-U[2 * ks][2], -U[2 * ks][3]), pack2(-U[2 * ks + 1][0], -U[2 * ks + 1][1]), pack2(-U[2 * ks + 1][2], -U[2 * ks + 1][3])};
          ubop[ks] = __builtin_bit_cast(bf16x8, uw);
        }
      }
#pragma unroll
      for (int m = 0; m < MB; ++m) {
        f32x4 hn = (f32x4){H[m][0] * p_g[m][0], H[m][1] * p_g[m][1], H[m][2] * p_g[m][2], H[m][3] * p_g[m][3]};
        const int krow = m * 16 + lr;
#pragma unroll
        for (int ks = 0; ks < 2; ++ks) {
          const int i1 = krow * 64 + ks * 32 + quad * 8;
          bf16x8 a = *(const bf16x8*)(L + 1 * OPSZ + (i1 / DK) * RS + (i1 % DK));
          hn = __builtin_amdgcn_mfma_f32_16x16x32_bf16(a, p_v[ks], hn, 0, 0, 0);
          if constexpr (LOW) {
            hn = __builtin_amdgcn_mfma_f32_16x16x32_bf16(*(const bf16x8*)(L + 3 * OPSZ + (i1 / DK) * RS + (i1 % DK)), ubop[ks], hn, 0, 0, 0);
          }
        }
        H[m] = hn;
      }
#pragma unroll
      for (int i = 0; i < NOP * DK / 128 + 1; ++i) tsink ^= tv[i];
      if (c + 2 < cend) issue_pr(c + 2, p_o, p_u, p_v, p_g);
      __syncthreads();
    };
    issue_sh(c0, preA); issue_pr(c0, poA, puA, pvA, pgA);
    if (nc > 1) { issue_sh(c0 + 1, preB); issue_pr(c0 + 1, poB, puB, pvB, pgB); }
    for (int c = c0; c < cend; c += 2) { step(c, preA, poA, puA, pvA, pgA); if (c + 1 < cend) step(c + 1, preB, poB, puB, pvB, pgB); }
    if (TYPE == 0) {
      float* S = POUT + (seq == 0 ? O_AWKV_P + ((size_t)j * 16 + h) * 4096 : O_AWKV_S + (((size_t)j * NSS + (seq - 1)) * 16 + h) * 4096) + (size_t)vcol * 64;
#pragma unroll
      for (int m = 0; m < MB; ++m) *(float4*)(S + m * 16 + quad * 4) = make_float4(H[m][0], H[m][1], H[m][2], H[m][3]);
    } else {
      const size_t ob = TYPE == 1 ? (seq == 0 ? O_BKV_P : O_BKV_S + (size_t)(seq - 1) * NH * DK * DV)
                                  : (seq == 0 ? O_CKV_P : O_CKV_S + (size_t)(seq - 1) * NH * DK * DV);
      float* S = POUT + ob + (size_t)h * DK * DV + vcol;
#pragma unroll
      for (int m = 0; m < MB; ++m)
#pragma unroll
        for (int jj = 0; jj < 4; ++jj) S[(size_t)(m * 16 + quad * 4 + jj) * DV] = H[m][jj];
    }
  }
  if (tsink == 0x9e3779b9u) ((unsigned*)(PWS + WS_SINK))[0] = tsink;
}

template <int TYPE>
DEVI void phase_post(const P& p, int j, char* smem) {
  constexpr int NH = TYPE == 0 ? 16 : (TYPE == 1 ? 4 : 8);
  constexpr int DV = TYPE == 0 ? 64 : (TYPE == 1 ? 256 : 128);
  constexpr int CPT = DV / 8;
  bf16* vt = (bf16*)smem;
  bf16* ot = (bf16*)(smem + 9216);
  const bf16* O = slot(p, TYPE == 0 ? 0 : (TYPE == 1 ? 4 : 3));
  const bf16* G = slot(p, TYPE == 0 ? 4 : (TYPE == 1 ? 3 : 4));
  bf16* og = slot(p, TYPE == 1 ? 0 : 1);
  const float* sm = (const float*)(PWS + WS_SM);
  for (int item = blockIdx.x; item < NCHUNK * NH; item += gridDim.x) {
    const int c = item / NH, h = item % NH; const size_t rb = (size_t)c * 64;
    int tid = threadIdx.x; asm volatile("" : "+v"(tid));
    const int part = tid & 7;
    if constexpr (TYPE == 0) {
      const bf16* V = slot(p, 7) + rb * 1024 + h * 64;
      const int r = tid >> 2, q4 = (tid & 3) * 16;
      *(uint4*)(vt + r * 72 + q4) = *(const uint4*)(V + (size_t)r * 1024 + q4);
      *(uint4*)(vt + r * 72 + q4 + 8) = *(const uint4*)(V + (size_t)r * 1024 + q4 + 8);
      __syncthreads();
    }
    {
      const uint4* srcp = (const uint4*)(O + ((size_t)c * NH + h) * 64 * DV);
#pragma unroll
      for (int i = 0; i < DV / 32; ++i) *(uint4*)(ot + (size_t)(i * 256 + tid) * 8) = srcp[i * 256 + tid];
      __syncthreads();
    }
#pragma unroll 1
    for (int pass = 0; pass < 2; ++pass) {
      const int t = pass * 32 + (tid >> 3);
      const size_t base = (rb + t) * 1024 + h * DV + part * CPT;
      float o[CPT];
#pragma unroll
      for (int e = 0; e < CPT; ++e) {
        const int v = part * CPT + e;
        o[e] = bf2f(ot[(((v >> 4) * 4 + (t >> 4)) * 64 + ((t & 15) >> 2) * 16 + (v & 15)) * 4 + (t & 3)]);
      }
      float s1 = 0.f, s2 = 0.f;
#pragma unroll
      for (int e = 0; e < CPT; ++e) { s1 += o[e]; s2 += o[e] * o[e]; }
      s1 += __shfl_xor(s1, 1); s1 += __shfl_xor(s1, 2); s1 += __shfl_xor(s1, 4);
      s2 += __shfl_xor(s2, 1); s2 += __shfl_xor(s2, 2); s2 += __shfl_xor(s2, 4);
      if constexpr (TYPE == 0) {
        const float mean = s1 * (1.f / 64.f); float var = s2 * (1.f / 64.f) - mean * mean; var = fmaxf(var, 0.f);
        const float rs = rsqrtf(var + 64e-5f); const float bonus = sm[(rb + t) * 16 + h];
        const float* lw = PIN(26) + j * 1024 + h * 64 + part * CPT; const float* lb = PIN(27) + j * 1024 + h * 64 + part * CPT;
#pragma unroll
        for (int e = 0; e < CPT; ++e) {
          const float vv = bf2f(vt[(part * CPT + e) * 72 + t]);
          o[e] = (o[e] - mean) * rs * lw[e] + lb[e] + bonus * vv;
        }
      } else {
        const float rs = rsqrtf(s2 * (1.f / DV) + 1e-6f);
        const float* on = PIN(TYPE == 1 ? 32 : 38) + part * CPT;
#pragma unroll
        for (int e = 0; e < CPT; ++e) o[e] = o[e] * rs * on[e];
      }
#pragma unroll
      for (int e = 0; e < CPT; e += 8) {
        uint4 u = *(const uint4*)(G + base + e);
        const unsigned w[4] = {u.x, u.y, u.z, u.w}; unsigned ow[4];
#pragma unroll
        for (int i = 0; i < 4; ++i) {
          float g0 = bf2f(w[i] & 0xffff), g1 = bf2f(w[i] >> 16);
          if constexpr (TYPE != 0) { g0 = silu(g0); g1 = silu(g1); }
          ow[i] = pack2(o[e + 2 * i] * g0, o[e + 2 * i + 1] * g1);
        }
        *(uint4*)(og + base + e) = make_uint4(ow[0], ow[1], ow[2], ow[3]);
      }
    }
    __syncthreads();
  }
}


#define XB_TMO      128
#define XB_XCNT(j)  (256  + 64 * (j))
#define XB_XSUB(j)  (1280 + 64 * (j))
#define XB_XGEN(j)  (2304 + 64 * (j))
#define XB_TOP      3328
#define XB_TOPGEN   3392
#define XCD_BAR_WORDS 3456
#define XB_SPIN_CAP (1u << 18)
#define LAS __attribute__((address_space(3)))
DEVI unsigned xb_ld(unsigned* p)              { return __hip_atomic_load(p, __ATOMIC_RELAXED, __HIP_MEMORY_SCOPE_AGENT); }
DEVI unsigned xb_add(unsigned* p, unsigned v) { return __hip_atomic_fetch_add(p, v, __ATOMIC_RELAXED, __HIP_MEMORY_SCOPE_AGENT); }
DEVI unsigned xb_xcc_id() { return (unsigned)__builtin_amdgcn_s_getreg((3 << 11) | 20) & 0xFu; }
#define XB_SPIN(cond, bar) do { unsigned _sp = 0; while (cond) { __builtin_amdgcn_s_sleep(1); \
    if ((++_sp & 255u) == 0u) { if (xb_ld(&(bar)[XB_TMO])) break; if (_sp > XB_SPIN_CAP) { atomicAdd(&(bar)[XB_TMO], 1u); break; } } } } while (0)
struct XcdBarrier { unsigned* bar; unsigned x; volatile LAS unsigned* st; };
DEVI XcdBarrier xcd_barrier_post(unsigned* bar, volatile LAS unsigned* st) {
  XcdBarrier b; b.bar = bar; b.x = xb_xcc_id(); b.st = st;
  if (threadIdx.x == 0) (void)xb_add(&bar[XB_XCNT(b.x)], 1u);
  return b;
}
DEVI void xcd_barrier_complete(unsigned* bar, unsigned x, unsigned& nloc, unsigned& nx) {
  const unsigned G = gridDim.x * gridDim.y * gridDim.z;
  unsigned sum, cnt, mine, sp = 0u;
  for (;;) {
    sum = 0u; cnt = 0u; mine = 0u;
#pragma unroll
    for (unsigned j = 0; j < 16; ++j) { const unsigned c = xb_ld(&bar[XB_XCNT(j)]); sum += c; cnt += (c > 0u) ? 1u : 0u; mine = (j == x) ? c : mine; }
    if (sum == G) break;
    __builtin_amdgcn_s_sleep(1);
    if ((++sp & 255u) == 0u) { if (xb_ld(&bar[XB_TMO])) break; if (sp > XB_SPIN_CAP) { atomicAdd(&bar[XB_TMO], 1u); break; } }
  }
  nloc = mine > 0u ? mine : 1u; nx = cnt > 0u ? cnt : 1u;
}
DEVI void xcd_barrier(const XcdBarrier& b) {
  asm volatile("s_waitcnt vmcnt(0)" ::: "memory");
  __syncthreads();
  if (threadIdx.x == 0) {
    unsigned* bar = b.bar;
    __builtin_amdgcn_s_waitcnt(0);
    unsigned nloc = b.st[0], nx = b.st[1];
    if (nloc == 0u) { xcd_barrier_complete(bar, b.x, nloc, nx); b.st[0] = nloc; b.st[1] = nx; }
    const unsigned old = xb_add(&bar[XB_XSUB(b.x)], 1u);
    const unsigned gen = old / nloc;
    if (old + 1u == (gen + 1u) * nloc) {
      __builtin_amdgcn_fence(__ATOMIC_RELEASE, "agent");
      asm volatile("s_waitcnt vmcnt(0)" ::: "memory");
      const unsigned og = xb_add(&bar[XB_TOP], 1u);
      const unsigned tg = og / nx;
      if (og + 1u == (tg + 1u) * nx) xb_add(&bar[XB_TOPGEN], 1u);
      else XB_SPIN(xb_ld(&bar[XB_TOPGEN]) == tg, bar);
      __builtin_amdgcn_fence(__ATOMIC_ACQUIRE, "agent");
      xb_add(&bar[XB_XGEN(b.x)], 1u);
      asm volatile("s_waitcnt vmcnt(0)" ::: "memory");
    } else {
      XB_SPIN(xb_ld(&bar[XB_XGEN(b.x)]) == gen, bar);
      __builtin_amdgcn_fence(__ATOMIC_ACQUIRE, "agent");
      asm volatile("s_waitcnt vmcnt(0)" ::: "memory");
    }
  }
  __syncthreads();
}

#ifndef DISMASK
#define DISMASK 0
#endif
#define EN(b) (!((DISMASK >> (b)) & 1))
#define GSYNC() xcd_barrier(xb)
#define GSYNC_CG() do { asm volatile("s_waitcnt vmcnt(0)" ::: "memory"); grid.sync(); } while (0)
__global__ void __launch_bounds__(256, 1) fwd_megakernel(P p) {
  extern __shared__ __attribute__((aligned(16))) char smem[];
  cg::grid_group grid = cg::this_grid();
  volatile LAS unsigned* xst = (volatile LAS unsigned*)(smem + LDS_BYTES - 16);
  if (threadIdx.x == 0) { xst[0] = 0u; xst[1] = 0u; }
  __syncthreads();
  const XcdBarrier xb = xcd_barrier_post((unsigned*)(PWS + WS_BAR), xst);
  bf16* wreg = (bf16*)(PWS + WS_W);
  bf16 *wfin = wreg + W_FIN, *wfout = wreg + W_FOUT, *wmix = wreg + W_MIX;
  float* sm = (float*)(PWS + WS_SM);
  for (int layer = 0; layer < 4; ++layer) {
    const int type = layer % 3, j = layer / 3;
    int tb = 0;
    if (type == 0) phase_norm<0>(p, layer, j, layer == 0, layer == 0);
    else phase_norm<1>(p, layer, j, false, false);
    conv_job(CvFfnIn{PIN(10) + (size_t)layer * 1024 * 2 * FF}, wfin, 1024, 2 * FF, 1024, tb, smem);
    conv_job(CvPlain{PIN(11) + (size_t)layer * FF * 1024, 1024, 1024}, wfout, FF, 1024, FF, tb, smem);
    if (type == 0) {
      for (int i = 0; i < 3; ++i) conv_job(CvPlain{PIN(24) + ((size_t)j * 3 + i) * 1048576, 1024, 1024}, wmix + (size_t)i * 1048576, 1024, 1024, 1024, tb, smem);
      conv_job(CvLora1{PIN(14) + (size_t)j * 65536, PIN(17) + (size_t)j * 65536, PIN(19) + (size_t)j * 131072, PIN(12) + (size_t)j * 6144}, wmix + 3145728, 2048, 256, 2048, tb, smem);
      conv_job(CvPlain{PIN(15) + (size_t)j * 65536, 1024, 1024}, wmix + 3670016, 64, 1024, 64, tb, smem);
      conv_job(CvPlain{PIN(18) + (size_t)j * 65536, 1024, 1024}, wmix + 3735552, 64, 1024, 64, tb, smem);
      conv_job(CvPlain{PIN(20) + (size_t)j * 131072, 1024, 1024}, wmix + 3801088, 128, 1024, 128, tb, smem);
      conv_job(CvPlain{PIN(25) + (size_t)j * 1048576, 1024, 1024}, wmix + 3932160, 1024, 1024, 1024, tb, smem);
    } else if (type == 1) {
      conv_job(CvGlaIn{PIN(28), PIN(29)}, wmix, 1024, 3200, 1024, tb, smem);
      conv_job(CvPlain{PIN(33), 1024, 1024}, wmix + 3276800, 1024, 1024, 1024, tb, smem);
    } else {
      conv_job(CvPlain{PIN(34), 4112, 4112}, wmix, 1024, 4224, 1024, tb, smem);
      conv_job(CvPlain{PIN(39), 1024, 1024}, wmix + 4325376, 1024, 1024, 1024, tb, smem);
    }
    GSYNC();
    tb = 0;
    const bf16* wo;
    if (type == 0) {
      for (int i = 0; i < 3; ++i)
        gemm_job(GemmDesc{slot(p, 2 + i), nullptr, 1024, 1024, wmix + (size_t)i * 1048576, 1024, 144, 8, 1024}, EpiStore{slot(p, 5 + i), 1024, 1.f}, tb, smem);
      gemm_job(GemmDesc{slot(p, 0), slot(p, 1), 1024, 1024, wmix + 3145728, 2048, 144, 2, 2048}, EpiLora1{(bf16*)(PWS + WS_L1)}, tb, smem);
      GSYNC();
      tb = 0;
      const bf16* l1 = (const bf16*)(PWS + WS_L1);
      gemm_job(GemmDesc{l1, nullptr, 256, 64, wmix + 3670016, 64, 144, 8, 64}, EpiLd{slot(p, 2), PIN(13) + j * 1024}, tb, smem);
      gemm_job(GemmDesc{l1 + 64, nullptr, 256, 64, wmix + 3735552, 64, 144, 8, 64}, EpiSig{slot(p, 3), PIN(16) + j * 1024}, tb, smem);
      gemm_job(GemmDesc{l1 + 128, nullptr, 256, 128, wmix + 3801088, 128, 144, 8, 128}, EpiStore{slot(p, 4), 1024, 1.f}, tb, smem);
      GSYNC();
      if (EN(2)) phase_prep<0>(p, j, smem);
      GSYNC();
      if (EN(5)) phase_seq2<0>(p, j, smem);
      GSYNC();
      if (EN(8)) phase_post<0>(p, j, smem);
      wo = wmix + 3932160;
    } else if (type == 1) {
      gemm_job(GemmDesc{slot(p, 0), nullptr, 1024, 1024, wmix, 1024, 144, 25, 1024},
               EpiGlaIn{slot(p, 1), slot(p, 1) + (size_t)MT * 512, slot(p, 2), slot(p, 3), sm}, tb, smem);
      GSYNC();
      if (EN(3)) phase_prep<1>(p, j, smem);
      GSYNC();
      if (EN(6)) phase_seq2<1>(p, j, smem);
      GSYNC();
      if (EN(8)) phase_post<1>(p, j, smem);
      wo = wmix + 3276800;
    } else {
      gemm_job(GemmDesc{slot(p, 0), nullptr, 1024, 1024, wmix, 1024, 144, 33, 1024},
               EpiGdnIn{slot(p, 1), slot(p, 4), sm, POUT}, tb, smem);
      GSYNC();
      if (EN(9)) phase_gdn_conv(p);
      GSYNC();
      if (EN(4)) phase_prep<2>(p, j, smem);
      GSYNC();
      if (EN(7)) phase_seq2<2>(p, j, smem);
      GSYNC();
      if (EN(8)) phase_post<2>(p, j, smem);
      wo = wmix + 4325376;
    }
    GSYNC();
    tb = 0;
    gemm_job(GemmDesc{slot(p, type == 1 ? 0 : 1), nullptr, 1024, 1024, wo, 1024, 144, 8, 1024}, EpiAcc{POUT}, tb, smem);
    GSYNC();
    phase_rms(POUT, PIN(8) + layer * 1024, slot(p, 0), nullptr);
    GSYNC();
    tb = 0;
    gemm_job(GemmDesc{slot(p, 0), nullptr, 1024, 1024, wfin, 1024, 144, 44, 1024}, EpiSwiglu{slot(p, 1)}, tb, smem);
    GSYNC();
    tb = 0;
    gemm_job(GemmDesc{slot(p, 1), nullptr, FF, FF, wfout, FF, 144, 8, FF}, EpiAcc{POUT}, tb, smem);
    if (layer == 3) GSYNC_CG(); else GSYNC();
  }
  phase_rms(POUT, PIN(9), nullptr, POUT);
}

extern "C" void kernel_launch(void* const* d_in, const int* in_sizes, int n_in, void* d_out, int out_size,
                              void* d_ws, size_t ws_size, hipStream_t stream) {
  if (n_in < 40 || ws_size < WS_TOTAL) { fprintf(stderr, "bad args: n_in %d ws %zu need %zu\n", n_in, ws_size, (size_t)WS_TOTAL); return; }
  static int grid_blocks = 0;
  if (!grid_blocks) {
    int dev = 0, cus = 0, per_cu = 0;
    hipGetDevice(&dev);
    hipDeviceGetAttribute(&cus, hipDeviceAttributeMultiprocessorCount, dev);
    hipFuncSetAttribute((const void*)fwd_megakernel, hipFuncAttributeMaxDynamicSharedMemorySize, LDS_BYTES);
    hipOccupancyMaxActiveBlocksPerMultiprocessor(&per_cu, (const void*)fwd_megakernel, 256, LDS_BYTES);
    if (per_cu > 1) per_cu = 1;
    if (per_cu < 1) per_cu = 1;
    grid_blocks = cus * per_cu;
  }
  hipMemsetAsync((char*)d_ws + WS_BAR, 0, 16384, stream);
  P p{};
  for (int i = 0; i < 40; ++i) p.in[i] = (const float*)d_in[i];
  p.out = (float*)d_out; p.ws = (char*)d_ws;
  void* args[] = {&p};
  hipError_t e = hipLaunchCooperativeKernel((const void*)fwd_megakernel, dim3(grid_blocks), dim3(256), args, LDS_BYTES, stream);
  if (e != hipSuccess) fprintf(stderr, "cooperative launch failed: %s (grid %d)\n", hipGetErrorString(e), grid_blocks);
}
```

```cpp
#include <hip/hip_runtime.h>
#include <hip/hip_cooperative_groups.h>
#include <cstdio>
#include <cstdint>
namespace cg = cooperative_groups;

typedef unsigned short bf16;
typedef __attribute__((ext_vector_type(8))) short bf16x8;
typedef __attribute__((ext_vector_type(4))) short bf16x4;
typedef __attribute__((ext_vector_type(4))) float f32x4;
typedef __attribute__((ext_vector_type(4))) unsigned u32x4;
typedef __attribute__((ext_vector_type(2))) unsigned u32x2;

#define DEVI __device__ __forceinline__

constexpr int Dm = 1024, FF = 2816, MT = 18432, MPR = 16384, NSS = 32, NCHUNK = 288, NPCH = 256;
constexpr size_t SLOT = (size_t)MT * 1024 * 2;
constexpr size_t WS_L1 = 8 * SLOT;
constexpr size_t WS_SM = WS_L1 + (size_t)MT * 256 * 2;
constexpr size_t WS_GAM = WS_SM + (size_t)MT * 16 * 4;
constexpr size_t WS_W = WS_GAM + (size_t)NCHUNK * 1024 * 4;
constexpr size_t W_FIN = 0, W_FOUT = 5767168, W_MIX = 8650752;
constexpr size_t WS_SINK = WS_W + (size_t)14200000 * 2 - 64;
constexpr size_t WS_BAR = WS_W + (size_t)14200000 * 2;
constexpr size_t WS_TOTAL = WS_BAR + 16384;
constexpr int LDS_BYTES = 77824;

constexpr size_t O_ASH_P = 18874368, O_AWKV_P = O_ASH_P + 2048, O_BKV_P = O_AWKV_P + 131072,
                 O_CCONV_P = O_BKV_P + 131072, O_CKV_P = O_CCONV_P + 9216, O_ASH_S = O_CKV_P + 131072,
                 O_AWKV_S = O_ASH_S + 65536, O_BKV_S = O_AWKV_S + 4194304, O_CCONV_S = O_BKV_S + 4194304,
                 O_CKV_S = O_CCONV_S + 294912;

struct P { const float* in[40]; float* out; char* ws; };
typedef const __attribute__((address_space(4))) char* kptr_t;
typedef const float* cfp_t; typedef float* fp_t; typedef char* cp_t;
DEVI kptr_t kbase() { kptr_t b = (kptr_t)__builtin_amdgcn_kernarg_segment_ptr(); asm volatile("" : "+s"(b)); return b; }
#define PIN(i) (*(const __attribute__((address_space(4))) cfp_t*)(kbase() + 8 * (i)))
#define POUT (*(const __attribute__((address_space(4))) fp_t*)(kbase() + 320))
#define PWS (*(const __attribute__((address_space(4))) cp_t*)(kbase() + 328))

typedef __attribute__((ext_vector_type(2))) float f32x2;
typedef __attribute__((ext_vector_type(2))) __bf16 bf16x2v;
DEVI unsigned pack2(float a, float b) { f32x2 v = {a, b}; bf16x2v r = __builtin_convertvector(v, bf16x2v); return __builtin_bit_cast(unsigned, r); }
DEVI bf16 f2bf(float f) { return (bf16)(pack2(f, 0.f) & 0xffffu); }
DEVI float bf2f(bf16 h) { return __uint_as_float(((unsigned)h) << 16); }
DEVI float wsum(float v) {
#pragma unroll
  for (int o = 32; o > 0; o >>= 1) v += __shfl_xor(v, o);
  return v;
}
DEVI float sigm(float x) { return 1.f / (1.f + __expf(-x)); }
DEVI float silu(float x) { return x * sigm(x); }
DEVI float softplus(float x) { return x > 20.f ? x : log1pf(__expf(x)); }
DEVI bf16* slot(const P& p, int i) { return (bf16*)(PWS + (size_t)i * SLOT); }

struct GemmDesc { const bf16* A; const bf16* A2; int lda; int ksplit; const bf16* Bt; int ldb; int tiles_m; int tiles_n; int K; };

template <class Epi>
DEVI void gemm_tile(const GemmDesc& g, int mt, int nt, Epi& epi, char* smem) {
  const int tid = threadIdx.x, lane = tid & 63, wave = tid >> 6;
  const int wm = wave >> 1, wn = wave & 1, lr = lane & 15, quad = lane >> 4;
  bf16* sA = (bf16*)smem;
  bf16* sB = sA + 2 * 8192;
  f32x4 acc[4][4];
#pragma unroll
  for (int i = 0; i < 4; ++i)
#pragma unroll
    for (int j = 0; j < 4; ++j) acc[i][j] = (f32x4){0.f, 0.f, 0.f, 0.f};
  const int m0 = mt * 128, n0 = nt * 128;
  const int r0 = tid >> 3, c0 = tid & 7;
  const size_t aoff = (size_t)(m0 + r0) * g.lda + c0 * 8;
  const bf16* bp = g.Bt + (size_t)(n0 + r0) * g.ldb + c0 * 8;
  const int soff = r0 * 64 + ((c0 ^ (r0 & 7)) << 3);
#define GL1(i_, RA, RB) RA##i_ = *(const u32x4*)(base_ + (size_t)(32 * i_) * g.lda); RB##i_ = *(const u32x4*)(bp + k0_ + (size_t)(32 * i_) * g.ldb);
#define GLOAD(kt_, RA, RB) do { const int k0_ = (kt_) << 6; \
    const bf16* base_ = ((k0_ < g.ksplit) ? (g.A + k0_) : (g.A2 + (k0_ - g.ksplit))) + aoff; \
    GL1(0, RA, RB) GL1(1, RA, RB) GL1(2, RA, RB) GL1(3, RA, RB) } while (0)
#define LS1(buf_, i_, RA, RB) *(u32x4*)(sA + (buf_) * 8192 + soff + i_ * 2048) = RA##i_; *(u32x4*)(sB + (buf_) * 8192 + soff + i_ * 2048) = RB##i_;
#define LSTORE(buf_, RA, RB) do { LS1(buf_, 0, RA, RB) LS1(buf_, 1, RA, RB) LS1(buf_, 2, RA, RB) LS1(buf_, 3, RA, RB) } while (0)
#define GSTEP(kt_, RA, RB) do { const int buf_ = (kt_) & 1; \
    const bf16* a_ = sA + buf_ * 8192 + (wm * 64 + lr) * 64; const bf16* b_ = sB + buf_ * 8192 + (wn * 64 + lr) * 64; \
    _Pragma("unroll") for (int ks_ = 0; ks_ < 2; ++ks_) { \
      const int co_ = (((ks_ * 4 + quad) ^ (lr & 7)) << 3); bf16x8 af_[4], bf_[4]; \
      _Pragma("unroll") for (int i_ = 0; i_ < 4; ++i_) { af_[i_] = *(const bf16x8*)(a_ + i_ * 1024 + co_); bf_[i_] = *(const bf16x8*)(b_ + i_ * 1024 + co_); } \
      _Pragma("unroll") for (int i_ = 0; i_ < 4; ++i_) _Pragma("unroll") for (int j_ = 0; j_ < 4; ++j_) \
        acc[i_][j_] = __builtin_amdgcn_mfma_f32_16x16x32_bf16(af_[i_], bf_[j_], acc[i_][j_], 0, 0, 0); } \
    if ((kt_) + 1 < nk) { LSTORE(buf_ ^ 1, RA, RB); if ((kt_) + 3 < nk) GLOAD((kt_) + 3, RA, RB); } \
    __syncthreads(); } while (0)
  const int nk = g.K >> 6;
  u32x4 pa0, pa1, pa2, pa3, pb0, pb1, pb2, pb3, qa0, qa1, qa2, qa3, qb0, qb1, qb2, qb3;
  qa0 = qa1 = qa2 = qa3 = qb0 = qb1 = qb2 = qb3 = (u32x4){0u, 0u, 0u, 0u};
  GLOAD(0, pa, pb);
  if (nk > 1) GLOAD(1, qa, qb);
  LSTORE(0, pa, pb);
  if (nk > 2) GLOAD(2, pa, pb);
  __syncthreads();
  for (int kt = 0; kt < nk; kt += 2) { GSTEP(kt, qa, qb); if (kt + 1 < nk) GSTEP(kt + 1, pa, pb); }
#pragma unroll
  for (int i = 0; i < 4; ++i) {
#pragma unroll
    for (int jj = 0; jj < 4; ++jj) {
      const int row = m0 + wm * 64 + i * 16 + quad * 4 + jj;
      if constexpr (Epi::PAIR) {
#pragma unroll
        for (int j = 0; j < 4; j += 2) {
          const int nn = n0 + wn * 64 + j * 16;
          epi.pair(row, (nn >> 5) * 16 + lr, acc[i][j][jj], acc[i][j + 1][jj]);
        }
      } else {
#pragma unroll
        for (int j = 0; j < 4; ++j) epi(row, n0 + wn * 64 + j * 16 + lr, acc[i][j][jj]);
      }
    }
  }
}

template <class Epi>
DEVI void gemm_job(const GemmDesc& g, Epi epi, int& tbase, char* smem) {
  const int ntiles = g.tiles_m * g.tiles_n, G = gridDim.x;
  const int first = tbase + (((int)blockIdx.x - tbase % G) + G) % G;
  const int width = 8 * g.tiles_n;
  for (int t = first; t < tbase + ntiles; t += G) {
    const int lt = t - tbase;
    const int grp = lt / width, rem = lt % width;
    gemm_tile(g, grp * 8 + (rem & 7), rem >> 3, epi, smem);
  }
  tbase += ntiles;
}

struct EpiStore { static constexpr bool PAIR = false; bf16* C; int ldc; float sc;
  DEVI void operator()(int r, int c, float v) { C[(size_t)r * ldc + c] = f2bf(v * sc); } };
struct EpiLora1 { static constexpr bool PAIR = false; bf16* C;
  DEVI void operator()(int r, int c, float v) { float o = c < 64 ? tanhf(v) : (c < 128 ? v : sigm(v)); C[(size_t)r * 256 + c] = f2bf(o); } };
struct EpiLd { static constexpr bool PAIR = false; bf16* C; const float* w0;
  DEVI void operator()(int r, int c, float v) { float x = w0[c] + v; float lr_ = -softplus(-x) - 0.5f; C[(size_t)r * 1024 + c] = f2bf(-__expf(lr_)); } };
struct EpiSig { static constexpr bool PAIR = false; bf16* C; const float* a0;
  DEVI void operator()(int r, int c, float v) { C[(size_t)r * 1024 + c] = f2bf(sigm(a0[c] + v)); } };
struct EpiAcc { static constexpr bool PAIR = false; float* X;
  DEVI void operator()(int r, int c, float v) { X[(size_t)r * 1024 + c] += v; } };
struct EpiSwiglu { static constexpr bool PAIR = true; bf16* C;
  DEVI void pair(int r, int c, float gt, float up) { C[(size_t)r * FF + c] = f2bf(silu(gt) * up); } };
struct EpiGlaIn { static constexpr bool PAIR = false; bf16 *q, *k, *v, *gate; float* sm;
  DEVI void operator()(int r, int c, float x) {
    if (c < 512) q[(size_t)r * 512 + c] = f2bf(x * 0.08838834764831845f);
    else if (c < 1024) k[(size_t)r * 512 + c - 512] = f2bf(x);
    else if (c < 2048) v[(size_t)r * 1024 + c - 1024] = f2bf(x);
    else if (c < 3072) gate[(size_t)r * 1024 + c - 2048] = f2bf(x);
    else if (c < 3088) sm[(size_t)r * 16 + c - 3072] = x;
  } };
struct EpiGdnIn { static constexpr bool PAIR = false; bf16 *qkv, *z; float* sm; float* out;
  DEVI void operator()(int r, int c, float x) {
    if (c < 3072) {
      qkv[(size_t)r * 3072 + c] = f2bf(x);
      if (r >= MPR - 3) {
        if (r < MPR) out[O_CCONV_P + (size_t)(r - (MPR - 3)) * 3072 + c] = x;
        else { int tt = (r - MPR) & 63; if (tt >= 61) out[O_CCONV_S + ((size_t)((r - MPR) >> 6) * 3 + (tt - 61)) * 3072 + c] = x; }
      }
    } else if (c < 4096) z[(size_t)r * 1024 + c - 3072] = f2bf(x);
    else if (c < 4112) sm[(size_t)r * 16 + c - 4096] = x;
  } };

template <class F>
DEVI void conv_job(F f, bf16* dst, int ldo, int Nd, int Kd, int& tbase, char* smem) {
  float* tile = (float*)smem;
  const int tn = Nd >> 6, tk = Kd >> 6, ntiles = tn * tk, G = gridDim.x, tid = threadIdx.x;
  const int first = tbase + (((int)blockIdx.x - tbase % G) + G) % G;
  for (int t = first; t < tbase + ntiles; t += G) {
    const int lt = t - tbase, n0 = (lt % tn) << 6, k0 = (lt / tn) << 6;
    const int i = tid >> 4, j4 = (tid & 15) << 2;
#pragma unroll
    for (int r = 0; r < 4; ++r) {
      float4 v = f(k0 + i + 16 * r, n0 + j4);
      float* d = tile + (i + 16 * r) * 65 + j4; d[0] = v.x; d[1] = v.y; d[2] = v.z; d[3] = v.w;
    }
    __syncthreads();
    const int jn = tid >> 2, iq = (tid & 3) << 4;
    unsigned w[8];
#pragma unroll
    for (int e = 0; e < 8; ++e) w[e] = pack2(tile[(iq + 2 * e) * 65 + jn], tile[(iq + 2 * e + 1) * 65 + jn]);
    uint4* o = (uint4*)(dst + (size_t)(n0 + jn) * ldo + k0 + iq);
    o[0] = make_uint4(w[0], w[1], w[2], w[3]); o[1] = make_uint4(w[4], w[5], w[6], w[7]);
    __syncthreads();
  }
  tbase += ntiles;
}
struct CvPlain { const float* W; int ld; int nsrc;
  DEVI float4 operator()(int k, int n) const { return n < nsrc ? *(const float4*)(W + (size_t)k * ld + n) : make_float4(0, 0, 0, 0); } };
struct CvFfnIn { const float* W;
  DEVI float4 operator()(int k, int n) const { int blk = n >> 5, w = n & 31; int src = (w < 16) ? blk * 16 + w : FF + blk * 16 + (w - 16);
    return *(const float4*)(W + (size_t)k * (2 * FF) + src); } };
struct CvLora1 { const float *w1, *a1, *g1, *mu;
  DEVI float4 operator()(int k, int n) const {
    int kk = k & 1023; float4 v; float m;
    if (n < 64) { v = *(const float4*)(w1 + kk * 64 + n); m = mu[1 * 1024 + kk]; }
    else if (n < 128) { v = *(const float4*)(a1 + kk * 64 + n - 64); m = mu[4 * 1024 + kk]; }
    else { v = *(const float4*)(g1 + kk * 128 + n - 128); m = mu[5 * 1024 + kk]; }
    float s = (k < 1024) ? (1.f - m) : m;
    return make_float4(v.x * s, v.y * s, v.z * s, v.w * s); } };
struct CvGlaIn { const float *win, *wa1;
  DEVI float4 operator()(int k, int n) const {
    if (n < 3072) return *(const float4*)(win + (size_t)k * 3072 + n);
    if (n < 3088) return *(const float4*)(wa1 + k * 16 + n - 3072);
    return make_float4(0, 0, 0, 0); } };

template <int TYPE>
DEVI void phase_norm(const P& p, int layer, int j, bool from_input, bool copy_x) {
  const int lane = threadIdx.x & 63, wave = threadIdx.x >> 6;
  const float* g = PIN(7) + layer * 1024;
  float* xres = POUT;
  bf16 *h = slot(p, 0), *hs = slot(p, 1), *xr = slot(p, 2), *xk = slot(p, 3), *xv = slot(p, 4);
  const float* mu = PIN(12) + (size_t)j * 6 * 1024;
  for (int row = blockIdx.x * 4 + wave; row < MT; row += gridDim.x * 4) {
    auto src = [&](int r) -> const float* {
      if (from_input) return r < MPR ? PIN(0) + (size_t)r * 1024 : PIN(1) + (size_t)(r - MPR) * 1024;
      return xres + (size_t)r * 1024; };
    const float* xp = src(row);
    float4 xv4[4]; float ss = 0.f;
#pragma unroll
    for (int i = 0; i < 4; ++i) { xv4[i] = *(const float4*)(xp + i * 256 + lane * 4); ss += xv4[i].x * xv4[i].x + xv4[i].y * xv4[i].y + xv4[i].z * xv4[i].z + xv4[i].w * xv4[i].w; }
    ss = wsum(ss);
    const float rstd = rsqrtf(ss * (1.f / 1024.f) + 1e-6f);
    if (copy_x) {
#pragma unroll
      for (int i = 0; i < 4; ++i) *(float4*)(xres + (size_t)row * 1024 + i * 256 + lane * 4) = xv4[i];
    }
    float hv[16];
#pragma unroll
    for (int i = 0; i < 4; ++i) { float4 gg = *(const float4*)(g + i * 256 + lane * 4);
      hv[i * 4 + 0] = xv4[i].x * rstd * gg.x; hv[i * 4 + 1] = xv4[i].y * rstd * gg.y; hv[i * 4 + 2] = xv4[i].z * rstd * gg.z; hv[i * 4 + 3] = xv4[i].w * rstd * gg.w; }
#pragma unroll
    for (int i = 0; i < 4; ++i) *(uint2*)(h + (size_t)row * 1024 + i * 256 + lane * 4) = make_uint2(pack2(hv[i * 4], hv[i * 4 + 1]), pack2(hv[i * 4 + 2], hv[i * 4 + 3]));
    if constexpr (TYPE == 0) {
      const bool is_p = row < MPR; const int tt = is_p ? row : ((row - MPR) & 63); const int b = is_p ? 0 : ((row - MPR) >> 6);
      float hp[16];
      if (tt == 0) {
        if (is_p) {
#pragma unroll
          for (int i = 0; i < 16; ++i) hp[i] = 0.f;
        } else {
          const float* sp = PIN(2) + ((size_t)j * NSS + b) * 1024;
#pragma unroll
          for (int i = 0; i < 4; ++i) { float4 v = *(const float4*)(sp + i * 256 + lane * 4); hp[i * 4] = v.x; hp[i * 4 + 1] = v.y; hp[i * 4 + 2] = v.z; hp[i * 4 + 3] = v.w; }
        }
      } else {
        const float* pp = src(row - 1); float4 pv[4]; float s2 = 0.f;
#pragma unroll
        for (int i = 0; i < 4; ++i) { pv[i] = *(const float4*)(pp + i * 256 + lane * 4); s2 += pv[i].x * pv[i].x + pv[i].y * pv[i].y + pv[i].z * pv[i].z + pv[i].w * pv[i].w; }
        s2 = wsum(s2); const float r2 = rsqrtf(s2 * (1.f / 1024.f) + 1e-6f);
#pragma unroll
        for (int i = 0; i < 4; ++i) { float4 gg = *(const float4*)(g + i * 256 + lane * 4);
          hp[i * 4] = pv[i].x * r2 * gg.x; hp[i * 4 + 1] = pv[i].y * r2 * gg.y; hp[i * 4 + 2] = pv[i].z * r2 * gg.z; hp[i * 4 + 3] = pv[i].w * r2 * gg.w; }
      }
#pragma unroll
      for (int i = 0; i < 4; ++i) {
        const int col = i * 256 + lane * 4; const size_t o = (size_t)row * 1024 + col;
        float4 m0 = *(const float4*)(mu + 0 * 1024 + col), m2 = *(const float4*)(mu + 2 * 1024 + col), m3 = *(const float4*)(mu + 3 * 1024 + col);
        const float mm0[4] = {m0.x, m0.y, m0.z, m0.w}, mm2[4] = {m2.x, m2.y, m2.z, m2.w}, mm3[4] = {m3.x, m3.y, m3.z, m3.w};
        float a[4], bb[4], c[4];
#pragma unroll
        for (int e = 0; e < 4; ++e) { float hh = hv[i * 4 + e], xx = hp[i * 4 + e] - hh; a[e] = hh + xx * mm0[e]; bb[e] = hh + xx * mm2[e]; c[e] = hh + xx * mm3[e]; }
        *(uint2*)(hs + o) = make_uint2(pack2(hp[i * 4], hp[i * 4 + 1]), pack2(hp[i * 4 + 2], hp[i * 4 + 3]));
        *(uint2*)(xr + o) = make_uint2(pack2(a[0], a[1]), pack2(a[2], a[3]));
        *(uint2*)(xk + o) = make_uint2(pack2(bb[0], bb[1]), pack2(bb[2], bb[3]));
        *(uint2*)(xv + o) = make_uint2(pack2(c[0], c[1]), pack2(c[2], c[3]));
      }
      if (is_p ? (row == MPR - 1) : (tt == 63)) {
        float* o = POUT + (is_p ? O_ASH_P + (size_t)j * 1024 : O_ASH_S + ((size_t)j * NSS + b) * 1024);
#pragma unroll
        for (int i = 0; i < 4; ++i) *(float4*)(o + i * 256 + lane * 4) = make_float4(hv[i * 4], hv[i * 4 + 1], hv[i * 4 + 2], hv[i * 4 + 3]);
      }
    }
  }
}

DEVI void phase_rms(const float* x, const float* g, bf16* dst, float* fdst) {
  const int lane = threadIdx.x & 63, wave = threadIdx.x >> 6;
  const int nw = gridDim.x * 4;
  for (int row = blockIdx.x * 4 + wave; row < MT; row += 2 * nw) {
    const int row2 = row + nw; const bool has2 = row2 < MT;
    float4 v[4], v2[4]; float ss = 0.f, ss2 = 0.f;
#pragma unroll
    for (int i = 0; i < 4; ++i) v[i] = *(const float4*)(x + (size_t)row * 1024 + i * 256 + lane * 4);
    if (has2) {
#pragma unroll
      for (int i = 0; i < 4; ++i) v2[i] = *(const float4*)(x + (size_t)row2 * 1024 + i * 256 + lane * 4);
    } else {
#pragma unroll
      for (int i = 0; i < 4; ++i) v2[i] = make_float4(0.f, 0.f, 0.f, 0.f);
    }
#pragma unroll
    for (int i = 0; i < 4; ++i) { ss += v[i].x * v[i].x + v[i].y * v[i].y + v[i].z * v[i].z + v[i].w * v[i].w; ss2 += v2[i].x * v2[i].x + v2[i].y * v2[i].y + v2[i].z * v2[i].z + v2[i].w * v2[i].w; }
    ss = wsum(ss); ss2 = wsum(ss2);
    const float r = rsqrtf(ss * (1.f / 1024.f) + 1e-6f), r2 = rsqrtf(ss2 * (1.f / 1024.f) + 1e-6f);
#pragma unroll
    for (int i = 0; i < 4; ++i) { float4 gg = *(const float4*)(g + i * 256 + lane * 4);
      { float a = v[i].x * r * gg.x, b = v[i].y * r * gg.y, c = v[i].z * r * gg.z, d = v[i].w * r * gg.w;
        if (dst) *(uint2*)(dst + (size_t)row * 1024 + i * 256 + lane * 4) = make_uint2(pack2(a, b), pack2(c, d));
        else *(float4*)(fdst + (size_t)row * 1024 + i * 256 + lane * 4) = make_float4(a, b, c, d); }
      if (has2) { float a = v2[i].x * r2 * gg.x, b = v2[i].y * r2 * gg.y, c = v2[i].z * r2 * gg.z, d = v2[i].w * r2 * gg.w;
        if (dst) *(uint2*)(dst + (size_t)row2 * 1024 + i * 256 + lane * 4) = make_uint2(pack2(a, b), pack2(c, d));
        else *(float4*)(fdst + (size_t)row2 * 1024 + i * 256 + lane * 4) = make_float4(a, b, c, d); }
    }
  }
}

DEVI void phase_gdn_conv(const P& p) {
  const bf16* qkv = slot(p, 1); const float* cw = PIN(35); const float* cst = PIN(5);
  const int tid = threadIdx.x;
  for (int item = blockIdx.x; item < (MT / 8) * 3; item += gridDim.x) {
    const int row0 = (item / 3) * 8, sec = item % 3, ch = sec * 1024 + tid * 4;
    const bool is_p = row0 < MPR; const int tt0 = is_p ? row0 : ((row0 - MPR) & 63); const int b = is_p ? 0 : ((row0 - MPR) >> 6);
    float x[11][4];
#pragma unroll
    for (int i = 0; i < 11; ++i) {
      const int pt = tt0 + i;
      if (pt >= 3) { uint2 u = *(const uint2*)(qkv + (size_t)(row0 + i - 3) * 3072 + ch);
        x[i][0] = bf2f(u.x & 0xffff); x[i][1] = bf2f(u.x >> 16); x[i][2] = bf2f(u.y & 0xffff); x[i][3] = bf2f(u.y >> 16); }
      else if (!is_p) { float4 s = *(const float4*)(cst + ((size_t)b * 3 + pt) * 3072 + ch); x[i][0] = s.x; x[i][1] = s.y; x[i][2] = s.z; x[i][3] = s.w; }
      else { x[i][0] = x[i][1] = x[i][2] = x[i][3] = 0.f; }
    }
    float w[4][4];
#pragma unroll
    for (int i = 0; i < 4; ++i) { float4 ww = *(const float4*)(cw + i * 3072 + ch); w[i][0] = ww.x; w[i][1] = ww.y; w[i][2] = ww.z; w[i][3] = ww.w; }
#pragma unroll
    for (int o = 0; o < 8; ++o) {
      float acc[4];
#pragma unroll
      for (int e = 0; e < 4; ++e) { acc[e] = x[o][e] * w[0][e] + x[o + 1][e] * w[1][e] + x[o + 2][e] * w[2][e] + x[o + 3][e] * w[3][e]; acc[e] = silu(acc[e]); }
      if (sec < 2) {
        float ss = acc[0] * acc[0] + acc[1] * acc[1] + acc[2] * acc[2] + acc[3] * acc[3];
#pragma unroll
        for (int sft = 16; sft > 0; sft >>= 1) ss += __shfl_xor(ss, sft);
        const float r = rsqrtf(ss + 1e-6f) * (sec == 0 ? 0.08838834764831845f : 1.f);
#pragma unroll
        for (int e = 0; e < 4; ++e) acc[e] *= r;
      }
      *(uint2*)(slot(p, 5 + sec) + (size_t)(row0 + o) * 1024 + tid * 4) = make_uint2(pack2(acc[0], acc[1]), pack2(acc[2], acc[3]));
    }
  }
}

DEVI void mm_strip(const bf16* At, const bf16* Bt, f32x4 (&acc)[4], int wave, int lane) {
  const int lr = lane & 15, quad = lane >> 4;
#pragma unroll
  for (int ks = 0; ks < 2; ++ks) {
    bf16x8 a = *(const bf16x8*)(At + (wave * 16 + lr) * 72 + ks * 32 + quad * 8);
#pragma unroll
    for (int nb = 0; nb < 4; ++nb) {
      bf16x8 b = *(const bf16x8*)(Bt + (nb * 16 + lr) * 72 + ks * 32 + quad * 8);
      acc[nb] = __builtin_amdgcn_mfma_f32_16x16x32_bf16(a, b, acc[nb], 0, 0, 0);
    }
  }
}
DEVI void zero4(f32x4 (&a)[4]) {
#pragma unroll
  for (int i = 0; i < 4; ++i) a[i] = (f32x4){0.f, 0.f, 0.f, 0.f};
}

DEVI int perm32(int x) { return (x & ~31) | (((x >> 2) & 3) << 3) | (((x >> 4) & 1) << 2) | (x & 3); }
template <int CW> DEVI size_t cont_off(int r, int s, int LD) { const int idx = r * 64 + s; return (size_t)(idx / CW) * LD + (idx % CW); }

template <int TYPE>
DEVI void phase_prep(const P& p, int j, char* smem) {
  constexpr int NH = TYPE == 0 ? 16 : (TYPE == 1 ? 4 : 8);
  constexpr int DK = TYPE == 0 ? 64 : 128;
  constexpr int DV = TYPE == 0 ? 64 : (TYPE == 1 ? 256 : 128);
  constexpr bool LOW = TYPE != 1;
  constexpr int KT = 256 / DK, TPT = 64 / KT, DKH = DK / 64, DVH = DV / 64;
  constexpr int LDQ = TYPE == 1 ? 512 : 1024;
  bf16* X0 = (bf16*)smem; bf16* X1 = X0 + 4608; bf16* Y0 = X1 + 4608; bf16* Y1 = Y0 + 4608;
  float* Lb = (float*)smem;
  bf16* LkT = (bf16*)(smem + 16384); bf16* Ak = LkT + 4608; bf16* nAb = Ak + 4608;
  bf16* M1 = (bf16*)smem;
  bf16* Tt = (bf16*)(smem + 44032); bf16* St1 = Tt + 4608; bf16* St2 = St1 + 4608;
  if (TYPE == 1) { Y0 = (bf16*)(smem + 9216); Ak = (bf16*)(smem + 18432); St1 = (bf16*)(smem + 27648); }
  float* lgL = (float*)(smem + 36864);
  float* tot = (float*)(smem + 71680);
  float* sc_beta = (float*)(smem + 73728);
  float* sc_eg = sc_beta + 64; float* sc_lg = sc_eg + 64; float* sc_g = sc_lg + 64;

  bf16 *Aq, *Akk, *Av, *Ald = nullptr, *Aa = nullptr, *Oq, *Okt, *Ovt, *Ow = nullptr, *Obt = nullptr, *Ool, *Ou0 = nullptr;
  if (TYPE == 0) { Aq = slot(p, 5); Akk = slot(p, 6); Av = slot(p, 7); Ald = slot(p, 2); Aa = slot(p, 3);
    Oq = Aq; Okt = Akk; Ovt = Av; Ow = Ald; Obt = Aa; Ool = slot(p, 0); Ou0 = slot(p, 1); }
  else if (TYPE == 1) { Aq = slot(p, 1); Akk = slot(p, 1) + (size_t)MT * 512; Av = slot(p, 2); Oq = Aq; Okt = Akk; Ovt = Av; Ool = slot(p, 4); }
  else { Aq = slot(p, 5); Akk = slot(p, 6); Av = slot(p, 7); Oq = Aq; Okt = Akk; Ovt = Av; Ow = slot(p, 1); Obt = slot(p, 2); Ool = slot(p, 3); Ou0 = slot(p, 0); }
  float* sm = (float*)(PWS + WS_SM);
  float* gam = (float*)(PWS + WS_GAM);

  for (int item = blockIdx.x; item < NCHUNK * NH; item += gridDim.x) {
    const int c = item / NH, h = item % NH;
    const size_t rb = (size_t)c * 64;
    int tid = threadIdx.x; asm volatile("" : "+v"(tid));
    const int lane = tid & 63, wave = tid >> 6, lr = lane & 15, quad = lane >> 4;
    const int k = tid % DK, tg = tid / DK;
    const int vv = tid & 63, tgv = tid >> 6;
    unsigned qP[TPT / 2], ktP[TPT / 2], kapP[(TYPE == 0) ? TPT / 2 : 1], bvP[(TYPE == 0) ? TPT / 2 : 1];
    float lg[(TYPE == 0) ? TPT : 1], ldv[(TYPE == 0) ? TPT : 1];
    unsigned vP[DVH][8];
    auto lo16 = [](unsigned w) { return __uint_as_float(w << 16); };
    auto hi16 = [](unsigned w) { return __uint_as_float(w & 0xffff0000u); };
#define GETP(arr, e) (((e) & 1) ? hi16(arr[(e) >> 1]) : lo16(arr[(e) >> 1]))
#pragma unroll
    for (int vh = 0; vh < DVH; ++vh) {
      bf16 va[16];
#pragma unroll
      for (int e = 0; e < 16; ++e) va[e] = Av[(rb + tgv * 16 + e) * 1024 + h * DV + vh * 64 + vv];
#pragma unroll
      for (int e = 0; e < 8; ++e) { vP[vh][e] = (unsigned)va[2 * e] | ((unsigned)va[2 * e + 1] << 16); asm volatile("" : "+v"(vP[vh][e])); }
    }
    if constexpr (TYPE == 2) {
      if (tid < 64) {
        const float a_log = PIN(36)[h], dtb = PIN(37)[h];
        const float braw = sm[(rb + tid) * 16 + h], araw = sm[(rb + tid) * 16 + 8 + h];
        const float gt = -__expf(a_log) * softplus(araw + dtb);
        sc_beta[tid] = sigm(braw); sc_eg[tid] = __expf(gt); sc_g[tid] = gt;
        float cs = gt;
#pragma unroll
        for (int o = 1; o < 64; o <<= 1) { float n = __shfl_up(cs, o); if (lane >= o) cs += n; }
        sc_lg[tid] = cs;
      }
      __syncthreads();
    }
    if constexpr (TYPE == 0) {
      const float k_k = PIN(21)[j * 1024 + h * 64 + k], k_a = PIN(22)[j * 1024 + h * 64 + k], r_k = PIN(23)[j * 1024 + h * 64 + k];
      float run = 0.f;
      bf16 rr[TPT], rk[TPT], ra[TPT], rl[TPT];
#pragma unroll
      for (int e = 0; e < TPT; ++e) {
        const size_t o = (rb + tg * TPT + e) * 1024 + h * 64 + k;
        rr[e] = Aq[o]; rk[e] = Akk[o]; ra[e] = Aa[o]; rl[e] = Ald[o];
      }
#pragma unroll
      for (int e2 = 0; e2 < TPT / 2; ++e2) {
        float qq[2], ka[2], kq[2], bq[2];
#pragma unroll
        for (int u = 0; u < 2; ++u) {
          const int e = e2 * 2 + u;
          const float r = bf2f(rr[e]), kr = bf2f(rk[e]), av = bf2f(ra[e]), l = bf2f(rl[e]);
          const float kk = kr * k_k;
          const float inv = rsqrtf(fmaxf(wsum(kk * kk), 1e-24f));
          qq[u] = r; ka[u] = kk * inv; kq[u] = kr * (1.f + (av - 1.f) * k_a); bq[u] = ka[u] * av; ldv[e] = l;
          const float bo = wsum(r * kq[u] * r_k);
          if (lane == 0) sm[(rb + tg * TPT + e) * 16 + h] = bo;
          run += l; lg[e] = run;
        }
        qP[e2] = pack2(qq[0], qq[1]); kapP[e2] = pack2(ka[0], ka[1]); ktP[e2] = pack2(kq[0], kq[1]); bvP[e2] = pack2(bq[0], bq[1]);
        asm volatile("" : "+v"(qP[e2]), "+v"(kapP[e2]), "+v"(ktP[e2]), "+v"(bvP[e2]));
      }
      tot[tg * 128 + k] = run;
    } else if constexpr (TYPE == 1) {
      float w2[16];
#pragma unroll
      for (int i = 0; i < 16; ++i) w2[i] = PIN(30)[i * 512 + h * 128 + k];
      const float ba = PIN(31)[h * 128 + k];
      bf16 rq[TPT], rk[TPT];
#pragma unroll
      for (int e = 0; e < TPT; ++e) { const size_t row = rb + tg * TPT + e; rq[e] = Aq[row * 512 + h * 128 + k]; rk[e] = Akk[row * 512 + h * 128 + k]; }
      float4 ar[TPT][4];
      float run = 0.f;
#pragma unroll
      for (int e = 0; e < TPT; e += 4) {
#pragma unroll
        for (int u = 0; u < 4; ++u)
#pragma unroll
          for (int q4 = 0; q4 < 4; ++q4) ar[e + u][q4] = *(const float4*)(sm + (rb + tg * TPT + e + u) * 16 + q4 * 4);
#pragma unroll
        for (int u = 0; u < 4; ++u) {
          float s = ba;
#pragma unroll
          for (int q4 = 0; q4 < 4; ++q4) { const float4 a4 = ar[e + u][q4]; s += a4.x * w2[q4 * 4] + a4.y * w2[q4 * 4 + 1] + a4.z * w2[q4 * 4 + 2] + a4.w * w2[q4 * 4 + 3]; }
          const float gk = (fminf(s, 0.f) - log1pf(__expf(-fabsf(s)))) * (1.f / 16.f);
          run += gk; lgL[(tg * TPT + e + u) * 128 + k] = run;
        }
      }
#pragma unroll
      for (int e2 = 0; e2 < TPT / 2; ++e2) {
        qP[e2] = (unsigned)rq[2 * e2] | ((unsigned)rq[2 * e2 + 1] << 16);
        ktP[e2] = (unsigned)rk[2 * e2] | ((unsigned)rk[2 * e2 + 1] << 16);
        asm volatile("" : "+v"(qP[e2]), "+v"(ktP[e2]));
      }
      tot[tg * 128 + k] = run;
    } else {
      bf16 rq[TPT], rk[TPT];
#pragma unroll
      for (int e = 0; e < TPT; ++e) { const size_t o = (rb + tg * TPT + e) * 1024 + h * 128 + k; rq[e] = Aq[o]; rk[e] = Akk[o]; }
#pragma unroll
      for (int e2 = 0; e2 < TPT / 2; ++e2) {
        qP[e2] = (unsigned)rq[2 * e2] | ((unsigned)rq[2 * e2 + 1] << 16);
        ktP[e2] = (unsigned)rk[2 * e2] | ((unsigned)rk[2 * e2 + 1] << 16);
        asm volatile("" : "+v"(qP[e2]), "+v"(ktP[e2]));
      }
    }
    __syncthreads();
    float lgC;
    if constexpr (TYPE == 2) { lgC = sc_lg[63]; }
    else {
      float off = 0.f, all = 0.f;
#pragma unroll
      for (int g2 = 0; g2 < KT; ++g2) { const float tv = tot[g2 * 128 + k]; all += tv; if (g2 < tg) off += tv; }
      if constexpr (TYPE == 0) {
#pragma unroll
        for (int e = 0; e < TPT; ++e) lg[e] += off;
      } else {
#pragma unroll
        for (int e = 0; e < TPT; ++e) lgL[(tg * TPT + e) * 128 + k] += off;
      }
      lgC = all;
    }
#define QV(e) GETP(qP, e)
#define LGV(e, t) ((TYPE == 2) ? sc_lg[t] : ((TYPE == 1) ? lgL[(t) * 128 + k] : lg[(TYPE == 0) ? (e) : 0]))
#define LPREV(e, t) ((TYPE == 0) ? (lg[(TYPE == 0) ? (e) : 0] - ldv[(TYPE == 0) ? (e) : 0]) : (sc_lg[t] - sc_g[t]))
#define KTV(e, t) ((TYPE == 2) ? (sc_beta[t] * GETP(ktP, e)) : GETP(ktP, e))
#define KAPV(e, t) ((TYPE == 2) ? GETP(ktP, e) : GETP(kapP, (TYPE == 0) ? (e) : 0))
#define BVV(e, t) ((TYPE == 2) ? (sc_beta[t] * sc_eg[t] * GETP(ktP, e)) : GETP(bvP, (TYPE == 0) ? (e) : 0))
    f32x4 sacc[LOW ? 4 : 1][4];
#pragma unroll
    for (int a = 0; a < (LOW ? 4 : 1); ++a) zero4(sacc[a]);
#pragma unroll
    for (int kh = 0; kh < DKH; ++kh) {
      if (k / 64 == kh) {
        const int kk = k & 63;
#pragma unroll
        for (int e = 0; e < TPT; ++e) {
          const int t = tg * TPT + e;
          if constexpr (TYPE == 2) {
            X0[t * 72 + kk] = f2bf(QV(e)); Y0[t * 72 + kk] = f2bf(KTV(e, t));
            X1[t * 72 + kk] = f2bf(KAPV(e, t)); Y1[t * 72 + kk] = f2bf(BVV(e, t));
          } else {
            const float lgt = LGV(e, t);
            const float el = __expf(lgt), eml = __expf(-lgt);
            X0[t * 72 + kk] = f2bf(QV(e) * el);
            Y0[t * 72 + kk] = f2bf(KTV(e, t) * eml);
            if constexpr (LOW) {
              X1[t * 72 + kk] = f2bf(KAPV(e, t) * __expf(LPREV(e, t)));
              Y1[t * 72 + kk] = f2bf(BVV(e, t) * eml);
            }
          }
        }
      }
      __syncthreads();
      mm_strip(X0, Y0, sacc[0], wave, lane);
      if constexpr (LOW) { mm_strip(X0, Y1, sacc[1], wave, lane); mm_strip(X1, Y0, sacc[2], wave, lane); mm_strip(X1, Y1, sacc[3], wave, lane); }
      __syncthreads();
    }
#pragma unroll
    for (int nb = 0; nb < 4; ++nb)
#pragma unroll
      for (int jj = 0; jj < 4; ++jj) {
        const int t = wave * 16 + quad * 4 + jj, s = nb * 16 + lr;
        float da = 1.f, dl = 1.f;
        if constexpr (TYPE == 2) { const float dd = sc_lg[t] - sc_lg[s]; da = __expf(fminf(dd, 0.f)); dl = __expf(fminf(dd - sc_g[t], 0.f)); }
        Ak[t * 72 + s] = f2bf(s <= t ? sacc[0][nb][jj] * da : 0.f);
        if constexpr (LOW) {
          nAb[t * 72 + s] = f2bf(s <= t ? -sacc[1][nb][jj] * da : 0.f);
          LkT[s * 72 + t] = f2bf(s < t ? sacc[2][nb][jj] * dl : 0.f);
          Lb[t * 64 + (s & 3) * 16 + (s >> 2)] = s < t ? sacc[3][nb][jj] * dl : 0.f;
        }
      }
    __syncthreads();
    f32x4 acc[4];
    if constexpr (LOW) {
      {
        const int q = lane & 3, jc = wave * 16 + (lane >> 2);
        float xr[16];
#pragma unroll
        for (int i = 0; i < 16; ++i) xr[i] = 0.f;
#pragma unroll
        for (int t = 0; t < 64; ++t) {
          float s = 0.f, s2 = 0.f;
          const float* Lr = Lb + t * 64 + q * 16;
#pragma unroll
          for (int i = 0; i < (t + 3) / 4; ++i) { if (i & 1) s2 += Lr[i] * xr[i]; else s += Lr[i] * xr[i]; }
          s += s2;
          s += __shfl_xor(s, 1); s += __shfl_xor(s, 2);
          s = ((t == jc) ? 1.f : 0.f) - s;
          xr[t >> 2] = (q == (t & 3)) ? s : xr[t >> 2];
          if (q == 0) Tt[t * 72 + jc] = f2bf(s);
        }
      }
      __syncthreads();
      zero4(acc); mm_strip(Tt, LkT, acc, wave, lane);
#pragma unroll
      for (int nb = 0; nb < 4; ++nb)
#pragma unroll
        for (int jj = 0; jj < 4; ++jj) M1[(wave * 16 + quad * 4 + jj) * 72 + nb * 16 + lr] = f2bf(acc[nb][jj]);
      __syncthreads();
    }
#pragma unroll
    for (int vh = 0; vh < DVH; ++vh) {
#pragma unroll
      for (int e = 0; e < 8; ++e) *(unsigned*)(St1 + vv * 72 + tgv * 16 + 2 * e) = vP[vh][e];
      __syncthreads();
      if constexpr (LOW) {
        zero4(acc); mm_strip(M1, St1, acc, wave, lane);
#pragma unroll
        for (int nb = 0; nb < 4; ++nb)
#pragma unroll
          for (int jj = 0; jj < 4; ++jj) {
            const int t = wave * 16 + quad * 4 + jj, col = nb * 16 + lr; const bf16 u = f2bf(acc[nb][jj]);
            St2[col * 72 + t] = u;
          }
#pragma unroll
        for (int nb = 0; nb < 4; ++nb)
          *(uint2*)(Ou0 + (((((size_t)c * NH + h) * (DV / 16) + vh * 4 + nb) * 4 + wave) * 64 + lane) * 4) = make_uint2(pack2(acc[nb][0], acc[nb][1]), pack2(acc[nb][2], acc[nb][3]));
        __syncthreads();
      }
      zero4(acc); mm_strip(Ak, St1, acc, wave, lane);
      if constexpr (LOW) mm_strip(nAb, St2, acc, wave, lane);
#pragma unroll
      for (int nb = 0; nb < 4; ++nb)
        *(uint2*)(Ool + (((((size_t)c * NH + h) * (DV / 16) + vh * 4 + nb) * 4 + wave) * 64 + lane) * 4) = make_uint2(pack2(acc[nb][0], acc[nb][1]), pack2(acc[nb][2], acc[nb][3]));
      __syncthreads();
    }
    if constexpr (LOW) {
#pragma unroll
      for (int kh = 0; kh < DKH; ++kh) {
        if (k / 64 == kh) {
          const int kk = k & 63;
#pragma unroll
          for (int e = 0; e < TPT; ++e) {
            const int t = tg * TPT + e;
            St1[kk * 72 + t] = f2bf(KAPV(e, t) * __expf(LPREV(e, t)));
            LkT[t * 72 + kk] = f2bf(QV(e) * __expf(LGV(e, t)));
            }
        }
        __syncthreads();
        zero4(acc); mm_strip(Tt, St1, acc, wave, lane);
#pragma unroll
        for (int nb = 0; nb < 4; ++nb)
#pragma unroll
          for (int jj = 0; jj < 4; ++jj) {
            const int t = wave * 16 + quad * 4 + jj, col = nb * 16 + lr; const bf16 u = f2bf(acc[nb][jj]);
            St2[col * 72 + t] = u;
            Ow[(rb + t) * 1024 + h * DK + perm32(kh * 64 + col)] = u;
          }
        __syncthreads();
        zero4(acc); mm_strip(nAb, St2, acc, wave, lane);
#pragma unroll
        for (int nb = 0; nb < 4; ++nb)
#pragma unroll
          for (int jj = 0; jj < 4; ++jj) {
            const int t = wave * 16 + quad * 4 + jj, col = nb * 16 + lr;
            Oq[(rb + t) * LDQ + h * DK + perm32(kh * 64 + col)] = f2bf(acc[nb][jj] + bf2f(LkT[t * 72 + col]));
          }
        __syncthreads();
      }
    } else {
#pragma unroll
      for (int e = 0; e < TPT; ++e) { Oq[(rb + tg * TPT + e) * LDQ + h * DK + perm32(k)] = f2bf(QV(e) * __expf(LGV(e, tg * TPT + e))); }
    }
    {
      unsigned wk[TPT / 2], wb[LOW ? TPT / 2 : 1];
#pragma unroll
      for (int e = 0; e < TPT; e += 2) {
        const int t0 = tg * TPT + e;
        const float d0 = __expf(lgC - LGV(e, t0)), d1 = __expf(lgC - LGV(e + 1, t0 + 1));
        wk[e / 2] = pack2(KTV(e, t0) * d0, KTV(e + 1, t0 + 1) * d1);
        if constexpr (LOW) wb[e / 2] = pack2(BVV(e, t0) * d0, BVV(e + 1, t0 + 1) * d1);
      }
      const size_t co = rb * LDQ + h * DK + cont_off<DK>(k, tg * TPT, LDQ);
#pragma unroll
      for (int e = 0; e < TPT / 8; ++e) {
        *(uint4*)(Okt + co + e * 8) = make_uint4(wk[e * 4], wk[e * 4 + 1], wk[e * 4 + 2], wk[e * 4 + 3]);
        if constexpr (LOW) {
#pragma unroll
          for (int g4 = 0; g4 < 2; ++g4) {
            const int s0 = tg * TPT + e * 8 + g4 * 4;
            *(uint2*)(Obt + rb * 1024 + h * DK + cont_off<DK>(k, perm32(s0), 1024)) = make_uint2(wb[e * 4 + g4 * 2], wb[e * 4 + g4 * 2 + 1]);
          }
        }
      }
#pragma unroll
      for (int vh = 0; vh < DVH; ++vh) {
        const unsigned* wv = vP[vh];
        const size_t vo = rb * 1024 + h * DV + cont_off<DV>(vh * 64 + vv, tgv * 16, 1024);
        *(uint4*)(Ovt + vo) = make_uint4(wv[0], wv[1], wv[2], wv[3]);
        *(uint4*)(Ovt + vo + 8) = make_uint4(wv[4], wv[5], wv[6], wv[7]);
      }
      if (tg == 0) gam[((size_t)c * NH + h) * DK + k] = __expf(lgC);
    }
    __syncthreads();
  }
}

template <int TYPE>
DEVI void phase_seq2(const P& p, int j, char* smem) {
  constexpr int NH = TYPE == 0 ? 16 : (TYPE == 1 ? 4 : 8);
  constexpr int DK = TYPE == 0 ? 64 : 128;
  constexpr int DV = TYPE == 0 ? 64 : (TYPE == 1 ? 256 : 128);
  constexpr bool LOW = TYPE != 1;
  constexpr int NVB = DV / 16, MB = DK / 16, KS = DK / 32, NG = NVB / 4, BIPS = NH * NG;
  constexpr int LDQ = TYPE == 1 ? 512 : 1024;
  constexpr int NOP = LOW ? 4 : 2, RS = DK + 8, OPSZ = 64 * RS, PPR = DK / 8;
  constexpr int PPO = 64 * PPR / 256;
  constexpr int PF = 4;
  bf16* L = (bf16*)smem;
  const int tid = threadIdx.x, lane = tid & 63, wave = tid >> 6, lr = lane & 15, quad = lane >> 4;
  const bf16 *Qp, *Kt, *Vt, *Wp = nullptr, *Bt = nullptr, *U0 = nullptr; bf16* Ol;
  if (TYPE == 0) { Qp = slot(p, 5); Kt = slot(p, 6); Vt = slot(p, 7); Wp = slot(p, 2); Bt = slot(p, 3); Ol = slot(p, 0); U0 = slot(p, 1); }
  else if (TYPE == 1) { Qp = slot(p, 1); Kt = slot(p, 1) + (size_t)MT * 512; Vt = slot(p, 2); Ol = slot(p, 4); }
  else { Qp = slot(p, 5); Kt = slot(p, 6); Vt = slot(p, 7); Wp = slot(p, 1); Bt = slot(p, 2); Ol = slot(p, 3); U0 = slot(p, 0); }
  const float* gam = (const float*)(PWS + WS_GAM);
  unsigned tsink = 0;
  for (int bitem = blockIdx.x; bitem < 33 * BIPS; bitem += gridDim.x) {
    const int seq = bitem / BIPS, rem = bitem % BIPS, h = rem / NG, vb = (rem % NG) * 4 + wave;
    const int c0 = seq == 0 ? 0 : NPCH + seq - 1, nc = seq == 0 ? NPCH : 1;
    const int vcol = vb * 16 + lr;
    f32x4 H[MB];
    if (seq == 0) {
#pragma unroll
      for (int m = 0; m < MB; ++m) H[m] = (f32x4){0.f, 0.f, 0.f, 0.f};
    } else {
      const int b = seq - 1;
      if (TYPE == 0) {
        const float* S = PIN(3) + (((size_t)j * NSS + b) * 16 + h) * 4096 + (size_t)vcol * 64;
#pragma unroll
        for (int m = 0; m < MB; ++m) { float4 v = *(const float4*)(S + m * 16 + quad * 4); H[m] = (f32x4){v.x, v.y, v.z, v.w}; }
      } else {
        const float* S = PIN(TYPE == 1 ? 4 : 6) + ((size_t)b * NH + h) * DK * DV + vcol;
#pragma unroll
        for (int m = 0; m < MB; ++m)
#pragma unroll
          for (int jj = 0; jj < 4; ++jj) H[m][jj] = S[(size_t)(m * 16 + quad * 4 + jj) * DV];
      }
    }
    u32x4 preA[NOP * PPO], preB[NOP * PPO]; u32x2 poA[4], poB[4], puA[4], puB[4]; bf16x8 pvA[2], pvB[2]; f32x4 pgA[MB], pgB[MB];
    auto issue_sh = [&](int cc, u32x4 (&pre)[NOP * PPO]) {
      const size_t rb_ = (size_t)cc * 64; int tl_ = threadIdx.x; asm volatile("" : "+v"(tl_));
#pragma unroll
      for (int i_ = 0; i_ < PPO; ++i_) { const int w_ = tl_ + 256 * i_; const size_t r_ = rb_ + w_ / PPR; const int c8_ = (w_ % PPR) * 8;
        pre[0 * PPO + i_] = *(const u32x4*)(Qp + r_ * LDQ + h * DK + c8_);
        pre[1 * PPO + i_] = *(const u32x4*)(Kt + r_ * LDQ + h * DK + c8_);
        if constexpr (LOW) { pre[2 * PPO + i_] = *(const u32x4*)(Wp + r_ * 1024 + h * DK + c8_); pre[3 * PPO + i_] = *(const u32x4*)(Bt + r_ * 1024 + h * DK + c8_); } }
    };
    auto issue_pr = [&](int cc, u32x2 (&p_o)[4], u32x2 (&p_u)[4], bf16x8 (&p_v)[2], f32x4 (&p_g)[MB]) {
      const size_t rb_ = (size_t)cc * 64; int tl_ = threadIdx.x; asm volatile("" : "+v"(tl_));
      const int lane = tl_ & 63, lr = lane & 15, quad = lane >> 4, vcol = vb * 16 + lr;
      const size_t fo_ = ((((size_t)cc * NH + h) * NVB + vb) * 4) * 256 + lane * 4;
#pragma unroll
      for (int tb_ = 0; tb_ < 4; ++tb_) { p_o[tb_] = *(const u32x2*)(Ol + fo_ + tb_ * 256); if constexpr (LOW) p_u[tb_] = *(const u32x2*)(U0 + fo_ + tb_ * 256); }
#pragma unroll
      for (int ks_ = 0; ks_ < 2; ++ks_) p_v[ks_] = *(const bf16x8*)(Vt + rb_ * 1024 + h * DV + cont_off<DV>(vcol, ks_ * 32 + quad * 8, 1024));
#pragma unroll
      for (int m_ = 0; m_ < MB; ++m_) p_g[m_] = *(const f32x4*)(gam + ((size_t)cc * NH + h) * DK + m_ * 16 + quad * 4);
    };
    const int cend = c0 + nc;
    auto step = [&](int c, u32x4 (&pre)[NOP * PPO], u32x2 (&p_o)[4], u32x2 (&p_u)[4], bf16x8 (&p_v)[2], f32x4 (&p_g)[MB]) {
#pragma unroll
      for (int o = 0; o < NOP; ++o)
#pragma unroll
        for (int i = 0; i < PPO; ++i) { const int w = tid + 256 * i; *(u32x4*)(L + o * OPSZ + (w / PPR) * RS + (w % PPR) * 8) = pre[o * PPO + i]; }
      __syncthreads();
      if (c + 2 < cend) issue_sh(c + 2, pre);
      unsigned tv[NOP * DK / 128 + 1];
#pragma unroll
      for (int i = 0; i < NOP * DK / 128 + 1; ++i) tv[i] = 0;
      if (false && c + PF < cend) {
        const size_t rb2 = (size_t)(c + PF) * 64;
        if (DK == 128 || tid < 128) {
          const int li = (DK == 128) ? tid : tid; const size_t ro = li / (DK / 64) % 64; const int co = (li % (DK / 64)) * 64;
          const int half = (DK == 128) ? (tid >> 7) : (tid >> 6);
          if (half == 0) { tv[0] = *(const unsigned*)(Qp + (rb2 + ro) * LDQ + h * DK + co); if constexpr (LOW) tv[1] = *(const unsigned*)(Wp + (rb2 + ro) * 1024 + h * DK + co); }
          else { tv[0] = *(const unsigned*)(Kt + (rb2 + ro) * LDQ + h * DK + co); if constexpr (LOW) tv[1] = *(const unsigned*)(Bt + (rb2 + ro) * 1024 + h * DK + co); }
        }
        {
          const size_t fo2 = ((((size_t)(c + PF) * NH + h) * NVB + vb) * 4) * 256;
          const unsigned* tp;
          if (lane < 16) tp = (const unsigned*)(Ol + fo2 + lane * 64);
          else if (LOW && lane < 32) tp = (const unsigned*)(U0 + fo2 + (lane - 16) * 64);
          else if (lane < 48) tp = (const unsigned*)(Vt + rb2 * 1024 + h * DV + cont_off<DV>(vb * 16 + (lane & 15), 0, 1024));
          else tp = (const unsigned*)(gam + ((size_t)(c + PF) * NH + h) * DK + ((lane - 48) & (DK / 32 - 1)) * 32);
          tv[NOP * DK / 128] = *tp;
        }
      }
      bf16x8 hb[KS];
#pragma unroll
      for (int ks = 0; ks < KS; ++ks) {
        const u32x4 hw = {pack2(H[2 * ks][0], H[2 * ks][1]), pack2(H[2 * ks][2], H[2 * ks][3]), pack2(H[2 * ks + 1][0], H[2 * ks + 1][1]), pack2(H[2 * ks + 1][2], H[2 * ks + 1][3])};
        hb[ks] = __builtin_bit_cast(bf16x8, hw);
      }
      const size_t fo = ((((size_t)c * NH + h) * NVB + vb) * 4) * 256 + lane * 4;
      f32x4 U[4];
#pragma unroll
      for (int tb = 0; tb < 4; ++tb) {
        f32x4 o_ = (f32x4){bf2f(p_o[tb].x & 0xffff), bf2f(p_o[tb].x >> 16), bf2f(p_o[tb].y & 0xffff), bf2f(p_o[tb].y >> 16)}, u_;
        if constexpr (LOW) u_ = (f32x4){bf2f(p_u[tb].x & 0xffff), bf2f(p_u[tb].x >> 16), bf2f(p_u[tb].y & 0xffff), bf2f(p_u[tb].y >> 16)};
#pragma unroll
        for (int ks = 0; ks < KS; ++ks) {
          o_ = __builtin_amdgcn_mfma_f32_16x16x32_bf16(*(const bf16x8*)(L + 0 * OPSZ + (tb * 16 + lr) * RS + ks * 32 + quad * 8), hb[ks], o_, 0, 0, 0);
          if constexpr (LOW) u_ = __builtin_amdgcn_mfma_f32_16x16x32_bf16(*(const bf16x8*)(L + 2 * OPSZ + (tb * 16 + lr) * RS + ks * 32 + quad * 8), hb[ks], u_, 0, 0, 0);
        }
        *(u32x2*)(Ol + fo + tb * 256) = (u32x2){pack2(o_[0], o_[1]), pack2(o_[2], o_[3])};
        if constexpr (LOW) U[tb] = u_;
      }
      bf16x8 ubop[2];
      if constexpr (LOW) {
#pragma unroll
        for (int ks = 0; ks < 2; ++ks) {
          const u32x4 uw = {pack2(-U[2 * ks][0], -U[2 * ks][1]), pack2(-U[2 * ks][2], -U[2 * ks][3]), pack2(-U[2 * ks + 1][0], -U[2 * ks + 1][1]), pack2(-U[2 * ks + 1][2], -U[2 * ks + 1][3])};
          ubop[ks] = __builtin_bit_cast(bf16x8, uw);
        }
      }
#pragma unroll
      for (int m = 0; m < MB; ++m) {
        f32x4 hn = (f32x4){H[m][0] * p_g[m][0], H[m][1] * p_g[m][1], H[m][2] * p_g[m][2], H[m][3] * p_g[m][3]};
        const int krow = m * 16 + lr;
#pragma unroll
        for (int ks = 0; ks < 2; ++ks) {
          const int i1 = krow * 64 + ks * 32 + quad * 8;
          bf16x8 a = *(const bf16x8*)(L + 1 * OPSZ + (i1 / DK) * RS + (i1 % DK));
          hn = __builtin_amdgcn_mfma_f32_16x16x32_bf16(a, p_v[ks], hn, 0, 0, 0);
          if constexpr (LOW) {
            hn = __builtin_amdgcn_mfma_f32_16x16x32_bf16(*(const bf16x8*)(L + 3 * OPSZ + (i1 / DK) * RS + (i1 % DK)), ubop[ks], hn, 0, 0, 0);
          }
        }
        H[m] = hn;
      }
#pragma unroll
      for (int i = 0; i < NOP * DK / 128 + 1; ++i) tsink ^= tv[i];
      if (c + 2 < cend) issue_pr(c + 2, p_o, p_u, p_v, p_g);
      __syncthreads();
    };
    issue_sh(c0, preA); issue_pr(c0, poA, puA, pvA, pgA);
    if (nc > 1) { issue_sh(c0 + 1, preB); issue_pr(c0 + 1, poB, puB, pvB, pgB); }
    for (int c = c0; c < cend; c += 2) { step(c, preA, poA, puA, pvA, pgA); if (c + 1 < cend) step(c + 1, preB, poB, puB, pvB, pgB); }
    if (TYPE == 0) {
      float* S = POUT + (seq == 0 ? O_AWKV_P + ((size_t)j * 16 + h) * 4096 : O_AWKV_S + (((size_t)j * NSS + (seq - 1)) * 16 + h) * 4096) + (size_t)vcol * 64;
#pragma unroll
      for (int m = 0; m < MB; ++m) *(float4*)(S + m * 16 + quad * 4) = make_float4(H[m][0], H[m][1], H[m][2], H[m][3]);
    } else {
      const size_t ob = TYPE == 1 ? (seq == 0 ? O_BKV_P : O_BKV_S + (size_t)(seq - 1) * NH * DK * DV)
                                  : (seq == 0 ? O_CKV_P : O_CKV_S + (size_t)(seq - 1) * NH * DK * DV);
      float* S = POUT + ob + (size_t)h * DK * DV + vcol;
#pragma unroll
      for (int m = 0; m < MB; ++m)
#pragma unroll
        for (int jj = 0; jj < 4; ++jj) S[(size_t)(m * 16 + quad * 4 + jj) * DV] = H[m][jj];
    }
  }
  if (tsink == 0x9e3779b9u) ((unsigned*)(PWS + WS_SINK))[0] = tsink;
}

template <int TYPE>
DEVI void phase_post(const P& p, int j, char* smem) {
  constexpr int NH = TYPE == 0 ? 16 : (TYPE == 1 ? 4 : 8);
  constexpr int DV = TYPE == 0 ? 64 : (TYPE == 1 ? 256 : 128);
  constexpr int CPT = DV / 8;
  bf16* vt = (bf16*)smem;
  bf16* ot = (bf16*)(smem + 9216);
  const bf16* O = slot(p, TYPE == 0 ? 0 : (TYPE == 1 ? 4 : 3));
  const bf16* G = slot(p, TYPE == 0 ? 4 : (TYPE == 1 ? 3 : 4));
  bf16* og = slot(p, TYPE == 1 ? 0 : 1);
  const float* sm = (const float*)(PWS + WS_SM);
  for (int item = blockIdx.x; item < NCHUNK * NH; item += gridDim.x) {
    const int c = item / NH, h = item % NH; const size_t rb = (size_t)c * 64;
    int tid = threadIdx.x; asm volatile("" : "+v"(tid));
    const int part = tid & 7;
    if constexpr (TYPE == 0) {
      const bf16* V = slot(p, 7) + rb * 1024 + h * 64;
      const int r = tid >> 2, q4 = (tid & 3) * 16;
      *(uint4*)(vt + r * 72 + q4) = *(const uint4*)(V + (size_t)r * 1024 + q4);
      *(uint4*)(vt + r * 72 + q4 + 8) = *(const uint4*)(V + (size_t)r * 1024 + q4 + 8);
      __syncthreads();
    }
    {
      const uint4* srcp = (const uint4*)(O + ((size_t)c * NH + h) * 64 * DV);
#pragma unroll
      for (int i = 0; i < DV / 32; ++i) *(uint4*)(ot + (size_t)(i * 256 + tid) * 8) = srcp[i * 256 + tid];
      __syncthreads();
    }
#pragma unroll 1
    for (int pass = 0; pass < 2; ++pass) {
      const int t = pass * 32 + (tid >> 3);
      const size_t base = (rb + t) * 1024 + h * DV + part * CPT;
      float o[CPT];
#pragma unroll
      for (int e = 0; e < CPT; ++e) {
        const int v = part * CPT + e;
        o[e] = bf2f(ot[(((v >> 4) * 4 + (t >> 4)) * 64 + ((t & 15) >> 2) * 16 + (v & 15)) * 4 + (t & 3)]);
      }
      float s1 = 0.f, s2 = 0.f;
#pragma unroll
      for (int e = 0; e < CPT; ++e) { s1 += o[e]; s2 += o[e] * o[e]; }
      s1 += __shfl_xor(s1, 1); s1 += __shfl_xor(s1, 2); s1 += __shfl_xor(s1, 4);
      s2 += __shfl_xor(s2, 1); s2 += __shfl_xor(s2, 2); s2 += __shfl_xor(s2, 4);
      if constexpr (TYPE == 0) {
        const float mean = s1 * (1.f / 64.f); float var = s2 * (1.f / 64.f) - mean * mean; var = fmaxf(var, 0.f);
        const float rs = rsqrtf(var + 64e-5f); const float bonus = sm[(rb + t) * 16 + h];
        const float* lw = PIN(26) + j * 1024 + h * 64 + part * CPT; const float* lb = PIN(27) + j * 1024 + h * 64 + part * CPT;
#pragma unroll
        for (int e = 0; e < CPT; ++e) {
          const float vv = bf2f(vt[(part * CPT + e) * 72 + t]);
          o[e] = (o[e] - mean) * rs * lw[e] + lb[e] + bonus * vv;
        }
      } else {
        const float rs = rsqrtf(s2 * (1.f / DV) + 1e-6f);
        const float* on = PIN(TYPE == 1 ? 32 : 38) + part * CPT;
#pragma unroll
        for (int e = 0; e < CPT; ++e) o[e] = o[e] * rs * on[e];
      }
#pragma unroll
      for (int e = 0; e < CPT; e += 8) {
        uint4 u = *(const uint4*)(G + base + e);
        const unsigned w[4] = {u.x, u.y, u.z, u.w}; unsigned ow[4];
#pragma unroll
        for (int i = 0; i < 4; ++i) {
          float g0 = bf2f(w[i] & 0xffff), g1 = bf2f(w[i] >> 16);
          if constexpr (TYPE != 0) { g0 = silu(g0); g1 = silu(g1); }
          ow[i] = pack2(o[e + 2 * i] * g0, o[e + 2 * i + 1] * g1);
        }
        *(uint4*)(og + base + e) = make_uint4(ow[0], ow[1], ow[2], ow[3]);
      }
    }
    __syncthreads();
  }
}


#define XB_TMO      128
#define XB_XCNT(j)  (256  + 64 * (j))
#define XB_XSUB(j)  (1280 + 64 * (j))
#define XB_XGEN(j)  (2304 + 64 * (j))
#define XB_TOP      3328
#define XB_TOPGEN   3392
#define XCD_BAR_WORDS 3456
#define XB_SPIN_CAP (1u << 18)
#define LAS __attribute__((address_space(3)))
DEVI unsigned xb_ld(unsigned* p)              { return __hip_atomic_load(p, __ATOMIC_RELAXED, __HIP_MEMORY_SCOPE_AGENT); }
DEVI unsigned xb_add(unsigned* p, unsigned v) { return __hip_atomic_fetch_add(p, v, __ATOMIC_RELAXED, __HIP_MEMORY_SCOPE_AGENT); }
DEVI unsigned xb_xcc_id() { return (unsigned)__builtin_amdgcn_s_getreg((3 << 11) | 20) & 0xFu; }
#define XB_SPIN(cond, bar) do { unsigned _sp = 0; while (cond) { __builtin_amdgcn_s_sleep(1); \
    if ((++_sp & 255u) == 0u) { if (xb_ld(&(bar)[XB_TMO])) break; if (_sp > XB_SPIN_CAP) { atomicAdd(&(bar)[XB_TMO], 1u); break; } } } } while (0)
struct XcdBarrier { unsigned* bar; unsigned x; volatile LAS unsigned* st; };
DEVI XcdBarrier xcd_barrier_post(unsigned* bar, volatile LAS unsigned* st) {
  XcdBarrier b; b.bar = bar; b.x = xb_xcc_id(); b.st = st;
  if (threadIdx.x == 0) (void)xb_add(&bar[XB_XCNT(b.x)], 1u);
  return b;
}
DEVI void xcd_barrier_complete(unsigned* bar, unsigned x, unsigned& nloc, unsigned& nx) {
  const unsigned G = gridDim.x * gridDim.y * gridDim.z;
  unsigned sum, cnt, mine, sp = 0u;
  for (;;) {
    sum = 0u; cnt = 0u; mine = 0u;
#pragma unroll
    for (unsigned j = 0; j < 16; ++j) { const unsigned c = xb_ld(&bar[XB_XCNT(j)]); sum += c; cnt += (c > 0u) ? 1u : 0u; mine = (j == x) ? c : mine; }
    if (sum == G) break;
    __builtin_amdgcn_s_sleep(1);
    if ((++sp & 255u) == 0u) { if (xb_ld(&bar[XB_TMO])) break; if (sp > XB_SPIN_CAP) { atomicAdd(&bar[XB_TMO], 1u); break; } }
  }
  nloc = mine > 0u ? mine : 1u; nx = cnt > 0u ? cnt : 1u;
}
DEVI void xcd_barrier(const XcdBarrier& b) {
  asm volatile("s_waitcnt vmcnt(0)" ::: "memory");
  __syncthreads();
  if (threadIdx.x == 0) {
    unsigned* bar = b.bar;
    __builtin_amdgcn_s_waitcnt(0);
    unsigned nloc = b.st[0], nx = b.st[1];
    if (nloc == 0u) { xcd_barrier_complete(bar, b.x, nloc, nx); b.st[0] = nloc; b.st[1] = nx; }
    const unsigned old = xb_add(&bar[XB_XSUB(b.x)], 1u);
    const unsigned gen = old / nloc;
    if (old + 1u == (gen + 1u) * nloc) {
      __builtin_amdgcn_fence(__ATOMIC_RELEASE, "agent");
      asm volatile("s_waitcnt vmcnt(0)" ::: "memory");
      const unsigned og = xb_add(&bar[XB_TOP], 1u);
      const unsigned tg = og / nx;
      if (og + 1u == (tg + 1u) * nx) xb_add(&bar[XB_TOPGEN], 1u);
      else XB_SPIN(xb_ld(&bar[XB_TOPGEN]) == tg, bar);
      __builtin_amdgcn_fence(__ATOMIC_ACQUIRE, "agent");
      xb_add(&bar[XB_XGEN(b.x)], 1u);
      asm volatile("s_waitcnt vmcnt(0)" ::: "memory");
    } else {
      XB_SPIN(xb_ld(&bar[XB_XGEN(b.x)]) == gen, bar);
      __builtin_amdgcn_fence(__ATOMIC_ACQUIRE, "agent");
      asm volatile("s_waitcnt vmcnt(0)" ::: "memory");
    }
  }
  __syncthreads();
}

#ifndef DISMASK
#define DISMASK 0
#endif
#define EN(b) (!((DISMASK >> (b)) & 1))
#define GSYNC() xcd_barrier(xb)
#define GSYNC_CG() do { asm volatile("s_waitcnt vmcnt(0)" ::: "memory"); grid.sync(); } while (0)
__global__ void __launch_bounds__(256, 1) fwd_megakernel(P p) {
  extern __shared__ __attribute__((aligned(16))) char smem[];
  cg::grid_group grid = cg::this_grid();
  volatile LAS unsigned* xst = (volatile LAS unsigned*)(smem + LDS_BYTES - 16);
  if (threadIdx.x == 0) { xst[0] = 0u; xst[1] = 0u; }
  __syncthreads();
  const XcdBarrier xb = xcd_barrier_post((unsigned*)(PWS + WS_BAR), xst);
  bf16* wreg = (bf16*)(PWS + WS_W);
  bf16 *wfin = wreg + W_FIN, *wfout = wreg + W_FOUT, *wmix = wreg + W_MIX;
  float* sm = (float*)(PWS + WS_SM);
  for (int layer = 0; layer < 4; ++layer) {
    const int type = layer % 3, j = layer / 3;
    int tb = 0;
    if (type == 0) phase_norm<0>(p, layer, j, layer == 0, layer == 0);
    else phase_norm<1>(p, layer, j, false, false);
    conv_job(CvFfnIn{PIN(10) + (size_t)layer * 1024 * 2 * FF}, wfin, 1024, 2 * FF, 1024, tb, smem);
    conv_job(CvPlain{PIN(11) + (size_t)layer * FF * 1024, 1024, 1024}, wfout, FF, 1024, FF, tb, smem);
    if (type == 0) {
      for (int i = 0; i < 3; ++i) conv_job(CvPlain{PIN(24) + ((size_t)j * 3 + i) * 1048576, 1024, 1024}, wmix + (size_t)i * 1048576, 1024, 1024, 1024, tb, smem);
      conv_job(CvLora1{PIN(14) + (size_t)j * 65536, PIN(17) + (size_t)j * 65536, PIN(19) + (size_t)j * 131072, PIN(12) + (size_t)j * 6144}, wmix + 3145728, 2048, 256, 2048, tb, smem);
      conv_job(CvPlain{PIN(15) + (size_t)j * 65536, 1024, 1024}, wmix + 3670016, 64, 1024, 64, tb, smem);
      conv_job(CvPlain{PIN(18) + (size_t)j * 65536, 1024, 1024}, wmix + 3735552, 64, 1024, 64, tb, smem);
      conv_job(CvPlain{PIN(20) + (size_t)j * 131072, 1024, 1024}, wmix + 3801088, 128, 1024, 128, tb, smem);
      conv_job(CvPlain{PIN(25) + (size_t)j * 1048576, 1024, 1024}, wmix + 3932160, 1024, 1024, 1024, tb, smem);
    } else if (type == 1) {
      conv_job(CvGlaIn{PIN(28), PIN(29)}, wmix, 1024, 3200, 1024, tb, smem);
      conv_job(CvPlain{PIN(33), 1024, 1024}, wmix + 3276800, 1024, 1024, 1024, tb, smem);
    } else {
      conv_job(CvPlain{PIN(34), 4112, 4112}, wmix, 1024, 4224, 1024, tb, smem);
      conv_job(CvPlain{PIN(39), 1024, 1024}, wmix + 4325376, 1024, 1024, 1024, tb, smem);
    }
    GSYNC();
    tb = 0;
    const bf16* wo;
    if (type == 0) {
      for (int i = 0; i < 3; ++i)
        gemm_job(GemmDesc{slot(p, 2 + i), nullptr, 1024, 1024, wmix + (size_t)i * 1048576, 1024, 144, 8, 1024}, EpiStore{slot(p, 5 + i), 1024, 1.f}, tb, smem);
      gemm_job(GemmDesc{slot(p, 0), slot(p, 1), 1024, 1024, wmix + 3145728, 2048, 144, 2, 2048}, EpiLora1{(bf16*)(PWS + WS_L1)}, tb, smem);
      GSYNC();
      tb = 0;
      const bf16* l1 = (const bf16*)(PWS + WS_L1);
      gemm_job(GemmDesc{l1, nullptr, 256, 64, wmix + 3670016, 64, 144, 8, 64}, EpiLd{slot(p, 2), PIN(13) + j * 1024}, tb, smem);
      gemm_job(GemmDesc{l1 + 64, nullptr, 256, 64, wmix + 3735552, 64, 144, 8, 64}, EpiSig{slot(p, 3), PIN(16) + j * 1024}, tb, smem);
      gemm_job(GemmDesc{l1 + 128, nullptr, 256, 128, wmix + 3801088, 128, 144, 8, 128}, EpiStore{slot(p, 4), 1024, 1.f}, tb, smem);
      GSYNC();
      if (EN(2)) phase_prep<0>(p, j, smem);
      GSYNC();
      if (EN(5)) phase_seq2<0>(p, j, smem);
      GSYNC();
      if (EN(8)) phase_post<0>(p, j, smem);
      wo = wmix + 3932160;
    } else if (type == 1) {
      gemm_job(GemmDesc{slot(p, 0), nullptr, 1024, 1024, wmix, 1024, 144, 25, 1024},
               EpiGlaIn{slot(p, 1), slot(p, 1) + (size_t)MT * 512, slot(p, 2), slot(p, 3), sm}, tb, smem);
      GSYNC();
      if (EN(3)) phase_prep<1>(p, j, smem);
      GSYNC();
      if (EN(6)) phase_seq2<1>(p, j, smem);
      GSYNC();
      if (EN(8)) phase_post<1>(p, j, smem);
      wo = wmix + 3276800;
    } else {
      gemm_job(GemmDesc{slot(p, 0), nullptr, 1024, 1024, wmix, 1024, 144, 33, 1024},
               EpiGdnIn{slot(p, 1), slot(p, 4), sm, POUT}, tb, smem);
      GSYNC();
      if (EN(9)) phase_gdn_conv(p);
      GSYNC();
      if (EN(4)) phase_prep<2>(p, j, smem);
      GSYNC();
      if (EN(7)) phase_seq2<2>(p, j, smem);
      GSYNC();
      if (EN(8)) phase_post<2>(p, j, smem);
      wo = wmix + 4325376;
    }
    GSYNC();
    tb = 0;
    gemm_job(GemmDesc{slot(p, type == 1 ? 0 : 1), nullptr, 1024, 1024, wo, 1024, 144, 8, 1024}, EpiAcc{POUT}, tb, smem);
    GSYNC();
    phase_rms(POUT, PIN(8) + layer * 1024, slot(p, 0), nullptr);
    GSYNC();
    tb = 0;
    gemm_job(GemmDesc{slot(p, 0), nullptr, 1024, 1024, wfin, 1024, 144, 44, 1024}, EpiSwiglu{slot(p, 1)}, tb, smem);
    GSYNC();
    tb = 0;
    gemm_job(GemmDesc{slot(p, 1), nullptr, FF, FF, wfout, FF, 144, 8, FF}, EpiAcc{POUT}, tb, smem);
    if (layer == 3) GSYNC_CG(); else GSYNC();
  }
  phase_rms(POUT, PIN(9), nullptr, POUT);
}

extern "C" void kernel_launch(void* const* d_in, const int* in_sizes, int n_in, void* d_out, int out_size,
                              void* d_ws, size_t ws_size, hipStream_t stream) {
  if (n_in < 40 || ws_size < WS_TOTAL) { fprintf(stderr, "bad args: n_in %d ws %zu need %zu\n", n_in, ws_size, (size_t)WS_TOTAL); return; }
  static int grid_blocks = 0;
  if (!grid_blocks) {
    int dev = 0, cus = 0, per_cu = 0;
    hipGetDevice(&dev);
    hipDeviceGetAttribute(&cus, hipDeviceAttributeMultiprocessorCount, dev);
    hipFuncSetAttribute((const void*)fwd_megakernel, hipFuncAttributeMaxDynamicSharedMemorySize, LDS_BYTES);
    hipOccupancyMaxActiveBlocksPerMultiprocessor(&per_cu, (const void*)fwd_megakernel, 256, LDS_BYTES);
    if (per_cu > 1) per_cu = 1;
    if (per_cu < 1) per_cu = 1;
    grid_blocks = cus * per_cu;
  }
  hipMemsetAsync((char*)d_ws + WS_BAR, 0, 16384, stream);
  P p{};
  for (int i = 0; i < 40; ++i) p.in[i] = (const float*)d_in[i];
  p.out = (float*)d_out; p.ws = (char*)d_ws;
  void* args[] = {&p};
  hipError_t e = hipLaunchCooperativeKernel((const void*)fwd_megakernel, dim3(grid_blocks), dim3(256), args, LDS_BYTES, stream);
  if (e != hipSuccess) fprintf(stderr, "cooperative launch failed: %s (grid %d)\n", hipGetErrorString(e), grid_blocks);
}
```

```cpp
#include <hip/hip_runtime.h>
#include <hip/hip_cooperative_groups.h>
#include <cstdio>
#include <cstdint>
namespace cg = cooperative_groups;

typedef unsigned short bf16;
typedef __attribute__((ext_vector_type(8))) short bf16x8;
typedef __attribute__((ext_vector_type(4))) short bf16x4;
typedef __attribute__((ext_vector_type(4))) float f32x4;
typedef __attribute__((ext_vector_type(4))) unsigned u32x4;
typedef __attribute__((ext_vector_type(2))) unsigned u32x2;

#define DEVI __device__ __forceinline__

constexpr int Dm = 1024, FF = 2816, MT = 18432, MPR = 16384, NSS = 32, NCHUNK = 288, NPCH = 256;
constexpr size_t SLOT = (size_t)MT * 1024 * 2;
constexpr size_t WS_L1 = 8 * SLOT;
constexpr size_t WS_SM = WS_L1 + (size_t)MT * 256 * 2;
constexpr size_t WS_GAM = WS_SM + (size_t)MT * 16 * 4;
constexpr size_t WS_W = WS_GAM + (size_t)NCHUNK * 1024 * 4;
constexpr size_t W_FIN = 0, W_FOUT = 5767168, W_MIX = 8650752;
constexpr size_t WS_SINK = WS_W + (size_t)14200000 * 2 - 64;
constexpr size_t WS_BAR = WS_W + (size_t)14200000 * 2;
constexpr size_t WS_TOTAL = WS_BAR + 16384;
constexpr int LDS_BYTES = 77824;

constexpr size_t O_ASH_P = 18874368, O_AWKV_P = O_ASH_P + 2048, O_BKV_P = O_AWKV_P + 131072,
                 O_CCONV_P = O_BKV_P + 131072, O_CKV_P = O_CCONV_P + 9216, O_ASH_S = O_CKV_P + 131072,
                 O_AWKV_S = O_ASH_S + 65536, O_BKV_S = O_AWKV_S + 4194304, O_CCONV_S = O_BKV_S + 4194304,
                 O_CKV_S = O_CCONV_S + 294912;

struct P { const float* in[40]; float* out; char* ws; };
typedef const __attribute__((address_space(4))) char* kptr_t;
typedef const float* cfp_t; typedef float* fp_t; typedef char* cp_t;
DEVI kptr_t kbase() { kptr_t b = (kptr_t)__builtin_amdgcn_kernarg_segment_ptr(); asm volatile("" : "+s"(b)); return b; }
#define PIN(i) (*(const __attribute__((address_space(4))) cfp_t*)(kbase() + 8 * (i)))
#define POUT (*(const __attribute__((address_space(4))) fp_t*)(kbase() + 320))
#define PWS (*(const __attribute__((address_space(4))) cp_t*)(kbase() + 328))

typedef __attribute__((ext_vector_type(2))) float f32x2;
typedef __attribute__((ext_vector_type(2))) __bf16 bf16x2v;
DEVI unsigned pack2(float a, float b) { f32x2 v = {a, b}; bf16x2v r = __builtin_convertvector(v, bf16x2v); return __builtin_bit_cast(unsigned, r); }
DEVI bf16 f2bf(float f) { return (bf16)(pack2(f, 0.f) & 0xffffu); }
DEVI float bf2f(bf16 h) { return __uint_as_float(((unsigned)h) << 16); }
template <int CTRL> DEVI float dpp_mov(float v) { return __int_as_float(__builtin_amdgcn_mov_dpp(__float_as_int(v), CTRL, 0xF, 0xF, true)); }
DEVI float rsum4(float v) { v += dpp_mov<0xB1>(v); v += dpp_mov<0x4E>(v); return v; }
DEVI float rsum8(float v) { v = rsum4(v); v += dpp_mov<0x141>(v); return v; }
DEVI float rsum16(float v) { v = rsum8(v); v += dpp_mov<0x140>(v); return v; }
DEVI float wsum(float v) {
  v = rsum16(v);
  const int iv = __float_as_int(v);
  return (__int_as_float(__builtin_amdgcn_readlane(iv, 0)) + __int_as_float(__builtin_amdgcn_readlane(iv, 16))) +
         (__int_as_float(__builtin_amdgcn_readlane(iv, 32)) + __int_as_float(__builtin_amdgcn_readlane(iv, 48)));
}
DEVI float sigm(float x) { return 1.f / (1.f + __expf(-x)); }
DEVI float silu(float x) { return x * sigm(x); }
DEVI float softplus(float x) { return x > 20.f ? x : log1pf(__expf(x)); }
DEVI bf16* slot(const P& p, int i) { return (bf16*)(PWS + (size_t)i * SLOT); }

struct GemmDesc { const bf16* A; const bf16* A2; int lda; int ksplit; const bf16* Bt; int ldb; int tiles_m; int tiles_n; int K; };

template <class Epi>
DEVI void gemm_tile(const GemmDesc& g, int mt, int nt, Epi& epi, char* smem) {
  const int tid = threadIdx.x, lane = tid & 63, wave = tid >> 6;
  const int wm = wave >> 1, wn = wave & 1, lr = lane & 15, quad = lane >> 4;
  bf16* sA = (bf16*)smem;
  bf16* sB = sA + 2 * 8192;
  f32x4 acc[4][4];
#pragma unroll
  for (int i = 0; i < 4; ++i)
#pragma unroll
    for (int j = 0; j < 4; ++j) acc[i][j] = (f32x4){0.f, 0.f, 0.f, 0.f};
  const int m0 = mt * 128, n0 = nt * 128;
  const int r0 = tid >> 3, c0 = tid & 7;
  const size_t aoff = (size_t)(m0 + r0) * g.lda + c0 * 8;
  const bf16* bp = g.Bt + (size_t)(n0 + r0) * g.ldb + c0 * 8;
  const int soff = r0 * 64 + ((c0 ^ (r0 & 7)) << 3);
#define GL1(i_, RA, RB) RA##i_ = *(const u32x4*)(base_ + (size_t)(32 * i_) * g.lda); RB##i_ = *(const u32x4*)(bp + k0_ + (size_t)(32 * i_) * g.ldb);
#define GLOAD(kt_, RA, RB) do { const int k0_ = (kt_) << 6; \
    const bf16* base_ = ((k0_ < g.ksplit) ? (g.A + k0_) : (g.A2 + (k0_ - g.ksplit))) + aoff; \
    GL1(0, RA, RB) GL1(1, RA, RB) GL1(2, RA, RB) GL1(3, RA, RB) } while (0)
#define LS1(buf_, i_, RA, RB) *(u32x4*)(sA + (buf_) * 8192 + soff + i_ * 2048) = RA##i_; *(u32x4*)(sB + (buf_) * 8192 + soff + i_ * 2048) = RB##i_;
#define LSTORE(buf_, RA, RB) do { LS1(buf_, 0, RA, RB) LS1(buf_, 1, RA, RB) LS1(buf_, 2, RA, RB) LS1(buf_, 3, RA, RB) } while (0)
#define GSTEP(kt_, RA, RB) do { const int buf_ = (kt_) & 1; \
    const bf16* a_ = sA + buf_ * 8192 + (wm * 64 + lr) * 64; const bf16* b_ = sB + buf_ * 8192 + (wn * 64 + lr) * 64; \
    _Pragma("unroll") for (int ks_ = 0; ks_ < 2; ++ks_) { \
      const int co_ = (((ks_ * 4 + quad) ^ (lr & 7)) << 3); bf16x8 af_[4], bf_[4]; \
      _Pragma("unroll") for (int i_ = 0; i_ < 4; ++i_) { af_[i_] = *(const bf16x8*)(a_ + i_ * 1024 + co_); bf_[i_] = *(const bf16x8*)(b_ + i_ * 1024 + co_); } \
      _Pragma("unroll") for (int i_ = 0; i_ < 4; ++i_) _Pragma("unroll") for (int j_ = 0; j_ < 4; ++j_) \
        acc[i_][j_] = __builtin_amdgcn_mfma_f32_16x16x32_bf16(af_[i_], bf_[j_], acc[i_][j_], 0, 0, 0); } \
    if ((kt_) + 1 < nk) { LSTORE(buf_ ^ 1, RA, RB); if ((kt_) + 3 < nk) GLOAD((kt_) + 3, RA, RB); } \
    __syncthreads(); } while (0)
  const int nk = g.K >> 6;
  u32x4 pa0, pa1, pa2, pa3, pb0, pb1, pb2, pb3, qa0, qa1, qa2, qa3, qb0, qb1, qb2, qb3;
  qa0 = qa1 = qa2 = qa3 = qb0 = qb1 = qb2 = qb3 = (u32x4){0u, 0u, 0u, 0u};
  GLOAD(0, pa, pb);
  if (nk > 1) GLOAD(1, qa, qb);
  LSTORE(0, pa, pb);
  if (nk > 2) GLOAD(2, pa, pb);
  __syncthreads();
  for (int kt = 0; kt < nk; kt += 2) { GSTEP(kt, qa, qb); if (kt + 1 < nk) GSTEP(kt + 1, pa, pb); }
#pragma unroll
  for (int i = 0; i < 4; ++i) {
#pragma unroll
    for (int jj = 0; jj < 4; ++jj) {
      const int row = m0 + wm * 64 + i * 16 + quad * 4 + jj;
      if constexpr (Epi::PAIR) {
#pragma unroll
        for (int j = 0; j < 4; j += 2) {
          const int nn = n0 + wn * 64 + j * 16;
          epi.pair(row, (nn >> 5) * 16 + lr, acc[i][j][jj], acc[i][j + 1][jj]);
        }
      } else {
#pragma unroll
        for (int j = 0; j < 4; ++j) epi(row, n0 + wn * 64 + j * 16 + lr, acc[i][j][jj]);
      }
    }
  }
}

template <class Epi>
DEVI void gemm_job(const GemmDesc& g, Epi epi, int& tbase, char* smem) {
  const int ntiles = g.tiles_m * g.tiles_n, G = gridDim.x;
  const int first = tbase + (((int)blockIdx.x - tbase % G) + G) % G;
  const int width = 8 * g.tiles_n;
  for (int t = first; t < tbase + ntiles; t += G) {
    const int lt = t - tbase;
    const int grp = lt / width, rem = lt % width;
    gemm_tile(g, grp * 8 + (rem & 7), rem >> 3, epi, smem);
  }
  tbase += ntiles;
}

struct EpiStore { static constexpr bool PAIR = false; bf16* C; int ldc; float sc;
  DEVI void operator()(int r, int c, float v) { C[(size_t)r * ldc + c] = f2bf(v * sc); } };
struct EpiLora1 { static constexpr bool PAIR = false; bf16* C;
  DEVI void operator()(int r, int c, float v) { float o = c < 64 ? tanhf(v) : (c < 128 ? v : sigm(v)); C[(size_t)r * 256 + c] = f2bf(o); } };
struct EpiLd { static constexpr bool PAIR = false; bf16* C; const float* w0;
  DEVI void operator()(int r, int c, float v) { float x = w0[c] + v; float lr_ = -softplus(-x) - 0.5f; C[(size_t)r * 1024 + c] = f2bf(-__expf(lr_)); } };
struct EpiSig { static constexpr bool PAIR = false; bf16* C; const float* a0;
  DEVI void operator()(int r, int c, float v) { C[(size_t)r * 1024 + c] = f2bf(sigm(a0[c] + v)); } };
struct EpiAcc { static constexpr bool PAIR = false; float* X;
  DEVI void operator()(int r, int c, float v) { X[(size_t)r * 1024 + c] += v; } };
struct EpiSwiglu { static constexpr bool PAIR = true; bf16* C;
  DEVI void pair(int r, int c, float gt, float up) { C[(size_t)r * FF + c] = f2bf(silu(gt) * up); } };
struct EpiGlaIn { static constexpr bool PAIR = false; bf16 *q, *k, *v, *gate; float* sm;
  DEVI void operator()(int r, int c, float x) {
    if (c < 512) q[(size_t)r * 512 + c] = f2bf(x * 0.08838834764831845f);
    else if (c < 1024) k[(size_t)r * 512 + c - 512] = f2bf(x);
    else if (c < 2048) v[(size_t)r * 1024 + c - 1024] = f2bf(x);
    else if (c < 3072) gate[(size_t)r * 1024 + c - 2048] = f2bf(x);
    else if (c < 3088) sm[(size_t)r * 16 + c - 3072] = x;
  } };
struct EpiGdnIn { static constexpr bool PAIR = false; bf16 *qkv, *z; float* sm; float* out;
  DEVI void operator()(int r, int c, float x) {
    if (c < 3072) {
      qkv[(size_t)r * 3072 + c] = f2bf(x);
      if (r >= MPR - 3) {
        if (r < MPR) out[O_CCONV_P + (size_t)(r - (MPR - 3)) * 3072 + c] = x;
        else { int tt = (r - MPR) & 63; if (tt >= 61) out[O_CCONV_S + ((size_t)((r - MPR) >> 6) * 3 + (tt - 61)) * 3072 + c] = x; }
      }
    } else if (c < 4096) z[(size_t)r * 1024 + c - 3072] = f2bf(x);
    else if (c < 4112) sm[(size_t)r * 16 + c - 4096] = x;
  } };

template <class F>
DEVI void conv_job(F f, bf16* dst, int ldo, int Nd, int Kd, int& tbase, char* smem) {
  float* tile = (float*)smem;
  const int tn = Nd >> 6, tk = Kd >> 6, ntiles = tn * tk, G = gridDim.x, tid = threadIdx.x;
  const int first = tbase + (((int)blockIdx.x - tbase % G) + G) % G;
  for (int t = first; t < tbase + ntiles; t += G) {
    const int lt = t - tbase, n0 = (lt % tn) << 6, k0 = (lt / tn) << 6;
    const int i = tid >> 4, j4 = (tid & 15) << 2;
#pragma unroll
    for (int r = 0; r < 4; ++r) {
      float4 v = f(k0 + i + 16 * r, n0 + j4);
      float* d = tile + (i + 16 * r) * 65 + j4; d[0] = v.x; d[1] = v.y; d[2] = v.z; d[3] = v.w;
    }
    __syncthreads();
    const int jn = tid >> 2, iq = (tid & 3) << 4;
    unsigned w[8];
#pragma unroll
    for (int e = 0; e < 8; ++e) w[e] = pack2(tile[(iq + 2 * e) * 65 + jn], tile[(iq + 2 * e + 1) * 65 + jn]);
    uint4* o = (uint4*)(dst + (size_t)(n0 + jn) * ldo + k0 + iq);
    o[0] = make_uint4(w[0], w[1], w[2], w[3]); o[1] = make_uint4(w[4], w[5], w[6], w[7]);
    __syncthreads();
  }
  tbase += ntiles;
}
struct CvPlain { const float* W; int ld; int nsrc;
  DEVI float4 operator()(int k, int n) const { return n < nsrc ? *(const float4*)(W + (size_t)k * ld + n) : make_float4(0, 0, 0, 0); } };
struct CvFfnIn { const float* W;
  DEVI float4 operator()(int k, int n) const { int blk = n >> 5, w = n & 31; int src = (w < 16) ? blk * 16 + w : FF + blk * 16 + (w - 16);
    return *(const float4*)(W + (size_t)k * (2 * FF) + src); } };
struct CvLora1 { const float *w1, *a1, *g1, *mu;
  DEVI float4 operator()(int k, int n) const {
    int kk = k & 1023; float4 v; float m;
    if (n < 64) { v = *(const float4*)(w1 + kk * 64 + n); m = mu[1 * 1024 + kk]; }
    else if (n < 128) { v = *(const float4*)(a1 + kk * 64 + n - 64); m = mu[4 * 1024 + kk]; }
    else { v = *(const float4*)(g1 + kk * 128 + n - 128); m = mu[5 * 1024 + kk]; }
    float s = (k < 1024) ? (1.f - m) : m;
    return make_float4(v.x * s, v.y * s, v.z * s, v.w * s); } };
struct CvGlaIn { const float *win, *wa1;
  DEVI float4 operator()(int k, int n) const {
    if (n < 3072) return *(const float4*)(win + (size_t)k * 3072 + n);
    if (n < 3088) return *(const float4*)(wa1 + k * 16 + n - 3072);
    return make_float4(0, 0, 0, 0); } };

template <int TYPE>
DEVI void phase_norm(const P& p, int layer, int j, bool from_input, bool copy_x) {
  const int lane = threadIdx.x & 63, wave = threadIdx.x >> 6;
  const float* g = PIN(7) + layer * 1024;
  float* xres = POUT;
  bf16 *h = slot(p, 0), *hs = slot(p, 1), *xr = slot(p, 2), *xk = slot(p, 3), *xv = slot(p, 4);
  const float* mu = PIN(12) + (size_t)j * 6 * 1024;
  for (int row = blockIdx.x * 4 + wave; row < MT; row += gridDim.x * 4) {
    auto src = [&](int r) -> const float* {
      if (from_input) return r < MPR ? PIN(0) + (size_t)r * 1024 : PIN(1) + (size_t)(r - MPR) * 1024;
      return xres + (size_t)r * 1024; };
    const float* xp = src(row);
    float4 xv4[4]; float ss = 0.f;
#pragma unroll
    for (int i = 0; i < 4; ++i) { xv4[i] = *(const float4*)(xp + i * 256 + lane * 4); ss += xv4[i].x * xv4[i].x + xv4[i].y * xv4[i].y + xv4[i].z * xv4[i].z + xv4[i].w * xv4[i].w; }
    ss = wsum(ss);
    const float rstd = rsqrtf(ss * (1.f / 1024.f) + 1e-6f);
    if (copy_x) {
#pragma unroll
      for (int i = 0; i < 4; ++i) *(float4*)(xres + (size_t)row * 1024 + i * 256 + lane * 4) = xv4[i];
    }
    float hv[16];
#pragma unroll
    for (int i = 0; i < 4; ++i) { float4 gg = *(const float4*)(g + i * 256 + lane * 4);
      hv[i * 4 + 0] = xv4[i].x * rstd * gg.x; hv[i * 4 + 1] = xv4[i].y * rstd * gg.y; hv[i * 4 + 2] = xv4[i].z * rstd * gg.z; hv[i * 4 + 3] = xv4[i].w * rstd * gg.w; }
#pragma unroll
    for (int i = 0; i < 4; ++i) *(uint2*)(h + (size_t)row * 1024 + i * 256 + lane * 4) = make_uint2(pack2(hv[i * 4], hv[i * 4 + 1]), pack2(hv[i * 4 + 2], hv[i * 4 + 3]));
    if constexpr (TYPE == 0) {
      const bool is_p = row < MPR; const int tt = is_p ? row : ((row - MPR) & 63); const int b = is_p ? 0 : ((row - MPR) >> 6);
      float hp[16];
      if (tt == 0) {
        if (is_p) {
#pragma unroll
          for (int i = 0; i < 16; ++i) hp[i] = 0.f;
        } else {
          const float* sp = PIN(2) + ((size_t)j * NSS + b) * 1024;
#pragma unroll
          for (int i = 0; i < 4; ++i) { float4 v = *(const float4*)(sp + i * 256 + lane * 4); hp[i * 4] = v.x; hp[i * 4 + 1] = v.y; hp[i * 4 + 2] = v.z; hp[i * 4 + 3] = v.w; }
        }
      } else {
        const float* pp = src(row - 1); float4 pv[4]; float s2 = 0.f;
#pragma unroll
        for (int i = 0; i < 4; ++i) { pv[i] = *(const float4*)(pp + i * 256 + lane * 4); s2 += pv[i].x * pv[i].x + pv[i].y * pv[i].y + pv[i].z * pv[i].z + pv[i].w * pv[i].w; }
        s2 = wsum(s2); const float r2 = rsqrtf(s2 * (1.f / 1024.f) + 1e-6f);
#pragma unroll
        for (int i = 0; i < 4; ++i) { float4 gg = *(const float4*)(g + i * 256 + lane * 4);
          hp[i * 4] = pv[i].x * r2 * gg.x; hp[i * 4 + 1] = pv[i].y * r2 * gg.y; hp[i * 4 + 2] = pv[i].z * r2 * gg.z; hp[i * 4 + 3] = pv[i].w * r2 * gg.w; }
      }
#pragma unroll
      for (int i = 0; i < 4; ++i) {
        const int col = i * 256 + lane * 4; const size_t o = (size_t)row * 1024 + col;
        float4 m0 = *(const float4*)(mu + 0 * 1024 + col), m2 = *(const float4*)(mu + 2 * 1024 + col), m3 = *(const float4*)(mu + 3 * 1024 + col);
        const float mm0[4] = {m0.x, m0.y, m0.z, m0.w}, mm2[4] = {m2.x, m2.y, m2.z, m2.w}, mm3[4] = {m3.x, m3.y, m3.z, m3.w};
        float a[4], bb[4], c[4];
#pragma unroll
        for (int e = 0; e < 4; ++e) { float hh = hv[i * 4 + e], xx = hp[i * 4 + e] - hh; a[e] = hh + xx * mm0[e]; bb[e] = hh + xx * mm2[e]; c[e] = hh + xx * mm3[e]; }
        *(uint2*)(hs + o) = make_uint2(pack2(hp[i * 4], hp[i * 4 + 1]), pack2(hp[i * 4 + 2], hp[i * 4 + 3]));
        *(uint2*)(xr + o) = make_uint2(pack2(a[0], a[1]), pack2(a[2], a[3]));
        *(uint2*)(xk + o) = make_uint2(pack2(bb[0], bb[1]), pack2(bb[2], bb[3]));
        *(uint2*)(xv + o) = make_uint2(pack2(c[0], c[1]), pack2(c[2], c[3]));
      }
      if (is_p ? (row == MPR - 1) : (tt == 63)) {
        float* o = POUT + (is_p ? O_ASH_P + (size_t)j * 1024 : O_ASH_S + ((size_t)j * NSS + b) * 1024);
#pragma unroll
        for (int i = 0; i < 4; ++i) *(float4*)(o + i * 256 + lane * 4) = make_float4(hv[i * 4], hv[i * 4 + 1], hv[i * 4 + 2], hv[i * 4 + 3]);
      }
    }
  }
}

DEVI void phase_rms(const float* x, const float* g, bf16* dst, float* fdst) {
  const int lane = threadIdx.x & 63, wave = threadIdx.x >> 6;
  const int nw = gridDim.x * 4;
  for (int row = blockIdx.x * 4 + wave; row < MT; row += 2 * nw) {
    const int row2 = row + nw; const bool has2 = row2 < MT;
    float4 v[4], v2[4]; float ss = 0.f, ss2 = 0.f;
#pragma unroll
    for (int i = 0; i < 4; ++i) v[i] = *(const float4*)(x + (size_t)row * 1024 + i * 256 + lane * 4);
    if (has2) {
#pragma unroll
      for (int i = 0; i < 4; ++i) v2[i] = *(const float4*)(x + (size_t)row2 * 1024 + i * 256 + lane * 4);
    } else {
#pragma unroll
      for (int i = 0; i < 4; ++i) v2[i] = make_float4(0.f, 0.f, 0.f, 0.f);
    }
#pragma unroll
    for (int i = 0; i < 4; ++i) { ss += v[i].x * v[i].x + v[i].y * v[i].y + v[i].z * v[i].z + v[i].w * v[i].w; ss2 += v2[i].x * v2[i].x + v2[i].y * v2[i].y + v2[i].z * v2[i].z + v2[i].w * v2[i].w; }
    ss = wsum(ss); ss2 = wsum(ss2);
    const float r = rsqrtf(ss * (1.f / 1024.f) + 1e-6f), r2 = rsqrtf(ss2 * (1.f / 1024.f) + 1e-6f);
#pragma unroll
    for (int i = 0; i < 4; ++i) { float4 gg = *(const float4*)(g + i * 256 + lane * 4);
      { float a = v[i].x * r * gg.x, b = v[i].y * r * gg.y, c = v[i].z * r * gg.z, d = v[i].w * r * gg.w;
        if (dst) *(uint2*)(dst + (size_t)row * 1024 + i * 256 + lane * 4) = make_uint2(pack2(a, b), pack2(c, d));
        else *(float4*)(fdst + (size_t)row * 1024 + i * 256 + lane * 4) = make_float4(a, b, c, d); }
      if (has2) { float a = v2[i].x * r2 * gg.x, b = v2[i].y * r2 * gg.y, c = v2[i].z * r2 * gg.z, d = v2[i].w * r2 * gg.w;
        if (dst) *(uint2*)(dst + (size_t)row2 * 1024 + i * 256 + lane * 4) = make_uint2(pack2(a, b), pack2(c, d));
        else *(float4*)(fdst + (size_t)row2 * 1024 + i * 256 + lane * 4) = make_float4(a, b, c, d); }
    }
  }
}

DEVI void phase_gdn_conv(const P& p) {
  const bf16* qkv = slot(p, 1); const float* cw = PIN(35); const float* cst = PIN(5);
  const int tid = threadIdx.x;
  for (int item = blockIdx.x; item < (MT / 8) * 3; item += gridDim.x) {
    const int row0 = (item / 3) * 8, sec = item % 3, ch = sec * 1024 + tid * 4;
    const bool is_p = row0 < MPR; const int tt0 = is_p ? row0 : ((row0 - MPR) & 63); const int b = is_p ? 0 : ((row0 - MPR) >> 6);
    float x[11][4];
#pragma unroll
    for (int i = 0; i < 11; ++i) {
      const int pt = tt0 + i;
      if (pt >= 3) { uint2 u = *(const uint2*)(qkv + (size_t)(row0 + i - 3) * 3072 + ch);
        x[i][0] = bf2f(u.x & 0xffff); x[i][1] = bf2f(u.x >> 16); x[i][2] = bf2f(u.y & 0xffff); x[i][3] = bf2f(u.y >> 16); }
      else if (!is_p) { float4 s = *(const float4*)(cst + ((size_t)b * 3 + pt) * 3072 + ch); x[i][0] = s.x; x[i][1] = s.y; x[i][2] = s.z; x[i][3] = s.w; }
      else { x[i][0] = x[i][1] = x[i][2] = x[i][3] = 0.f; }
    }
    float w[4][4];
#pragma unroll
    for (int i = 0; i < 4; ++i) { float4 ww = *(const float4*)(cw + i * 3072 + ch); w[i][0] = ww.x; w[i][1] = ww.y; w[i][2] = ww.z; w[i][3] = ww.w; }
#pragma unroll
    for (int o = 0; o < 8; ++o) {
      float acc[4];
#pragma unroll
      for (int e = 0; e < 4; ++e) { acc[e] = x[o][e] * w[0][e] + x[o + 1][e] * w[1][e] + x[o + 2][e] * w[2][e] + x[o + 3][e] * w[3][e]; acc[e] = silu(acc[e]); }
      if (sec < 2) {
        float ss = acc[0] * acc[0] + acc[1] * acc[1] + acc[2] * acc[2] + acc[3] * acc[3];
#pragma unroll
        for (int once = 0; once < 1; ++once) { ss = rsum16(ss); ss += __shfl_xor(ss, 16); }
        const float r = rsqrtf(ss + 1e-6f) * (sec == 0 ? 0.08838834764831845f : 1.f);
#pragma unroll
        for (int e = 0; e < 4; ++e) acc[e] *= r;
      }
      *(uint2*)(slot(p, 5 + sec) + (size_t)(row0 + o) * 1024 + tid * 4) = make_uint2(pack2(acc[0], acc[1]), pack2(acc[2], acc[3]));
    }
  }
}

DEVI void mm_strip(const bf16* At, const bf16* Bt, f32x4 (&acc)[4], int wave, int lane) {
  const int lr = lane & 15, quad = lane >> 4;
#pragma unroll
  for (int ks = 0; ks < 2; ++ks) {
    bf16x8 a = *(const bf16x8*)(At + (wave * 16 + lr) * 72 + ks * 32 + quad * 8);
#pragma unroll
    for (int nb = 0; nb < 4; ++nb) {
      bf16x8 b = *(const bf16x8*)(Bt + (nb * 16 + lr) * 72 + ks * 32 + quad * 8);
      acc[nb] = __builtin_amdgcn_mfma_f32_16x16x32_bf16(a, b, acc[nb], 0, 0, 0);
    }
  }
}
DEVI void zero4(f32x4 (&a)[4]) {
#pragma unroll
  for (int i = 0; i < 4; ++i) a[i] = (f32x4){0.f, 0.f, 0.f, 0.f};
}

DEVI int perm32(int x) { return (x & ~31) | (((x >> 2) & 3) << 3) | (((x >> 4) & 1) << 2) | (x & 3); }
template <int CW> DEVI size_t cont_off(int r, int s, int LD) { const int idx = r * 64 + s; return (size_t)(idx / CW) * LD + (idx % CW); }

template <int TYPE>
DEVI void phase_prep(const P& p, int j, char* smem) {
  constexpr int NH = TYPE == 0 ? 16 : (TYPE == 1 ? 4 : 8);
  constexpr int DK = TYPE == 0 ? 64 : 128;
  constexpr int DV = TYPE == 0 ? 64 : (TYPE == 1 ? 256 : 128);
  constexpr bool LOW = TYPE != 1;
  constexpr int KT = 256 / DK, TPT = 64 / KT, DKH = DK / 64, DVH = DV / 64;
  constexpr int LDQ = TYPE == 1 ? 512 : 1024;
  bf16* X0 = (bf16*)smem; bf16* X1 = X0 + 4608; bf16* Y0 = X1 + 4608; bf16* Y1 = Y0 + 4608;
  float* Lb = (float*)smem;
  bf16* LkT = (bf16*)(smem + 16384); bf16* Ak = LkT + 4608; bf16* nAb = Ak + 4608;
  bf16* M1 = (bf16*)smem;
  bf16* Tt = (bf16*)(smem + 44032); bf16* St1 = Tt + 4608; bf16* St2 = St1 + 4608;
  if (TYPE == 1) { Y0 = (bf16*)(smem + 9216); Ak = (bf16*)(smem + 18432); St1 = (bf16*)(smem + 27648); }
  float* lgL = (float*)(smem + 36864);
  float* tot = (float*)(smem + 71680);
  float* sc_beta = (float*)(smem + 73728);
  float* sc_eg = sc_beta + 64; float* sc_lg = sc_eg + 64; float* sc_g = sc_lg + 64;

  bf16 *Aq, *Akk, *Av, *Ald = nullptr, *Aa = nullptr, *Oq, *Okt, *Ovt, *Ow = nullptr, *Obt = nullptr, *Ool, *Ou0 = nullptr;
  if (TYPE == 0) { Aq = slot(p, 5); Akk = slot(p, 6); Av = slot(p, 7); Ald = slot(p, 2); Aa = slot(p, 3);
    Oq = Aq; Okt = Akk; Ovt = Av; Ow = Ald; Obt = Aa; Ool = slot(p, 0); Ou0 = slot(p, 1); }
  else if (TYPE == 1) { Aq = slot(p, 1); Akk = slot(p, 1) + (size_t)MT * 512; Av = slot(p, 2); Oq = Aq; Okt = Akk; Ovt = Av; Ool = slot(p, 4); }
  else { Aq = slot(p, 5); Akk = slot(p, 6); Av = slot(p, 7); Oq = Aq; Okt = Akk; Ovt = Av; Ow = slot(p, 1); Obt = slot(p, 2); Ool = slot(p, 3); Ou0 = slot(p, 0); }
  float* sm = (float*)(PWS + WS_SM);
  float* gam = (float*)(PWS + WS_GAM);

  for (int item = blockIdx.x; item < NCHUNK * NH; item += gridDim.x) {
    const int c = item / NH, h = item % NH;
    const size_t rb = (size_t)c * 64;
    int tid = threadIdx.x; asm volatile("" : "+v"(tid));
    const int lane = tid & 63, wave = tid >> 6, lr = lane & 15, quad = lane >> 4;
    const int k = tid % DK, tg = tid / DK;
    const int vv = tid & 63, tgv = tid >> 6;
    unsigned qP[TPT / 2], ktP[TPT / 2], kapP[(TYPE == 0) ? TPT / 2 : 1], bvP[(TYPE == 0) ? TPT / 2 : 1];
    float lg[(TYPE == 0) ? TPT : 1], ldv[(TYPE == 0) ? TPT : 1];
    unsigned vP[DVH][8];
    auto lo16 = [](unsigned w) { return __uint_as_float(w << 16); };
    auto hi16 = [](unsigned w) { return __uint_as_float(w & 0xffff0000u); };
#define GETP(arr, e) (((e) & 1) ? hi16(arr[(e) >> 1]) : lo16(arr[(e) >> 1]))
#pragma unroll
    for (int vh = 0; vh < DVH; ++vh) {
      bf16 va[16];
#pragma unroll
      for (int e = 0; e < 16; ++e) va[e] = Av[(rb + tgv * 16 + e) * 1024 + h * DV + vh * 64 + vv];
#pragma unroll
      for (int e = 0; e < 8; ++e) { vP[vh][e] = (unsigned)va[2 * e] | ((unsigned)va[2 * e + 1] << 16); asm volatile("" : "+v"(vP[vh][e])); }
    }
    if constexpr (TYPE == 2) {
      if (tid < 64) {
        const float a_log = PIN(36)[h], dtb = PIN(37)[h];
        const float braw = sm[(rb + tid) * 16 + h], araw = sm[(rb + tid) * 16 + 8 + h];
        const float gt = -__expf(a_log) * softplus(araw + dtb);
        sc_beta[tid] = sigm(braw); sc_eg[tid] = __expf(gt); sc_g[tid] = gt;
        float cs = gt;
#pragma unroll
        for (int o = 1; o < 64; o <<= 1) { float n = __shfl_up(cs, o); if (lane >= o) cs += n; }
        sc_lg[tid] = cs;
      }
      __syncthreads();
    }
    if constexpr (TYPE == 0) {
      const float k_k = PIN(21)[j * 1024 + h * 64 + k], k_a = PIN(22)[j * 1024 + h * 64 + k], r_k = PIN(23)[j * 1024 + h * 64 + k];
      float run = 0.f;
      bf16 rr[TPT], rk[TPT], ra[TPT], rl[TPT];
#pragma unroll
      for (int e = 0; e < TPT; ++e) {
        const size_t o = (rb + tg * TPT + e) * 1024 + h * 64 + k;
        rr[e] = Aq[o]; rk[e] = Akk[o]; ra[e] = Aa[o]; rl[e] = Ald[o];
      }
#pragma unroll
      for (int e2 = 0; e2 < TPT / 2; ++e2) {
        float qq[2], ka[2], kq[2], bq[2];
#pragma unroll
        for (int u = 0; u < 2; ++u) {
          const int e = e2 * 2 + u;
          const float r = bf2f(rr[e]), kr = bf2f(rk[e]), av = bf2f(ra[e]), l = bf2f(rl[e]);
          const float kk = kr * k_k;
          const float inv = rsqrtf(fmaxf(wsum(kk * kk), 1e-24f));
          qq[u] = r; ka[u] = kk * inv; kq[u] = kr * (1.f + (av - 1.f) * k_a); bq[u] = ka[u] * av; ldv[e] = l;
          const float bo = wsum(r * kq[u] * r_k);
          if (lane == 0) sm[(rb + tg * TPT + e) * 16 + h] = bo;
          run += l; lg[e] = run;
        }
        qP[e2] = pack2(qq[0], qq[1]); kapP[e2] = pack2(ka[0], ka[1]); ktP[e2] = pack2(kq[0], kq[1]); bvP[e2] = pack2(bq[0], bq[1]);
        asm volatile("" : "+v"(qP[e2]), "+v"(kapP[e2]), "+v"(ktP[e2]), "+v"(bvP[e2]));
      }
      tot[tg * 128 + k] = run;
    } else if constexpr (TYPE == 1) {
      float w2[16];
#pragma unroll
      for (int i = 0; i < 16; ++i) w2[i] = PIN(30)[i * 512 + h * 128 + k];
      const float ba = PIN(31)[h * 128 + k];
      bf16 rq[TPT], rk[TPT];
#pragma unroll
      for (int e = 0; e < TPT; ++e) { const size_t row = rb + tg * TPT + e; rq[e] = Aq[row * 512 + h * 128 + k]; rk[e] = Akk[row * 512 + h * 128 + k]; }
      float4 ar[TPT][4];
      float run = 0.f;
#pragma unroll
      for (int e = 0; e < TPT; e += 4) {
#pragma unroll
        for (int u = 0; u < 4; ++u)
#pragma unroll
          for (int q4 = 0; q4 < 4; ++q4) ar[e + u][q4] = *(const float4*)(sm + (rb + tg * TPT + e + u) * 16 + q4 * 4);
#pragma unroll
        for (int u = 0; u < 4; ++u) {
          float s = ba;
#pragma unroll
          for (int q4 = 0; q4 < 4; ++q4) { const float4 a4 = ar[e + u][q4]; s += a4.x * w2[q4 * 4] + a4.y * w2[q4 * 4 + 1] + a4.z * w2[q4 * 4 + 2] + a4.w * w2[q4 * 4 + 3]; }
          const float gk = (fminf(s, 0.f) - log1pf(__expf(-fabsf(s)))) * (1.f / 16.f);
          run += gk; lgL[(tg * TPT + e + u) * 128 + k] = run;
        }
      }
#pragma unroll
      for (int e2 = 0; e2 < TPT / 2; ++e2) {
        qP[e2] = (unsigned)rq[2 * e2] | ((unsigned)rq[2 * e2 + 1] << 16);
        ktP[e2] = (unsigned)rk[2 * e2] | ((unsigned)rk[2 * e2 + 1] << 16);
        asm volatile("" : "+v"(qP[e2]), "+v"(ktP[e2]));
      }
      tot[tg * 128 + k] = run;
    } else {
      bf16 rq[TPT], rk[TPT];
#pragma unroll
      for (int e = 0; e < TPT; ++e) { const size_t o = (rb + tg * TPT + e) * 1024 + h * 128 + k; rq[e] = Aq[o]; rk[e] = Akk[o]; }
#pragma unroll
      for (int e2 = 0; e2 < TPT / 2; ++e2) {
        qP[e2] = (unsigned)rq[2 * e2] | ((unsigned)rq[2 * e2 + 1] << 16);
        ktP[e2] = (unsigned)rk[2 * e2] | ((unsigned)rk[2 * e2 + 1] << 16);
        asm volatile("" : "+v"(qP[e2]), "+v"(ktP[e2]));
      }
    }
    __syncthreads();
    float lgC;
    if constexpr (TYPE == 2) { lgC = sc_lg[63]; }
    else {
      float off = 0.f, all = 0.f;
#pragma unroll
      for (int g2 = 0; g2 < KT; ++g2) { const float tv = tot[g2 * 128 + k]; all += tv; if (g2 < tg) off += tv; }
      if constexpr (TYPE == 0) {
#pragma unroll
        for (int e = 0; e < TPT; ++e) lg[e] += off;
      } else {
#pragma unroll
        for (int e = 0; e < TPT; ++e) lgL[(tg * TPT + e) * 128 + k] += off;
      }
      lgC = all;
    }
#define QV(e) GETP(qP, e)
#define LGV(e, t) ((TYPE == 2) ? sc_lg[t] : ((TYPE == 1) ? lgL[(t) * 128 + k] : lg[(TYPE == 0) ? (e) : 0]))
#define LPREV(e, t) ((TYPE == 0) ? (lg[(TYPE == 0) ? (e) : 0] - ldv[(TYPE == 0) ? (e) : 0]) : (sc_lg[t] - sc_g[t]))
#define KTV(e, t) ((TYPE == 2) ? (sc_beta[t] * GETP(ktP, e)) : GETP(ktP, e))
#define KAPV(e, t) ((TYPE == 2) ? GETP(ktP, e) : GETP(kapP, (TYPE == 0) ? (e) : 0))
#define BVV(e, t) ((TYPE == 2) ? (sc_beta[t] * sc_eg[t] * GETP(ktP, e)) : GETP(bvP, (TYPE == 0) ? (e) : 0))
    f32x4 sacc[LOW ? 4 : 1][4];
#pragma unroll
    for (int a = 0; a < (LOW ? 4 : 1); ++a) zero4(sacc[a]);
#pragma unroll
    for (int kh = 0; kh < DKH; ++kh) {
      if (k / 64 == kh) {
        const int kk = k & 63;
#pragma unroll
        for (int e = 0; e < TPT; ++e) {
          const int t = tg * TPT + e;
          if constexpr (TYPE == 2) {
            X0[t * 72 + kk] = f2bf(QV(e)); Y0[t * 72 + kk] = f2bf(KTV(e, t));
            X1[t * 72 + kk] = f2bf(KAPV(e, t)); Y1[t * 72 + kk] = f2bf(BVV(e, t));
          } else {
            const float lgt = LGV(e, t);
            const float el = __expf(lgt), eml = __expf(-lgt);
            X0[t * 72 + kk] = f2bf(QV(e) * el);
            Y0[t * 72 + kk] = f2bf(KTV(e, t) * eml);
            if constexpr (LOW) {
              X1[t * 72 + kk] = f2bf(KAPV(e, t) * __expf(LPREV(e, t)));
              Y1[t * 72 + kk] = f2bf(BVV(e, t) * eml);
            }
          }
        }
      }
      __syncthreads();
      mm_strip(X0, Y0, sacc[0], wave, lane);
      if constexpr (LOW) { mm_strip(X0, Y1, sacc[1], wave, lane); mm_strip(X1, Y0, sacc[2], wave, lane); mm_strip(X1, Y1, sacc[3], wave, lane); }
      __syncthreads();
    }
#pragma unroll
    for (int nb = 0; nb < 4; ++nb)
#pragma unroll
      for (int jj = 0; jj < 4; ++jj) {
        const int t = wave * 16 + quad * 4 + jj, s = nb * 16 + lr;
        float da = 1.f, dl = 1.f;
        if constexpr (TYPE == 2) { const float dd = sc_lg[t] - sc_lg[s]; da = __expf(fminf(dd, 0.f)); dl = __expf(fminf(dd - sc_g[t], 0.f)); }
        Ak[t * 72 + s] = f2bf(s <= t ? sacc[0][nb][jj] * da : 0.f);
        if constexpr (LOW) {
          nAb[t * 72 + s] = f2bf(s <= t ? -sacc[1][nb][jj] * da : 0.f);
          LkT[s * 72 + t] = f2bf(s < t ? sacc[2][nb][jj] * dl : 0.f);
          Lb[t * 64 + (s & 3) * 16 + (s >> 2)] = s < t ? sacc[3][nb][jj] * dl : 0.f;
        }
      }
    __syncthreads();
    f32x4 acc[4];
    if constexpr (LOW) {
      {
        const int q = lane & 3, jc = wave * 16 + (lane >> 2);
        float xr[16];
#pragma unroll
        for (int i = 0; i < 16; ++i) xr[i] = 0.f;
#pragma unroll
        for (int t = 0; t < 64; ++t) {
          float s = 0.f, s2 = 0.f;
          const float* Lr = Lb + t * 64 + q * 16;
#pragma unroll
          for (int i = 0; i < (t + 3) / 4; ++i) { if (i & 1) s2 += Lr[i] * xr[i]; else s += Lr[i] * xr[i]; }
          s += s2;
          s = rsum4(s);
          s = ((t == jc) ? 1.f : 0.f) - s;
          xr[t >> 2] = (q == (t & 3)) ? s : xr[t >> 2];
          if (q == 0) Tt[t * 72 + jc] = f2bf(s);
        }
      }
      __syncthreads();
      zero4(acc); mm_strip(Tt, LkT, acc, wave, lane);
#pragma unroll
      for (int nb = 0; nb < 4; ++nb)
#pragma unroll
        for (int jj = 0; jj < 4; ++jj) M1[(wave * 16 + quad * 4 + jj) * 72 + nb * 16 + lr] = f2bf(acc[nb][jj]);
      __syncthreads();
    }
#pragma unroll
    for (int vh = 0; vh < DVH; ++vh) {
#pragma unroll
      for (int e = 0; e < 8; ++e) *(unsigned*)(St1 + vv * 72 + tgv * 16 + 2 * e) = vP[vh][e];
      __syncthreads();
      if constexpr (LOW) {
        zero4(acc); mm_strip(M1, St1, acc, wave, lane);
#pragma unroll
        for (int nb = 0; nb < 4; ++nb)
#pragma unroll
          for (int jj = 0; jj < 4; ++jj) {
            const int t = wave * 16 + quad * 4 + jj, col = nb * 16 + lr; const bf16 u = f2bf(acc[nb][jj]);
            St2[col * 72 + t] = u;
          }
#pragma unroll
        for (int nb = 0; nb < 4; ++nb)
          *(uint2*)(Ou0 + (((((size_t)c * NH + h) * (DV / 16) + vh * 4 + nb) * 4 + wave) * 64 + lane) * 4) = make_uint2(pack2(acc[nb][0], acc[nb][1]), pack2(acc[nb][2], acc[nb][3]));
        __syncthreads();
      }
      zero4(acc); mm_strip(Ak, St1, acc, wave, lane);
      if constexpr (LOW) mm_strip(nAb, St2, acc, wave, lane);
#pragma unroll
      for (int nb = 0; nb < 4; ++nb)
        *(uint2*)(Ool + (((((size_t)c * NH + h) * (DV / 16) + vh * 4 + nb) * 4 + wave) * 64 + lane) * 4) = make_uint2(pack2(acc[nb][0], acc[nb][1]), pack2(acc[nb][2], acc[nb][3]));
      __syncthreads();
    }
    if constexpr (LOW) {
#pragma unroll
      for (int kh = 0; kh < DKH; ++kh) {
        if (k / 64 == kh) {
          const int kk = k & 63;
#pragma unroll
          for (int e = 0; e < TPT; ++e) {
            const int t = tg * TPT + e;
            St1[kk * 72 + t] = f2bf(KAPV(e, t) * __expf(LPREV(e, t)));
            LkT[t * 72 + kk] = f2bf(QV(e) * __expf(LGV(e, t)));
            }
        }
        __syncthreads();
        zero4(acc); mm_strip(Tt, St1, acc, wave, lane);
#pragma unroll
        for (int nb = 0; nb < 4; ++nb)
#pragma unroll
          for (int jj = 0; jj < 4; ++jj) {
            const int t = wave * 16 + quad * 4 + jj, col = nb * 16 + lr; const bf16 u = f2bf(acc[nb][jj]);
            St2[col * 72 + t] = u;
            Ow[(rb + t) * 1024 + h * DK + perm32(kh * 64 + col)] = u;
          }
        __syncthreads();
        zero4(acc); mm_strip(nAb, St2, acc, wave, lane);
#pragma unroll
        for (int nb = 0; nb < 4; ++nb)
#pragma unroll
          for (int jj = 0; jj < 4; ++jj) {
            const int t = wave * 16 + quad * 4 + jj, col = nb * 16 + lr;
            Oq[(rb + t) * LDQ + h * DK + perm32(kh * 64 + col)] = f2bf(acc[nb][jj] + bf2f(LkT[t * 72 + col]));
          }
        __syncthreads();
      }
    } else {
#pragma unroll
      for (int e = 0; e < TPT; ++e) { Oq[(rb + tg * TPT + e) * LDQ + h * DK + perm32(k)] = f2bf(QV(e) * __expf(LGV(e, tg * TPT + e))); }
    }
    {
      unsigned wk[TPT / 2], wb[LOW ? TPT / 2 : 1];
#pragma unroll
      for (int e = 0; e < TPT; e += 2) {
        const int t0 = tg * TPT + e;
        const float d0 = __expf(lgC - LGV(e, t0)), d1 = __expf(lgC - LGV(e + 1, t0 + 1));
        wk[e / 2] = pack2(KTV(e, t0) * d0, KTV(e + 1, t0 + 1) * d1);
        if constexpr (LOW) wb[e / 2] = pack2(BVV(e, t0) * d0, BVV(e + 1, t0 + 1) * d1);
      }
      const size_t co = rb * LDQ + h * DK + cont_off<DK>(k, tg * TPT, LDQ);
#pragma unroll
      for (int e = 0; e < TPT / 8; ++e) {
        *(uint4*)(Okt + co + e * 8) = make_uint4(wk[e * 4], wk[e * 4 + 1], wk[e * 4 + 2], wk[e * 4 + 3]);
        if constexpr (LOW) {
#pragma unroll
          for (int g4 = 0; g4 < 2; ++g4) {
            const int s0 = tg * TPT + e * 8 + g4 * 4;
            *(uint2*)(Obt + rb * 1024 + h * DK + cont_off<DK>(k, perm32(s0), 1024)) = make_uint2(wb[e * 4 + g4 * 2], wb[e * 4 + g4 * 2 + 1]);
          }
        }
      }
#pragma unroll
      for (int vh = 0; vh < DVH; ++vh) {
        const unsigned* wv = vP[vh];
        const size_t vo = rb * 1024 + h * DV + cont_off<DV>(vh * 64 + vv, tgv * 16, 1024);
        *(uint4*)(Ovt + vo) = make_uint4(wv[0], wv[1], wv[2], wv[3]);
        *(uint4*)(Ovt + vo + 8) = make_uint4(wv[4], wv[5], wv[6], wv[7]);
      }
      if (tg == 0) gam[((size_t)c * NH + h) * DK + k] = __expf(lgC);
    }
    __syncthreads();
  }
}

template <int TYPE>
DEVI void phase_seq2(const P& p, int j, char* smem) {
  constexpr int NH = TYPE == 0 ? 16 : (TYPE == 1 ? 4 : 8);
  constexpr int DK = TYPE == 0 ? 64 : 128;
  constexpr int DV = TYPE == 0 ? 64 : (TYPE == 1 ? 256 : 128);
  constexpr bool LOW = TYPE != 1;
  constexpr int NVB = DV / 16, MB = DK / 16, KS = DK / 32, NG = NVB / 4, BIPS = NH * NG;
  constexpr int LDQ = TYPE == 1 ? 512 : 1024;
  constexpr int NOP = LOW ? 4 : 2, RS = DK + 8, OPSZ = 64 * RS, PPR = DK / 8;
  constexpr int PPO = 64 * PPR / 256;
  constexpr int PF = 4;
  bf16* L = (bf16*)smem;
  const int tid = threadIdx.x, lane = tid & 63, wave = tid >> 6, lr = lane & 15, quad = lane >> 4;
  const bf16 *Qp, *Kt, *Vt, *Wp = nullptr, *Bt = nullptr, *U0 = nullptr; bf16* Ol;
  if (TYPE == 0) { Qp = slot(p, 5); Kt = slot(p, 6); Vt = slot(p, 7); Wp = slot(p, 2); Bt = slot(p, 3); Ol = slot(p, 0); U0 = slot(p, 1); }
  else if (TYPE == 1) { Qp = slot(p, 1); Kt = slot(p, 1) + (size_t)MT * 512; Vt = slot(p, 2); Ol = slot(p, 4); }
  else { Qp = slot(p, 5); Kt = slot(p, 6); Vt = slot(p, 7); Wp = slot(p, 1); Bt = slot(p, 2); Ol = slot(p, 3); U0 = slot(p, 0); }
  const float* gam = (const float*)(PWS + WS_GAM);
  unsigned tsink = 0;
  for (int bitem = blockIdx.x; bitem < 33 * BIPS; bitem += gridDim.x) {
    const int seq = bitem / BIPS, rem = bitem % BIPS, h = rem / NG, vb = (rem % NG) * 4 + wave;
    const int c0 = seq == 0 ? 0 : NPCH + seq - 1, nc = seq == 0 ? NPCH : 1;
    const int vcol = vb * 16 + lr;
    f32x4 H[MB];
    if (seq == 0) {
#pragma unroll
      for (int m = 0; m < MB; ++m) H[m] = (f32x4){0.f, 0.f, 0.f, 0.f};
    } else {
      const int b = seq - 1;
      if (TYPE == 0) {
        const float* S = PIN(3) + (((size_t)j * NSS + b) * 16 + h) * 4096 + (size_t)vcol * 64;
#pragma unroll
        for (int m = 0; m < MB; ++m) { float4 v = *(const float4*)(S + m * 16 + quad * 4); H[m] = (f32x4){v.x, v.y, v.z, v.w}; }
      } else {
        const float* S = PIN(TYPE == 1 ? 4 : 6) + ((size_t)b * NH + h) * DK * DV + vcol;
#pragma unroll
        for (int m = 0; m < MB; ++m)
#pragma unroll
          for (int jj = 0; jj < 4; ++jj) H[m][jj] = S[(size_t)(m * 16 + quad * 4 + jj) * DV];
      }
    }
    u32x4 preA[NOP * PPO], preB[NOP * PPO]; u32x2 poA[4], poB[4], puA[4], puB[4]; bf16x8 pvA[2], pvB[2]; f32x4 pgA[MB], pgB[MB];
    auto issue_sh = [&](int cc, u32x4 (&pre)[NOP * PPO]) {
      const size_t rb_ = (size_t)cc * 64; int tl_ = threadIdx.x; asm volatile("" : "+v"(tl_));
#pragma unroll
      for (int i_ = 0; i_ < PPO; ++i_) { const int w_ = tl_ + 256 * i_; const size_t r_ = rb_ + w_ / PPR; const int c8_ = (w_ % PPR) * 8;
        pre[0 * PPO + i_] = *(const u32x4*)(Qp + r_ * LDQ + h * DK + c8_);
        pre[1 * PPO + i_] = *(const u32x4*)(Kt + r_ * LDQ + h * DK + c8_);
        if constexpr (LOW) { pre[2 * PPO + i_] = *(const u32x4*)(Wp + r_ * 1024 + h * DK + c8_); pre[3 * PPO + i_] = *(const u32x4*)(Bt + r_ * 1024 + h * DK + c8_); } }
    };
    auto issue_pr = [&](int cc, u32x2 (&p_o)[4], u32x2 (&p_u)[4], bf16x8 (&p_v)[2], f32x4 (&p_g)[MB]) {
      const size_t rb_ = (size_t)cc * 64; int tl_ = threadIdx.x; asm volatile("" : "+v"(tl_));
      const int lane = tl_ & 63, lr = lane & 15, quad = lane >> 4, vcol = vb * 16 + lr;
      const size_t fo_ = ((((size_t)cc * NH + h) * NVB + vb) * 4) * 256 + lane * 4;
#pragma unroll
      for (int tb_ = 0; tb_ < 4; ++tb_) { p_o[tb_] = *(const u32x2*)(Ol + fo_ + tb_ * 256); if constexpr (LOW) p_u[tb_] = *(const u32x2*)(U0 + fo_ + tb_ * 256); }
#pragma unroll
      for (int ks_ = 0; ks_ < 2; ++ks_) p_v[ks_] = *(const bf16x8*)(Vt + rb_ * 1024 + h * DV + cont_off<DV>(vcol, ks_ * 32 + quad * 8, 1024));
#pragma unroll
      for (int m_ = 0; m_ < MB; ++m_) p_g[m_] = *(const f32x4*)(gam + ((size_t)cc * NH + h) * DK + m_ * 16 + quad * 4);
    };
    const int cend = c0 + nc;
    auto step = [&](int c, u32x4 (&pre)[NOP * PPO], u32x2 (&p_o)[4], u32x2 (&p_u)[4], bf16x8 (&p_v)[2], f32x4 (&p_g)[MB]) {
#pragma unroll
      for (int o = 0; o < NOP; ++o)
#pragma unroll
        for (int i = 0; i < PPO; ++i) { const int w = tid + 256 * i; *(u32x4*)(L + o * OPSZ + (w / PPR) * RS + (w % PPR) * 8) = pre[o * PPO + i]; }
      __syncthreads();
      if (c + 2 < cend) issue_sh(c + 2, pre);
      unsigned tv[NOP * DK / 128 + 1];
#pragma unroll
      for (int i = 0; i < NOP * DK / 128 + 1; ++i) tv[i] = 0;
      if (false && c + PF < cend) {
        const size_t rb2 = (size_t)(c + PF) * 64;
        if (DK == 128 || tid < 128) {
          const int li = (DK == 128) ? tid : tid; const size_t ro = li / (DK / 64) % 64; const int co = (li % (DK / 64)) * 64;
          const int half = (DK == 128) ? (tid >> 7) : (tid >> 6);
          if (half == 0) { tv[0] = *(const unsigned*)(Qp + (rb2 + ro) * LDQ + h * DK + co); if constexpr (LOW) tv[1] = *(const unsigned*)(Wp + (rb2 + ro) * 1024 + h * DK + co); }
          else { tv[0] = *(const unsigned*)(Kt + (rb2 + ro) * LDQ + h * DK + co); if constexpr (LOW) tv[1] = *(const unsigned*)(Bt + (rb2 + ro) * 1024 + h * DK + co); }
        }
        {
          const size_t fo2 = ((((size_t)(c + PF) * NH + h) * NVB + vb) * 4) * 256;
          const unsigned* tp;
          if (lane < 16) tp = (const unsigned*)(Ol + fo2 + lane * 64);
          else if (LOW && lane < 32) tp = (const unsigned*)(U0 + fo2 + (lane - 16) * 64);
          else if (lane < 48) tp = (const unsigned*)(Vt + rb2 * 1024 + h * DV + cont_off<DV>(vb * 16 + (lane & 15), 0, 1024));
          else tp = (const unsigned*)(gam + ((size_t)(c + PF) * NH + h) * DK + ((lane - 48) & (DK / 32 - 1)) * 32);
          tv[NOP * DK / 128] = *tp;
        }
      }
      bf16x8 hb[KS];
#pragma unroll
      for (int ks = 0; ks < KS; ++ks) {
        const u32x4 hw = {pack2(H[2 * ks][0], H[2 * ks][1]), pack2(H[2 * ks][2], H[2 * ks][3]), pack2(H[2 * ks + 1][0], H[2 * ks + 1][1]), pack2(H[2 * ks + 1][2], H[2 * ks + 1][3])};
        hb[ks] = __builtin_bit_cast(bf16x8, hw);
      }
      const size_t fo = ((((size_t)c * NH + h) * NVB + vb) * 4) * 256 + lane * 4;
      f32x4 U[4];
#pragma unroll
      for (int tb = 0; tb < 4; ++tb) {
        f32x4 o_ = (f32x4){bf2f(p_o[tb].x & 0xffff), bf2f(p_o[tb].x >> 16), bf2f(p_o[tb].y & 0xffff), bf2f(p_o[tb].y >> 16)}, u_;
        if constexpr (LOW) u_ = (f32x4){bf2f(p_u[tb].x & 0xffff), bf2f(p_u[tb].x >> 16), bf2f(p_u[tb].y & 0xffff), bf2f(p_u[tb].y >> 16)};
#pragma unroll
        for (int ks = 0; ks < KS; ++ks) {
          o_ = __builtin_amdgcn_mfma_f32_16x16x32_bf16(*(const bf16x8*)(L + 0 * OPSZ + (tb * 16 + lr) * RS + ks * 32 + quad * 8), hb[ks], o_, 0, 0, 0);
          if constexpr (LOW) u_ = __builtin_amdgcn_mfma_f32_16x16x32_bf16(*(const bf16x8*)(L + 2 * OPSZ + (tb * 16 + lr) * RS + ks * 32 + quad * 8), hb[ks], u_, 0, 0, 0);
        }
        *(u32x2*)(Ol + fo + tb * 256) = (u32x2){pack2(o_[0], o_[1]), pack2(o_[2], o_[3])};
        if constexpr (LOW) U[tb] = u_;
      }
      bf16x8 ubop[2];
      if constexpr (LOW) {
#pragma unroll
        for (int ks = 0; ks < 2; ++ks) {
          const u32x4 uw = {pack2(-U[2 * ks][0], -U[2 * ks][1]), pack2(-U[2 * ks][2], -U[2 * ks][3]), pack2(-U[2 * ks + 1][0], -U[2 * ks + 1][1]), pack2(-U[2 * ks + 1][2], -U[2 * ks + 1][3])};
          ubop[ks] = __builtin_bit_cast(bf16x8, uw);
        }
      }
#pragma unroll
      for (int m = 0; m < MB; ++m) {
        f32x4 hn = (f32x4){H[m][0] * p_g[m][0], H[m][1] * p_g[m][1], H[m][2] * p_g[m][2], H[m][3] * p_g[m][3]};
        const int krow = m * 16 + lr;
#pragma unroll
        for (int ks = 0; ks < 2; ++ks) {
          const int i1 = krow * 64 + ks * 32 + quad * 8;
          bf16x8 a = *(const bf16x8*)(L + 1 * OPSZ + (i1 / DK) * RS + (i1 % DK));
          hn = __builtin_amdgcn_mfma_f32_16x16x32_bf16(a, p_v[ks], hn, 0, 0, 0);
          if constexpr (LOW) {
            hn = __builtin_amdgcn_mfma_f32_16x16x32_bf16(*(const bf16x8*)(L + 3 * OPSZ + (i1 / DK) * RS + (i1 % DK)), ubop[ks], hn, 0, 0, 0);
          }
        }
        H[m] = hn;
      }
#pragma unroll
      for (int i = 0; i < NOP * DK / 128 + 1; ++i) tsink ^= tv[i];
      if (c + 2 < cend) issue_pr(c + 2, p_o, p_u, p_v, p_g);
      __syncthreads();
    };
    issue_sh(c0, preA); issue_pr(c0, poA, puA, pvA, pgA);
    if (nc > 1) { issue_sh(c0 + 1, preB); issue_pr(c0 + 1, poB, puB, pvB, pgB); }
    for (int c = c0; c < cend; c += 2) { step(c, preA, poA, puA, pvA, pgA); if (c + 1 < cend) step(c + 1, preB, poB, puB, pvB, pgB); }
    if (TYPE == 0) {
      float* S = POUT + (seq == 0 ? O_AWKV_P + ((size_t)j * 16 + h) * 4096 : O_AWKV_S + (((size_t)j * NSS + (seq - 1)) * 16 + h) * 4096) + (size_t)vcol * 64;
#pragma unroll
      for (int m = 0; m < MB; ++m) *(float4*)(S + m * 16 + quad * 4) = make_float4(H[m][0], H[m][1], H[m][2], H[m][3]);
    } else {
      const size_t ob = TYPE == 1 ? (seq == 0 ? O_BKV_P : O_BKV_S + (size_t)(seq - 1) * NH * DK * DV)
                                  : (seq == 0 ? O_CKV_P : O_CKV_S + (size_t)(seq - 1) * NH * DK * DV);
      float* S = POUT + ob + (size_t)h * DK * DV + vcol;
#pragma unroll
      for (int m = 0; m < MB; ++m)
#pragma unroll
        for (int jj = 0; jj < 4; ++jj) S[(size_t)(m * 16 + quad * 4 + jj) * DV] = H[m][jj];
    }
  }
  if (tsink == 0x9e3779b9u) ((unsigned*)(PWS + WS_SINK))[0] = tsink;
}

template <int TYPE>
DEVI void phase_post(const P& p, int j, char* smem) {
  constexpr int NH = TYPE == 0 ? 16 : (TYPE == 1 ? 4 : 8);
  constexpr int DV = TYPE == 0 ? 64 : (TYPE == 1 ? 256 : 128);
  constexpr int CPT = DV / 8;
  bf16* vt = (bf16*)smem;
  bf16* ot = (bf16*)(smem + 9216);
  const bf16* O = slot(p, TYPE == 0 ? 0 : (TYPE == 1 ? 4 : 3));
  const bf16* G = slot(p, TYPE == 0 ? 4 : (TYPE == 1 ? 3 : 4));
  bf16* og = slot(p, TYPE == 1 ? 0 : 1);
  const float* sm = (const float*)(PWS + WS_SM);
  for (int item = blockIdx.x; item < NCHUNK * NH; item += gridDim.x) {
    const int c = item / NH, h = item % NH; const size_t rb = (size_t)c * 64;
    int tid = threadIdx.x; asm volatile("" : "+v"(tid));
    const int part = tid & 7;
    if constexpr (TYPE == 0) {
      const bf16* V = slot(p, 7) + rb * 1024 + h * 64;
      const int r = tid >> 2, q4 = (tid & 3) * 16;
      *(uint4*)(vt + r * 72 + q4) = *(const uint4*)(V + (size_t)r * 1024 + q4);
      *(uint4*)(vt + r * 72 + q4 + 8) = *(const uint4*)(V + (size_t)r * 1024 + q4 + 8);
      __syncthreads();
    }
    {
      const uint4* srcp = (const uint4*)(O + ((size_t)c * NH + h) * 64 * DV);
#pragma unroll
      for (int i = 0; i < DV / 32; ++i) *(uint4*)(ot + (size_t)(i * 256 + tid) * 8) = srcp[i * 256 + tid];
      __syncthreads();
    }
#pragma unroll 1
    for (int pass = 0; pass < 2; ++pass) {
      const int t = pass * 32 + (tid >> 3);
      const size_t base = (rb + t) * 1024 + h * DV + part * CPT;
      float o[CPT];
#pragma unroll
      for (int e = 0; e < CPT; ++e) {
        const int v = part * CPT + e;
        o[e] = bf2f(ot[(((v >> 4) * 4 + (t >> 4)) * 64 + ((t & 15) >> 2) * 16 + (v & 15)) * 4 + (t & 3)]);
      }
      float s1 = 0.f, s2 = 0.f;
#pragma unroll
      for (int e = 0; e < CPT; ++e) { s1 += o[e]; s2 += o[e] * o[e]; }
      s1 = rsum8(s1); s2 = rsum8(s2);
      if constexpr (TYPE == 0) {
        const float mean = s1 * (1.f / 64.f); float var = s2 * (1.f / 64.f) - mean * mean; var = fmaxf(var, 0.f);
        const float rs = rsqrtf(var + 64e-5f); const float bonus = sm[(rb + t) * 16 + h];
        const float* lw = PIN(26) + j * 1024 + h * 64 + part * CPT; const float* lb = PIN(27) + j * 1024 + h * 64 + part * CPT;
#pragma unroll
        for (int e = 0; e < CPT; ++e) {
          const float vv = bf2f(vt[(part * CPT + e) * 72 + t]);
          o[e] = (o[e] - mean) * rs * lw[e] + lb[e] + bonus * vv;
        }
      } else {
        const float rs = rsqrtf(s2 * (1.f / DV) + 1e-6f);
        const float* on = PIN(TYPE == 1 ? 32 : 38) + part * CPT;
#pragma unroll
        for (int e = 0; e < CPT; ++e) o[e] = o[e] * rs * on[e];
      }
#pragma unroll
      for (int e = 0; e < CPT; e += 8) {
        uint4 u = *(const uint4*)(G + base + e);
        const unsigned w[4] = {u.x, u.y, u.z, u.w}; unsigned ow[4];
#pragma unroll
        for (int i = 0; i < 4; ++i) {
          float g0 = bf2f(w[i] & 0xffff), g1 = bf2f(w[i] >> 16);
          if constexpr (TYPE != 0) { g0 = silu(g0); g1 = silu(g1); }
          ow[i] = pack2(o[e + 2 * i] * g0, o[e + 2 * i + 1] * g1);
        }
        *(uint4*)(og + base + e) = make_uint4(ow[0], ow[1], ow[2], ow[3]);
      }
    }
    __syncthreads();
  }
}


#define XB_TMO      128
#define XB_XCNT(j)  (256  + 64 * (j))
#define XB_XSUB(j)  (1280 + 64 * (j))
#define XB_XGEN(j)  (2304 + 64 * (j))
#define XB_TOP      3328
#define XB_TOPGEN   3392
#define XCD_BAR_WORDS 3456
#define XB_SPIN_CAP (1u << 18)
#define LAS __attribute__((address_space(3)))
DEVI unsigned xb_ld(unsigned* p)              { return __hip_atomic_load(p, __ATOMIC_RELAXED, __HIP_MEMORY_SCOPE_AGENT); }
DEVI unsigned xb_add(unsigned* p, unsigned v) { return __hip_atomic_fetch_add(p, v, __ATOMIC_RELAXED, __HIP_MEMORY_SCOPE_AGENT); }
DEVI unsigned xb_xcc_id() { return (unsigned)__builtin_amdgcn_s_getreg((3 << 11) | 20) & 0xFu; }
#define XB_SPIN(cond, bar) do { unsigned _sp = 0; while (cond) { __builtin_amdgcn_s_sleep(1); \
    if ((++_sp & 255u) == 0u) { if (xb_ld(&(bar)[XB_TMO])) break; if (_sp > XB_SPIN_CAP) { atomicAdd(&(bar)[XB_TMO], 1u); break; } } } } while (0)
struct XcdBarrier { unsigned* bar; unsigned x; volatile LAS unsigned* st; };
DEVI XcdBarrier xcd_barrier_post(unsigned* bar, volatile LAS unsigned* st) {
  XcdBarrier b; b.bar = bar; b.x = xb_xcc_id(); b.st = st;
  if (threadIdx.x == 0) (void)xb_add(&bar[XB_XCNT(b.x)], 1u);
  return b;
}
DEVI void xcd_barrier_complete(unsigned* bar, unsigned x, unsigned& nloc, unsigned& nx) {
  const unsigned G = gridDim.x * gridDim.y * gridDim.z;
  unsigned sum, cnt, mine, sp = 0u;
  for (;;) {
    sum = 0u; cnt = 0u; mine = 0u;
#pragma unroll
    for (unsigned j = 0; j < 16; ++j) { const unsigned c = xb_ld(&bar[XB_XCNT(j)]); sum += c; cnt += (c > 0u) ? 1u : 0u; mine = (j == x) ? c : mine; }
    if (sum == G) break;
    __builtin_amdgcn_s_sleep(1);
    if ((++sp & 255u) == 0u) { if (xb_ld(&bar[XB_TMO])) break; if (sp > XB_SPIN_CAP) { atomicAdd(&bar[XB_TMO], 1u); break; } }
  }
  nloc = mine > 0u ? mine : 1u; nx = cnt > 0u ? cnt : 1u;
}
DEVI void xcd_barrier(const XcdBarrier& b) {
  asm volatile("s_waitcnt vmcnt(0)" ::: "memory");
  __syncthreads();
  if (threadIdx.x == 0) {
    unsigned* bar = b.bar;
    __builtin_amdgcn_s_waitcnt(0);
    unsigned nloc = b.st[0], nx = b.st[1];
    if (nloc == 0u) { xcd_barrier_complete(bar, b.x, nloc, nx); b.st[0] = nloc; b.st[1] = nx; }
    const unsigned old = xb_add(&bar[XB_XSUB(b.x)], 1u);
    const unsigned gen = old / nloc;
    if (old + 1u == (gen + 1u) * nloc) {
      __builtin_amdgcn_fence(__ATOMIC_RELEASE, "agent");
      asm volatile("s_waitcnt vmcnt(0)" ::: "memory");
      const unsigned og = xb_add(&bar[XB_TOP], 1u);
      const unsigned tg = og / nx;
      if (og + 1u == (tg + 1u) * nx) xb_add(&bar[XB_TOPGEN], 1u);
      else XB_SPIN(xb_ld(&bar[XB_TOPGEN]) == tg, bar);
      __builtin_amdgcn_fence(__ATOMIC_ACQUIRE, "agent");
      xb_add(&bar[XB_XGEN(b.x)], 1u);
      asm volatile("s_waitcnt vmcnt(0)" ::: "memory");
    } else {
      XB_SPIN(xb_ld(&bar[XB_XGEN(b.x)]) == gen, bar);
      __builtin_amdgcn_fence(__ATOMIC_ACQUIRE, "agent");
      asm volatile("s_waitcnt vmcnt(0)" ::: "memory");
    }
  }
  __syncthreads();
}

#ifndef DISMASK
#define DISMASK 0
#endif
#define EN(b) (!((DISMASK >> (b)) & 1))
#define GSYNC() xcd_barrier(xb)
#define GSYNC_CG() do { asm volatile("s_waitcnt vmcnt(0)" ::: "memory"); grid.sync(); } while (0)
__global__ void __launch_bounds__(256, 1) fwd_megakernel(P p) {
  extern __shared__ __attribute__((aligned(16))) char smem[];
  cg::grid_group grid = cg::this_grid();
  volatile LAS unsigned* xst = (volatile LAS unsigned*)(smem + LDS_BYTES - 16);
  if (threadIdx.x == 0) { xst[0] = 0u; xst[1] = 0u; }
  __syncthreads();
  const XcdBarrier xb = xcd_barrier_post((unsigned*)(PWS + WS_BAR), xst);
  bf16* wreg = (bf16*)(PWS + WS_W);
  bf16 *wfin = wreg + W_FIN, *wfout = wreg + W_FOUT, *wmix = wreg + W_MIX;
  float* sm = (float*)(PWS + WS_SM);
  for (int layer = 0; layer < 4; ++layer) {
    const int type = layer % 3, j = layer / 3;
    int tb = 0;
    if (type == 0) phase_norm<0>(p, layer, j, layer == 0, layer == 0);
    else phase_norm<1>(p, layer, j, false, false);
    conv_job(CvFfnIn{PIN(10) + (size_t)layer * 1024 * 2 * FF}, wfin, 1024, 2 * FF, 1024, tb, smem);
    conv_job(CvPlain{PIN(11) + (size_t)layer * FF * 1024, 1024, 1024}, wfout, FF, 1024, FF, tb, smem);
    if (type == 0) {
      for (int i = 0; i < 3; ++i) conv_job(CvPlain{PIN(24) + ((size_t)j * 3 + i) * 1048576, 1024, 1024}, wmix + (size_t)i * 1048576, 1024, 1024, 1024, tb, smem);
      conv_job(CvLora1{PIN(14) + (size_t)j * 65536, PIN(17) + (size_t)j * 65536, PIN(19) + (size_t)j * 131072, PIN(12) + (size_t)j * 6144}, wmix + 3145728, 2048, 256, 2048, tb, smem);
      conv_job(CvPlain{PIN(15) + (size_t)j * 65536, 1024, 1024}, wmix + 3670016, 64, 1024, 64, tb, smem);
      conv_job(CvPlain{PIN(18) + (size_t)j * 65536, 1024, 1024}, wmix + 3735552, 64, 1024, 64, tb, smem);
      conv_job(CvPlain{PIN(20) + (size_t)j * 131072, 1024, 1024}, wmix + 3801088, 128, 1024, 128, tb, smem);
      conv_job(CvPlain{PIN(25) + (size_t)j * 1048576, 1024, 1024}, wmix + 3932160, 1024, 1024, 1024, tb, smem);
    } else if (type == 1) {
      conv_job(CvGlaIn{PIN(28), PIN(29)}, wmix, 1024, 3200, 1024, tb, smem);
      conv_job(CvPlain{PIN(33), 1024, 1024}, wmix + 3276800, 1024, 1024, 1024, tb, smem);
    } else {
      conv_job(CvPlain{PIN(34), 4112, 4112}, wmix, 1024, 4224, 1024, tb, smem);
      conv_job(CvPlain{PIN(39), 1024, 1024}, wmix + 4325376, 1024, 1024, 1024, tb, smem);
    }
    GSYNC();
    tb = 0;
    const bf16* wo;
    if (type == 0) {
      for (int i = 0; i < 3; ++i)
        gemm_job(GemmDesc{slot(p, 2 + i), nullptr, 1024, 1024, wmix + (size_t)i * 1048576, 1024, 144, 8, 1024}, EpiStore{slot(p, 5 + i), 1024, 1.f}, tb, smem);
      gemm_job(GemmDesc{slot(p, 0), slot(p, 1), 1024, 1024, wmix + 3145728, 2048, 144, 2, 2048}, EpiLora1{(bf16*)(PWS + WS_L1)}, tb, smem);
      GSYNC();
      tb = 0;
      const bf16* l1 = (const bf16*)(PWS + WS_L1);
      gemm_job(GemmDesc{l1, nullptr, 256, 64, wmix + 3670016, 64, 144, 8, 64}, EpiLd{slot(p, 2), PIN(13) + j * 1024}, tb, smem);
      gemm_job(GemmDesc{l1 + 64, nullptr, 256, 64, wmix + 3735552, 64, 144, 8, 64}, EpiSig{slot(p, 3), PIN(16) + j * 1024}, tb, smem);
      gemm_job(GemmDesc{l1 + 128, nullptr, 256, 128, wmix + 3801088, 128, 144, 8, 128}, EpiStore{slot(p, 4), 1024, 1.f}, tb, smem);
      GSYNC();
      if (EN(2)) phase_prep<0>(p, j, smem);
      GSYNC();
      if (EN(5)) phase_seq2<0>(p, j, smem);
      GSYNC();
      if (EN(8)) phase_post<0>(p, j, smem);
      wo = wmix + 3932160;
    } else if (type == 1) {
      gemm_job(GemmDesc{slot(p, 0), nullptr, 1024, 1024, wmix, 1024, 144, 25, 1024},
               EpiGlaIn{slot(p, 1), slot(p, 1) + (size_t)MT * 512, slot(p, 2), slot(p, 3), sm}, tb, smem);
      GSYNC();
      if (EN(3)) phase_prep<1>(p, j, smem);
      GSYNC();
      if (EN(6)) phase_seq2<1>(p, j, smem);
      GSYNC();
      if (EN(8)) phase_post<1>(p, j, smem);
      wo = wmix + 3276800;
    } else {
      gemm_job(GemmDesc{slot(p, 0), nullptr, 1024, 1024, wmix, 1024, 144, 33, 1024},
               EpiGdnIn{slot(p, 1), slot(p, 4), sm, POUT}, tb, smem);
      GSYNC();
      if (EN(9)) phase_gdn_conv(p);
      GSYNC();
      if (EN(4)) phase_prep<2>(p, j, smem);
      GSYNC();
      if (EN(7)) phase_seq2<2>(p, j, smem);
      GSYNC();
      if (EN(8)) phase_post<2>(p, j, smem);
      wo = wmix + 4325376;
    }
    GSYNC();
    tb = 0;
    gemm_job(GemmDesc{slot(p, type == 1 ? 0 : 1), nullptr, 1024, 1024, wo, 1024, 144, 8, 1024}, EpiAcc{POUT}, tb, smem);
    GSYNC();
    phase_rms(POUT, PIN(8) + layer * 1024, slot(p, 0), nullptr);
    GSYNC();
    tb = 0;
    gemm_job(GemmDesc{slot(p, 0), nullptr, 1024, 1024, wfin, 1024, 144, 44, 1024}, EpiSwiglu{slot(p, 1)}, tb, smem);
    GSYNC();
    tb = 0;
    gemm_job(GemmDesc{slot(p, 1), nullptr, FF, FF, wfout, FF, 144, 8, FF}, EpiAcc{POUT}, tb, smem);
    if (layer == 3) GSYNC_CG(); else GSYNC();
  }
  phase_rms(POUT, PIN(9), nullptr, POUT);
}

extern "C" void kernel_launch(void* const* d_in, const int* in_sizes, int n_in, void* d_out, int out_size,
                              void* d_ws, size_t ws_size, hipStream_t stream) {
  if (n_in < 40 || ws_size < WS_TOTAL) { fprintf(stderr, "bad args: n_in %d ws %zu need %zu\n", n_in, ws_size, (size_t)WS_TOTAL); return; }
  static int grid_blocks = 0;
  if (!grid_blocks) {
    int dev = 0, cus = 0, per_cu = 0;
    hipGetDevice(&dev);
    hipDeviceGetAttribute(&cus, hipDeviceAttributeMultiprocessorCount, dev);
    hipFuncSetAttribute((const void*)fwd_megakernel, hipFuncAttributeMaxDynamicSharedMemorySize, LDS_BYTES);
    hipOccupancyMaxActiveBlocksPerMultiprocessor(&per_cu, (const void*)fwd_megakernel, 256, LDS_BYTES);
    if (per_cu > 1) per_cu = 1;
    if (per_cu < 1) per_cu = 1;
    grid_blocks = cus * per_cu;
  }
  hipMemsetAsync((char*)d_ws + WS_BAR, 0, 16384, stream);
  P p{};
  for (int i = 0; i < 40; ++i) p.in[i] = (const float*)d_in[i];
  p.out = (float*)d_out; p.ws = (char*)d_ws;
  void* args[] = {&p};
  hipError_t e = hipLaunchCooperativeKernel((const void*)fwd_megakernel, dim3(grid_blocks), dim3(256), args, LDS_BYTES, stream);
  if (e != hipSuccess) fprintf(stderr, "cooperative launch failed: %s (grid %d)\n", hipGetErrorString(e), grid_blocks);
}
```

```cpp
#include <hip/hip_runtime.h>
#include <hip/hip_cooperative_groups.h>
#include <cstdio>
#include <cstdint>
namespace cg = cooperative_groups;

typedef unsigned short bf16;
typedef __attribute__((ext_vector_type(8))) short bf16x8;
typedef __attribute__((ext_vector_type(4))) short bf16x4;
typedef __attribute__((ext_vector_type(4))) float f32x4;
typedef __attribute__((ext_vector_type(4))) unsigned u32x4;
typedef __attribute__((ext_vector_type(2))) unsigned u32x2;

#define DEVI __device__ __forceinline__

constexpr int Dm = 1024, FF = 2816, MT = 18432, MPR = 16384, NSS = 32, NCHUNK = 288, NPCH = 256;
constexpr size_t SLOT = (size_t)MT * 1024 * 2;
constexpr size_t WS_L1 = 8 * SLOT;
constexpr size_t WS_SM = WS_L1 + (size_t)MT * 256 * 2;
constexpr size_t WS_GAM = WS_SM + (size_t)MT * 16 * 4;
constexpr size_t WS_W = WS_GAM + (size_t)NCHUNK * 1024 * 4;
constexpr size_t W_FIN = 0, W_FOUT = 5767168, W_MIX = 8650752;
constexpr size_t WS_SINK = WS_W + (size_t)14200000 * 2 - 64;
constexpr size_t WS_BAR = WS_W + (size_t)14200000 * 2;
constexpr size_t WS_TOTAL = WS_BAR + 16384;
constexpr int LDS_BYTES = 77824;

constexpr size_t O_ASH_P = 18874368, O_AWKV_P = O_ASH_P + 2048, O_BKV_P = O_AWKV_P + 131072,
                 O_CCONV_P = O_BKV_P + 131072, O_CKV_P = O_CCONV_P + 9216, O_ASH_S = O_CKV_P + 131072,
                 O_AWKV_S = O_ASH_S + 65536, O_BKV_S = O_AWKV_S + 4194304, O_CCONV_S = O_BKV_S + 4194304,
                 O_CKV_S = O_CCONV_S + 294912;

struct P { const float* in[40]; float* out; char* ws; };
typedef const __attribute__((address_space(4))) char* kptr_t;
typedef const float* cfp_t; typedef float* fp_t; typedef char* cp_t;
DEVI kptr_t kbase() { kptr_t b = (kptr_t)__builtin_amdgcn_kernarg_segment_ptr(); asm volatile("" : "+s"(b)); return b; }
#define PIN(i) (*(const __attribute__((address_space(4))) cfp_t*)(kbase() + 8 * (i)))
#define POUT (*(const __attribute__((address_space(4))) fp_t*)(kbase() + 320))
#define PWS (*(const __attribute__((address_space(4))) cp_t*)(kbase() + 328))

typedef __attribute__((ext_vector_type(2))) float f32x2;
typedef __attribute__((ext_vector_type(2))) __bf16 bf16x2v;
DEVI unsigned pack2(float a, float b) { f32x2 v = {a, b}; bf16x2v r = __builtin_convertvector(v, bf16x2v); return __builtin_bit_cast(unsigned, r); }
DEVI bf16 f2bf(float f) { return (bf16)(pack2(f, 0.f) & 0xffffu); }
DEVI float bf2f(bf16 h) { return __uint_as_float(((unsigned)h) << 16); }
template <int CTRL> DEVI float dpp_mov(float v) { return __int_as_float(__builtin_amdgcn_mov_dpp(__float_as_int(v), CTRL, 0xF, 0xF, true)); }
DEVI float rsum4(float v) { v += dpp_mov<0xB1>(v); v += dpp_mov<0x4E>(v); return v; }
DEVI float rsum8(float v) { v = rsum4(v); v += dpp_mov<0x141>(v); return v; }
DEVI float rsum16(float v) { v = rsum8(v); v += dpp_mov<0x140>(v); return v; }
DEVI float wsum(float v) {
  v = rsum16(v);
  const int iv = __float_as_int(v);
  return (__int_as_float(__builtin_amdgcn_readlane(iv, 0)) + __int_as_float(__builtin_amdgcn_readlane(iv, 16))) +
         (__int_as_float(__builtin_amdgcn_readlane(iv, 32)) + __int_as_float(__builtin_amdgcn_readlane(iv, 48)));
}
DEVI float sigm(float x) { return 1.f / (1.f + __expf(-x)); }
DEVI float silu(float x) { return x * sigm(x); }
DEVI float softplus(float x) { return x > 20.f ? x : log1pf(__expf(x)); }
DEVI bf16* slot(const P& p, int i) { return (bf16*)(PWS + (size_t)i * SLOT); }

struct GemmDesc { const bf16* A; const bf16* A2; int lda; int ksplit; const bf16* Bt; int ldb; int tiles_m; int tiles_n; int K; };

template <class Epi>
DEVI void gemm_tile(const GemmDesc& g, int mt, int nt, Epi& epi, char* smem) {
  const int tid = threadIdx.x, lane = tid & 63, wave = tid >> 6;
  const int wm = wave >> 1, wn = wave & 1, lr = lane & 15, quad = lane >> 4;
  bf16* sA = (bf16*)smem;
  bf16* sB = sA + 2 * 8192;
  f32x4 acc[4][4];
#pragma unroll
  for (int i = 0; i < 4; ++i)
#pragma unroll
    for (int j = 0; j < 4; ++j) acc[i][j] = (f32x4){0.f, 0.f, 0.f, 0.f};
  const int m0 = mt * 128, n0 = nt * 128;
  const int r0 = tid >> 3, c0 = tid & 7;
  const size_t aoff = (size_t)(m0 + r0) * g.lda + c0 * 8;
  const bf16* bp = g.Bt + (size_t)(n0 + r0) * g.ldb + c0 * 8;
  const int soff = r0 * 64 + ((c0 ^ (r0 & 7)) << 3);
#define GL1(i_, RA, RB) RA##i_ = *(const u32x4*)(base_ + (size_t)(32 * i_) * g.lda); RB##i_ = *(const u32x4*)(bp + k0_ + (size_t)(32 * i_) * g.ldb);
#define GLOAD(kt_, RA, RB) do { const int k0_ = (kt_) << 6; \
    const bf16* base_ = ((k0_ < g.ksplit) ? (g.A + k0_) : (g.A2 + (k0_ - g.ksplit))) + aoff; \
    GL1(0, RA, RB) GL1(1, RA, RB) GL1(2, RA, RB) GL1(3, RA, RB) } while (0)
#define LS1(buf_, i_, RA, RB) *(u32x4*)(sA + (buf_) * 8192 + soff + i_ * 2048) = RA##i_; *(u32x4*)(sB + (buf_) * 8192 + soff + i_ * 2048) = RB##i_;
#define LSTORE(buf_, RA, RB) do { LS1(buf_, 0, RA, RB) LS1(buf_, 1, RA, RB) LS1(buf_, 2, RA, RB) LS1(buf_, 3, RA, RB) } while (0)
#define GSTEP(kt_, RA, RB) do { const int buf_ = (kt_) & 1; \
    const bf16* a_ = sA + buf_ * 8192 + (wm * 64 + lr) * 64; const bf16* b_ = sB + buf_ * 8192 + (wn * 64 + lr) * 64; \
    _Pragma("unroll") for (int ks_ = 0; ks_ < 2; ++ks_) { \
      const int co_ = (((ks_ * 4 + quad) ^ (lr & 7)) << 3); bf16x8 af_[4], bf_[4]; \
      _Pragma("unroll") for (int i_ = 0; i_ < 4; ++i_) { af_[i_] = *(const bf16x8*)(a_ + i_ * 1024 + co_); bf_[i_] = *(const bf16x8*)(b_ + i_ * 1024 + co_); } \
      _Pragma("unroll") for (int i_ = 0; i_ < 4; ++i_) _Pragma("unroll") for (int j_ = 0; j_ < 4; ++j_) \
        acc[i_][j_] = __builtin_amdgcn_mfma_f32_16x16x32_bf16(af_[i_], bf_[j_], acc[i_][j_], 0, 0, 0); } \
    if ((kt_) + 1 < nk) { LSTORE(buf_ ^ 1, RA, RB); if ((kt_) + 3 < nk) GLOAD((kt_) + 3, RA, RB); } \
    __syncthreads(); } while (0)
  const int nk = g.K >> 6;
  u32x4 pa0, pa1, pa2, pa3, pb0, pb1, pb2, pb3, qa0, qa1, qa2, qa3, qb0, qb1, qb2, qb3;
  qa0 = qa1 = qa2 = qa3 = qb0 = qb1 = qb2 = qb3 = (u32x4){0u, 0u, 0u, 0u};
  GLOAD(0, pa, pb);
  if (nk > 1) GLOAD(1, qa, qb);
  LSTORE(0, pa, pb);
  if (nk > 2) GLOAD(2, pa, pb);
  __syncthreads();
  for (int kt = 0; kt < nk; kt += 2) { GSTEP(kt, qa, qb); if (kt + 1 < nk) GSTEP(kt + 1, pa, pb); }
#pragma unroll
  for (int i = 0; i < 4; ++i) {
#pragma unroll
    for (int jj = 0; jj < 4; ++jj) {
      const int row = m0 + wm * 64 + i * 16 + quad * 4 + jj;
      if constexpr (Epi::PAIR) {
#pragma unroll
        for (int j = 0; j < 4; j += 2) {
          const int nn = n0 + wn * 64 + j * 16;
          epi.pair(row, (nn >> 5) * 16 + lr, acc[i][j][jj], acc[i][j + 1][jj]);
        }
      } else {
#pragma unroll
        for (int j = 0; j < 4; ++j) epi(row, n0 + wn * 64 + j * 16 + lr, acc[i][j][jj]);
      }
    }
  }
}

template <class Epi>
DEVI void gemm_job(const GemmDesc& g, Epi epi, int& tbase, char* smem) {
  const int ntiles = g.tiles_m * g.tiles_n, G = gridDim.x;
  const int first = tbase + (((int)blockIdx.x - tbase % G) + G) % G;
  const int width = 8 * g.tiles_n;
  for (int t = first; t < tbase + ntiles; t += G) {
    const int lt = t - tbase;
    const int grp = lt / width, rem = lt % width;
    gemm_tile(g, grp * 8 + (rem & 7), rem >> 3, epi, smem);
  }
  tbase += ntiles;
}

struct EpiStore { static constexpr bool PAIR = false; bf16* C; int ldc; float sc;
  DEVI void operator()(int r, int c, float v) { C[(size_t)r * ldc + c] = f2bf(v * sc); } };
struct EpiLora1 { static constexpr bool PAIR = false; bf16* C;
  DEVI void operator()(int r, int c, float v) { float o = c < 64 ? tanhf(v) : (c < 128 ? v : sigm(v)); C[(size_t)r * 256 + c] = f2bf(o); } };
struct EpiLd { static constexpr bool PAIR = false; bf16* C; const float* w0;
  DEVI void operator()(int r, int c, float v) { float x = w0[c] + v; float lr_ = -softplus(-x) - 0.5f; C[(size_t)r * 1024 + c] = f2bf(-__expf(lr_)); } };
struct EpiSig { static constexpr bool PAIR = false; bf16* C; const float* a0;
  DEVI void operator()(int r, int c, float v) { C[(size_t)r * 1024 + c] = f2bf(sigm(a0[c] + v)); } };
struct EpiAcc { static constexpr bool PAIR = false; float* X;
  DEVI void operator()(int r, int c, float v) { X[(size_t)r * 1024 + c] += v; } };
struct EpiSwiglu { static constexpr bool PAIR = true; bf16* C;
  DEVI void pair(int r, int c, float gt, float up) { C[(size_t)r * FF + c] = f2bf(silu(gt) * up); } };
struct EpiGlaIn { static constexpr bool PAIR = false; bf16 *q, *k, *v, *gate; float* sm;
  DEVI void operator()(int r, int c, float x) {
    if (c < 512) q[(size_t)r * 512 + c] = f2bf(x * 0.08838834764831845f);
    else if (c < 1024) k[(size_t)r * 512 + c - 512] = f2bf(x);
    else if (c < 2048) v[(size_t)r * 1024 + c - 1024] = f2bf(x);
    else if (c < 3072) gate[(size_t)r * 1024 + c - 2048] = f2bf(x);
    else if (c < 3088) sm[(size_t)r * 16 + c - 3072] = x;
  } };
struct EpiGdnIn { static constexpr bool PAIR = false; bf16 *qkv, *z; float* sm; float* out;
  DEVI void operator()(int r, int c, float x) {
    if (c < 3072) {
      qkv[(size_t)r * 3072 + c] = f2bf(x);
      if (r >= MPR - 3) {
        if (r < MPR) out[O_CCONV_P + (size_t)(r - (MPR - 3)) * 3072 + c] = x;
        else { int tt = (r - MPR) & 63; if (tt >= 61) out[O_CCONV_S + ((size_t)((r - MPR) >> 6) * 3 + (tt - 61)) * 3072 + c] = x; }
      }
    } else if (c < 4096) z[(size_t)r * 1024 + c - 3072] = f2bf(x);
    else if (c < 4112) sm[(size_t)r * 16 + c - 4096] = x;
  } };

template <class F>
DEVI void conv_job(F f, bf16* dst, int ldo, int Nd, int Kd, int& tbase, char* smem) {
  float* tile = (float*)smem;
  const int tn = Nd >> 6, tk = Kd >> 6, ntiles = tn * tk, G = gridDim.x, tid = threadIdx.x;
  const int first = tbase + (((int)blockIdx.x - tbase % G) + G) % G;
  for (int t = first; t < tbase + ntiles; t += G) {
    const int lt = t - tbase, n0 = (lt % tn) << 6, k0 = (lt / tn) << 6;
    const int i = tid >> 4, j4 = (tid & 15) << 2;
#pragma unroll
    for (int r = 0; r < 4; ++r) {
      float4 v = f(k0 + i + 16 * r, n0 + j4);
      float* d = tile + (i + 16 * r) * 65 + j4; d[0] = v.x; d[1] = v.y; d[2] = v.z; d[3] = v.w;
    }
    __syncthreads();
    const int jn = tid >> 2, iq = (tid & 3) << 4;
    unsigned w[8];
#pragma unroll
    for (int e = 0; e < 8; ++e) w[e] = pack2(tile[(iq + 2 * e) * 65 + jn], tile[(iq + 2 * e + 1) * 65 + jn]);
    uint4* o = (uint4*)(dst + (size_t)(n0 + jn) * ldo + k0 + iq);
    o[0] = make_uint4(w[0], w[1], w[2], w[3]); o[1] = make_uint4(w[4], w[5], w[6], w[7]);
    __syncthreads();
  }
  tbase += ntiles;
}
struct CvPlain { const float* W; int ld; int nsrc;
  DEVI float4 operator()(int k, int n) const { return n < nsrc ? *(const float4*)(W + (size_t)k * ld + n) : make_float4(0, 0, 0, 0); } };
struct CvFfnIn { const float* W;
  DEVI float4 operator()(int k, int n) const { int blk = n >> 5, w = n & 31; int src = (w < 16) ? blk * 16 + w : FF + blk * 16 + (w - 16);
    return *(const float4*)(W + (size_t)k * (2 * FF) + src); } };
struct CvLora1 { const float *w1, *a1, *g1, *mu;
  DEVI float4 operator()(int k, int n) const {
    int kk = k & 1023; float4 v; float m;
    if (n < 64) { v = *(const float4*)(w1 + kk * 64 + n); m = mu[1 * 1024 + kk]; }
    else if (n < 128) { v = *(const float4*)(a1 + kk * 64 + n - 64); m = mu[4 * 1024 + kk]; }
    else { v = *(const float4*)(g1 + kk * 128 + n - 128); m = mu[5 * 1024 + kk]; }
    float s = (k < 1024) ? (1.f - m) : m;
    return make_float4(v.x * s, v.y * s, v.z * s, v.w * s); } };
struct CvGlaIn { const float *win, *wa1;
  DEVI float4 operator()(int k, int n) const {
    if (n < 3072) return *(const float4*)(win + (size_t)k * 3072 + n);
    if (n < 3088) return *(const float4*)(wa1 + k * 16 + n - 3072);
    return make_float4(0, 0, 0, 0); } };

template <int TYPE>
DEVI void phase_norm(const P& p, int layer, int j, bool from_input, bool copy_x) {
  const int lane = threadIdx.x & 63, wave = threadIdx.x >> 6;
  const float* g = PIN(7) + layer * 1024;
  float* xres = POUT;
  bf16 *h = slot(p, 0), *hs = slot(p, 1), *xr = slot(p, 2), *xk = slot(p, 3), *xv = slot(p, 4);
  const float* mu = PIN(12) + (size_t)j * 6 * 1024;
  for (int row = blockIdx.x * 4 + wave; row < MT; row += gridDim.x * 4) {
    auto src = [&](int r) -> const float* {
      if (from_input) return r < MPR ? PIN(0) + (size_t)r * 1024 : PIN(1) + (size_t)(r - MPR) * 1024;
      return xres + (size_t)r * 1024; };
    const float* xp = src(row);
    float4 xv4[4]; float ss = 0.f;
#pragma unroll
    for (int i = 0; i < 4; ++i) { xv4[i] = *(const float4*)(xp + i * 256 + lane * 4); ss += xv4[i].x * xv4[i].x + xv4[i].y * xv4[i].y + xv4[i].z * xv4[i].z + xv4[i].w * xv4[i].w; }
    ss = wsum(ss);
    const float rstd = rsqrtf(ss * (1.f / 1024.f) + 1e-6f);
    if (copy_x) {
#pragma unroll
      for (int i = 0; i < 4; ++i) *(float4*)(xres + (size_t)row * 1024 + i * 256 + lane * 4) = xv4[i];
    }
    float hv[16];
#pragma unroll
    for (int i = 0; i < 4; ++i) { float4 gg = *(const float4*)(g + i * 256 + lane * 4);
      hv[i * 4 + 0] = xv4[i].x * rstd * gg.x; hv[i * 4 + 1] = xv4[i].y * rstd * gg.y; hv[i * 4 + 2] = xv4[i].z * rstd * gg.z; hv[i * 4 + 3] = xv4[i].w * rstd * gg.w; }
#pragma unroll
    for (int i = 0; i < 4; ++i) *(uint2*)(h + (size_t)row * 1024 + i * 256 + lane * 4) = make_uint2(pack2(hv[i * 4], hv[i * 4 + 1]), pack2(hv[i * 4 + 2], hv[i * 4 + 3]));
    if constexpr (TYPE == 0) {
      const bool is_p = row < MPR; const int tt = is_p ? row : ((row - MPR) & 63); const int b = is_p ? 0 : ((row - MPR) >> 6);
      float hp[16];
      if (tt == 0) {
        if (is_p) {
#pragma unroll
          for (int i = 0; i < 16; ++i) hp[i] = 0.f;
        } else {
          const float* sp = PIN(2) + ((size_t)j * NSS + b) * 1024;
#pragma unroll
          for (int i = 0; i < 4; ++i) { float4 v = *(const float4*)(sp + i * 256 + lane * 4); hp[i * 4] = v.x; hp[i * 4 + 1] = v.y; hp[i * 4 + 2] = v.z; hp[i * 4 + 3] = v.w; }
        }
      } else {
        const float* pp = src(row - 1); float4 pv[4]; float s2 = 0.f;
#pragma unroll
        for (int i = 0; i < 4; ++i) { pv[i] = *(const float4*)(pp + i * 256 + lane * 4); s2 += pv[i].x * pv[i].x + pv[i].y * pv[i].y + pv[i].z * pv[i].z + pv[i].w * pv[i].w; }
        s2 = wsum(s2); const float r2 = rsqrtf(s2 * (1.f / 1024.f) + 1e-6f);
#pragma unroll
        for (int i = 0; i < 4; ++i) { float4 gg = *(const float4*)(g + i * 256 + lane * 4);
          hp[i * 4] = pv[i].x * r2 * gg.x; hp[i * 4 + 1] = pv[i].y * r2 * gg.y; hp[i * 4 + 2] = pv[i].z * r2 * gg.z; hp[i * 4 + 3] = pv[i].w * r2 * gg.w; }
      }
#pragma unroll
      for (int i = 0; i < 4; ++i) {
        const int col = i * 256 + lane * 4; const size_t o = (size_t)row * 1024 + col;
        float4 m0 = *(const float4*)(mu + 0 * 1024 + col), m2 = *(const float4*)(mu + 2 * 1024 + col), m3 = *(const float4*)(mu + 3 * 1024 + col);
        const float mm0[4] = {m0.x, m0.y, m0.z, m0.w}, mm2[4] = {m2.x, m2.y, m2.z, m2.w}, mm3[4] = {m3.x, m3.y, m3.z, m3.w};
        float a[4], bb[4], c[4];
#pragma unroll
        for (int e = 0; e < 4; ++e) { float hh = hv[i * 4 + e], xx = hp[i * 4 + e] - hh; a[e] = hh + xx * mm0[e]; bb[e] = hh + xx * mm2[e]; c[e] = hh + xx * mm3[e]; }
        *(uint2*)(hs + o) = make_uint2(pack2(hp[i * 4], hp[i * 4 + 1]), pack2(hp[i * 4 + 2], hp[i * 4 + 3]));
        *(uint2*)(xr + o) = make_uint2(pack2(a[0], a[1]), pack2(a[2], a[3]));
        *(uint2*)(xk + o) = make_uint2(pack2(bb[0], bb[1]), pack2(bb[2], bb[3]));
        *(uint2*)(xv + o) = make_uint2(pack2(c[0], c[1]), pack2(c[2], c[3]));
      }
      if (is_p ? (row == MPR - 1) : (tt == 63)) {
        float* o = POUT + (is_p ? O_ASH_P + (size_t)j * 1024 : O_ASH_S + ((size_t)j * NSS + b) * 1024);
#pragma unroll
        for (int i = 0; i < 4; ++i) *(float4*)(o + i * 256 + lane * 4) = make_float4(hv[i * 4], hv[i * 4 + 1], hv[i * 4 + 2], hv[i * 4 + 3]);
      }
    }
  }
}

DEVI void phase_rms(const float* x, const float* g, bf16* dst, float* fdst) {
  const int lane = threadIdx.x & 63, wave = threadIdx.x >> 6;
  const int nw = gridDim.x * 4;
  for (int row = blockIdx.x * 4 + wave; row < MT; row += 2 * nw) {
    const int row2 = row + nw; const bool has2 = row2 < MT;
    float4 v[4], v2[4]; float ss = 0.f, ss2 = 0.f;
#pragma unroll
    for (int i = 0; i < 4; ++i) v[i] = *(const float4*)(x + (size_t)row * 1024 + i * 256 + lane * 4);
    if (has2) {
#pragma unroll
      for (int i = 0; i < 4; ++i) v2[i] = *(const float4*)(x + (size_t)row2 * 1024 + i * 256 + lane * 4);
    } else {
#pragma unroll
      for (int i = 0; i < 4; ++i) v2[i] = make_float4(0.f, 0.f, 0.f, 0.f);
    }
#pragma unroll
    for (int i = 0; i < 4; ++i) { ss += v[i].x * v[i].x + v[i].y * v[i].y + v[i].z * v[i].z + v[i].w * v[i].w; ss2 += v2[i].x * v2[i].x + v2[i].y * v2[i].y + v2[i].z * v2[i].z + v2[i].w * v2[i].w; }
    ss = wsum(ss); ss2 = wsum(ss2);
    const float r = rsqrtf(ss * (1.f / 1024.f) + 1e-6f), r2 = rsqrtf(ss2 * (1.f / 1024.f) + 1e-6f);
#pragma unroll
    for (int i = 0; i < 4; ++i) { float4 gg = *(const float4*)(g + i * 256 + lane * 4);
      { float a = v[i].x * r * gg.x, b = v[i].y * r * gg.y, c = v[i].z * r * gg.z, d = v[i].w * r * gg.w;
        if (dst) *(uint2*)(dst + (size_t)row * 1024 + i * 256 + lane * 4) = make_uint2(pack2(a, b), pack2(c, d));
        else *(float4*)(fdst + (size_t)row * 1024 + i * 256 + lane * 4) = make_float4(a, b, c, d); }
      if (has2) { float a = v2[i].x * r2 * gg.x, b = v2[i].y * r2 * gg.y, c = v2[i].z * r2 * gg.z, d = v2[i].w * r2 * gg.w;
        if (dst) *(uint2*)(dst + (size_t)row2 * 1024 + i * 256 + lane * 4) = make_uint2(pack2(a, b), pack2(c, d));
        else *(float4*)(fdst + (size_t)row2 * 1024 + i * 256 + lane * 4) = make_float4(a, b, c, d); }
    }
  }
}

DEVI void phase_gdn_conv(const P& p) {
  const bf16* qkv = slot(p, 1); const float* cw = PIN(35); const float* cst = PIN(5);
  const int tid = threadIdx.x;
  for (int item = blockIdx.x; item < (MT / 8) * 3; item += gridDim.x) {
    const int row0 = (item / 3) * 8, sec = item % 3, ch = sec * 1024 + tid * 4;
    const bool is_p = row0 < MPR; const int tt0 = is_p ? row0 : ((row0 - MPR) & 63); const int b = is_p ? 0 : ((row0 - MPR) >> 6);
    float x[11][4];
#pragma unroll
    for (int i = 0; i < 11; ++i) {
      const int pt = tt0 + i;
      if (pt >= 3) { uint2 u = *(const uint2*)(qkv + (size_t)(row0 + i - 3) * 3072 + ch);
        x[i][0] = bf2f(u.x & 0xffff); x[i][1] = bf2f(u.x >> 16); x[i][2] = bf2f(u.y & 0xffff); x[i][3] = bf2f(u.y >> 16); }
      else if (!is_p) { float4 s = *(const float4*)(cst + ((size_t)b * 3 + pt) * 3072 + ch); x[i][0] = s.x; x[i][1] = s.y; x[i][2] = s.z; x[i][3] = s.w; }
      else { x[i][0] = x[i][1] = x[i][2] = x[i][3] = 0.f; }
    }
    float w[4][4];
#pragma unroll
    for (int i = 0; i < 4; ++i) { float4 ww = *(const float4*)(cw + i * 3072 + ch); w[i][0] = ww.x; w[i][1] = ww.y; w[i][2] = ww.z; w[i][3] = ww.w; }
#pragma unroll
    for (int o = 0; o < 8; ++o) {
      float acc[4];
#pragma unroll
      for (int e = 0; e < 4; ++e) { acc[e] = x[o][e] * w[0][e] + x[o + 1][e] * w[1][e] + x[o + 2][e] * w[2][e] + x[o + 3][e] * w[3][e]; acc[e] = silu(acc[e]); }
      if (sec < 2) {
        float ss = acc[0] * acc[0] + acc[1] * acc[1] + acc[2] * acc[2] + acc[3] * acc[3];
#pragma unroll
        for (int once = 0; once < 1; ++once) { ss = rsum16(ss); ss += __shfl_xor(ss, 16); }
        const float r = rsqrtf(ss + 1e-6f) * (sec == 0 ? 0.08838834764831845f : 1.f);
#pragma unroll
        for (int e = 0; e < 4; ++e) acc[e] *= r;
      }
      *(uint2*)(slot(p, 5 + sec) + (size_t)(row0 + o) * 1024 + tid * 4) = make_uint2(pack2(acc[0], acc[1]), pack2(acc[2], acc[3]));
    }
  }
}

DEVI void mm_strip(const bf16* At, const bf16* Bt, f32x4 (&acc)[4], int wave, int lane) {
  const int lr = lane & 15, quad = lane >> 4;
#pragma unroll
  for (int ks = 0; ks < 2; ++ks) {
    bf16x8 a = *(const bf16x8*)(At + (wave * 16 + lr) * 72 + ks * 32 + quad * 8);
#pragma unroll
    for (int nb = 0; nb < 4; ++nb) {
      bf16x8 b = *(const bf16x8*)(Bt + (nb * 16 + lr) * 72 + ks * 32 + quad * 8);
      acc[nb] = __builtin_amdgcn_mfma_f32_16x16x32_bf16(a, b, acc[nb], 0, 0, 0);
    }
  }
}
DEVI void zero4(f32x4 (&a)[4]) {
#pragma unroll
  for (int i = 0; i < 4; ++i) a[i] = (f32x4){0.f, 0.f, 0.f, 0.f};
}

DEVI int perm32(int x) { return (x & ~31) | (((x >> 2) & 3) << 3) | (((x >> 4) & 1) << 2) | (x & 3); }
template <int CW> DEVI size_t cont_off(int r, int s, int LD) { const int idx = r * 64 + s; return (size_t)(idx / CW) * LD + (idx % CW); }

template <int TYPE>
DEVI void phase_prep(const P& p, int j, char* smem) {
  constexpr int NH = TYPE == 0 ? 16 : (TYPE == 1 ? 4 : 8);
  constexpr int DK = TYPE == 0 ? 64 : 128;
  constexpr int DV = TYPE == 0 ? 64 : (TYPE == 1 ? 256 : 128);
  constexpr bool LOW = TYPE != 1;
  constexpr int KT = 256 / DK, TPT = 64 / KT, DKH = DK / 64, DVH = DV / 64;
  constexpr int LDQ = TYPE == 1 ? 512 : 1024;
  bf16* X0 = (bf16*)smem; bf16* X1 = X0 + 4608; bf16* Y0 = X1 + 4608; bf16* Y1 = Y0 + 4608;
  float* Lb = (float*)smem;
  bf16* LkT = (bf16*)(smem + 16384); bf16* Ak = LkT + 4608; bf16* nAb = Ak + 4608;
  bf16* M1 = (bf16*)smem;
  bf16* Tt = (bf16*)(smem + 44032); bf16* St1 = Tt + 4608; bf16* St2 = St1 + 4608;
  if (TYPE == 1) { Y0 = (bf16*)(smem + 9216); Ak = (bf16*)(smem + 18432); St1 = (bf16*)(smem + 27648); }
  float* lgL = (float*)(smem + 36864);
  float* tot = (float*)(smem + 71680);
  float* sc_beta = (float*)(smem + 73728);
  float* sc_eg = sc_beta + 64; float* sc_lg = sc_eg + 64; float* sc_g = sc_lg + 64;

  bf16 *Aq, *Akk, *Av, *Ald = nullptr, *Aa = nullptr, *Oq, *Okt, *Ovt, *Ow = nullptr, *Obt = nullptr, *Ool, *Ou0 = nullptr;
  if (TYPE == 0) { Aq = slot(p, 5); Akk = slot(p, 6); Av = slot(p, 7); Ald = slot(p, 2); Aa = slot(p, 3);
    Oq = Aq; Okt = Akk; Ovt = Av; Ow = Ald; Obt = Aa; Ool = slot(p, 0); Ou0 = slot(p, 1); }
  else if (TYPE == 1) { Aq = slot(p, 1); Akk = slot(p, 1) + (size_t)MT * 512; Av = slot(p, 2); Oq = Aq; Okt = Akk; Ovt = Av; Ool = slot(p, 4); }
  else { Aq = slot(p, 5); Akk = slot(p, 6); Av = slot(p, 7); Oq = Aq; Okt = Akk; Ovt = Av; Ow = slot(p, 1); Obt = slot(p, 2); Ool = slot(p, 3); Ou0 = slot(p, 0); }
  float* sm = (float*)(PWS + WS_SM);
  float* gam = (float*)(PWS + WS_GAM);

  for (int item = blockIdx.x; item < NCHUNK * NH; item += gridDim.x) {
    const int c = item / NH, h = item % NH;
    const size_t rb = (size_t)c * 64;
    int tid = threadIdx.x; asm volatile("" : "+v"(tid));
    const int lane = tid & 63, wave = tid >> 6, lr = lane & 15, quad = lane >> 4;
    const int k = tid % DK, tg = tid / DK;
    const int vv = tid & 63, tgv = tid >> 6;
    unsigned qP[TPT / 2], ktP[TPT / 2], kapP[(TYPE == 0) ? TPT / 2 : 1], bvP[(TYPE == 0) ? TPT / 2 : 1];
    float lg[(TYPE == 0) ? TPT : 1], ldv[(TYPE == 0) ? TPT : 1];
    unsigned vP[DVH][8];
    auto lo16 = [](unsigned w) { return __uint_as_float(w << 16); };
    auto hi16 = [](unsigned w) { return __uint_as_float(w & 0xffff0000u); };
#define GETP(arr, e) (((e) & 1) ? hi16(arr[(e) >> 1]) : lo16(arr[(e) >> 1]))
#pragma unroll
    for (int vh = 0; vh < DVH; ++vh) {
      bf16 va[16];
#pragma unroll
      for (int e = 0; e < 16; ++e) va[e] = Av[(rb + tgv * 16 + e) * 1024 + h * DV + vh * 64 + vv];
#pragma unroll
      for (int e = 0; e < 8; ++e) { vP[vh][e] = (unsigned)va[2 * e] | ((unsigned)va[2 * e + 1] << 16); asm volatile("" : "+v"(vP[vh][e])); }
    }
    if constexpr (TYPE == 2) {
      if (tid < 64) {
        const float a_log = PIN(36)[h], dtb = PIN(37)[h];
        const float braw = sm[(rb + tid) * 16 + h], araw = sm[(rb + tid) * 16 + 8 + h];
        const float gt = -__expf(a_log) * softplus(araw + dtb);
        sc_beta[tid] = sigm(braw); sc_eg[tid] = __expf(gt); sc_g[tid] = gt;
        float cs = gt;
#pragma unroll
        for (int o = 1; o < 64; o <<= 1) { float n = __shfl_up(cs, o); if (lane >= o) cs += n; }
        sc_lg[tid] = cs;
      }
      __syncthreads();
    }
    if constexpr (TYPE == 0) {
      const float k_k = PIN(21)[j * 1024 + h * 64 + k], k_a = PIN(22)[j * 1024 + h * 64 + k], r_k = PIN(23)[j * 1024 + h * 64 + k];
      float run = 0.f;
      bf16 rr[TPT], rk[TPT], ra[TPT], rl[TPT];
#pragma unroll
      for (int e = 0; e < TPT; ++e) {
        const size_t o = (rb + tg * TPT + e) * 1024 + h * 64 + k;
        rr[e] = Aq[o]; rk[e] = Akk[o]; ra[e] = Aa[o]; rl[e] = Ald[o];
      }
#pragma unroll
      for (int e2 = 0; e2 < TPT / 2; ++e2) {
        float qq[2], ka[2], kq[2], bq[2];
#pragma unroll
        for (int u = 0; u < 2; ++u) {
          const int e = e2 * 2 + u;
          const float r = bf2f(rr[e]), kr = bf2f(rk[e]), av = bf2f(ra[e]), l = bf2f(rl[e]);
          const float kk = kr * k_k;
          const float inv = rsqrtf(fmaxf(wsum(kk * kk), 1e-24f));
          qq[u] = r; ka[u] = kk * inv; kq[u] = kr * (1.f + (av - 1.f) * k_a); bq[u] = ka[u] * av; ldv[e] = l;
          const float bo = wsum(r * kq[u] * r_k);
          if (lane == 0) sm[(rb + tg * TPT + e) * 16 + h] = bo;
          run += l; lg[e] = run;
        }
        qP[e2] = pack2(qq[0], qq[1]); kapP[e2] = pack2(ka[0], ka[1]); ktP[e2] = pack2(kq[0], kq[1]); bvP[e2] = pack2(bq[0], bq[1]);
        asm volatile("" : "+v"(qP[e2]), "+v"(kapP[e2]), "+v"(ktP[e2]), "+v"(bvP[e2]));
      }
      tot[tg * 128 + k] = run;
    } else if constexpr (TYPE == 1) {
      float w2[16];
#pragma unroll
      for (int i = 0; i < 16; ++i) w2[i] = PIN(30)[i * 512 + h * 128 + k];
      const float ba = PIN(31)[h * 128 + k];
      bf16 rq[TPT], rk[TPT];
#pragma unroll
      for (int e = 0; e < TPT; ++e) { const size_t row = rb + tg * TPT + e; rq[e] = Aq[row * 512 + h * 128 + k]; rk[e] = Akk[row * 512 + h * 128 + k]; }
      float4 ar[TPT][4];
      float run = 0.f;
#pragma unroll
      for (int e = 0; e < TPT; e += 4) {
#pragma unroll
        for (int u = 0; u < 4; ++u)
#pragma unroll
          for (int q4 = 0; q4 < 4; ++q4) ar[e + u][q4] = *(const float4*)(sm + (rb + tg * TPT + e + u) * 16 + q4 * 4);
#pragma unroll
        for (int u = 0; u < 4; ++u) {
          float s = ba;
#pragma unroll
          for (int q4 = 0; q4 < 4; ++q4) { const float4 a4 = ar[e + u][q4]; s += a4.x * w2[q4 * 4] + a4.y * w2[q4 * 4 + 1] + a4.z * w2[q4 * 4 + 2] + a4.w * w2[q4 * 4 + 3]; }
          const float gk = (fminf(s, 0.f) - log1pf(__expf(-fabsf(s)))) * (1.f / 16.f);
          run += gk; lgL[(tg * TPT + e + u) * 128 + k] = run;
        }
      }
#pragma unroll
      for (int e2 = 0; e2 < TPT / 2; ++e2) {
        qP[e2] = (unsigned)rq[2 * e2] | ((unsigned)rq[2 * e2 + 1] << 16);
        ktP[e2] = (unsigned)rk[2 * e2] | ((unsigned)rk[2 * e2 + 1] << 16);
        asm volatile("" : "+v"(qP[e2]), "+v"(ktP[e2]));
      }
      tot[tg * 128 + k] = run;
    } else {
      bf16 rq[TPT], rk[TPT];
#pragma unroll
      for (int e = 0; e < TPT; ++e) { const size_t o = (rb + tg * TPT + e) * 1024 + h * 128 + k; rq[e] = Aq[o]; rk[e] = Akk[o]; }
#pragma unroll
      for (int e2 = 0; e2 < TPT / 2; ++e2) {
        qP[e2] = (unsigned)rq[2 * e2] | ((unsigned)rq[2 * e2 + 1] << 16);
        ktP[e2] = (unsigned)rk[2 * e2] | ((unsigned)rk[2 * e2 + 1] << 16);
        asm volatile("" : "+v"(qP[e2]), "+v"(ktP[e2]));
      }
    }
    __syncthreads();
    float lgC;
    if constexpr (TYPE == 2) { lgC = sc_lg[63]; }
    else {
      float off = 0.f, all = 0.f;
#pragma unroll
      for (int g2 = 0; g2 < KT; ++g2) { const float tv = tot[g2 * 128 + k]; all += tv; if (g2 < tg) off += tv; }
      if constexpr (TYPE == 0) {
#pragma unroll
        for (int e = 0; e < TPT; ++e) lg[e] += off;
      } else {
#pragma unroll
        for (int e = 0; e < TPT; ++e) lgL[(tg * TPT + e) * 128 + k] += off;
      }
      lgC = all;
    }
#define QV(e) GETP(qP, e)
#define LGV(e, t) ((TYPE == 2) ? sc_lg[t] : ((TYPE == 1) ? lgL[(t) * 128 + k] : lg[(TYPE == 0) ? (e) : 0]))
#define LPREV(e, t) ((TYPE == 0) ? (lg[(TYPE == 0) ? (e) : 0] - ldv[(TYPE == 0) ? (e) : 0]) : (sc_lg[t] - sc_g[t]))
#define KTV(e, t) ((TYPE == 2) ? (sc_beta[t] * GETP(ktP, e)) : GETP(ktP, e))
#define KAPV(e, t) ((TYPE == 2) ? GETP(ktP, e) : GETP(kapP, (TYPE == 0) ? (e) : 0))
#define BVV(e, t) ((TYPE == 2) ? (sc_beta[t] * sc_eg[t] * GETP(ktP, e)) : GETP(bvP, (TYPE == 0) ? (e) : 0))
    f32x4 sacc[LOW ? 4 : 1][4];
#pragma unroll
    for (int a = 0; a < (LOW ? 4 : 1); ++a) zero4(sacc[a]);
#pragma unroll
    for (int kh = 0; kh < DKH; ++kh) {
      if (k / 64 == kh) {
        const int kk = k & 63;
#pragma unroll
        for (int e = 0; e < TPT; ++e) {
          const int t = tg * TPT + e;
          if constexpr (TYPE == 2) {
            X0[t * 72 + kk] = f2bf(QV(e)); Y0[t * 72 + kk] = f2bf(KTV(e, t));
            X1[t * 72 + kk] = f2bf(KAPV(e, t)); Y1[t * 72 + kk] = f2bf(BVV(e, t));
          } else {
            const float lgt = LGV(e, t);
            const float el = __expf(lgt), eml = __expf(-lgt);
            X0[t * 72 + kk] = f2bf(QV(e) * el);
            Y0[t * 72 + kk] = f2bf(KTV(e, t) * eml);
            if constexpr (LOW) {
              X1[t * 72 + kk] = f2bf(KAPV(e, t) * __expf(LPREV(e, t)));
              Y1[t * 72 + kk] = f2bf(BVV(e, t) * eml);
            }
          }
        }
      }
      __syncthreads();
      mm_strip(X0, Y0, sacc[0], wave, lane);
      if constexpr (LOW) { mm_strip(X0, Y1, sacc[1], wave, lane); mm_strip(X1, Y0, sacc[2], wave, lane); mm_strip(X1, Y1, sacc[3], wave, lane); }
      __syncthreads();
    }
#pragma unroll
    for (int nb = 0; nb < 4; ++nb)
#pragma unroll
      for (int jj = 0; jj < 4; ++jj) {
        const int t = wave * 16 + quad * 4 + jj, s = nb * 16 + lr;
        float da = 1.f, dl = 1.f;
        if constexpr (TYPE == 2) { const float dd = sc_lg[t] - sc_lg[s]; da = __expf(fminf(dd, 0.f)); dl = __expf(fminf(dd - sc_g[t], 0.f)); }
        Ak[t * 72 + s] = f2bf(s <= t ? sacc[0][nb][jj] * da : 0.f);
        if constexpr (LOW) {
          nAb[t * 72 + s] = f2bf(s <= t ? -sacc[1][nb][jj] * da : 0.f);
          LkT[s * 72 + t] = f2bf(s < t ? sacc[2][nb][jj] * dl : 0.f);
          Lb[t * 64 + (s & 3) * 16 + (s >> 2)] = s < t ? sacc[3][nb][jj] * dl : 0.f;
        }
      }
    __syncthreads();
    f32x4 acc[4];
    if constexpr (LOW) {
      {
        const int q = lane & 3, jc = wave * 16 + (lane >> 2);
        float xr[16];
#pragma unroll
        for (int i = 0; i < 16; ++i) xr[i] = 0.f;
#pragma unroll
        for (int t = 0; t < 64; ++t) {
          float s = 0.f, s2 = 0.f;
          const float* Lr = Lb + t * 64 + q * 16;
#pragma unroll
          for (int i = 0; i < (t + 3) / 4; ++i) { if (i & 1) s2 += Lr[i] * xr[i]; else s += Lr[i] * xr[i]; }
          s += s2;
          s = rsum4(s);
          s = ((t == jc) ? 1.f : 0.f) - s;
          xr[t >> 2] = (q == (t & 3)) ? s : xr[t >> 2];
          if (q == 0) Tt[t * 72 + jc] = f2bf(s);
        }
      }
      __syncthreads();
      zero4(acc); mm_strip(Tt, LkT, acc, wave, lane);
#pragma unroll
      for (int nb = 0; nb < 4; ++nb)
#pragma unroll
        for (int jj = 0; jj < 4; ++jj) M1[(wave * 16 + quad * 4 + jj) * 72 + nb * 16 + lr] = f2bf(acc[nb][jj]);
      __syncthreads();
    }
#pragma unroll
    for (int vh = 0; vh < DVH; ++vh) {
#pragma unroll
      for (int e = 0; e < 8; ++e) *(unsigned*)(St1 + vv * 72 + tgv * 16 + 2 * e) = vP[vh][e];
      __syncthreads();
      if constexpr (LOW) {
        zero4(acc); mm_strip(M1, St1, acc, wave, lane);
#pragma unroll
        for (int nb = 0; nb < 4; ++nb)
#pragma unroll
          for (int jj = 0; jj < 4; ++jj) {
            const int t = wave * 16 + quad * 4 + jj, col = nb * 16 + lr; const bf16 u = f2bf(acc[nb][jj]);
            St2[col * 72 + t] = u;
          }
#pragma unroll
        for (int nb = 0; nb < 4; ++nb)
          *(uint2*)(Ou0 + (((((size_t)c * NH + h) * (DV / 16) + vh * 4 + nb) * 4 + wave) * 64 + lane) * 4) = make_uint2(pack2(acc[nb][0], acc[nb][1]), pack2(acc[nb][2], acc[nb][3]));
        __syncthreads();
      }
      zero4(acc); mm_strip(Ak, St1, acc, wave, lane);
      if constexpr (LOW) mm_strip(nAb, St2, acc, wave, lane);
#pragma unroll
      for (int nb = 0; nb < 4; ++nb)
        *(uint2*)(Ool + (((((size_t)c * NH + h) * (DV / 16) + vh * 4 + nb) * 4 + wave) * 64 + lane) * 4) = make_uint2(pack2(acc[nb][0], acc[nb][1]), pack2(acc[nb][2], acc[nb][3]));
      __syncthreads();
    }
    if constexpr (LOW) {
#pragma unroll
      for (int kh = 0; kh < DKH; ++kh) {
        if (k / 64 == kh) {
          const int kk = k & 63;
#pragma unroll
          for (int e = 0; e < TPT; ++e) {
            const int t = tg * TPT + e;
            St1[kk * 72 + t] = f2bf(KAPV(e, t) * __expf(LPREV(e, t)));
            LkT[t * 72 + kk] = f2bf(QV(e) * __expf(LGV(e, t)));
            }
        }
        __syncthreads();
        zero4(acc); mm_strip(Tt, St1, acc, wave, lane);
#pragma unroll
        for (int nb = 0; nb < 4; ++nb)
#pragma unroll
          for (int jj = 0; jj < 4; ++jj) {
            const int t = wave * 16 + quad * 4 + jj, col = nb * 16 + lr; const bf16 u = f2bf(acc[nb][jj]);
            St2[col * 72 + t] = u;
            Ow[(rb + t) * 1024 + h * DK + perm32(kh * 64 + col)] = u;
          }
        __syncthreads();
        zero4(acc); mm_strip(nAb, St2, acc, wave, lane);
#pragma unroll
        for (int nb = 0; nb < 4; ++nb)
#pragma unroll
          for (int jj = 0; jj < 4; ++jj) {
            const int t = wave * 16 + quad * 4 + jj, col = nb * 16 + lr;
            Oq[(rb + t) * LDQ + h * DK + perm32(kh * 64 + col)] = f2bf(acc[nb][jj] + bf2f(LkT[t * 72 + col]));
          }
        __syncthreads();
      }
    } else {
#pragma unroll
      for (int e = 0; e < TPT; ++e) { Oq[(rb + tg * TPT + e) * LDQ + h * DK + perm32(k)] = f2bf(QV(e) * __expf(LGV(e, tg * TPT + e))); }
    }
    {
      unsigned wk[TPT / 2], wb[LOW ? TPT / 2 : 1];
#pragma unroll
      for (int e = 0; e < TPT; e += 2) {
        const int t0 = tg * TPT + e;
        const float d0 = __expf(lgC - LGV(e, t0)), d1 = __expf(lgC - LGV(e + 1, t0 + 1));
        wk[e / 2] = pack2(KTV(e, t0) * d0, KTV(e + 1, t0 + 1) * d1);
        if constexpr (LOW) wb[e / 2] = pack2(BVV(e, t0) * d0, BVV(e + 1, t0 + 1) * d1);
      }
      const size_t co = rb * LDQ + h * DK + cont_off<DK>(k, tg * TPT, LDQ);
#pragma unroll
      for (int e = 0; e < TPT / 8; ++e) {
        *(uint4*)(Okt + co + e * 8) = make_uint4(wk[e * 4], wk[e * 4 + 1], wk[e * 4 + 2], wk[e * 4 + 3]);
        if constexpr (LOW) {
#pragma unroll
          for (int g4 = 0; g4 < 2; ++g4) {
            const int s0 = tg * TPT + e * 8 + g4 * 4;
            *(uint2*)(Obt + rb * 1024 + h * DK + cont_off<DK>(k, perm32(s0), 1024)) = make_uint2(wb[e * 4 + g4 * 2], wb[e * 4 + g4 * 2 + 1]);
          }
        }
      }
#pragma unroll
      for (int vh = 0; vh < DVH; ++vh) {
        const unsigned* wv = vP[vh];
        const size_t vo = rb * 1024 + h * DV + cont_off<DV>(vh * 64 + vv, tgv * 16, 1024);
        *(uint4*)(Ovt + vo) = make_uint4(wv[0], wv[1], wv[2], wv[3]);
        *(uint4*)(Ovt + vo + 8) = make_uint4(wv[4], wv[5], wv[6], wv[7]);
      }
      if (tg == 0) gam[((size_t)c * NH + h) * DK + k] = __expf(lgC);
    }
    __syncthreads();
  }
}

template <int TYPE>
DEVI void phase_seq2(const P& p, int j, char* smem) {
  constexpr int NH = TYPE == 0 ? 16 : (TYPE == 1 ? 4 : 8);
  constexpr int DK = TYPE == 0 ? 64 : 128;
  constexpr int DV = TYPE == 0 ? 64 : (TYPE == 1 ? 256 : 128);
  constexpr bool LOW = TYPE != 1;
  constexpr int NVB = DV / 16, MB = DK / 16, KS = DK / 32, NG = NVB / 4, BIPS = NH * NG;
  constexpr int LDQ = TYPE == 1 ? 512 : 1024;
  constexpr int NOP = LOW ? 4 : 2, RS = DK + 8, OPSZ = 64 * RS, PPR = DK / 8;
  constexpr int PPO = 64 * PPR / 256;
  constexpr int PF = 4;
  bf16* L = (bf16*)smem;
  const int tid = threadIdx.x, lane = tid & 63, wave = tid >> 6, lr = lane & 15, quad = lane >> 4;
  const bf16 *Qp, *Kt, *Vt, *Wp = nullptr, *Bt = nullptr, *U0 = nullptr; bf16* Ol;
  if (TYPE == 0) { Qp = slot(p, 5); Kt = slot(p, 6); Vt = slot(p, 7); Wp = slot(p, 2); Bt = slot(p, 3); Ol = slot(p, 0); U0 = slot(p, 1); }
  else if (TYPE == 1) { Qp = slot(p, 1); Kt = slot(p, 1) + (size_t)MT * 512; Vt = slot(p, 2); Ol = slot(p, 4); }
  else { Qp = slot(p, 5); Kt = slot(p, 6); Vt = slot(p, 7); Wp = slot(p, 1); Bt = slot(p, 2); Ol = slot(p, 3); U0 = slot(p, 0); }
  const float* gam = (const float*)(PWS + WS_GAM);
  unsigned tsink = 0;
  const bool split = (int)gridDim.x > 2 * BIPS;
  const int bstart = !split ? (int)blockIdx.x : ((int)blockIdx.x < BIPS ? (int)blockIdx.x : BIPS + ((int)blockIdx.x - BIPS));
  const int bstep = !split ? (int)gridDim.x : ((int)blockIdx.x < BIPS ? (1 << 30) : ((int)gridDim.x - BIPS));
  for (int bitem = bstart; bitem < 33 * BIPS; bitem += bstep) {
    const int seq = bitem / BIPS, rem = bitem % BIPS, h = rem / NG, vb = (rem % NG) * 4 + wave;
    const int c0 = seq == 0 ? 0 : NPCH + seq - 1, nc = seq == 0 ? NPCH : 1;
    const int vcol = vb * 16 + lr;
    f32x4 H[MB];
    if (seq == 0) {
#pragma unroll
      for (int m = 0; m < MB; ++m) H[m] = (f32x4){0.f, 0.f, 0.f, 0.f};
    } else {
      const int b = seq - 1;
      if (TYPE == 0) {
        const float* S = PIN(3) + (((size_t)j * NSS + b) * 16 + h) * 4096 + (size_t)vcol * 64;
#pragma unroll
        for (int m = 0; m < MB; ++m) { float4 v = *(const float4*)(S + m * 16 + quad * 4); H[m] = (f32x4){v.x, v.y, v.z, v.w}; }
      } else {
        const float* S = PIN(TYPE == 1 ? 4 : 6) + ((size_t)b * NH + h) * DK * DV + vcol;
#pragma unroll
        for (int m = 0; m < MB; ++m)
#pragma unroll
          for (int jj = 0; jj < 4; ++jj) H[m][jj] = S[(size_t)(m * 16 + quad * 4 + jj) * DV];
      }
    }
    u32x4 preA[NOP * PPO], preB[NOP * PPO]; u32x2 poA[4], poB[4], puA[4], puB[4]; bf16x8 pvA[2], pvB[2]; f32x4 pgA[MB], pgB[MB];
    auto issue_sh = [&](int cc, u32x4 (&pre)[NOP * PPO]) {
      const size_t rb_ = (size_t)cc * 64; int tl_ = threadIdx.x; asm volatile("" : "+v"(tl_));
#pragma unroll
      for (int i_ = 0; i_ < PPO; ++i_) { const int w_ = tl_ + 256 * i_; const size_t r_ = rb_ + w_ / PPR; const int c8_ = (w_ % PPR) * 8;
        pre[0 * PPO + i_] = *(const u32x4*)(Qp + r_ * LDQ + h * DK + c8_);
        pre[1 * PPO + i_] = *(const u32x4*)(Kt + r_ * LDQ + h * DK + c8_);
        if constexpr (LOW) { pre[2 * PPO + i_] = *(const u32x4*)(Wp + r_ * 1024 + h * DK + c8_); pre[3 * PPO + i_] = *(const u32x4*)(Bt + r_ * 1024 + h * DK + c8_); } }
    };
    auto issue_pr = [&](int cc, u32x2 (&p_o)[4], u32x2 (&p_u)[4], bf16x8 (&p_v)[2], f32x4 (&p_g)[MB]) {
      const size_t rb_ = (size_t)cc * 64; int tl_ = threadIdx.x; asm volatile("" : "+v"(tl_));
      const int lane = tl_ & 63, lr = lane & 15, quad = lane >> 4, vcol = vb * 16 + lr;
      const size_t fo_ = ((((size_t)cc * NH + h) * NVB + vb) * 4) * 256 + lane * 4;
#pragma unroll
      for (int tb_ = 0; tb_ < 4; ++tb_) { p_o[tb_] = *(const u32x2*)(Ol + fo_ + tb_ * 256); if constexpr (LOW) p_u[tb_] = *(const u32x2*)(U0 + fo_ + tb_ * 256); }
#pragma unroll
      for (int ks_ = 0; ks_ < 2; ++ks_) p_v[ks_] = *(const bf16x8*)(Vt + rb_ * 1024 + h * DV + cont_off<DV>(vcol, ks_ * 32 + quad * 8, 1024));
#pragma unroll
      for (int m_ = 0; m_ < MB; ++m_) p_g[m_] = *(const f32x4*)(gam + ((size_t)cc * NH + h) * DK + m_ * 16 + quad * 4);
    };
    const int cend = c0 + nc;
    auto step = [&](int c, u32x4 (&pre)[NOP * PPO], u32x2 (&p_o)[4], u32x2 (&p_u)[4], bf16x8 (&p_v)[2], f32x4 (&p_g)[MB]) {
#pragma unroll
      for (int o = 0; o < NOP; ++o)
#pragma unroll
        for (int i = 0; i < PPO; ++i) { const int w = tid + 256 * i; *(u32x4*)(L + o * OPSZ + (w / PPR) * RS + (w % PPR) * 8) = pre[o * PPO + i]; }
      __syncthreads();
      if (c + 2 < cend) issue_sh(c + 2, pre);
      unsigned tv[NOP * DK / 128 + 1];
#pragma unroll
      for (int i = 0; i < NOP * DK / 128 + 1; ++i) tv[i] = 0;
      if (false && c + PF < cend) {
        const size_t rb2 = (size_t)(c + PF) * 64;
        if (DK == 128 || tid < 128) {
          const int li = (DK == 128) ? tid : tid; const size_t ro = li / (DK / 64) % 64; const int co = (li % (DK / 64)) * 64;
          const int half = (DK == 128) ? (tid >> 7) : (tid >> 6);
          if (half == 0) { tv[0] = *(const unsigned*)(Qp + (rb2 + ro) * LDQ + h * DK + co); if constexpr (LOW) tv[1] = *(const unsigned*)(Wp + (rb2 + ro) * 1024 + h * DK + co); }
          else { tv[0] = *(const unsigned*)(Kt + (rb2 + ro) * LDQ + h * DK + co); if constexpr (LOW) tv[1] = *(const unsigned*)(Bt + (rb2 + ro) * 1024 + h * DK + co); }
        }
        {
          const size_t fo2 = ((((size_t)(c + PF) * NH + h) * NVB + vb) * 4) * 256;
          const unsigned* tp;
          if (lane < 16) tp = (const unsigned*)(Ol + fo2 + lane * 64);
          else if (LOW && lane < 32) tp = (const unsigned*)(U0 + fo2 + (lane - 16) * 64);
          else if (lane < 48) tp = (const unsigned*)(Vt + rb2 * 1024 + h * DV + cont_off<DV>(vb * 16 + (lane & 15), 0, 1024));
          else tp = (const unsigned*)(gam + ((size_t)(c + PF) * NH + h) * DK + ((lane - 48) & (DK / 32 - 1)) * 32);
          tv[NOP * DK / 128] = *tp;
        }
      }
      bf16x8 hb[KS];
#pragma unroll
      for (int ks = 0; ks < KS; ++ks) {
        const u32x4 hw = {pack2(H[2 * ks][0], H[2 * ks][1]), pack2(H[2 * ks][2], H[2 * ks][3]), pack2(H[2 * ks + 1][0], H[2 * ks + 1][1]), pack2(H[2 * ks + 1][2], H[2 * ks + 1][3])};
        hb[ks] = __builtin_bit_cast(bf16x8, hw);
      }
      const size_t fo = ((((size_t)c * NH + h) * NVB + vb) * 4) * 256 + lane * 4;
      f32x4 U[4];
#pragma unroll
      for (int tb = 0; tb < 4; ++tb) {
        f32x4 o_ = (f32x4){bf2f(p_o[tb].x & 0xffff), bf2f(p_o[tb].x >> 16), bf2f(p_o[tb].y & 0xffff), bf2f(p_o[tb].y >> 16)}, u_;
        if constexpr (LOW) u_ = (f32x4){bf2f(p_u[tb].x & 0xffff), bf2f(p_u[tb].x >> 16), bf2f(p_u[tb].y & 0xffff), bf2f(p_u[tb].y >> 16)};
#pragma unroll
        for (int ks = 0; ks < KS; ++ks) {
          o_ = __builtin_amdgcn_mfma_f32_16x16x32_bf16(*(const bf16x8*)(L + 0 * OPSZ + (tb * 16 + lr) * RS + ks * 32 + quad * 8), hb[ks], o_, 0, 0, 0);
          if constexpr (LOW) u_ = __builtin_amdgcn_mfma_f32_16x16x32_bf16(*(const bf16x8*)(L + 2 * OPSZ + (tb * 16 + lr) * RS + ks * 32 + quad * 8), hb[ks], u_, 0, 0, 0);
        }
        *(u32x2*)(Ol + fo + tb * 256) = (u32x2){pack2(o_[0], o_[1]), pack2(o_[2], o_[3])};
        if constexpr (LOW) U[tb] = u_;
      }
      bf16x8 ubop[2];
      if constexpr (LOW) {
#pragma unroll
        for (int ks = 0; ks < 2; ++ks) {
          const u32x4 uw = {pack2(-U[2 * ks][0], -U[2 * ks][1]), pack2(-U[2 * ks][2], -U[2 * ks][3]), pack2(-U[2 * ks + 1][0], -U[2 * ks + 1][1]), pack2(-U[2 * ks + 1][2], -U[2 * ks + 1][3])};
          ubop[ks] = __builtin_bit_cast(bf16x8, uw);
        }
      }
#pragma unroll
      for (int m = 0; m < MB; ++m) {
        f32x4 hn = (f32x4){H[m][0] * p_g[m][0], H[m][1] * p_g[m][1], H[m][2] * p_g[m][2], H[m][3] * p_g[m][3]};
        const int krow = m * 16 + lr;
#pragma unroll
        for (int ks = 0; ks < 2; ++ks) {
          const int i1 = krow * 64 + ks * 32 + quad * 8;
          bf16x8 a = *(const bf16x8*)(L + 1 * OPSZ + (i1 / DK) * RS + (i1 % DK));
          hn = __builtin_amdgcn_mfma_f32_16x16x32_bf16(a, p_v[ks], hn, 0, 0, 0);
          if constexpr (LOW) {
            hn = __builtin_amdgcn_mfma_f32_16x16x32_bf16(*(const bf16x8*)(L + 3 * OPSZ + (i1 / DK) * RS + (i1 % DK)), ubop[ks], hn, 0, 0, 0);
          }
        }
        H[m] = hn;
      }
#pragma unroll
      for (int i = 0; i < NOP * DK / 128 + 1; ++i) tsink ^= tv[i];
      if (c + 2 < cend) issue_pr(c + 2, p_o, p_u, p_v, p_g);
      __syncthreads();
    };
    issue_sh(c0, preA); issue_pr(c0, poA, puA, pvA, pgA);
    if (nc > 1) { issue_sh(c0 + 1, preB); issue_pr(c0 + 1, poB, puB, pvB, pgB); }
    for (int c = c0; c < cend; c += 2) { step(c, preA, poA, puA, pvA, pgA); if (c + 1 < cend) step(c + 1, preB, poB, puB, pvB, pgB); }
    if (TYPE == 0) {
      float* S = POUT + (seq == 0 ? O_AWKV_P + ((size_t)j * 16 + h) * 4096 : O_AWKV_S + (((size_t)j * NSS + (seq - 1)) * 16 + h) * 4096) + (size_t)vcol * 64;
#pragma unroll
      for (int m = 0; m < MB; ++m) *(float4*)(S + m * 16 + quad * 4) = make_float4(H[m][0], H[m][1], H[m][2], H[m][3]);
    } else {
      const size_t ob = TYPE == 1 ? (seq == 0 ? O_BKV_P : O_BKV_S + (size_t)(seq - 1) * NH * DK * DV)
                                  : (seq == 0 ? O_CKV_P : O_CKV_S + (size_t)(seq - 1) * NH * DK * DV);
      float* S = POUT + ob + (size_t)h * DK * DV + vcol;
#pragma unroll
      for (int m = 0; m < MB; ++m)
#pragma unroll
        for (int jj = 0; jj < 4; ++jj) S[(size_t)(m * 16 + quad * 4 + jj) * DV] = H[m][jj];
    }
  }
  if (tsink == 0x9e3779b9u) ((unsigned*)(PWS + WS_SINK))[0] = tsink;
}

template <int TYPE>
DEVI void phase_post(const P& p, int j, char* smem) {
  constexpr int NH = TYPE == 0 ? 16 : (TYPE == 1 ? 4 : 8);
  constexpr int DV = TYPE == 0 ? 64 : (TYPE == 1 ? 256 : 128);
  constexpr int CPT = DV / 8;
  bf16* vt = (bf16*)smem;
  bf16* ot = (bf16*)(smem + 9216);
  const bf16* O = slot(p, TYPE == 0 ? 0 : (TYPE == 1 ? 4 : 3));
  const bf16* G = slot(p, TYPE == 0 ? 4 : (TYPE == 1 ? 3 : 4));
  bf16* og = slot(p, TYPE == 1 ? 0 : 1);
  const float* sm = (const float*)(PWS + WS_SM);
  for (int item = blockIdx.x; item < NCHUNK * NH; item += gridDim.x) {
    const int c = item / NH, h = item % NH; const size_t rb = (size_t)c * 64;
    int tid = threadIdx.x; asm volatile("" : "+v"(tid));
    const int part = tid & 7;
    if constexpr (TYPE == 0) {
      const bf16* V = slot(p, 7) + rb * 1024 + h * 64;
      const int r = tid >> 2, q4 = (tid & 3) * 16;
      *(uint4*)(vt + r * 72 + q4) = *(const uint4*)(V + (size_t)r * 1024 + q4);
      *(uint4*)(vt + r * 72 + q4 + 8) = *(const uint4*)(V + (size_t)r * 1024 + q4 + 8);
      __syncthreads();
    }
    {
      const uint4* srcp = (const uint4*)(O + ((size_t)c * NH + h) * 64 * DV);
#pragma unroll
      for (int i = 0; i < DV / 32; ++i) *(uint4*)(ot + (size_t)(i * 256 + tid) * 8) = srcp[i * 256 + tid];
      __syncthreads();
    }
#pragma unroll 1
    for (int pass = 0; pass < 2; ++pass) {
      const int t = pass * 32 + (tid >> 3);
      const size_t base = (rb + t) * 1024 + h * DV + part * CPT;
      float o[CPT];
#pragma unroll
      for (int e = 0; e < CPT; ++e) {
        const int v = part * CPT + e;
        o[e] = bf2f(ot[(((v >> 4) * 4 + (t >> 4)) * 64 + ((t & 15) >> 2) * 16 + (v & 15)) * 4 + (t & 3)]);
      }
      float s1 = 0.f, s2 = 0.f;
#pragma unroll
      for (int e = 0; e < CPT; ++e) { s1 += o[e]; s2 += o[e] * o[e]; }
      s1 = rsum8(s1); s2 = rsum8(s2);
      if constexpr (TYPE == 0) {
        const float mean = s1 * (1.f / 64.f); float var = s2 * (1.f / 64.f) - mean * mean; var = fmaxf(var, 0.f);
        const float rs = rsqrtf(var + 64e-5f); const float bonus = sm[(rb + t) * 16 + h];
        const float* lw = PIN(26) + j * 1024 + h * 64 + part * CPT; const float* lb = PIN(27) + j * 1024 + h * 64 + part * CPT;
#pragma unroll
        for (int e = 0; e < CPT; ++e) {
          const float vv = bf2f(vt[(part * CPT + e) * 72 + t]);
          o[e] = (o[e] - mean) * rs * lw[e] + lb[e] + bonus * vv;
        }
      } else {
        const float rs = rsqrtf(s2 * (1.f / DV) + 1e-6f);
        const float* on = PIN(TYPE == 1 ? 32 : 38) + part * CPT;
#pragma unroll
        for (int e = 0; e < CPT; ++e) o[e] = o[e] * rs * on[e];
      }
#pragma unroll
      for (int e = 0; e < CPT; e += 8) {
        uint4 u = *(const uint4*)(G + base + e);
        const unsigned w[4] = {u.x, u.y, u.z, u.w}; unsigned ow[4];
#pragma unroll
        for (int i = 0; i < 4; ++i) {
          float g0 = bf2f(w[i] & 0xffff), g1 = bf2f(w[i] >> 16);
          if constexpr (TYPE != 0) { g0 = silu(g0); g1 = silu(g1); }
          ow[i] = pack2(o[e + 2 * i] * g0, o[e + 2 * i + 1] * g1);
        }
        *(uint4*)(og + base + e) = make_uint4(ow[0], ow[1], ow[2], ow[3]);
      }
    }
    __syncthreads();
  }
}


#define XB_TMO      128
#define XB_XCNT(j)  (256  + 64 * (j))
#define XB_XSUB(j)  (1280 + 64 * (j))
#define XB_XGEN(j)  (2304 + 64 * (j))
#define XB_TOP      3328
#define XB_TOPGEN   3392
#define XCD_BAR_WORDS 3456
#define XB_SPIN_CAP (1u << 18)
#define LAS __attribute__((address_space(3)))
DEVI unsigned xb_ld(unsigned* p)              { return __hip_atomic_load(p, __ATOMIC_RELAXED, __HIP_MEMORY_SCOPE_AGENT); }
DEVI unsigned xb_add(unsigned* p, unsigned v) { return __hip_atomic_fetch_add(p, v, __ATOMIC_RELAXED, __HIP_MEMORY_SCOPE_AGENT); }
DEVI unsigned xb_xcc_id() { return (unsigned)__builtin_amdgcn_s_getreg((3 << 11) | 20) & 0xFu; }
#define XB_SPIN(cond, bar) do { unsigned _sp = 0; while (cond) { __builtin_amdgcn_s_sleep(1); \
    if ((++_sp & 255u) == 0u) { if (xb_ld(&(bar)[XB_TMO])) break; if (_sp > XB_SPIN_CAP) { atomicAdd(&(bar)[XB_TMO], 1u); break; } } } } while (0)
struct XcdBarrier { unsigned* bar; unsigned x; volatile LAS unsigned* st; };
DEVI XcdBarrier xcd_barrier_post(unsigned* bar, volatile LAS unsigned* st) {
  XcdBarrier b; b.bar = bar; b.x = xb_xcc_id(); b.st = st;
  if (threadIdx.x == 0) (void)xb_add(&bar[XB_XCNT(b.x)], 1u);
  return b;
}
DEVI void xcd_barrier_complete(unsigned* bar, unsigned x, unsigned& nloc, unsigned& nx) {
  const unsigned G = gridDim.x * gridDim.y * gridDim.z;
  unsigned sum, cnt, mine, sp = 0u;
  for (;;) {
    sum = 0u; cnt = 0u; mine = 0u;
#pragma unroll
    for (unsigned j = 0; j < 16; ++j) { const unsigned c = xb_ld(&bar[XB_XCNT(j)]); sum += c; cnt += (c > 0u) ? 1u : 0u; mine = (j == x) ? c : mine; }
    if (sum == G) break;
    __builtin_amdgcn_s_sleep(1);
    if ((++sp & 255u) == 0u) { if (xb_ld(&bar[XB_TMO])) break; if (sp > XB_SPIN_CAP) { atomicAdd(&bar[XB_TMO], 1u); break; } }
  }
  nloc = mine > 0u ? mine : 1u; nx = cnt > 0u ? cnt : 1u;
}
DEVI void xcd_barrier(const XcdBarrier& b) {
  asm volatile("s_waitcnt vmcnt(0)" ::: "memory");
  __syncthreads();
  if (threadIdx.x == 0) {
    unsigned* bar = b.bar;
    __builtin_amdgcn_s_waitcnt(0);
    unsigned nloc = b.st[0], nx = b.st[1];
    if (nloc == 0u) { xcd_barrier_complete(bar, b.x, nloc, nx); b.st[0] = nloc; b.st[1] = nx; }
    const unsigned old = xb_add(&bar[XB_XSUB(b.x)], 1u);
    const unsigned gen = old / nloc;
    if (old + 1u == (gen + 1u) * nloc) {
      __builtin_amdgcn_fence(__ATOMIC_RELEASE, "agent");
      asm volatile("s_waitcnt vmcnt(0)" ::: "memory");
      const unsigned og = xb_add(&bar[XB_TOP], 1u);
      const unsigned tg = og / nx;
      if (og + 1u == (tg + 1u) * nx) xb_add(&bar[XB_TOPGEN], 1u);
      else XB_SPIN(xb_ld(&bar[XB_TOPGEN]) == tg, bar);
      __builtin_amdgcn_fence(__ATOMIC_ACQUIRE, "agent");
      xb_add(&bar[XB_XGEN(b.x)], 1u);
      asm volatile("s_waitcnt vmcnt(0)" ::: "memory");
    } else {
      XB_SPIN(xb_ld(&bar[XB_XGEN(b.x)]) == gen, bar);
      __builtin_amdgcn_fence(__ATOMIC_ACQUIRE, "agent");
      asm volatile("s_waitcnt vmcnt(0)" ::: "memory");
    }
  }
  __syncthreads();
}

#ifndef DISMASK
#define DISMASK 0
#endif
#define EN(b) (!((DISMASK >> (b)) & 1))
#define GSYNC() xcd_barrier(xb)
#define GSYNC_CG() do { asm volatile("s_waitcnt vmcnt(0)" ::: "memory"); grid.sync(); } while (0)
__global__ void __launch_bounds__(256, 1) fwd_megakernel(P p) {
  extern __shared__ __attribute__((aligned(16))) char smem[];
  cg::grid_group grid = cg::this_grid();
  volatile LAS unsigned* xst = (volatile LAS unsigned*)(smem + LDS_BYTES - 16);
  if (threadIdx.x == 0) { xst[0] = 0u; xst[1] = 0u; }
  __syncthreads();
  const XcdBarrier xb = xcd_barrier_post((unsigned*)(PWS + WS_BAR), xst);
  bf16* wreg = (bf16*)(PWS + WS_W);
  bf16 *wfin = wreg + W_FIN, *wfout = wreg + W_FOUT, *wmix = wreg + W_MIX;
  float* sm = (float*)(PWS + WS_SM);
  for (int layer = 0; layer < 4; ++layer) {
    const int type = layer % 3, j = layer / 3;
    int tb = 0;
    if (type == 0) phase_norm<0>(p, layer, j, layer == 0, layer == 0);
    else phase_norm<1>(p, layer, j, false, false);
    conv_job(CvFfnIn{PIN(10) + (size_t)layer * 1024 * 2 * FF}, wfin, 1024, 2 * FF, 1024, tb, smem);
    conv_job(CvPlain{PIN(11) + (size_t)layer * FF * 1024, 1024, 1024}, wfout, FF, 1024, FF, tb, smem);
    if (type == 0) {
      for (int i = 0; i < 3; ++i) conv_job(CvPlain{PIN(24) + ((size_t)j * 3 + i) * 1048576, 1024, 1024}, wmix + (size_t)i * 1048576, 1024, 1024, 1024, tb, smem);
      conv_job(CvLora1{PIN(14) + (size_t)j * 65536, PIN(17) + (size_t)j * 65536, PIN(19) + (size_t)j * 131072, PIN(12) + (size_t)j * 6144}, wmix + 3145728, 2048, 256, 2048, tb, smem);
      conv_job(CvPlain{PIN(15) + (size_t)j * 65536, 1024, 1024}, wmix + 3670016, 64, 1024, 64, tb, smem);
      conv_job(CvPlain{PIN(18) + (size_t)j * 65536, 1024, 1024}, wmix + 3735552, 64, 1024, 64, tb, smem);
      conv_job(CvPlain{PIN(20) + (size_t)j * 131072, 1024, 1024}, wmix + 3801088, 128, 1024, 128, tb, smem);
      conv_job(CvPlain{PIN(25) + (size_t)j * 1048576, 1024, 1024}, wmix + 3932160, 1024, 1024, 1024, tb, smem);
    } else if (type == 1) {
      conv_job(CvGlaIn{PIN(28), PIN(29)}, wmix, 1024, 3200, 1024, tb, smem);
      conv_job(CvPlain{PIN(33), 1024, 1024}, wmix + 3276800, 1024, 1024, 1024, tb, smem);
    } else {
      conv_job(CvPlain{PIN(34), 4112, 4112}, wmix, 1024, 4224, 1024, tb, smem);
      conv_job(CvPlain{PIN(39), 1024, 1024}, wmix + 4325376, 1024, 1024, 1024, tb, smem);
    }
    GSYNC();
    tb = 0;
    const bf16* wo;
    if (type == 0) {
      for (int i = 0; i < 3; ++i)
        gemm_job(GemmDesc{slot(p, 2 + i), nullptr, 1024, 1024, wmix + (size_t)i * 1048576, 1024, 144, 8, 1024}, EpiStore{slot(p, 5 + i), 1024, 1.f}, tb, smem);
      gemm_job(GemmDesc{slot(p, 0), slot(p, 1), 1024, 1024, wmix + 3145728, 2048, 144, 2, 2048}, EpiLora1{(bf16*)(PWS + WS_L1)}, tb, smem);
      GSYNC();
      tb = 0;
      const bf16* l1 = (const bf16*)(PWS + WS_L1);
      gemm_job(GemmDesc{l1, nullptr, 256, 64, wmix + 3670016, 64, 144, 8, 64}, EpiLd{slot(p, 2), PIN(13) + j * 1024}, tb, smem);
      gemm_job(GemmDesc{l1 + 64, nullptr, 256, 64, wmix + 3735552, 64, 144, 8, 64}, EpiSig{slot(p, 3), PIN(16) + j * 1024}, tb, smem);
      gemm_job(GemmDesc{l1 + 128, nullptr, 256, 128, wmix + 3801088, 128, 144, 8, 128}, EpiStore{slot(p, 4), 1024, 1.f}, tb, smem);
      GSYNC();
      if (EN(2)) phase_prep<0>(p, j, smem);
      GSYNC();
      if (EN(5)) phase_seq2<0>(p, j, smem);
      GSYNC();
      if (EN(8)) phase_post<0>(p, j, smem);
      wo = wmix + 3932160;
    } else if (type == 1) {
      gemm_job(GemmDesc{slot(p, 0), nullptr, 1024, 1024, wmix, 1024, 144, 25, 1024},
               EpiGlaIn{slot(p, 1), slot(p, 1) + (size_t)MT * 512, slot(p, 2), slot(p, 3), sm}, tb, smem);
      GSYNC();
      if (EN(3)) phase_prep<1>(p, j, smem);
      GSYNC();
      if (EN(6)) phase_seq2<1>(p, j, smem);
      GSYNC();
      if (EN(8)) phase_post<1>(p, j, smem);
      wo = wmix + 3276800;
    } else {
      gemm_job(GemmDesc{slot(p, 0), nullptr, 1024, 1024, wmix, 1024, 144, 33, 1024},
               EpiGdnIn{slot(p, 1), slot(p, 4), sm, POUT}, tb, smem);
      GSYNC();
      if (EN(9)) phase_gdn_conv(p);
      GSYNC();
      if (EN(4)) phase_prep<2>(p, j, smem);
      GSYNC();
      if (EN(7)) phase_seq2<2>(p, j, smem);
      GSYNC();
      if (EN(8)) phase_post<2>(p, j, smem);
      wo = wmix + 4325376;
    }
    GSYNC();
    tb = 0;
    gemm_job(GemmDesc{slot(p, type == 1 ? 0 : 1), nullptr, 1024, 1024, wo, 1024, 144, 8, 1024}, EpiAcc{POUT}, tb, smem);
    GSYNC();
    phase_rms(POUT, PIN(8) + layer * 1024, slot(p, 0), nullptr);
    GSYNC();
    tb = 0;
    gemm_job(GemmDesc{slot(p, 0), nullptr, 1024, 1024, wfin, 1024, 144, 44, 1024}, EpiSwiglu{slot(p, 1)}, tb, smem);
    GSYNC();
    tb = 0;
    gemm_job(GemmDesc{slot(p, 1), nullptr, FF, FF, wfout, FF, 144, 8, FF}, EpiAcc{POUT}, tb, smem);
    if (layer == 3) GSYNC_CG(); else GSYNC();
  }
  phase_rms(POUT, PIN(9), nullptr, POUT);
}

extern "C" void kernel_launch(void* const* d_in, const int* in_sizes, int n_in, void* d_out, int out_size,
                              void* d_ws, size_t ws_size, hipStream_t stream) {
  if (n_in < 40 || ws_size < WS_TOTAL) { fprintf(stderr, "bad args: n_in %d ws %zu need %zu\n", n_in, ws_size, (size_t)WS_TOTAL); return; }
  static int grid_blocks = 0;
  if (!grid_blocks) {
    int dev = 0, cus = 0, per_cu = 0;
    hipGetDevice(&dev);
    hipDeviceGetAttribute(&cus, hipDeviceAttributeMultiprocessorCount, dev);
    hipFuncSetAttribute((const void*)fwd_megakernel, hipFuncAttributeMaxDynamicSharedMemorySize, LDS_BYTES);
    hipOccupancyMaxActiveBlocksPerMultiprocessor(&per_cu, (const void*)fwd_megakernel, 256, LDS_BYTES);
    if (per_cu > 1) per_cu = 1;
    if (per_cu < 1) per_cu = 1;
    grid_blocks = cus * per_cu;
  }
  hipMemsetAsync((char*)d_ws + WS_BAR, 0, 16384, stream);
  P p{};
  for (int i = 0; i < 40; ++i) p.in[i] = (const float*)d_in[i];
  p.out = (float*)d_out; p.ws = (char*)d_ws;
  void* args[] = {&p};
  hipError_t e = hipLaunchCooperativeKernel((const void*)fwd_megakernel, dim3(grid_blocks), dim3(256), args, LDS_BYTES, stream);
  if (e != hipSuccess) fprintf(stderr, "cooperative launch failed: %s (grid %d)\n", hipGetErrorString(e), grid_blocks);
}
```

```cpp
#include <hip/hip_runtime.h>
#include <hip/hip_cooperative_groups.h>
#include <cstdio>
#include <cstdint>
namespace cg = cooperative_groups;

typedef unsigned short bf16;
typedef __attribute__((ext_vector_type(8))) short bf16x8;
typedef __attribute__((ext_vector_type(4))) short bf16x4;
typedef __attribute__((ext_vector_type(4))) float f32x4;
typedef __attribute__((ext_vector_type(4))) unsigned u32x4;
typedef __attribute__((ext_vector_type(2))) unsigned u32x2;

#define DEVI __device__ __forceinline__

constexpr int Dm = 1024, FF = 2816, MT = 18432, MPR = 16384, NSS = 32, NCHUNK = 288, NPCH = 256;
constexpr size_t SLOT = (size_t)MT * 1024 * 2;
constexpr size_t WS_L1 = 8 * SLOT;
constexpr size_t WS_SM = WS_L1 + (size_t)MT * 256 * 2;
constexpr size_t WS_GAM = WS_SM + (size_t)MT * 16 * 4;
constexpr size_t WS_W = WS_GAM + (size_t)NCHUNK * 1024 * 4;
constexpr size_t W_FIN = 0, W_FOUT = 5767168, W_MIX = 8650752;
constexpr size_t WS_SINK = WS_W + (size_t)14200000 * 2 - 64;
constexpr size_t WS_BAR = WS_W + (size_t)14200000 * 2;
constexpr size_t WS_TOTAL = WS_BAR + 16384;
constexpr int LDS_BYTES = 77824;

constexpr size_t O_ASH_P = 18874368, O_AWKV_P = O_ASH_P + 2048, O_BKV_P = O_AWKV_P + 131072,
                 O_CCONV_P = O_BKV_P + 131072, O_CKV_P = O_CCONV_P + 9216, O_ASH_S = O_CKV_P + 131072,
                 O_AWKV_S = O_ASH_S + 65536, O_BKV_S = O_AWKV_S + 4194304, O_CCONV_S = O_BKV_S + 4194304,
                 O_CKV_S = O_CCONV_S + 294912;

struct P { const float* in[40]; float* out; char* ws; };
typedef const __attribute__((address_space(4))) char* kptr_t;
typedef const float* cfp_t; typedef float* fp_t; typedef char* cp_t;
DEVI kptr_t kbase() { kptr_t b = (kptr_t)__builtin_amdgcn_kernarg_segment_ptr(); asm volatile("" : "+s"(b)); return b; }
#define PIN(i) (*(const __attribute__((address_space(4))) cfp_t*)(kbase() + 8 * (i)))
#define POUT (*(const __attribute__((address_space(4))) fp_t*)(kbase() + 320))
#define PWS (*(const __attribute__((address_space(4))) cp_t*)(kbase() + 328))

typedef __attribute__((ext_vector_type(2))) float f32x2;
typedef __attribute__((ext_vector_type(2))) __bf16 bf16x2v;
DEVI unsigned pack2(float a, float b) { f32x2 v = {a, b}; bf16x2v r = __builtin_convertvector(v, bf16x2v); return __builtin_bit_cast(unsigned, r); }
DEVI bf16 f2bf(float f) { return (bf16)(pack2(f, 0.f) & 0xffffu); }
DEVI float bf2f(bf16 h) { return __uint_as_float(((unsigned)h) << 16); }
template <int CTRL> DEVI float dpp_mov(float v) { return __int_as_float(__builtin_amdgcn_mov_dpp(__float_as_int(v), CTRL, 0xF, 0xF, true)); }
DEVI float rsum4(float v) { v += dpp_mov<0xB1>(v); v += dpp_mov<0x4E>(v); return v; }
DEVI float rsum8(float v) { v = rsum4(v); v += dpp_mov<0x141>(v); return v; }
DEVI float rsum16(float v) { v = rsum8(v); v += dpp_mov<0x140>(v); return v; }
DEVI float wsum(float v) {
  v = rsum16(v);
  const int iv = __float_as_int(v);
  return (__int_as_float(__builtin_amdgcn_readlane(iv, 0)) + __int_as_float(__builtin_amdgcn_readlane(iv, 16))) +
         (__int_as_float(__builtin_amdgcn_readlane(iv, 32)) + __int_as_float(__builtin_amdgcn_readlane(iv, 48)));
}
DEVI float sigm(float x) { return 1.f / (1.f + __expf(-x)); }
DEVI float silu(float x) { return x * sigm(x); }
DEVI float softplus(float x) { return x > 20.f ? x : log1pf(__expf(x)); }
DEVI bf16* slot(const P& p, int i) { return (bf16*)(PWS + (size_t)i * SLOT); }

struct GemmDesc { const bf16* A; const bf16* A2; int lda; int ksplit; const bf16* Bt; int ldb; int tiles_m; int tiles_n; int K; };

template <class Epi>
DEVI void gemm_tile(const GemmDesc& g, int mt, int nt, Epi& epi, char* smem) {
  const int tid = threadIdx.x, lane = tid & 63, wave = tid >> 6;
  const int wm = wave >> 1, wn = wave & 1, lr = lane & 15, quad = lane >> 4;
  bf16* sA = (bf16*)smem;
  bf16* sB = sA + 2 * 8192;
  f32x4 acc[4][4];
#pragma unroll
  for (int i = 0; i < 4; ++i)
#pragma unroll
    for (int j = 0; j < 4; ++j) acc[i][j] = (f32x4){0.f, 0.f, 0.f, 0.f};
  const int m0 = mt * 128, n0 = nt * 128;
  const int r0 = tid >> 3, c0 = tid & 7;
  const size_t aoff = (size_t)(m0 + r0) * g.lda + c0 * 8;
  const bf16* bp = g.Bt + (size_t)(n0 + r0) * g.ldb + c0 * 8;
  const int soff = r0 * 64 + ((c0 ^ (r0 & 7)) << 3);
#define GL1(i_, RA, RB) RA##i_ = *(const u32x4*)(base_ + (size_t)(32 * i_) * g.lda); RB##i_ = *(const u32x4*)(bp + k0_ + (size_t)(32 * i_) * g.ldb);
#define GLOAD(kt_, RA, RB) do { const int k0_ = (kt_) << 6; \
    const bf16* base_ = ((k0_ < g.ksplit) ? (g.A + k0_) : (g.A2 + (k0_ - g.ksplit))) + aoff; \
    GL1(0, RA, RB) GL1(1, RA, RB) GL1(2, RA, RB) GL1(3, RA, RB) } while (0)
#define LS1(buf_, i_, RA, RB) *(u32x4*)(sA + (buf_) * 8192 + soff + i_ * 2048) = RA##i_; *(u32x4*)(sB + (buf_) * 8192 + soff + i_ * 2048) = RB##i_;
#define LSTORE(buf_, RA, RB) do { LS1(buf_, 0, RA, RB) LS1(buf_, 1, RA, RB) LS1(buf_, 2, RA, RB) LS1(buf_, 3, RA, RB) } while (0)
#define GSTEP(kt_, RA, RB) do { const int buf_ = (kt_) & 1; \
    if ((kt_) + 1 < nk) { LSTORE(buf_ ^ 1, RA, RB); if ((kt_) + 3 < nk) GLOAD((kt_) + 3, RA, RB); } \
    const bf16* a_ = sA + buf_ * 8192 + (wm * 64 + lr) * 64; const bf16* b_ = sB + buf_ * 8192 + (wn * 64 + lr) * 64; \
    _Pragma("unroll") for (int ks_ = 0; ks_ < 2; ++ks_) { \
      const int co_ = (((ks_ * 4 + quad) ^ (lr & 7)) << 3); bf16x8 af_[4], bf_[4]; \
      _Pragma("unroll") for (int i_ = 0; i_ < 4; ++i_) { af_[i_] = *(const bf16x8*)(a_ + i_ * 1024 + co_); bf_[i_] = *(const bf16x8*)(b_ + i_ * 1024 + co_); } \
      _Pragma("unroll") for (int i_ = 0; i_ < 4; ++i_) _Pragma("unroll") for (int j_ = 0; j_ < 4; ++j_) \
        acc[i_][j_] = __builtin_amdgcn_mfma_f32_16x16x32_bf16(af_[i_], bf_[j_], acc[i_][j_], 0, 0, 0); } \
    __syncthreads(); } while (0)
  const int nk = g.K >> 6;
  u32x4 pa0, pa1, pa2, pa3, pb0, pb1, pb2, pb3, qa0, qa1, qa2, qa3, qb0, qb1, qb2, qb3;
  qa0 = qa1 = qa2 = qa3 = qb0 = qb1 = qb2 = qb3 = (u32x4){0u, 0u, 0u, 0u};
  GLOAD(0, pa, pb);
  if (nk > 1) GLOAD(1, qa, qb);
  LSTORE(0, pa, pb);
  if (nk > 2) GLOAD(2, pa, pb);
  __syncthreads();
  for (int kt = 0; kt < nk; kt += 2) { GSTEP(kt, qa, qb); if (kt + 1 < nk) GSTEP(kt + 1, pa, pb); }
#pragma unroll
  for (int i = 0; i < 4; ++i) {
#pragma unroll
    for (int jj = 0; jj < 4; ++jj) {
      const int row = m0 + wm * 64 + i * 16 + quad * 4 + jj;
      if constexpr (Epi::PAIR) {
#pragma unroll
        for (int j = 0; j < 4; j += 2) {
          const int nn = n0 + wn * 64 + j * 16;
          epi.pair(row, (nn >> 5) * 16 + lr, acc[i][j][jj], acc[i][j + 1][jj]);
        }
      } else {
#pragma unroll
        for (int j = 0; j < 4; ++j) epi(row, n0 + wn * 64 + j * 16 + lr, acc[i][j][jj]);
      }
    }
  }
}

template <class Epi>
DEVI void gemm_job(const GemmDesc& g, Epi epi, int& tbase, char* smem) {
  const int ntiles = g.tiles_m * g.tiles_n, G = gridDim.x;
  const int first = tbase + (((int)blockIdx.x - tbase % G) + G) % G;
  const int width = 8 * g.tiles_n;
  for (int t = first; t < tbase + ntiles; t += G) {
    const int lt = t - tbase;
    const int grp = lt / width, rem = lt % width;
    gemm_tile(g, grp * 8 + (rem & 7), rem >> 3, epi, smem);
  }
  tbase += ntiles;
}

struct EpiStore { static constexpr bool PAIR = false; bf16* C; int ldc; float sc;
  DEVI void operator()(int r, int c, float v) { C[(size_t)r * ldc + c] = f2bf(v * sc); } };
struct EpiLora1 { static constexpr bool PAIR = false; bf16* C;
  DEVI void operator()(int r, int c, float v) { float o = c < 64 ? tanhf(v) : (c < 128 ? v : sigm(v)); C[(size_t)r * 256 + c] = f2bf(o); } };
struct EpiLd { static constexpr bool PAIR = false; bf16* C; const float* w0;
  DEVI void operator()(int r, int c, float v) { float x = w0[c] + v; float lr_ = -softplus(-x) - 0.5f; C[(size_t)r * 1024 + c] = f2bf(-__expf(lr_)); } };
struct EpiSig { static constexpr bool PAIR = false; bf16* C; const float* a0;
  DEVI void operator()(int r, int c, float v) { C[(size_t)r * 1024 + c] = f2bf(sigm(a0[c] + v)); } };
struct EpiAcc { static constexpr bool PAIR = false; float* X;
  DEVI void operator()(int r, int c, float v) { X[(size_t)r * 1024 + c] += v; } };
struct EpiSwiglu { static constexpr bool PAIR = true; bf16* C;
  DEVI void pair(int r, int c, float gt, float up) { C[(size_t)r * FF + c] = f2bf(silu(gt) * up); } };
struct EpiGlaIn { static constexpr bool PAIR = false; bf16 *q, *k, *v, *gate; float* sm;
  DEVI void operator()(int r, int c, float x) {
    if (c < 512) q[(size_t)r * 512 + c] = f2bf(x * 0.08838834764831845f);
    else if (c < 1024) k[(size_t)r * 512 + c - 512] = f2bf(x);
    else if (c < 2048) v[(size_t)r * 1024 + c - 1024] = f2bf(x);
    else if (c < 3072) gate[(size_t)r * 1024 + c - 2048] = f2bf(x);
    else if (c < 3088) sm[(size_t)r * 16 + c - 3072] = x;
  } };
struct EpiGdnIn { static constexpr bool PAIR = false; bf16 *qkv, *z; float* sm; float* out;
  DEVI void operator()(int r, int c, float x) {
    if (c < 3072) {
      qkv[(size_t)r * 3072 + c] = f2bf(x);
      if (r >= MPR - 3) {
        if (r < MPR) out[O_CCONV_P + (size_t)(r - (MPR - 3)) * 3072 + c] = x;
        else { int tt = (r - MPR) & 63; if (tt >= 61) out[O_CCONV_S + ((size_t)((r - MPR) >> 6) * 3 + (tt - 61)) * 3072 + c] = x; }
      }
    } else if (c < 4096) z[(size_t)r * 1024 + c - 3072] = f2bf(x);
    else if (c < 4112) sm[(size_t)r * 16 + c - 4096] = x;
  } };

template <class F>
DEVI void conv_job(F f, bf16* dst, int ldo, int Nd, int Kd, int& tbase, char* smem) {
  float* tile = (float*)smem;
  const int tn = Nd >> 6, tk = Kd >> 6, ntiles = tn * tk, G = gridDim.x, tid = threadIdx.x;
  const int first = tbase + (((int)blockIdx.x - tbase % G) + G) % G;
  for (int t = first; t < tbase + ntiles; t += G) {
    const int lt = t - tbase, n0 = (lt % tn) << 6, k0 = (lt / tn) << 6;
    const int i = tid >> 4, j4 = (tid & 15) << 2;
#pragma unroll
    for (int r = 0; r < 4; ++r) {
      float4 v = f(k0 + i + 16 * r, n0 + j4);
      float* d = tile + (i + 16 * r) * 65 + j4; d[0] = v.x; d[1] = v.y; d[2] = v.z; d[3] = v.w;
    }
    __syncthreads();
    const int jn = tid >> 2, iq = (tid & 3) << 4;
    unsigned w[8];
#pragma unroll
    for (int e = 0; e < 8; ++e) w[e] = pack2(tile[(iq + 2 * e) * 65 + jn], tile[(iq + 2 * e + 1) * 65 + jn]);
    uint4* o = (uint4*)(dst + (size_t)(n0 + jn) * ldo + k0 + iq);
    o[0] = make_uint4(w[0], w[1], w[2], w[3]); o[1] = make_uint4(w[4], w[5], w[6], w[7]);
    __syncthreads();
  }
  tbase += ntiles;
}
struct CvPlain { const float* W; int ld; int nsrc;
  DEVI float4 operator()(int k, int n) const { return n < nsrc ? *(const float4*)(W + (size_t)k * ld + n) : make_float4(0, 0, 0, 0); } };
struct CvFfnIn { const float* W;
  DEVI float4 operator()(int k, int n) const { int blk = n >> 5, w = n & 31; int src = (w < 16) ? blk * 16 + w : FF + blk * 16 + (w - 16);
    return *(const float4*)(W + (size_t)k * (2 * FF) + src); } };
struct CvLora1 { const float *w1, *a1, *g1, *mu;
  DEVI float4 operator()(int k, int n) const {
    int kk = k & 1023; float4 v; float m;
    if (n < 64) { v = *(const float4*)(w1 + kk * 64 + n); m = mu[1 * 1024 + kk]; }
    else if (n < 128) { v = *(const float4*)(a1 + kk * 64 + n - 64); m = mu[4 * 1024 + kk]; }
    else { v = *(const float4*)(g1 + kk * 128 + n - 128); m = mu[5 * 1024 + kk]; }
    float s = (k < 1024) ? (1.f - m) : m;
    return make_float4(v.x * s, v.y * s, v.z * s, v.w * s); } };
struct CvGlaIn { const float *win, *wa1;
  DEVI float4 operator()(int k, int n) const {
    if (n < 3072) return *(const float4*)(win + (size_t)k * 3072 + n);
    if (n < 3088) return *(const float4*)(wa1 + k * 16 + n - 3072);
    return make_float4(0, 0, 0, 0); } };

template <int TYPE>
DEVI void phase_norm(const P& p, int layer, int j, bool from_input, bool copy_x) {
  const int lane = threadIdx.x & 63, wave = threadIdx.x >> 6;
  const float* g = PIN(7) + layer * 1024;
  float* xres = POUT;
  bf16 *h = slot(p, 0), *hs = slot(p, 1), *xr = slot(p, 2), *xk = slot(p, 3), *xv = slot(p, 4);
  const float* mu = PIN(12) + (size_t)j * 6 * 1024;
  for (int row = blockIdx.x * 4 + wave; row < MT; row += gridDim.x * 4) {
    auto src = [&](int r) -> const float* {
      if (from_input) return r < MPR ? PIN(0) + (size_t)r * 1024 : PIN(1) + (size_t)(r - MPR) * 1024;
      return xres + (size_t)r * 1024; };
    const float* xp = src(row);
    float4 xv4[4]; float ss = 0.f;
#pragma unroll
    for (int i = 0; i < 4; ++i) { xv4[i] = *(const float4*)(xp + i * 256 + lane * 4); ss += xv4[i].x * xv4[i].x + xv4[i].y * xv4[i].y + xv4[i].z * xv4[i].z + xv4[i].w * xv4[i].w; }
    ss = wsum(ss);
    const float rstd = rsqrtf(ss * (1.f / 1024.f) + 1e-6f);
    if (copy_x) {
#pragma unroll
      for (int i = 0; i < 4; ++i) *(float4*)(xres + (size_t)row * 1024 + i * 256 + lane * 4) = xv4[i];
    }
    float hv[16];
#pragma unroll
    for (int i = 0; i < 4; ++i) { float4 gg = *(const float4*)(g + i * 256 + lane * 4);
      hv[i * 4 + 0] = xv4[i].x * rstd * gg.x; hv[i * 4 + 1] = xv4[i].y * rstd * gg.y; hv[i * 4 + 2] = xv4[i].z * rstd * gg.z; hv[i * 4 + 3] = xv4[i].w * rstd * gg.w; }
#pragma unroll
    for (int i = 0; i < 4; ++i) *(uint2*)(h + (size_t)row * 1024 + i * 256 + lane * 4) = make_uint2(pack2(hv[i * 4], hv[i * 4 + 1]), pack2(hv[i * 4 + 2], hv[i * 4 + 3]));
    if constexpr (TYPE == 0) {
      const bool is_p = row < MPR; const int tt = is_p ? row : ((row - MPR) & 63); const int b = is_p ? 0 : ((row - MPR) >> 6);
      float hp[16];
      if (tt == 0) {
        if (is_p) {
#pragma unroll
          for (int i = 0; i < 16; ++i) hp[i] = 0.f;
        } else {
          const float* sp = PIN(2) + ((size_t)j * NSS + b) * 1024;
#pragma unroll
          for (int i = 0; i < 4; ++i) { float4 v = *(const float4*)(sp + i * 256 + lane * 4); hp[i * 4] = v.x; hp[i * 4 + 1] = v.y; hp[i * 4 + 2] = v.z; hp[i * 4 + 3] = v.w; }
        }
      } else {
        const float* pp = src(row - 1); float4 pv[4]; float s2 = 0.f;
#pragma unroll
        for (int i = 0; i < 4; ++i) { pv[i] = *(const float4*)(pp + i * 256 + lane * 4); s2 += pv[i].x * pv[i].x + pv[i].y * pv[i].y + pv[i].z * pv[i].z + pv[i].w * pv[i].w; }
        s2 = wsum(s2); const float r2 = rsqrtf(s2 * (1.f / 1024.f) + 1e-6f);
#pragma unroll
        for (int i = 0; i < 4; ++i) { float4 gg = *(const float4*)(g + i * 256 + lane * 4);
          hp[i * 4] = pv[i].x * r2 * gg.x; hp[i * 4 + 1] = pv[i].y * r2 * gg.y; hp[i * 4 + 2] = pv[i].z * r2 * gg.z; hp[i * 4 + 3] = pv[i].w * r2 * gg.w; }
      }
#pragma unroll
      for (int i = 0; i < 4; ++i) {
        const int col = i * 256 + lane * 4; const size_t o = (size_t)row * 1024 + col;
        float4 m0 = *(const float4*)(mu + 0 * 1024 + col), m2 = *(const float4*)(mu + 2 * 1024 + col), m3 = *(const float4*)(mu + 3 * 1024 + col);
        const float mm0[4] = {m0.x, m0.y, m0.z, m0.w}, mm2[4] = {m2.x, m2.y, m2.z, m2.w}, mm3[4] = {m3.x, m3.y, m3.z, m3.w};
        float a[4], bb[4], c[4];
#pragma unroll
        for (int e = 0; e < 4; ++e) { float hh = hv[i * 4 + e], xx = hp[i * 4 + e] - hh; a[e] = hh + xx * mm0[e]; bb[e] = hh + xx * mm2[e]; c[e] = hh + xx * mm3[e]; }
        *(uint2*)(hs + o) = make_uint2(pack2(hp[i * 4], hp[i * 4 + 1]), pack2(hp[i * 4 + 2], hp[i * 4 + 3]));
        *(uint2*)(xr + o) = make_uint2(pack2(a[0], a[1]), pack2(a[2], a[3]));
        *(uint2*)(xk + o) = make_uint2(pack2(bb[0], bb[1]), pack2(bb[2], bb[3]));
        *(uint2*)(xv + o) = make_uint2(pack2(c[0], c[1]), pack2(c[2], c[3]));
      }
      if (is_p ? (row == MPR - 1) : (tt == 63)) {
        float* o = POUT + (is_p ? O_ASH_P + (size_t)j * 1024 : O_ASH_S + ((size_t)j * NSS + b) * 1024);
#pragma unroll
        for (int i = 0; i < 4; ++i) *(float4*)(o + i * 256 + lane * 4) = make_float4(hv[i * 4], hv[i * 4 + 1], hv[i * 4 + 2], hv[i * 4 + 3]);
      }
    }
  }
}

DEVI void phase_rms(const float* x, const float* g, bf16* dst, float* fdst) {
  const int lane = threadIdx.x & 63, wave = threadIdx.x >> 6;
  const int nw = gridDim.x * 4;
  for (int row = blockIdx.x * 4 + wave; row < MT; row += 2 * nw) {
    const int row2 = row + nw; const bool has2 = row2 < MT;
    float4 v[4], v2[4]; float ss = 0.f, ss2 = 0.f;
#pragma unroll
    for (int i = 0; i < 4; ++i) v[i] = *(const float4*)(x + (size_t)row * 1024 + i * 256 + lane * 4);
    if (has2) {
#pragma unroll
      for (int i = 0; i < 4; ++i) v2[i] = *(const float4*)(x + (size_t)row2 * 1024 + i * 256 + lane * 4);
    } else {
#pragma unroll
      for (int i = 0; i < 4; ++i) v2[i] = make_float4(0.f, 0.f, 0.f, 0.f);
    }
#pragma unroll
    for (int i = 0; i < 4; ++i) { ss += v[i].x * v[i].x + v[i].y * v[i].y + v[i].z * v[i].z + v[i].w * v[i].w; ss2 += v2[i].x * v2[i].x + v2[i].y * v2[i].y + v2[i].z * v2[i].z + v2[i].w * v2[i].w; }
    ss = wsum(ss); ss2 = wsum(ss2);
    const float r = rsqrtf(ss * (1.f / 1024.f) + 1e-6f), r2 = rsqrtf(ss2 * (1.f / 1024.f) + 1e-6f);
#pragma unroll
    for (int i = 0; i < 4; ++i) { float4 gg = *(const float4*)(g + i * 256 + lane * 4);
      { float a = v[i].x * r * gg.x, b = v[i].y * r * gg.y, c = v[i].z * r * gg.z, d = v[i].w * r * gg.w;
        if (dst) *(uint2*)(dst + (size_t)row * 1024 + i * 256 + lane * 4) = make_uint2(pack2(a, b), pack2(c, d));
        else *(float4*)(fdst + (size_t)row * 1024 + i * 256 + lane * 4) = make_float4(a, b, c, d); }
      if (has2) { float a = v2[i].x * r2 * gg.x, b = v2[i].y * r2 * gg.y, c = v2[i].z * r2 * gg.z, d = v2[i].w * r2 * gg.w;
        if (dst) *(uint2*)(dst + (size_t)row2 * 1024 + i * 256 + lane * 4) = make_uint2(pack2(a, b), pack2(c, d));
        else *(float4*)(fdst + (size_t)row2 * 1024 + i * 256 + lane * 4) = make_float4(a, b, c, d); }
    }
  }
}

DEVI void phase_gdn_conv(const P& p) {
  const bf16* qkv = slot(p, 1); const float* cw = PIN(35); const float* cst = PIN(5);
  const int tid = threadIdx.x;
  for (int item = blockIdx.x; item < (MT / 8) * 3; item += gridDim.x) {
    const int row0 = (item / 3) * 8, sec = item % 3, ch = sec * 1024 + tid * 4;
    const bool is_p = row0 < MPR; const int tt0 = is_p ? row0 : ((row0 - MPR) & 63); const int b = is_p ? 0 : ((row0 - MPR) >> 6);
    float x[11][4];
#pragma unroll
    for (int i = 0; i < 11; ++i) {
      const int pt = tt0 + i;
      if (pt >= 3) { uint2 u = *(const uint2*)(qkv + (size_t)(row0 + i - 3) * 3072 + ch);
        x[i][0] = bf2f(u.x & 0xffff); x[i][1] = bf2f(u.x >> 16); x[i][2] = bf2f(u.y & 0xffff); x[i][3] = bf2f(u.y >> 16); }
      else if (!is_p) { float4 s = *(const float4*)(cst + ((size_t)b * 3 + pt) * 3072 + ch); x[i][0] = s.x; x[i][1] = s.y; x[i][2] = s.z; x[i][3] = s.w; }
      else { x[i][0] = x[i][1] = x[i][2] = x[i][3] = 0.f; }
    }
    float w[4][4];
#pragma unroll
    for (int i = 0; i < 4; ++i) { float4 ww = *(const float4*)(cw + i * 3072 + ch); w[i][0] = ww.x; w[i][1] = ww.y; w[i][2] = ww.z; w[i][3] = ww.w; }
#pragma unroll
    for (int o = 0; o < 8; ++o) {
      float acc[4];
#pragma unroll
      for (int e = 0; e < 4; ++e) { acc[e] = x[o][e] * w[0][e] + x[o + 1][e] * w[1][e] + x[o + 2][e] * w[2][e] + x[o + 3][e] * w[3][e]; acc[e] = silu(acc[e]); }
      if (sec < 2) {
        float ss = acc[0] * acc[0] + acc[1] * acc[1] + acc[2] * acc[2] + acc[3] * acc[3];
#pragma unroll
        for (int once = 0; once < 1; ++once) { ss = rsum16(ss); ss += __shfl_xor(ss, 16); }
        const float r = rsqrtf(ss + 1e-6f) * (sec == 0 ? 0.08838834764831845f : 1.f);
#pragma unroll
        for (int e = 0; e < 4; ++e) acc[e] *= r;
      }
      *(uint2*)(slot(p, 5 + sec) + (size_t)(row0 + o) * 1024 + tid * 4) = make_uint2(pack2(acc[0], acc[1]), pack2(acc[2], acc[3]));
    }
  }
}

DEVI void mm_strip(const bf16* At, const bf16* Bt, f32x4 (&acc)[4], int wave, int lane) {
  const int lr = lane & 15, quad = lane >> 4;
#pragma unroll
  for (int ks = 0; ks < 2; ++ks) {
    bf16x8 a = *(const bf16x8*)(At + (wave * 16 + lr) * 72 + ks * 32 + quad * 8);
#pragma unroll
    for (int nb = 0; nb < 4; ++nb) {
      bf16x8 b = *(const bf16x8*)(Bt + (nb * 16 + lr) * 72 + ks * 32 + quad * 8);
      acc[nb] = __builtin_amdgcn_mfma_f32_16x16x32_bf16(a, b, acc[nb], 0, 0, 0);
    }
  }
}
DEVI void zero4(f32x4 (&a)[4]) {
#pragma unroll
  for (int i = 0; i < 4; ++i) a[i] = (f32x4){0.f, 0.f, 0.f, 0.f};
}

DEVI int perm32(int x) { return (x & ~31) | (((x >> 2) & 3) << 3) | (((x >> 4) & 1) << 2) | (x & 3); }
template <int CW> DEVI size_t cont_off(int r, int s, int LD) { const int idx = r * 64 + s; return (size_t)(idx / CW) * LD + (idx % CW); }

template <int TYPE>
DEVI void phase_prep(const P& p, int j, char* smem) {
  constexpr int NH = TYPE == 0 ? 16 : (TYPE == 1 ? 4 : 8);
  constexpr int DK = TYPE == 0 ? 64 : 128;
  constexpr int DV = TYPE == 0 ? 64 : (TYPE == 1 ? 256 : 128);
  constexpr bool LOW = TYPE != 1;
  constexpr int KT = 256 / DK, TPT = 64 / KT, DKH = DK / 64, DVH = DV / 64;
  constexpr int LDQ = TYPE == 1 ? 512 : 1024;
  bf16* X0 = (bf16*)smem; bf16* X1 = X0 + 4608; bf16* Y0 = X1 + 4608; bf16* Y1 = Y0 + 4608;
  float* Lb = (float*)smem;
  bf16* LkT = (bf16*)(smem + 16384); bf16* Ak = LkT + 4608; bf16* nAb = Ak + 4608;
  bf16* M1 = (bf16*)smem;
  bf16* Tt = (bf16*)(smem + 44032); bf16* St1 = Tt + 4608; bf16* St2 = St1 + 4608;
  if (TYPE == 1) { Y0 = (bf16*)(smem + 9216); Ak = (bf16*)(smem + 18432); St1 = (bf16*)(smem + 27648); }
  float* lgL = (float*)(smem + 36864);
  float* tot = (float*)(smem + 71680);
  float* sc_beta = (float*)(smem + 73728);
  float* sc_eg = sc_beta + 64; float* sc_lg = sc_eg + 64; float* sc_g = sc_lg + 64;

  bf16 *Aq, *Akk, *Av, *Ald = nullptr, *Aa = nullptr, *Oq, *Okt, *Ovt, *Ow = nullptr, *Obt = nullptr, *Ool, *Ou0 = nullptr;
  if (TYPE == 0) { Aq = slot(p, 5); Akk = slot(p, 6); Av = slot(p, 7); Ald = slot(p, 2); Aa = slot(p, 3);
    Oq = Aq; Okt = Akk; Ovt = Av; Ow = Ald; Obt = Aa; Ool = slot(p, 0); Ou0 = slot(p, 1); }
  else if (TYPE == 1) { Aq = slot(p, 1); Akk = slot(p, 1) + (size_t)MT * 512; Av = slot(p, 2); Oq = Aq; Okt = Akk; Ovt = Av; Ool = slot(p, 4); }
  else { Aq = slot(p, 5); Akk = slot(p, 6); Av = slot(p, 7); Oq = Aq; Okt = Akk; Ovt = Av; Ow = slot(p, 1); Obt = slot(p, 2); Ool = slot(p, 3); Ou0 = slot(p, 0); }
  float* sm = (float*)(PWS + WS_SM);
  float* gam = (float*)(PWS + WS_GAM);

  for (int item = blockIdx.x; item < NCHUNK * NH; item += gridDim.x) {
    const int c = item / NH, h = item % NH;
    const size_t rb = (size_t)c * 64;
    int tid = threadIdx.x; asm volatile("" : "+v"(tid));
    const int lane = tid & 63, wave = tid >> 6, lr = lane & 15, quad = lane >> 4;
    const int k = tid % DK, tg = tid / DK;
    const int vv = tid & 63, tgv = tid >> 6;
    unsigned qP[TPT / 2], ktP[TPT / 2], kapP[(TYPE == 0) ? TPT / 2 : 1], bvP[(TYPE == 0) ? TPT / 2 : 1];
    float lg[(TYPE == 0) ? TPT : 1], ldv[(TYPE == 0) ? TPT : 1];
    unsigned vP[DVH][8];
    auto lo16 = [](unsigned w) { return __uint_as_float(w << 16); };
    auto hi16 = [](unsigned w) { return __uint_as_float(w & 0xffff0000u); };
#define GETP(arr, e) (((e) & 1) ? hi16(arr[(e) >> 1]) : lo16(arr[(e) >> 1]))
#pragma unroll
    for (int vh = 0; vh < DVH; ++vh) {
      bf16 va[16];
#pragma unroll
      for (int e = 0; e < 16; ++e) va[e] = Av[(rb + tgv * 16 + e) * 1024 + h * DV + vh * 64 + vv];
#pragma unroll
      for (int e = 0; e < 8; ++e) { vP[vh][e] = (unsigned)va[2 * e] | ((unsigned)va[2 * e + 1] << 16); asm volatile("" : "+v"(vP[vh][e])); }
    }
    if constexpr (TYPE == 2) {
      if (tid < 64) {
        const float a_log = PIN(36)[h], dtb = PIN(37)[h];
        const float braw = sm[(rb + tid) * 16 + h], araw = sm[(rb + tid) * 16 + 8 + h];
        const float gt = -__expf(a_log) * softplus(araw + dtb);
        sc_beta[tid] = sigm(braw); sc_eg[tid] = __expf(gt); sc_g[tid] = gt;
        float cs = gt;
#pragma unroll
        for (int o = 1; o < 64; o <<= 1) { float n = __shfl_up(cs, o); if (lane >= o) cs += n; }
        sc_lg[tid] = cs;
      }
      __syncthreads();
    }
    if constexpr (TYPE == 0) {
      const float k_k = PIN(21)[j * 1024 + h * 64 + k], k_a = PIN(22)[j * 1024 + h * 64 + k], r_k = PIN(23)[j * 1024 + h * 64 + k];
      float run = 0.f;
      bf16 rr[TPT], rk[TPT], ra[TPT], rl[TPT];
#pragma unroll
      for (int e = 0; e < TPT; ++e) {
        const size_t o = (rb + tg * TPT + e) * 1024 + h * 64 + k;
        rr[e] = Aq[o]; rk[e] = Akk[o]; ra[e] = Aa[o]; rl[e] = Ald[o];
      }
#pragma unroll
      for (int e2 = 0; e2 < TPT / 2; ++e2) {
        float qq[2], ka[2], kq[2], bq[2];
#pragma unroll
        for (int u = 0; u < 2; ++u) {
          const int e = e2 * 2 + u;
          const float r = bf2f(rr[e]), kr = bf2f(rk[e]), av = bf2f(ra[e]), l = bf2f(rl[e]);
          const float kk = kr * k_k;
          const float inv = rsqrtf(fmaxf(wsum(kk * kk), 1e-24f));
          qq[u] = r; ka[u] = kk * inv; kq[u] = kr * (1.f + (av - 1.f) * k_a); bq[u] = ka[u] * av; ldv[e] = l;
          const float bo = wsum(r * kq[u] * r_k);
          if (lane == 0) sm[(rb + tg * TPT + e) * 16 + h] = bo;
          run += l; lg[e] = run;
        }
        qP[e2] = pack2(qq[0], qq[1]); kapP[e2] = pack2(ka[0], ka[1]); ktP[e2] = pack2(kq[0], kq[1]); bvP[e2] = pack2(bq[0], bq[1]);
        asm volatile("" : "+v"(qP[e2]), "+v"(kapP[e2]), "+v"(ktP[e2]), "+v"(bvP[e2]));
      }
      tot[tg * 128 + k] = run;
    } else if constexpr (TYPE == 1) {
      float w2[16];
#pragma unroll
      for (int i = 0; i < 16; ++i) w2[i] = PIN(30)[i * 512 + h * 128 + k];
      const float ba = PIN(31)[h * 128 + k];
      bf16 rq[TPT], rk[TPT];
#pragma unroll
      for (int e = 0; e < TPT; ++e) { const size_t row = rb + tg * TPT + e; rq[e] = Aq[row * 512 + h * 128 + k]; rk[e] = Akk[row * 512 + h * 128 + k]; }
      float4 ar[TPT][4];
      float run = 0.f;
#pragma unroll
      for (int e = 0; e < TPT; e += 4) {
#pragma unroll
        for (int u = 0; u < 4; ++u)
#pragma unroll
          for (int q4 = 0; q4 < 4; ++q4) ar[e + u][q4] = *(const float4*)(sm + (rb + tg * TPT + e + u) * 16 + q4 * 4);
#pragma unroll
        for (int u = 0; u < 4; ++u) {
          float s = ba;
#pragma unroll
          for (int q4 = 0; q4 < 4; ++q4) { const float4 a4 = ar[e + u][q4]; s += a4.x * w2[q4 * 4] + a4.y * w2[q4 * 4 + 1] + a4.z * w2[q4 * 4 + 2] + a4.w * w2[q4 * 4 + 3]; }
          const float gk = (fminf(s, 0.f) - log1pf(__expf(-fabsf(s)))) * (1.f / 16.f);
          run += gk; lgL[(tg * TPT + e + u) * 128 + k] = run;
        }
      }
#pragma unroll
      for (int e2 = 0; e2 < TPT / 2; ++e2) {
        qP[e2] = (unsigned)rq[2 * e2] | ((unsigned)rq[2 * e2 + 1] << 16);
        ktP[e2] = (unsigned)rk[2 * e2] | ((unsigned)rk[2 * e2 + 1] << 16);
        asm volatile("" : "+v"(qP[e2]), "+v"(ktP[e2]));
      }
      tot[tg * 128 + k] = run;
    } else {
      bf16 rq[TPT], rk[TPT];
#pragma unroll
      for (int e = 0; e < TPT; ++e) { const size_t o = (rb + tg * TPT + e) * 1024 + h * 128 + k; rq[e] = Aq[o]; rk[e] = Akk[o]; }
#pragma unroll
      for (int e2 = 0; e2 < TPT / 2; ++e2) {
        qP[e2] = (unsigned)rq[2 * e2] | ((unsigned)rq[2 * e2 + 1] << 16);
        ktP[e2] = (unsigned)rk[2 * e2] | ((unsigned)rk[2 * e2 + 1] << 16);
        asm volatile("" : "+v"(qP[e2]), "+v"(ktP[e2]));
      }
    }
    __syncthreads();
    float lgC;
    if constexpr (TYPE == 2) { lgC = sc_lg[63]; }
    else {
      float off = 0.f, all = 0.f;
#pragma unroll
      for (int g2 = 0; g2 < KT; ++g2) { const float tv = tot[g2 * 128 + k]; all += tv; if (g2 < tg) off += tv; }
      if constexpr (TYPE == 0) {
#pragma unroll
        for (int e = 0; e < TPT; ++e) lg[e] += off;
      } else {
#pragma unroll
        for (int e = 0; e < TPT; ++e) lgL[(tg * TPT + e) * 128 + k] += off;
      }
      lgC = all;
    }
#define QV(e) GETP(qP, e)
#define LGV(e, t) ((TYPE == 2) ? sc_lg[t] : ((TYPE == 1) ? lgL[(t) * 128 + k] : lg[(TYPE == 0) ? (e) : 0]))
#define LPREV(e, t) ((TYPE == 0) ? (lg[(TYPE == 0) ? (e) : 0] - ldv[(TYPE == 0) ? (e) : 0]) : (sc_lg[t] - sc_g[t]))
#define KTV(e, t) ((TYPE == 2) ? (sc_beta[t] * GETP(ktP, e)) : GETP(ktP, e))
#define KAPV(e, t) ((TYPE == 2) ? GETP(ktP, e) : GETP(kapP, (TYPE == 0) ? (e) : 0))
#define BVV(e, t) ((TYPE == 2) ? (sc_beta[t] * sc_eg[t] * GETP(ktP, e)) : GETP(bvP, (TYPE == 0) ? (e) : 0))
    f32x4 sacc[LOW ? 4 : 1][4];
#pragma unroll
    for (int a = 0; a < (LOW ? 4 : 1); ++a) zero4(sacc[a]);
#pragma unroll
    for (int kh = 0; kh < DKH; ++kh) {
      if (k / 64 == kh) {
        const int kk = k & 63;
#pragma unroll
        for (int e = 0; e < TPT; ++e) {
          const int t = tg * TPT + e;
          if constexpr (TYPE == 2) {
            X0[t * 72 + kk] = f2bf(QV(e)); Y0[t * 72 + kk] = f2bf(KTV(e, t));
            X1[t * 72 + kk] = f2bf(KAPV(e, t)); Y1[t * 72 + kk] = f2bf(BVV(e, t));
          } else {
            const float lgt = LGV(e, t);
            const float el = __expf(lgt), eml = __expf(-lgt);
            X0[t * 72 + kk] = f2bf(QV(e) * el);
            Y0[t * 72 + kk] = f2bf(KTV(e, t) * eml);
            if constexpr (LOW) {
              X1[t * 72 + kk] = f2bf(KAPV(e, t) * __expf(LPREV(e, t)));
              Y1[t * 72 + kk] = f2bf(BVV(e, t) * eml);
            }
          }
        }
      }
      __syncthreads();
      mm_strip(X0, Y0, sacc[0], wave, lane);
      if constexpr (LOW) { mm_strip(X0, Y1, sacc[1], wave, lane); mm_strip(X1, Y0, sacc[2], wave, lane); mm_strip(X1, Y1, sacc[3], wave, lane); }
      __syncthreads();
    }
#pragma unroll
    for (int nb = 0; nb < 4; ++nb)
#pragma unroll
      for (int jj = 0; jj < 4; ++jj) {
        const int t = wave * 16 + quad * 4 + jj, s = nb * 16 + lr;
        float da = 1.f, dl = 1.f;
        if constexpr (TYPE == 2) { const float dd = sc_lg[t] - sc_lg[s]; da = __expf(fminf(dd, 0.f)); dl = __expf(fminf(dd - sc_g[t], 0.f)); }
        Ak[t * 72 + s] = f2bf(s <= t ? sacc[0][nb][jj] * da : 0.f);
        if constexpr (LOW) {
          nAb[t * 72 + s] = f2bf(s <= t ? -sacc[1][nb][jj] * da : 0.f);
          LkT[s * 72 + t] = f2bf(s < t ? sacc[2][nb][jj] * dl : 0.f);
          Lb[t * 64 + (s & 3) * 16 + (s >> 2)] = s < t ? sacc[3][nb][jj] * dl : 0.f;
        }
      }
    __syncthreads();
    f32x4 acc[4];
    if constexpr (LOW) {
      {
        const int q = lane & 3, jc = wave * 16 + (lane >> 2);
        float xr[16];
#pragma unroll
        for (int i = 0; i < 16; ++i) xr[i] = 0.f;
#pragma unroll
        for (int t = 0; t < 64; ++t) {
          float s = 0.f, s2 = 0.f;
          const float* Lr = Lb + t * 64 + q * 16;
#pragma unroll
          for (int i = 0; i < (t + 3) / 4; ++i) { if (i & 1) s2 += Lr[i] * xr[i]; else s += Lr[i] * xr[i]; }
          s += s2;
          s = rsum4(s);
          s = ((t == jc) ? 1.f : 0.f) - s;
          xr[t >> 2] = (q == (t & 3)) ? s : xr[t >> 2];
          if (q == 0) Tt[t * 72 + jc] = f2bf(s);
        }
      }
      __syncthreads();
      zero4(acc); mm_strip(Tt, LkT, acc, wave, lane);
#pragma unroll
      for (int nb = 0; nb < 4; ++nb)
#pragma unroll
        for (int jj = 0; jj < 4; ++jj) M1[(wave * 16 + quad * 4 + jj) * 72 + nb * 16 + lr] = f2bf(acc[nb][jj]);
      __syncthreads();
    }
#pragma unroll
    for (int vh = 0; vh < DVH; ++vh) {
#pragma unroll
      for (int e = 0; e < 8; ++e) *(unsigned*)(St1 + vv * 72 + tgv * 16 + 2 * e) = vP[vh][e];
      __syncthreads();
      if constexpr (LOW) {
        zero4(acc); mm_strip(M1, St1, acc, wave, lane);
#pragma unroll
        for (int nb = 0; nb < 4; ++nb)
#pragma unroll
          for (int jj = 0; jj < 4; ++jj) {
            const int t = wave * 16 + quad * 4 + jj, col = nb * 16 + lr; const bf16 u = f2bf(acc[nb][jj]);
            St2[col * 72 + t] = u;
          }
#pragma unroll
        for (int nb = 0; nb < 4; ++nb)
          *(uint2*)(Ou0 + (((((size_t)c * NH + h) * (DV / 16) + vh * 4 + nb) * 4 + wave) * 64 + lane) * 4) = make_uint2(pack2(acc[nb][0], acc[nb][1]), pack2(acc[nb][2], acc[nb][3]));
        __syncthreads();
      }
      zero4(acc); mm_strip(Ak, St1, acc, wave, lane);
      if constexpr (LOW) mm_strip(nAb, St2, acc, wave, lane);
#pragma unroll
      for (int nb = 0; nb < 4; ++nb)
        *(uint2*)(Ool + (((((size_t)c * NH + h) * (DV / 16) + vh * 4 + nb) * 4 + wave) * 64 + lane) * 4) = make_uint2(pack2(acc[nb][0], acc[nb][1]), pack2(acc[nb][2], acc[nb][3]));
      __syncthreads();
    }
    if constexpr (LOW) {
#pragma unroll
      for (int kh = 0; kh < DKH; ++kh) {
        if (k / 64 == kh) {
          const int kk = k & 63;
#pragma unroll
          for (int e = 0; e < TPT; ++e) {
            const int t = tg * TPT + e;
            St1[kk * 72 + t] = f2bf(KAPV(e, t) * __expf(LPREV(e, t)));
            LkT[t * 72 + kk] = f2bf(QV(e) * __expf(LGV(e, t)));
            }
        }
        __syncthreads();
        zero4(acc); mm_strip(Tt, St1, acc, wave, lane);
#pragma unroll
        for (int nb = 0; nb < 4; ++nb)
#pragma unroll
          for (int jj = 0; jj < 4; ++jj) {
            const int t = wave * 16 + quad * 4 + jj, col = nb * 16 + lr; const bf16 u = f2bf(acc[nb][jj]);
            St2[col * 72 + t] = u;
            Ow[(rb + t) * 1024 + h * DK + perm32(kh * 64 + col)] = u;
          }
        __syncthreads();
        zero4(acc); mm_strip(nAb, St2, acc, wave, lane);
#pragma unroll
        for (int nb = 0; nb < 4; ++nb)
#pragma unroll
          for (int jj = 0; jj < 4; ++jj) {
            const int t = wave * 16 + quad * 4 + jj, col = nb * 16 + lr;
            Oq[(rb + t) * LDQ + h * DK + perm32(kh * 64 + col)] = f2bf(acc[nb][jj] + bf2f(LkT[t * 72 + col]));
          }
        __syncthreads();
      }
    } else {
#pragma unroll
      for (int e = 0; e < TPT; ++e) { Oq[(rb + tg * TPT + e) * LDQ + h * DK + perm32(k)] = f2bf(QV(e) * __expf(LGV(e, tg * TPT + e))); }
    }
    {
      unsigned wk[TPT / 2], wb[LOW ? TPT / 2 : 1];
#pragma unroll
      for (int e = 0; e < TPT; e += 2) {
        const int t0 = tg * TPT + e;
        const float d0 = __expf(lgC - LGV(e, t0)), d1 = __expf(lgC - LGV(e + 1, t0 + 1));
        wk[e / 2] = pack2(KTV(e, t0) * d0, KTV(e + 1, t0 + 1) * d1);
        if constexpr (LOW) wb[e / 2] = pack2(BVV(e, t0) * d0, BVV(e + 1, t0 + 1) * d1);
      }
      const size_t co = rb * LDQ + h * DK + cont_off<DK>(k, tg * TPT, LDQ);
#pragma unroll
      for (int e = 0; e < TPT / 8; ++e) {
        *(uint4*)(Okt + co + e * 8) = make_uint4(wk[e * 4], wk[e * 4 + 1], wk[e * 4 + 2], wk[e * 4 + 3]);
        if constexpr (LOW) {
#pragma unroll
          for (int g4 = 0; g4 < 2; ++g4) {
            const int s0 = tg * TPT + e * 8 + g4 * 4;
            *(uint2*)(Obt + rb * 1024 + h * DK + cont_off<DK>(k, perm32(s0), 1024)) = make_uint2(wb[e * 4 + g4 * 2], wb[e * 4 + g4 * 2 + 1]);
          }
        }
      }
#pragma unroll
      for (int vh = 0; vh < DVH; ++vh) {
        const unsigned* wv = vP[vh];
        const size_t vo = rb * 1024 + h * DV + cont_off<DV>(vh * 64 + vv, tgv * 16, 1024);
        *(uint4*)(Ovt + vo) = make_uint4(wv[0], wv[1], wv[2], wv[3]);
        *(uint4*)(Ovt + vo + 8) = make_uint4(wv[4], wv[5], wv[6], wv[7]);
      }
      if (tg == 0) gam[((size_t)c * NH + h) * DK + k] = __expf(lgC);
    }
    __syncthreads();
  }
}

template <int TYPE>
DEVI void phase_seq2(const P& p, int j, char* smem) {
  constexpr int NH = TYPE == 0 ? 16 : (TYPE == 1 ? 4 : 8);
  constexpr int DK = TYPE == 0 ? 64 : 128;
  constexpr int DV = TYPE == 0 ? 64 : (TYPE == 1 ? 256 : 128);
  constexpr bool LOW = TYPE != 1;
  constexpr int NVB = DV / 16, MB = DK / 16, KS = DK / 32, NG = NVB / 4, BIPS = NH * NG;
  constexpr int LDQ = TYPE == 1 ? 512 : 1024;
  constexpr int NOP = LOW ? 4 : 2, RS = DK + 8, OPSZ = 64 * RS, PPR = DK / 8;
  constexpr int PPO = 64 * PPR / 256;
  constexpr int PF = 4;
  bf16* L = (bf16*)smem;
  const int tid = threadIdx.x, lane = tid & 63, wave = tid >> 6, lr = lane & 15, quad = lane >> 4;
  const bf16 *Qp, *Kt, *Vt, *Wp = nullptr, *Bt = nullptr, *U0 = nullptr; bf16* Ol;
  if (TYPE == 0) { Qp = slot(p, 5); Kt = slot(p, 6); Vt = slot(p, 7); Wp = slot(p, 2); Bt = slot(p, 3); Ol = slot(p, 0); U0 = slot(p, 1); }
  else if (TYPE == 1) { Qp = slot(p, 1); Kt = slot(p, 1) + (size_t)MT * 512; Vt = slot(p, 2); Ol = slot(p, 4); }
  else { Qp = slot(p, 5); Kt = slot(p, 6); Vt = slot(p, 7); Wp = slot(p, 1); Bt = slot(p, 2); Ol = slot(p, 3); U0 = slot(p, 0); }
  const float* gam = (const float*)(PWS + WS_GAM);
  unsigned tsink = 0;
  const bool split = (int)gridDim.x > 2 * BIPS;
  const int bstart = !split ? (int)blockIdx.x : ((int)blockIdx.x < BIPS ? (int)blockIdx.x : BIPS + ((int)blockIdx.x - BIPS));
  const int bstep = !split ? (int)gridDim.x : ((int)blockIdx.x < BIPS ? (1 << 30) : ((int)gridDim.x - BIPS));
  for (int bitem = bstart; bitem < 33 * BIPS; bitem += bstep) {
    const int seq = bitem / BIPS, rem = bitem % BIPS, h = rem / NG, vb = (rem % NG) * 4 + wave;
    const int c0 = seq == 0 ? 0 : NPCH + seq - 1, nc = seq == 0 ? NPCH : 1;
    const int vcol = vb * 16 + lr;
    f32x4 H[MB];
    if (seq == 0) {
#pragma unroll
      for (int m = 0; m < MB; ++m) H[m] = (f32x4){0.f, 0.f, 0.f, 0.f};
    } else {
      const int b = seq - 1;
      if (TYPE == 0) {
        const float* S = PIN(3) + (((size_t)j * NSS + b) * 16 + h) * 4096 + (size_t)vcol * 64;
#pragma unroll
        for (int m = 0; m < MB; ++m) { float4 v = *(const float4*)(S + m * 16 + quad * 4); H[m] = (f32x4){v.x, v.y, v.z, v.w}; }
      } else {
        const float* S = PIN(TYPE == 1 ? 4 : 6) + ((size_t)b * NH + h) * DK * DV + vcol;
#pragma unroll
        for (int m = 0; m < MB; ++m)
#pragma unroll
          for (int jj = 0; jj < 4; ++jj) H[m][jj] = S[(size_t)(m * 16 + quad * 4 + jj) * DV];
      }
    }
    u32x4 preA[NOP * PPO], preB[NOP * PPO]; u32x2 poA[4], poB[4], puA[4], puB[4]; bf16x8 pvA[2], pvB[2]; f32x4 pgA[MB], pgB[MB];
    auto issue_sh = [&](int cc, u32x4 (&pre)[NOP * PPO]) {
      const size_t rb_ = (size_t)cc * 64; int tl_ = threadIdx.x; asm volatile("" : "+v"(tl_));
#pragma unroll
      for (int i_ = 0; i_ < PPO; ++i_) { const int w_ = tl_ + 256 * i_; const size_t r_ = rb_ + w_ / PPR; const int c8_ = (w_ % PPR) * 8;
        pre[0 * PPO + i_] = *(const u32x4*)(Qp + r_ * LDQ + h * DK + c8_);
        pre[1 * PPO + i_] = *(const u32x4*)(Kt + r_ * LDQ + h * DK + c8_);
        if constexpr (LOW) { pre[2 * PPO + i_] = *(const u32x4*)(Wp + r_ * 1024 + h * DK + c8_); pre[3 * PPO + i_] = *(const u32x4*)(Bt + r_ * 1024 + h * DK + c8_); } }
    };
    auto issue_pr = [&](int cc, u32x2 (&p_o)[4], u32x2 (&p_u)[4], bf16x8 (&p_v)[2], f32x4 (&p_g)[MB]) {
      const size_t rb_ = (size_t)cc * 64; int tl_ = threadIdx.x; asm volatile("" : "+v"(tl_));
      const int lane = tl_ & 63, lr = lane & 15, quad = lane >> 4, vcol = vb * 16 + lr;
      const size_t fo_ = ((((size_t)cc * NH + h) * NVB + vb) * 4) * 256 + lane * 4;
#pragma unroll
      for (int tb_ = 0; tb_ < 4; ++tb_) { p_o[tb_] = *(const u32x2*)(Ol + fo_ + tb_ * 256); if constexpr (LOW) p_u[tb_] = *(const u32x2*)(U0 + fo_ + tb_ * 256); }
#pragma unroll
      for (int ks_ = 0; ks_ < 2; ++ks_) p_v[ks_] = *(const bf16x8*)(Vt + rb_ * 1024 + h * DV + cont_off<DV>(vcol, ks_ * 32 + quad * 8, 1024));
#pragma unroll
      for (int m_ = 0; m_ < MB; ++m_) p_g[m_] = *(const f32x4*)(gam + ((size_t)cc * NH + h) * DK + m_ * 16 + quad * 4);
    };
    const int cend = c0 + nc;
    auto step = [&](int c, u32x4 (&pre)[NOP * PPO], u32x2 (&p_o)[4], u32x2 (&p_u)[4], bf16x8 (&p_v)[2], f32x4 (&p_g)[MB]) {
#pragma unroll
      for (int o = 0; o < NOP; ++o)
#pragma unroll
        for (int i = 0; i < PPO; ++i) { const int w = tid + 256 * i; *(u32x4*)(L + o * OPSZ + (w / PPR) * RS + (w % PPR) * 8) = pre[o * PPO + i]; }
      __syncthreads();
      if (c + 2 < cend) issue_sh(c + 2, pre);
      unsigned tv[NOP * DK / 128 + 1];
#pragma unroll
      for (int i = 0; i < NOP * DK / 128 + 1; ++i) tv[i] = 0;
      if (false && c + PF < cend) {
        const size_t rb2 = (size_t)(c + PF) * 64;
        if (DK == 128 || tid < 128) {
          const int li = (DK == 128) ? tid : tid; const size_t ro = li / (DK / 64) % 64; const int co = (li % (DK / 64)) * 64;
          const int half = (DK == 128) ? (tid >> 7) : (tid >> 6);
          if (half == 0) { tv[0] = *(const unsigned*)(Qp + (rb2 + ro) * LDQ + h * DK + co); if constexpr (LOW) tv[1] = *(const unsigned*)(Wp + (rb2 + ro) * 1024 + h * DK + co); }
          else { tv[0] = *(const unsigned*)(Kt + (rb2 + ro) * LDQ + h * DK + co); if constexpr (LOW) tv[1] = *(const unsigned*)(Bt + (rb2 + ro) * 1024 + h * DK + co); }
        }
        {
          const size_t fo2 = ((((size_t)(c + PF) * NH + h) * NVB + vb) * 4) * 256;
          const unsigned* tp;
          if (lane < 16) tp = (const unsigned*)(Ol + fo2 + lane * 64);
          else if (LOW && lane < 32) tp = (const unsigned*)(U0 + fo2 + (lane - 16) * 64);
          else if (lane < 48) tp = (const unsigned*)(Vt + rb2 * 1024 + h * DV + cont_off<DV>(vb * 16 + (lane & 15), 0, 1024));
          else tp = (const unsigned*)(gam + ((size_t)(c + PF) * NH + h) * DK + ((lane - 48) & (DK / 32 - 1)) * 32);
          tv[NOP * DK / 128] = *tp;
        }
      }
      bf16x8 hb[KS];
#pragma unroll
      for (int ks = 0; ks < KS; ++ks) {
        const u32x4 hw = {pack2(H[2 * ks][0], H[2 * ks][1]), pack2(H[2 * ks][2], H[2 * ks][3]), pack2(H[2 * ks + 1][0], H[2 * ks + 1][1]), pack2(H[2 * ks + 1][2], H[2 * ks + 1][3])};
        hb[ks] = __builtin_bit_cast(bf16x8, hw);
      }
      const size_t fo = ((((size_t)c * NH + h) * NVB + vb) * 4) * 256 + lane * 4;
      f32x4 U[4];
#pragma unroll
      for (int tb = 0; tb < 4; ++tb) {
        f32x4 o_ = (f32x4){bf2f(p_o[tb].x & 0xffff), bf2f(p_o[tb].x >> 16), bf2f(p_o[tb].y & 0xffff), bf2f(p_o[tb].y >> 16)}, u_;
        if constexpr (LOW) u_ = (f32x4){bf2f(p_u[tb].x & 0xffff), bf2f(p_u[tb].x >> 16), bf2f(p_u[tb].y & 0xffff), bf2f(p_u[tb].y >> 16)};
#pragma unroll
        for (int ks = 0; ks < KS; ++ks) {
          o_ = __builtin_amdgcn_mfma_f32_16x16x32_bf16(*(const bf16x8*)(L + 0 * OPSZ + (tb * 16 + lr) * RS + ks * 32 + quad * 8), hb[ks], o_, 0, 0, 0);
          if constexpr (LOW) u_ = __builtin_amdgcn_mfma_f32_16x16x32_bf16(*(const bf16x8*)(L + 2 * OPSZ + (tb * 16 + lr) * RS + ks * 32 + quad * 8), hb[ks], u_, 0, 0, 0);
        }
        *(u32x2*)(Ol + fo + tb * 256) = (u32x2){pack2(o_[0], o_[1]), pack2(o_[2], o_[3])};
        if constexpr (LOW) U[tb] = u_;
      }
      bf16x8 ubop[2];
      if constexpr (LOW) {
#pragma unroll
        for (int ks = 0; ks < 2; ++ks) {
          const u32x4 uw = {pack2(-U[2 * ks][0], -U[2 * ks][1]), pack2(-U[2 * ks][2], -U[2 * ks][3]), pack2(-U[2 * ks + 1][0], -U[2 * ks + 1][1]), pack2(-U[2 * ks + 1][2], -U[2 * ks + 1][3])};
          ubop[ks] = __builtin_bit_cast(bf16x8, uw);
        }
      }
#pragma unroll
      for (int m = 0; m < MB; ++m) {
        f32x4 hn = (f32x4){H[m][0] * p_g[m][0], H[m][1] * p_g[m][1], H[m][2] * p_g[m][2], H[m][3] * p_g[m][3]};
        const int krow = m * 16 + lr;
#pragma unroll
        for (int ks = 0; ks < 2; ++ks) {
          const int i1 = krow * 64 + ks * 32 + quad * 8;
          bf16x8 a = *(const bf16x8*)(L + 1 * OPSZ + (i1 / DK) * RS + (i1 % DK));
          hn = __builtin_amdgcn_mfma_f32_16x16x32_bf16(a, p_v[ks], hn, 0, 0, 0);
          if constexpr (LOW) {
            hn = __builtin_amdgcn_mfma_f32_16x16x32_bf16(*(const bf16x8*)(L + 3 * OPSZ + (i1 / DK) * RS + (i1 % DK)), ubop[ks], hn, 0, 0, 0);
          }
        }
        H[m] = hn;
      }
#pragma unroll
      for (int i = 0; i < NOP * DK / 128 + 1; ++i) tsink ^= tv[i];
      if (c + 2 < cend) issue_pr(c + 2, p_o, p_u, p_v, p_g);
      __syncthreads();
    };
    issue_sh(c0, preA); issue_pr(c0, poA, puA, pvA, pgA);
    if (nc > 1) { issue_sh(c0 + 1, preB); issue_pr(c0 + 1, poB, puB, pvB, pgB); }
    for (int c = c0; c < cend; c += 2) { step(c, preA, poA, puA, pvA, pgA); if (c + 1 < cend) step(c + 1, preB, poB, puB, pvB, pgB); }
    if (TYPE == 0) {
      float* S = POUT + (seq == 0 ? O_AWKV_P + ((size_t)j * 16 + h) * 4096 : O_AWKV_S + (((size_t)j * NSS + (seq - 1)) * 16 + h) * 4096) + (size_t)vcol * 64;
#pragma unroll
      for (int m = 0; m < MB; ++m) *(float4*)(S + m * 16 + quad * 4) = make_float4(H[m][0], H[m][1], H[m][2], H[m][3]);
    } else {
      const size_t ob = TYPE == 1 ? (seq == 0 ? O_BKV_P : O_BKV_S + (size_t)(seq - 1) * NH * DK * DV)
                                  : (seq == 0 ? O_CKV_P : O_CKV_S + (size_t)(seq - 1) * NH * DK * DV);
      float* S = POUT + ob + (size_t)h * DK * DV + vcol;
#pragma unroll
      for (int m = 0; m < MB; ++m)
#pragma unroll
        for (int jj = 0; jj < 4; ++jj) S[(size_t)(m * 16 + quad * 4 + jj) * DV] = H[m][jj];
    }
  }
  if (tsink == 0x9e3779b9u) ((unsigned*)(PWS + WS_SINK))[0] = tsink;
}

template <int TYPE>
DEVI void phase_post(const P& p, int j, char* smem) {
  constexpr int NH = TYPE == 0 ? 16 : (TYPE == 1 ? 4 : 8);
  constexpr int DV = TYPE == 0 ? 64 : (TYPE == 1 ? 256 : 128);
  constexpr int CPT = DV / 8;
  bf16* vt = (bf16*)smem;
  bf16* ot = (bf16*)(smem + 9216);
  const bf16* O = slot(p, TYPE == 0 ? 0 : (TYPE == 1 ? 4 : 3));
  const bf16* G = slot(p, TYPE == 0 ? 4 : (TYPE == 1 ? 3 : 4));
  bf16* og = slot(p, TYPE == 1 ? 0 : 1);
  const float* sm = (const float*)(PWS + WS_SM);
  for (int item = blockIdx.x; item < NCHUNK * NH; item += gridDim.x) {
    const int c = item / NH, h = item % NH; const size_t rb = (size_t)c * 64;
    int tid = threadIdx.x; asm volatile("" : "+v"(tid));
    const int part = tid & 7;
    if constexpr (TYPE == 0) {
      const bf16* V = slot(p, 7) + rb * 1024 + h * 64;
      const int r = tid >> 2, q4 = (tid & 3) * 16;
      *(uint4*)(vt + r * 72 + q4) = *(const uint4*)(V + (size_t)r * 1024 + q4);
      *(uint4*)(vt + r * 72 + q4 + 8) = *(const uint4*)(V + (size_t)r * 1024 + q4 + 8);
      __syncthreads();
    }
    {
      const uint4* srcp = (const uint4*)(O + ((size_t)c * NH + h) * 64 * DV);
#pragma unroll
      for (int i = 0; i < DV / 32; ++i) *(uint4*)(ot + (size_t)(i * 256 + tid) * 8) = srcp[i * 256 + tid];
      __syncthreads();
    }
#pragma unroll 1
    for (int pass = 0; pass < 2; ++pass) {
      const int t = pass * 32 + (tid >> 3);
      const size_t base = (rb + t) * 1024 + h * DV + part * CPT;
      float o[CPT];
#pragma unroll
      for (int e = 0; e < CPT; ++e) {
        const int v = part * CPT + e;
        o[e] = bf2f(ot[(((v >> 4) * 4 + (t >> 4)) * 64 + ((t & 15) >> 2) * 16 + (v & 15)) * 4 + (t & 3)]);
      }
      float s1 = 0.f, s2 = 0.f;
#pragma unroll
      for (int e = 0; e < CPT; ++e) { s1 += o[e]; s2 += o[e] * o[e]; }
      s1 = rsum8(s1); s2 = rsum8(s2);
      if constexpr (TYPE == 0) {
        const float mean = s1 * (1.f / 64.f); float var = s2 * (1.f / 64.f) - mean * mean; var = fmaxf(var, 0.f);
        const float rs = rsqrtf(var + 64e-5f); const float bonus = sm[(rb + t) * 16 + h];
        const float* lw = PIN(26) + j * 1024 + h * 64 + part * CPT; const float* lb = PIN(27) + j * 1024 + h * 64 + part * CPT;
#pragma unroll
        for (int e = 0; e < CPT; ++e) {
          const float vv = bf2f(vt[(part * CPT + e) * 72 + t]);
          o[e] = (o[e] - mean) * rs * lw[e] + lb[e] + bonus * vv;
        }
      } else {
        const float rs = rsqrtf(s2 * (1.f / DV) + 1e-6f);
        const float* on = PIN(TYPE == 1 ? 32 : 38) + part * CPT;
#pragma unroll
        for (int e = 0; e < CPT; ++e) o[e] = o[e] * rs * on[e];
      }
#pragma unroll
      for (int e = 0; e < CPT; e += 8) {
        uint4 u = *(const uint4*)(G + base + e);
        const unsigned w[4] = {u.x, u.y, u.z, u.w}; unsigned ow[4];
#pragma unroll
        for (int i = 0; i < 4; ++i) {
          float g0 = bf2f(w[i] & 0xffff), g1 = bf2f(w[i] >> 16);
          if constexpr (TYPE != 0) { g0 = silu(g0); g1 = silu(g1); }
          ow[i] = pack2(o[e + 2 * i] * g0, o[e + 2 * i + 1] * g1);
        }
        *(uint4*)(og + base + e) = make_uint4(ow[0], ow[1], ow[2], ow[3]);
      }
    }
    __syncthreads();
  }
}


#define XB_TMO      128
#define XB_XCNT(j)  (256  + 64 * (j))
#define XB_XSUB(j)  (1280 + 64 * (j))
#define XB_XGEN(j)  (2304 + 64 * (j))
#define XB_TOP      3328
#define XB_TOPGEN   3392
#define XCD_BAR_WORDS 3456
#define XB_SPIN_CAP (1u << 18)
#define LAS __attribute__((address_space(3)))
DEVI unsigned xb_ld(unsigned* p)              { return __hip_atomic_load(p, __ATOMIC_RELAXED, __HIP_MEMORY_SCOPE_AGENT); }
DEVI unsigned xb_add(unsigned* p, unsigned v) { return __hip_atomic_fetch_add(p, v, __ATOMIC_RELAXED, __HIP_MEMORY_SCOPE_AGENT); }
DEVI unsigned xb_xcc_id() { return (unsigned)__builtin_amdgcn_s_getreg((3 << 11) | 20) & 0xFu; }
#define XB_SPIN(cond, bar) do { unsigned _sp = 0; while (cond) { __builtin_amdgcn_s_sleep(1); \
    if ((++_sp & 255u) == 0u) { if (xb_ld(&(bar)[XB_TMO])) break; if (_sp > XB_SPIN_CAP) { atomicAdd(&(bar)[XB_TMO], 1u); break; } } } } while (0)
struct XcdBarrier { unsigned* bar; unsigned x; volatile LAS unsigned* st; };
DEVI XcdBarrier xcd_barrier_post(unsigned* bar, volatile LAS unsigned* st) {
  XcdBarrier b; b.bar = bar; b.x = xb_xcc_id(); b.st = st;
  if (threadIdx.x == 0) (void)xb_add(&bar[XB_XCNT(b.x)], 1u);
  return b;
}
DEVI void xcd_barrier_complete(unsigned* bar, unsigned x, unsigned& nloc, unsigned& nx) {
  const unsigned G = gridDim.x * gridDim.y * gridDim.z;
  unsigned sum, cnt, mine, sp = 0u;
  for (;;) {
    sum = 0u; cnt = 0u; mine = 0u;
#pragma unroll
    for (unsigned j = 0; j < 16; ++j) { const unsigned c = xb_ld(&bar[XB_XCNT(j)]); sum += c; cnt += (c > 0u) ? 1u : 0u; mine = (j == x) ? c : mine; }
    if (sum == G) break;
    __builtin_amdgcn_s_sleep(1);
    if ((++sp & 255u) == 0u) { if (xb_ld(&bar[XB_TMO])) break; if (sp > XB_SPIN_CAP) { atomicAdd(&bar[XB_TMO], 1u); break; } }
  }
  nloc = mine > 0u ? mine : 1u; nx = cnt > 0u ? cnt : 1u;
}
DEVI void xcd_barrier(const XcdBarrier& b) {
  asm volatile("s_waitcnt vmcnt(0)" ::: "memory");
  __syncthreads();
  if (threadIdx.x == 0) {
    unsigned* bar = b.bar;
    __builtin_amdgcn_s_waitcnt(0);
    unsigned nloc = b.st[0], nx = b.st[1];
    if (nloc == 0u) { xcd_barrier_complete(bar, b.x, nloc, nx); b.st[0] = nloc; b.st[1] = nx; }
    const unsigned old = xb_add(&bar[XB_XSUB(b.x)], 1u);
    const unsigned gen = old / nloc;
    if (old + 1u == (gen + 1u) * nloc) {
      __builtin_amdgcn_fence(__ATOMIC_RELEASE, "agent");
      asm volatile("s_waitcnt vmcnt(0)" ::: "memory");
      const unsigned og = xb_add(&bar[XB_TOP], 1u);
      const unsigned tg = og / nx;
      if (og + 1u == (tg + 1u) * nx) xb_add(&bar[XB_TOPGEN], 1u);
      else XB_SPIN(xb_ld(&bar[XB_TOPGEN]) == tg, bar);
      __builtin_amdgcn_fence(__ATOMIC_ACQUIRE, "agent");
      xb_add(&bar[XB_XGEN(b.x)], 1u);
      asm volatile("s_waitcnt vmcnt(0)" ::: "memory");
    } else {
      XB_SPIN(xb_ld(&bar[XB_XGEN(b.x)]) == gen, bar);
      __builtin_amdgcn_fence(__ATOMIC_ACQUIRE, "agent");
      asm volatile("s_waitcnt vmcnt(0)" ::: "memory");
    }
  }
  __syncthreads();
}

#ifndef DISMASK
#define DISMASK 0
#endif
#define EN(b) (!((DISMASK >> (b)) & 1))
#define GSYNC() xcd_barrier(xb)
#define GSYNC_CG() do { asm volatile("s_waitcnt vmcnt(0)" ::: "memory"); grid.sync(); } while (0)
__global__ void __launch_bounds__(256, 1) fwd_megakernel(P p) {
  extern __shared__ __attribute__((aligned(16))) char smem[];
  cg::grid_group grid = cg::this_grid();
  volatile LAS unsigned* xst = (volatile LAS unsigned*)(smem + LDS_BYTES - 16);
  if (threadIdx.x == 0) { xst[0] = 0u; xst[1] = 0u; }
  __syncthreads();
  const XcdBarrier xb = xcd_barrier_post((unsigned*)(PWS + WS_BAR), xst);
  bf16* wreg = (bf16*)(PWS + WS_W);
  bf16 *wfin = wreg + W_FIN, *wfout = wreg + W_FOUT, *wmix = wreg + W_MIX;
  float* sm = (float*)(PWS + WS_SM);
  for (int layer = 0; layer < 4; ++layer) {
    const int type = layer % 3, j = layer / 3;
    int tb = 0;
    if (type == 0) phase_norm<0>(p, layer, j, layer == 0, layer == 0);
    else phase_norm<1>(p, layer, j, false, false);
    conv_job(CvFfnIn{PIN(10) + (size_t)layer * 1024 * 2 * FF}, wfin, 1024, 2 * FF, 1024, tb, smem);
    conv_job(CvPlain{PIN(11) + (size_t)layer * FF * 1024, 1024, 1024}, wfout, FF, 1024, FF, tb, smem);
    if (type == 0) {
      for (int i = 0; i < 3; ++i) conv_job(CvPlain{PIN(24) + ((size_t)j * 3 + i) * 1048576, 1024, 1024}, wmix + (size_t)i * 1048576, 1024, 1024, 1024, tb, smem);
      conv_job(CvLora1{PIN(14) + (size_t)j * 65536, PIN(17) + (size_t)j * 65536, PIN(19) + (size_t)j * 131072, PIN(12) + (size_t)j * 6144}, wmix + 3145728, 2048, 256, 2048, tb, smem);
      conv_job(CvPlain{PIN(15) + (size_t)j * 65536, 1024, 1024}, wmix + 3670016, 64, 1024, 64, tb, smem);
      conv_job(CvPlain{PIN(18) + (size_t)j * 65536, 1024, 1024}, wmix + 3735552, 64, 1024, 64, tb, smem);
      conv_job(CvPlain{PIN(20) + (size_t)j * 131072, 1024, 1024}, wmix + 3801088, 128, 1024, 128, tb, smem);
      conv_job(CvPlain{PIN(25) + (size_t)j * 1048576, 1024, 1024}, wmix + 3932160, 1024, 1024, 1024, tb, smem);
    } else if (type == 1) {
      conv_job(CvGlaIn{PIN(28), PIN(29)}, wmix, 1024, 3200, 1024, tb, smem);
      conv_job(CvPlain{PIN(33), 1024, 1024}, wmix + 3276800, 1024, 1024, 1024, tb, smem);
    } else {
      conv_job(CvPlain{PIN(34), 4112, 4112}, wmix, 1024, 4224, 1024, tb, smem);
      conv_job(CvPlain{PIN(39), 1024, 1024}, wmix + 4325376, 1024, 1024, 1024, tb, smem);
    }
    GSYNC();
    tb = 0;
    const bf16* wo;
    if (type == 0) {
      for (int i = 0; i < 3; ++i)
        gemm_job(GemmDesc{slot(p, 2 + i), nullptr, 1024, 1024, wmix + (size_t)i * 1048576, 1024, 144, 8, 1024}, EpiStore{slot(p, 5 + i), 1024, 1.f}, tb, smem);
      gemm_job(GemmDesc{slot(p, 0), slot(p, 1), 1024, 1024, wmix + 3145728, 2048, 144, 2, 2048}, EpiLora1{(bf16*)(PWS + WS_L1)}, tb, smem);
      GSYNC();
      tb = 0;
      const bf16* l1 = (const bf16*)(PWS + WS_L1);
      gemm_job(GemmDesc{l1, nullptr, 256, 64, wmix + 3670016, 64, 144, 8, 64}, EpiLd{slot(p, 2), PIN(13) + j * 1024}, tb, smem);
      gemm_job(GemmDesc{l1 + 64, nullptr, 256, 64, wmix + 3735552, 64, 144, 8, 64}, EpiSig{slot(p, 3), PIN(16) + j * 1024}, tb, smem);
      gemm_job(GemmDesc{l1 + 128, nullptr, 256, 128, wmix + 3801088, 128, 144, 8, 128}, EpiStore{slot(p, 4), 1024, 1.f}, tb, smem);
      GSYNC();
      if (EN(2)) phase_prep<0>(p, j, smem);
      GSYNC();
      if (EN(5)) phase_seq2<0>(p, j, smem);
      GSYNC();
      if (EN(8)) phase_post<0>(p, j, smem);
      wo = wmix + 3932160;
    } else if (type == 1) {
      gemm_job(GemmDesc{slot(p, 0), nullptr, 1024, 1024, wmix, 1024, 144, 25, 1024},
               EpiGlaIn{slot(p, 1), slot(p, 1) + (size_t)MT * 512, slot(p, 2), slot(p, 3), sm}, tb, smem);
      GSYNC();
      if (EN(3)) phase_prep<1>(p, j, smem);
      GSYNC();
      if (EN(6)) phase_seq2<1>(p, j, smem);
      GSYNC();
      if (EN(8)) phase_post<1>(p, j, smem);
      wo = wmix + 3276800;
    } else {
      gemm_job(GemmDesc{slot(p, 0), nullptr, 1024, 1024, wmix, 1024, 144, 33, 1024},
               EpiGdnIn{slot(p, 1), slot(p, 4), sm, POUT}, tb, smem);
      GSYNC();
      if (EN(9)) phase_gdn_conv(p);
      GSYNC();
      if (EN(4)) phase_prep<2>(p, j, smem);
      GSYNC();
      if (EN(7)) phase_seq2<2>(p, j, smem);
      GSYNC();
      if (EN(8)) phase_post<2>(p, j, smem);
      wo = wmix + 4325376;
    }
    GSYNC();
    tb = 0;
    gemm_job(GemmDesc{slot(p, type == 1 ? 0 : 1), nullptr, 1024, 1024, wo, 1024, 144, 8, 1024}, EpiAcc{POUT}, tb, smem);
    GSYNC();
    phase_rms(POUT, PIN(8) + layer * 1024, slot(p, 0), nullptr);
    GSYNC();
    tb = 0;
    gemm_job(GemmDesc{slot(p, 0), nullptr, 1024, 1024, wfin, 1024, 144, 44, 1024}, EpiSwiglu{slot(p, 1)}, tb, smem);
    GSYNC();
    tb = 0;
    gemm_job(GemmDesc{slot(p, 1), nullptr, FF, FF, wfout, FF, 144, 8, FF}, EpiAcc{POUT}, tb, smem);
    if (layer == 3) GSYNC_CG(); else GSYNC();
  }
  phase_rms(POUT, PIN(9), nullptr, POUT);
}

extern "C" void kernel_launch(void* const* d_in, const int* in_sizes, int n_in, void* d_out, int out_size,
                              void* d_ws, size_t ws_size, hipStream_t stream) {
  if (n_in < 40 || ws_size < WS_TOTAL) { fprintf(stderr, "bad args: n_in %d ws %zu need %zu\n", n_in, ws_size, (size_t)WS_TOTAL); return; }
  static int grid_blocks = 0;
  if (!grid_blocks) {
    int dev = 0, cus = 0, per_cu = 0;
    hipGetDevice(&dev);
    hipDeviceGetAttribute(&cus, hipDeviceAttributeMultiprocessorCount, dev);
    hipFuncSetAttribute((const void*)fwd_megakernel, hipFuncAttributeMaxDynamicSharedMemorySize, LDS_BYTES);
    hipOccupancyMaxActiveBlocksPerMultiprocessor(&per_cu, (const void*)fwd_megakernel, 256, LDS_BYTES);
    if (per_cu > 1) per_cu = 1;
    if (per_cu < 1) per_cu = 1;
    grid_blocks = cus * per_cu;
  }
  hipMemsetAsync((char*)d_ws + WS_BAR, 0, 16384, stream);
  P p{};
  for (int i = 0; i < 40; ++i) p.in[i] = (const float*)d_in[i];
  p.out = (float*)d_out; p.ws = (char*)d_ws;
  void* args[] = {&p};
  hipError_t e = hipLaunchCooperativeKernel((const void*)fwd_megakernel, dim3(grid_blocks), dim3(256), args, LDS_BYTES, stream);
  if (e != hipSuccess) fprintf(stderr, "cooperative launch failed: %s (grid %d)\n", hipGetErrorString(e), grid_blocks);
}
```

```cpp
#include <hip/hip_runtime.h>
#include <hip/hip_cooperative_groups.h>
#include <cstdio>
#include <cstdint>
namespace cg = cooperative_groups;

typedef unsigned short bf16;
typedef __attribute__((ext_vector_type(8))) short bf16x8;
typedef __attribute__((ext_vector_type(4))) short bf16x4;
typedef __attribute__((ext_vector_type(4))) float f32x4;
typedef __attribute__((ext_vector_type(4))) unsigned u32x4;
typedef __attribute__((ext_vector_type(2))) unsigned u32x2;

#define DEVI __device__ __forceinline__

constexpr int Dm = 1024, FF = 2816, MT = 18432, MPR = 16384, NSS = 32, NCHUNK = 288, NPCH = 256;
constexpr size_t SLOT = (size_t)MT * 1024 * 2;
constexpr size_t WS_L1 = 8 * SLOT;
constexpr size_t WS_SM = WS_L1 + (size_t)MT * 256 * 2;
constexpr size_t WS_GAM = WS_SM + (size_t)MT * 16 * 4;
constexpr size_t WS_W = WS_GAM + (size_t)NCHUNK * 1024 * 4;
constexpr size_t W_FIN = 0, W_FOUT = 5767168, W_MIX = 8650752;
constexpr size_t WS_SINK = WS_W + (size_t)14200000 * 2 - 64;
constexpr size_t WS_BAR = WS_W + (size_t)14200000 * 2;
constexpr size_t WS_TOTAL = WS_BAR + 16384;
constexpr int LDS_BYTES = 77824;

constexpr size_t O_ASH_P = 18874368, O_AWKV_P = O_ASH_P + 2048, O_BKV_P = O_AWKV_P + 131072,
                 O_CCONV_P = O_BKV_P + 131072, O_CKV_P = O_CCONV_P + 9216, O_ASH_S = O_CKV_P + 131072,
                 O_AWKV_S = O_ASH_S + 65536, O_BKV_S = O_AWKV_S + 4194304, O_CCONV_S = O_BKV_S + 4194304,
                 O_CKV_S = O_CCONV_S + 294912;

struct P { const float* in[40]; float* out; char* ws; };
typedef const __attribute__((address_space(4))) char* kptr_t;
typedef const float* cfp_t; typedef float* fp_t; typedef char* cp_t;
DEVI kptr_t kbase() { kptr_t b = (kptr_t)__builtin_amdgcn_kernarg_segment_ptr(); asm volatile("" : "+s"(b)); return b; }
#define PIN(i) (*(const __attribute__((address_space(4))) cfp_t*)(kbase() + 8 * (i)))
#define POUT (*(const __attribute__((address_space(4))) fp_t*)(kbase() + 320))
#define PWS (*(const __attribute__((address_space(4))) cp_t*)(kbase() + 328))

typedef __attribute__((ext_vector_type(2))) float f32x2;
typedef __attribute__((ext_vector_type(2))) __bf16 bf16x2v;
DEVI unsigned pack2(float a, float b) { f32x2 v = {a, b}; bf16x2v r = __builtin_convertvector(v, bf16x2v); return __builtin_bit_cast(unsigned, r); }
DEVI bf16 f2bf(float f) { return (bf16)(pack2(f, 0.f) & 0xffffu); }
DEVI float bf2f(bf16 h) { return __uint_as_float(((unsigned)h) << 16); }
template <int CTRL> DEVI float dpp_mov(float v) { return __int_as_float(__builtin_amdgcn_mov_dpp(__float_as_int(v), CTRL, 0xF, 0xF, true)); }
DEVI float rsum4(float v) { v += dpp_mov<0xB1>(v); v += dpp_mov<0x4E>(v); return v; }
DEVI float rsum8(float v) { v = rsum4(v); v += dpp_mov<0x141>(v); return v; }
DEVI float rsum16(float v) { v = rsum8(v); v += dpp_mov<0x140>(v); return v; }
DEVI float wsum(float v) {
  v = rsum16(v);
  const int iv = __float_as_int(v);
  return (__int_as_float(__builtin_amdgcn_readlane(iv, 0)) + __int_as_float(__builtin_amdgcn_readlane(iv, 16))) +
         (__int_as_float(__builtin_amdgcn_readlane(iv, 32)) + __int_as_float(__builtin_amdgcn_readlane(iv, 48)));
}
DEVI float sigm(float x) { return 1.f / (1.f + __expf(-x)); }
DEVI float silu(float x) { return x * sigm(x); }
DEVI float softplus(float x) { return x > 20.f ? x : log1pf(__expf(x)); }
DEVI bf16* slot(const P& p, int i) { return (bf16*)(PWS + (size_t)i * SLOT); }

struct GemmDesc { const bf16* A; const bf16* A2; int lda; int ksplit; const bf16* Bt; int ldb; int tiles_m; int tiles_n; int K; };

template <class Epi>
DEVI void gemm_tile(const GemmDesc& g, int mt, int nt, Epi& epi, char* smem) {
  const int tid = threadIdx.x, lane = tid & 63, wave = tid >> 6;
  const int wm = wave >> 1, wn = wave & 1, lr = lane & 15, quad = lane >> 4;
  bf16* sA = (bf16*)smem;
  bf16* sB = sA + 2 * 8192;
  f32x4 acc[4][4];
#pragma unroll
  for (int i = 0; i < 4; ++i)
#pragma unroll
    for (int j = 0; j < 4; ++j) acc[i][j] = (f32x4){0.f, 0.f, 0.f, 0.f};
  const int m0 = mt * 128, n0 = nt * 128;
  const int r0 = tid >> 3, c0 = tid & 7;
  const size_t aoff = (size_t)(m0 + r0) * g.lda + c0 * 8;
  const bf16* bp = g.Bt + (size_t)(n0 + r0) * g.ldb + c0 * 8;
  const int soff = r0 * 64 + ((c0 ^ (r0 & 7)) << 3);
#define GL1(i_, RA, RB) RA##i_ = *(const u32x4*)(base_ + (size_t)(32 * i_) * g.lda); RB##i_ = *(const u32x4*)(bp + k0_ + (size_t)(32 * i_) * g.ldb);
#define GLOAD(kt_, RA, RB) do { const int k0_ = (kt_) << 6; \
    const bf16* base_ = ((k0_ < g.ksplit) ? (g.A + k0_) : (g.A2 + (k0_ - g.ksplit))) + aoff; \
    GL1(0, RA, RB) GL1(1, RA, RB) GL1(2, RA, RB) GL1(3, RA, RB) } while (0)
#define LS1(buf_, i_, RA, RB) *(u32x4*)(sA + (buf_) * 8192 + soff + i_ * 2048) = RA##i_; *(u32x4*)(sB + (buf_) * 8192 + soff + i_ * 2048) = RB##i_;
#define LSTORE(buf_, RA, RB) do { LS1(buf_, 0, RA, RB) LS1(buf_, 1, RA, RB) LS1(buf_, 2, RA, RB) LS1(buf_, 3, RA, RB) } while (0)
#define GSTEP(kt_, RA, RB) do { const int buf_ = (kt_) & 1; \
    if ((kt_) + 1 < nk) { LSTORE(buf_ ^ 1, RA, RB); if ((kt_) + 3 < nk) GLOAD((kt_) + 3, RA, RB); } \
    const bf16* a_ = sA + buf_ * 8192 + (wm * 64 + lr) * 64; const bf16* b_ = sB + buf_ * 8192 + (wn * 64 + lr) * 64; \
    _Pragma("unroll") for (int ks_ = 0; ks_ < 2; ++ks_) { \
      const int co_ = (((ks_ * 4 + quad) ^ (lr & 7)) << 3); bf16x8 af_[4], bf_[4]; \
      _Pragma("unroll") for (int i_ = 0; i_ < 4; ++i_) { af_[i_] = *(const bf16x8*)(a_ + i_ * 1024 + co_); bf_[i_] = *(const bf16x8*)(b_ + i_ * 1024 + co_); } \
      _Pragma("unroll") for (int i_ = 0; i_ < 4; ++i_) _Pragma("unroll") for (int j_ = 0; j_ < 4; ++j_) \
        acc[i_][j_] = __builtin_amdgcn_mfma_f32_16x16x32_bf16(af_[i_], bf_[j_], acc[i_][j_], 0, 0, 0); } \
    __syncthreads(); } while (0)
  const int nk = g.K >> 6;
  u32x4 pa0, pa1, pa2, pa3, pb0, pb1, pb2, pb3, qa0, qa1, qa2, qa3, qb0, qb1, qb2, qb3;
  qa0 = qa1 = qa2 = qa3 = qb0 = qb1 = qb2 = qb3 = (u32x4){0u, 0u, 0u, 0u};
  GLOAD(0, pa, pb);
  if (nk > 1) GLOAD(1, qa, qb);
  LSTORE(0, pa, pb);
  if (nk > 2) GLOAD(2, pa, pb);
  __syncthreads();
  for (int kt = 0; kt < nk; kt += 2) { GSTEP(kt, qa, qb); if (kt + 1 < nk) GSTEP(kt + 1, pa, pb); }
#pragma unroll
  for (int i = 0; i < 4; ++i) {
#pragma unroll
    for (int jj = 0; jj < 4; ++jj) {
      const int row = m0 + wm * 64 + i * 16 + quad * 4 + jj;
      if constexpr (Epi::PAIR) {
#pragma unroll
        for (int j = 0; j < 4; j += 2) {
          const int nn = n0 + wn * 64 + j * 16;
          epi.pair(row, (nn >> 5) * 16 + lr, acc[i][j][jj], acc[i][j + 1][jj]);
        }
      } else {
#pragma unroll
        for (int j = 0; j < 4; ++j) epi(row, n0 + wn * 64 + j * 16 + lr, acc[i][j][jj]);
      }
    }
  }
}

template <class Epi>
DEVI void gemm_job(const GemmDesc& g, Epi epi, int& tbase, char* smem) {
  const int ntiles = g.tiles_m * g.tiles_n, G = gridDim.x;
  const int first = tbase + (((int)blockIdx.x - tbase % G) + G) % G;
  const int width = 8 * g.tiles_n;
  for (int t = first; t < tbase + ntiles; t += G) {
    const int lt = t - tbase;
    const int grp = lt / width, rem = lt % width;
    gemm_tile(g, grp * 8 + (rem & 7), rem >> 3, epi, smem);
  }
  tbase += ntiles;
}

struct EpiStore { static constexpr bool PAIR = false; bf16* C; int ldc; float sc;
  DEVI void operator()(int r, int c, float v) { C[(size_t)r * ldc + c] = f2bf(v * sc); } };
struct EpiLora1 { static constexpr bool PAIR = false; bf16* C;
  DEVI void operator()(int r, int c, float v) { float o = c < 64 ? tanhf(v) : (c < 128 ? v : sigm(v)); C[(size_t)r * 256 + c] = f2bf(o); } };
struct EpiLd { static constexpr bool PAIR = false; bf16* C; const float* w0;
  DEVI void operator()(int r, int c, float v) { float x = w0[c] + v; float lr_ = -softplus(-x) - 0.5f; C[(size_t)r * 1024 + c] = f2bf(-__expf(lr_)); } };
struct EpiSig { static constexpr bool PAIR = false; bf16* C; const float* a0;
  DEVI void operator()(int r, int c, float v) { C[(size_t)r * 1024 + c] = f2bf(sigm(a0[c] + v)); } };
struct EpiAcc { static constexpr bool PAIR = false; float* X;
  DEVI void operator()(int r, int c, float v) { X[(size_t)r * 1024 + c] += v; } };
struct EpiSwiglu { static constexpr bool PAIR = true; bf16* C;
  DEVI void pair(int r, int c, float gt, float up) { C[(size_t)r * FF + c] = f2bf(silu(gt) * up); } };
struct EpiGlaIn { static constexpr bool PAIR = false; bf16 *q, *k, *v, *gate; float* sm;
  DEVI void operator()(int r, int c, float x) {
    if (c < 512) q[(size_t)r * 512 + c] = f2bf(x * 0.08838834764831845f);
    else if (c < 1024) k[(size_t)r * 512 + c - 512] = f2bf(x);
    else if (c < 2048) v[(size_t)r * 1024 + c - 1024] = f2bf(x);
    else if (c < 3072) gate[(size_t)r * 1024 + c - 2048] = f2bf(x);
    else if (c < 3088) sm[(size_t)r * 16 + c - 3072] = x;
  } };
struct EpiGdnIn { static constexpr bool PAIR = false; bf16 *qkv, *z; float* sm; float* out;
  DEVI void operator()(int r, int c, float x) {
    if (c < 3072) {
      qkv[(size_t)r * 3072 + c] = f2bf(x);
      if (r >= MPR - 3) {
        if (r < MPR) out[O_CCONV_P + (size_t)(r - (MPR - 3)) * 3072 + c] = x;
        else { int tt = (r - MPR) & 63; if (tt >= 61) out[O_CCONV_S + ((size_t)((r - MPR) >> 6) * 3 + (tt - 61)) * 3072 + c] = x; }
      }
    } else if (c < 4096) z[(size_t)r * 1024 + c - 3072] = f2bf(x);
    else if (c < 4112) sm[(size_t)r * 16 + c - 4096] = x;
  } };

template <class F>
DEVI void conv_job(F f, bf16* dst, int ldo, int Nd, int Kd, int& tbase, char* smem) {
  float* tile = (float*)smem;
  const int tn = Nd >> 6, tk = Kd >> 6, ntiles = tn * tk, G = gridDim.x, tid = threadIdx.x;
  const int first = tbase + (((int)blockIdx.x - tbase % G) + G) % G;
  for (int t = first; t < tbase + ntiles; t += G) {
    const int lt = t - tbase, n0 = (lt % tn) << 6, k0 = (lt / tn) << 6;
    const int i = tid >> 4, j4 = (tid & 15) << 2;
#pragma unroll
    for (int r = 0; r < 4; ++r) {
      float4 v = f(k0 + i + 16 * r, n0 + j4);
      float* d = tile + (i + 16 * r) * 65 + j4; d[0] = v.x; d[1] = v.y; d[2] = v.z; d[3] = v.w;
    }
    __syncthreads();
    const int jn = tid >> 2, iq = (tid & 3) << 4;
    unsigned w[8];
#pragma unroll
    for (int e = 0; e < 8; ++e) w[e] = pack2(tile[(iq + 2 * e) * 65 + jn], tile[(iq + 2 * e + 1) * 65 + jn]);
    uint4* o = (uint4*)(dst + (size_t)(n0 + jn) * ldo + k0 + iq);
    o[0] = make_uint4(w[0], w[1], w[2], w[3]); o[1] = make_uint4(w[4], w[5], w[6], w[7]);
    __syncthreads();
  }
  tbase += ntiles;
}
struct CvPlain { const float* W; int ld; int nsrc;
  DEVI float4 operator()(int k, int n) const { return n < nsrc ? *(const float4*)(W + (size_t)k * ld + n) : make_float4(0, 0, 0, 0); } };
struct CvFfnIn { const float* W;
  DEVI float4 operator()(int k, int n) const { int blk = n >> 5, w = n & 31; int src = (w < 16) ? blk * 16 + w : FF + blk * 16 + (w - 16);
    return *(const float4*)(W + (size_t)k * (2 * FF) + src); } };
struct CvLora1 { const float *w1, *a1, *g1, *mu;
  DEVI float4 operator()(int k, int n) const {
    int kk = k & 1023; float4 v; float m;
    if (n < 64) { v = *(const float4*)(w1 + kk * 64 + n); m = mu[1 * 1024 + kk]; }
    else if (n < 128) { v = *(const float4*)(a1 + kk * 64 + n - 64); m = mu[4 * 1024 + kk]; }
    else { v = *(const float4*)(g1 + kk * 128 + n - 128); m = mu[5 * 1024 + kk]; }
    float s = (k < 1024) ? (1.f - m) : m;
    return make_float4(v.x * s, v.y * s, v.z * s, v.w * s); } };
struct CvGlaIn { const float *win, *wa1;
  DEVI float4 operator()(int k, int n) const {
    if (n < 3072) return *(const float4*)(win + (size_t)k * 3072 + n);
    if (n < 3088) return *(const float4*)(wa1 + k * 16 + n - 3072);
    return make_float4(0, 0, 0, 0); } };

template <int TYPE>
DEVI void phase_norm(const P& p, int layer, int j, bool from_input, bool copy_x) {
  const int lane = threadIdx.x & 63, wave = threadIdx.x >> 6;
  const float* g = PIN(7) + layer * 1024;
  float* xres = POUT;
  bf16 *h = slot(p, 0), *hs = slot(p, 1), *xr = slot(p, 2), *xk = slot(p, 3), *xv = slot(p, 4);
  const float* mu = PIN(12) + (size_t)j * 6 * 1024;
  for (int row = blockIdx.x * 4 + wave; row < MT; row += gridDim.x * 4) {
    auto src = [&](int r) -> const float* {
      if (from_input) return r < MPR ? PIN(0) + (size_t)r * 1024 : PIN(1) + (size_t)(r - MPR) * 1024;
      return xres + (size_t)r * 1024; };
    const float* xp = src(row);
    float4 xv4[4]; float ss = 0.f;
    float4 pv[4];
    bool pnorm = false;
    if constexpr (TYPE == 0) {
      const bool is_p0 = row < MPR; const int tt0 = is_p0 ? row : ((row - MPR) & 63);
      if (tt0 != 0) { const float* pp = src(row - 1); pnorm = true;
#pragma unroll
        for (int i = 0; i < 4; ++i) pv[i] = *(const float4*)(pp + i * 256 + lane * 4);
      } else if (!is_p0) { const float* sp = PIN(2) + ((size_t)j * NSS + ((row - MPR) >> 6)) * 1024;
#pragma unroll
        for (int i = 0; i < 4; ++i) pv[i] = *(const float4*)(sp + i * 256 + lane * 4);
      } else {
#pragma unroll
        for (int i = 0; i < 4; ++i) pv[i] = make_float4(0.f, 0.f, 0.f, 0.f);
      }
    }
#pragma unroll
    for (int i = 0; i < 4; ++i) { xv4[i] = *(const float4*)(xp + i * 256 + lane * 4); ss += xv4[i].x * xv4[i].x + xv4[i].y * xv4[i].y + xv4[i].z * xv4[i].z + xv4[i].w * xv4[i].w; }
    ss = wsum(ss);
    const float rstd = rsqrtf(ss * (1.f / 1024.f) + 1e-6f);
    if (copy_x) {
#pragma unroll
      for (int i = 0; i < 4; ++i) *(float4*)(xres + (size_t)row * 1024 + i * 256 + lane * 4) = xv4[i];
    }
    float hv[16];
#pragma unroll
    for (int i = 0; i < 4; ++i) { float4 gg = *(const float4*)(g + i * 256 + lane * 4);
      hv[i * 4 + 0] = xv4[i].x * rstd * gg.x; hv[i * 4 + 1] = xv4[i].y * rstd * gg.y; hv[i * 4 + 2] = xv4[i].z * rstd * gg.z; hv[i * 4 + 3] = xv4[i].w * rstd * gg.w; }
#pragma unroll
    for (int i = 0; i < 4; ++i) *(uint2*)(h + (size_t)row * 1024 + i * 256 + lane * 4) = make_uint2(pack2(hv[i * 4], hv[i * 4 + 1]), pack2(hv[i * 4 + 2], hv[i * 4 + 3]));
    if constexpr (TYPE == 0) {
      const bool is_p = row < MPR; const int tt = is_p ? row : ((row - MPR) & 63); const int b = is_p ? 0 : ((row - MPR) >> 6);
      float hp[16];
      {
        float s2 = 0.f;
#pragma unroll
        for (int i = 0; i < 4; ++i) s2 += pv[i].x * pv[i].x + pv[i].y * pv[i].y + pv[i].z * pv[i].z + pv[i].w * pv[i].w;
        s2 = wsum(s2); const float r2 = rsqrtf(s2 * (1.f / 1024.f) + 1e-6f);
#pragma unroll
        for (int i = 0; i < 4; ++i) { float4 gg = *(const float4*)(g + i * 256 + lane * 4);
          const float sx = pnorm ? r2 * gg.x : 1.f, sy = pnorm ? r2 * gg.y : 1.f, sz = pnorm ? r2 * gg.z : 1.f, sw = pnorm ? r2 * gg.w : 1.f;
          hp[i * 4] = pv[i].x * sx; hp[i * 4 + 1] = pv[i].y * sy; hp[i * 4 + 2] = pv[i].z * sz; hp[i * 4 + 3] = pv[i].w * sw; }
      }
#pragma unroll
      for (int i = 0; i < 4; ++i) {
        const int col = i * 256 + lane * 4; const size_t o = (size_t)row * 1024 + col;
        float4 m0 = *(const float4*)(mu + 0 * 1024 + col), m2 = *(const float4*)(mu + 2 * 1024 + col), m3 = *(const float4*)(mu + 3 * 1024 + col);
        const float mm0[4] = {m0.x, m0.y, m0.z, m0.w}, mm2[4] = {m2.x, m2.y, m2.z, m2.w}, mm3[4] = {m3.x, m3.y, m3.z, m3.w};
        float a[4], bb[4], c[4];
#pragma unroll
        for (int e = 0; e < 4; ++e) { float hh = hv[i * 4 + e], xx = hp[i * 4 + e] - hh; a[e] = hh + xx * mm0[e]; bb[e] = hh + xx * mm2[e]; c[e] = hh + xx * mm3[e]; }
        *(uint2*)(hs + o) = make_uint2(pack2(hp[i * 4], hp[i * 4 + 1]), pack2(hp[i * 4 + 2], hp[i * 4 + 3]));
        *(uint2*)(xr + o) = make_uint2(pack2(a[0], a[1]), pack2(a[2], a[3]));
        *(uint2*)(xk + o) = make_uint2(pack2(bb[0], bb[1]), pack2(bb[2], bb[3]));
        *(uint2*)(xv + o) = make_uint2(pack2(c[0], c[1]), pack2(c[2], c[3]));
      }
      if (is_p ? (row == MPR - 1) : (tt == 63)) {
        float* o = POUT + (is_p ? O_ASH_P + (size_t)j * 1024 : O_ASH_S + ((size_t)j * NSS + b) * 1024);
#pragma unroll
        for (int i = 0; i < 4; ++i) *(float4*)(o + i * 256 + lane * 4) = make_float4(hv[i * 4], hv[i * 4 + 1], hv[i * 4 + 2], hv[i * 4 + 3]);
      }
    }
  }
}

DEVI void phase_rms(const float* x, const float* g, bf16* dst, float* fdst) {
  const int lane = threadIdx.x & 63, wave = threadIdx.x >> 6;
  const int nw = gridDim.x * 4;
  for (int row = blockIdx.x * 4 + wave; row < MT; row += 2 * nw) {
    const int row2 = row + nw; const bool has2 = row2 < MT;
    float4 v[4], v2[4]; float ss = 0.f, ss2 = 0.f;
#pragma unroll
    for (int i = 0; i < 4; ++i) v[i] = *(const float4*)(x + (size_t)row * 1024 + i * 256 + lane * 4);
    if (has2) {
#pragma unroll
      for (int i = 0; i < 4; ++i) v2[i] = *(const float4*)(x + (size_t)row2 * 1024 + i * 256 + lane * 4);
    } else {
#pragma unroll
      for (int i = 0; i < 4; ++i) v2[i] = make_float4(0.f, 0.f, 0.f, 0.f);
    }
#pragma unroll
    for (int i = 0; i < 4; ++i) { ss += v[i].x * v[i].x + v[i].y * v[i].y + v[i].z * v[i].z + v[i].w * v[i].w; ss2 += v2[i].x * v2[i].x + v2[i].y * v2[i].y + v2[i].z * v2[i].z + v2[i].w * v2[i].w; }
    ss = wsum(ss); ss2 = wsum(ss2);
    const float r = rsqrtf(ss * (1.f / 1024.f) + 1e-6f), r2 = rsqrtf(ss2 * (1.f / 1024.f) + 1e-6f);
#pragma unroll
    for (int i = 0; i < 4; ++i) { float4 gg = *(const float4*)(g + i * 256 + lane * 4);
      { float a = v[i].x * r * gg.x, b = v[i].y * r * gg.y, c = v[i].z * r * gg.z, d = v[i].w * r * gg.w;
        if (dst) *(uint2*)(dst + (size_t)row * 1024 + i * 256 + lane * 4) = make_uint2(pack2(a, b), pack2(c, d));
        else *(float4*)(fdst + (size_t)row * 1024 + i * 256 + lane * 4) = make_float4(a, b, c, d); }
      if (has2) { float a = v2[i].x * r2 * gg.x, b = v2[i].y * r2 * gg.y, c = v2[i].z * r2 * gg.z, d = v2[i].w * r2 * gg.w;
        if (dst) *(uint2*)(dst + (size_t)row2 * 1024 + i * 256 + lane * 4) = make_uint2(pack2(a, b), pack2(c, d));
        else *(float4*)(fdst + (size_t)row2 * 1024 + i * 256 + lane * 4) = make_float4(a, b, c, d); }
    }
  }
}

DEVI void phase_gdn_conv(const P& p) {
  const bf16* qkv = slot(p, 1); const float* cw = PIN(35); const float* cst = PIN(5);
  const int tid = threadIdx.x;
  for (int item = blockIdx.x; item < (MT / 8) * 3; item += gridDim.x) {
    const int row0 = (item / 3) * 8, sec = item % 3, ch = sec * 1024 + tid * 4;
    const bool is_p = row0 < MPR; const int tt0 = is_p ? row0 : ((row0 - MPR) & 63); const int b = is_p ? 0 : ((row0 - MPR) >> 6);
    float x[11][4];
#pragma unroll
    for (int i = 0; i < 11; ++i) {
      const int pt = tt0 + i;
      if (pt >= 3) { uint2 u = *(const uint2*)(qkv + (size_t)(row0 + i - 3) * 3072 + ch);
        x[i][0] = bf2f(u.x & 0xffff); x[i][1] = bf2f(u.x >> 16); x[i][2] = bf2f(u.y & 0xffff); x[i][3] = bf2f(u.y >> 16); }
      else if (!is_p) { float4 s = *(const float4*)(cst + ((size_t)b * 3 + pt) * 3072 + ch); x[i][0] = s.x; x[i][1] = s.y; x[i][2] = s.z; x[i][3] = s.w; }
      else { x[i][0] = x[i][1] = x[i][2] = x[i][3] = 0.f; }
    }
    float w[4][4];
#pragma unroll
    for (int i = 0; i < 4; ++i) { float4 ww = *(const float4*)(cw + i * 3072 + ch); w[i][0] = ww.x; w[i][1] = ww.y; w[i][2] = ww.z; w[i][3] = ww.w; }
#pragma unroll
    for (int o = 0; o < 8; ++o) {
      float acc[4];
#pragma unroll
      for (int e = 0; e < 4; ++e) { acc[e] = x[o][e] * w[0][e] + x[o + 1][e] * w[1][e] + x[o + 2][e] * w[2][e] + x[o + 3][e] * w[3][e]; acc[e] = silu(acc[e]); }
      if (sec < 2) {
        float ss = acc[0] * acc[0] + acc[1] * acc[1] + acc[2] * acc[2] + acc[3] * acc[3];
#pragma unroll
        for (int once = 0; once < 1; ++once) { ss = rsum16(ss); ss += __shfl_xor(ss, 16); }
        const float r = rsqrtf(ss + 1e-6f) * (sec == 0 ? 0.08838834764831845f : 1.f);
#pragma unroll
        for (int e = 0; e < 4; ++e) acc[e] *= r;
      }
      *(uint2*)(slot(p, 5 + sec) + (size_t)(row0 + o) * 1024 + tid * 4) = make_uint2(pack2(acc[0], acc[1]), pack2(acc[2], acc[3]));
    }
  }
}

DEVI void mm_strip(const bf16* At, const bf16* Bt, f32x4 (&acc)[4], int wave, int lane) {
  const int lr = lane & 15, quad = lane >> 4;
#pragma unroll
  for (int ks = 0; ks < 2; ++ks) {
    bf16x8 a = *(const bf16x8*)(At + (wave * 16 + lr) * 72 + ks * 32 + quad * 8);
#pragma unroll
    for (int nb = 0; nb < 4; ++nb) {
      bf16x8 b = *(const bf16x8*)(Bt + (nb * 16 + lr) * 72 + ks * 32 + quad * 8);
      acc[nb] = __builtin_amdgcn_mfma_f32_16x16x32_bf16(a, b, acc[nb], 0, 0, 0);
    }
  }
}
DEVI void zero4(f32x4 (&a)[4]) {
#pragma unroll
  for (int i = 0; i < 4; ++i) a[i] = (f32x4){0.f, 0.f, 0.f, 0.f};
}

DEVI int perm32(int x) { return (x & ~31) | (((x >> 2) & 3) << 3) | (((x >> 4) & 1) << 2) | (x & 3); }
template <int CW> DEVI size_t cont_off(int r, int s, int LD) { const int idx = r * 64 + s; return (size_t)(idx / CW) * LD + (idx % CW); }

template <int TYPE>
DEVI void phase_prep(const P& p, int j, char* smem) {
  constexpr int NH = TYPE == 0 ? 16 : (TYPE == 1 ? 4 : 8);
  constexpr int DK = TYPE == 0 ? 64 : 128;
  constexpr int DV = TYPE == 0 ? 64 : (TYPE == 1 ? 256 : 128);
  constexpr bool LOW = TYPE != 1;
  constexpr int KT = 256 / DK, TPT = 64 / KT, DKH = DK / 64, DVH = DV / 64;
  constexpr int LDQ = TYPE == 1 ? 512 : 1024;
  bf16* X0 = (bf16*)smem; bf16* X1 = X0 + 4608; bf16* Y0 = X1 + 4608; bf16* Y1 = Y0 + 4608;
  float* Lb = (float*)smem;
  bf16* LkT = (bf16*)(smem + 16384); bf16* Ak = LkT + 4608; bf16* nAb = Ak + 4608;
  bf16* M1 = (bf16*)smem;
  bf16* Tt = (bf16*)(smem + 44032); bf16* St1 = Tt + 4608; bf16* St2 = St1 + 4608;
  if (TYPE == 1) { Y0 = (bf16*)(smem + 9216); Ak = (bf16*)(smem + 18432); St1 = (bf16*)(smem + 27648); }
  float* lgL = (float*)(smem + 36864);
  float* tot = (float*)(smem + 71680);
  float* sc_beta = (float*)(smem + 73728);
  float* sc_eg = sc_beta + 64; float* sc_lg = sc_eg + 64; float* sc_g = sc_lg + 64;

  bf16 *Aq, *Akk, *Av, *Ald = nullptr, *Aa = nullptr, *Oq, *Okt, *Ovt, *Ow = nullptr, *Obt = nullptr, *Ool, *Ou0 = nullptr;
  if (TYPE == 0) { Aq = slot(p, 5); Akk = slot(p, 6); Av = slot(p, 7); Ald = slot(p, 2); Aa = slot(p, 3);
    Oq = Aq; Okt = Akk; Ovt = Av; Ow = Ald; Obt = Aa; Ool = slot(p, 0); Ou0 = slot(p, 1); }
  else if (TYPE == 1) { Aq = slot(p, 1); Akk = slot(p, 1) + (size_t)MT * 512; Av = slot(p, 2); Oq = Aq; Okt = Akk; Ovt = Av; Ool = slot(p, 4); }
  else { Aq = slot(p, 5); Akk = slot(p, 6); Av = slot(p, 7); Oq = Aq; Okt = Akk; Ovt = Av; Ow = slot(p, 1); Obt = slot(p, 2); Ool = slot(p, 3); Ou0 = slot(p, 0); }
  float* sm = (float*)(PWS + WS_SM);
  float* gam = (float*)(PWS + WS_GAM);

  for (int item = blockIdx.x; item < NCHUNK * NH; item += gridDim.x) {
    const int c = item / NH, h = item % NH;
    const size_t rb = (size_t)c * 64;
    int tid = threadIdx.x; asm volatile("" : "+v"(tid));
    const int lane = tid & 63, wave = tid >> 6, lr = lane & 15, quad = lane >> 4;
    const int k = tid % DK, tg = tid / DK;
    const int vv = tid & 63, tgv = tid >> 6;
    unsigned qP[TPT / 2], ktP[TPT / 2], kapP[(TYPE == 0) ? TPT / 2 : 1], bvP[(TYPE == 0) ? TPT / 2 : 1];
    float lg[(TYPE == 0) ? TPT : 1], ldv[(TYPE == 0) ? TPT : 1];
    unsigned vP[DVH][8];
    auto lo16 = [](unsigned w) { return __uint_as_float(w << 16); };
    auto hi16 = [](unsigned w) { return __uint_as_float(w & 0xffff0000u); };
#define GETP(arr, e) (((e) & 1) ? hi16(arr[(e) >> 1]) : lo16(arr[(e) >> 1]))
#pragma unroll
    for (int vh = 0; vh < DVH; ++vh) {
      bf16 va[16];
#pragma unroll
      for (int e = 0; e < 16; ++e) va[e] = Av[(rb + tgv * 16 + e) * 1024 + h * DV + vh * 64 + vv];
#pragma unroll
      for (int e = 0; e < 8; ++e) { vP[vh][e] = (unsigned)va[2 * e] | ((unsigned)va[2 * e + 1] << 16); asm volatile("" : "+v"(vP[vh][e])); }
    }
    if constexpr (TYPE == 2) {
      if (tid < 64) {
        const float a_log = PIN(36)[h], dtb = PIN(37)[h];
        const float braw = sm[(rb + tid) * 16 + h], araw = sm[(rb + tid) * 16 + 8 + h];
        const float gt = -__expf(a_log) * softplus(araw + dtb);
        sc_beta[tid] = sigm(braw); sc_eg[tid] = __expf(gt); sc_g[tid] = gt;
        float cs = gt;
#pragma unroll
        for (int o = 1; o < 64; o <<= 1) { float n = __shfl_up(cs, o); if (lane >= o) cs += n; }
        sc_lg[tid] = cs;
      }
      __syncthreads();
    }
    if constexpr (TYPE == 0) {
      const float k_k = PIN(21)[j * 1024 + h * 64 + k], k_a = PIN(22)[j * 1024 + h * 64 + k], r_k = PIN(23)[j * 1024 + h * 64 + k];
      float run = 0.f;
      bf16 rr[TPT], rk[TPT], ra[TPT], rl[TPT];
#pragma unroll
      for (int e = 0; e < TPT; ++e) {
        const size_t o = (rb + tg * TPT + e) * 1024 + h * 64 + k;
        rr[e] = Aq[o]; rk[e] = Akk[o]; ra[e] = Aa[o]; rl[e] = Ald[o];
      }
#pragma unroll
      for (int e2 = 0; e2 < TPT / 2; ++e2) {
        float qq[2], ka[2], kq[2], bq[2];
#pragma unroll
        for (int u = 0; u < 2; ++u) {
          const int e = e2 * 2 + u;
          const float r = bf2f(rr[e]), kr = bf2f(rk[e]), av = bf2f(ra[e]), l = bf2f(rl[e]);
          const float kk = kr * k_k;
          const float inv = rsqrtf(fmaxf(wsum(kk * kk), 1e-24f));
          qq[u] = r; ka[u] = kk * inv; kq[u] = kr * (1.f + (av - 1.f) * k_a); bq[u] = ka[u] * av; ldv[e] = l;
          const float bo = wsum(r * kq[u] * r_k);
          if (lane == 0) sm[(rb + tg * TPT + e) * 16 + h] = bo;
          run += l; lg[e] = run;
        }
        qP[e2] = pack2(qq[0], qq[1]); kapP[e2] = pack2(ka[0], ka[1]); ktP[e2] = pack2(kq[0], kq[1]); bvP[e2] = pack2(bq[0], bq[1]);
        asm volatile("" : "+v"(qP[e2]), "+v"(kapP[e2]), "+v"(ktP[e2]), "+v"(bvP[e2]));
      }
      tot[tg * 128 + k] = run;
    } else if constexpr (TYPE == 1) {
      float w2[16];
#pragma unroll
      for (int i = 0; i < 16; ++i) w2[i] = PIN(30)[i * 512 + h * 128 + k];
      const float ba = PIN(31)[h * 128 + k];
      bf16 rq[TPT], rk[TPT];
#pragma unroll
      for (int e = 0; e < TPT; ++e) { const size_t row = rb + tg * TPT + e; rq[e] = Aq[row * 512 + h * 128 + k]; rk[e] = Akk[row * 512 + h * 128 + k]; }
      float4 ar[TPT][4];
      float run = 0.f;
#pragma unroll
      for (int e = 0; e < TPT; e += 4) {
#pragma unroll
        for (int u = 0; u < 4; ++u)
#pragma unroll
          for (int q4 = 0; q4 < 4; ++q4) ar[e + u][q4] = *(const float4*)(sm + (rb + tg * TPT + e + u) * 16 + q4 * 4);
#pragma unroll
        for (int u = 0; u < 4; ++u) {
          float s = ba;
#pragma unroll
          for (int q4 = 0; q4 < 4; ++q4) { const float4 a4 = ar[e + u][q4]; s += a4.x * w2[q4 * 4] + a4.y * w2[q4 * 4 + 1] + a4.z * w2[q4 * 4 + 2] + a4.w * w2[q4 * 4 + 3]; }
          const float gk = (fminf(s, 0.f) - log1pf(__expf(-fabsf(s)))) * (1.f / 16.f);
          run += gk; lgL[(tg * TPT + e + u) * 128 + k] = run;
        }
      }
#pragma unroll
      for (int e2 = 0; e2 < TPT / 2; ++e2) {
        qP[e2] = (unsigned)rq[2 * e2] | ((unsigned)rq[2 * e2 + 1] << 16);
        ktP[e2] = (unsigned)rk[2 * e2] | ((unsigned)rk[2 * e2 + 1] << 16);
        asm volatile("" : "+v"(qP[e2]), "+v"(ktP[e2]));
      }
      tot[tg * 128 + k] = run;
    } else {
      bf16 rq[TPT], rk[TPT];
#pragma unroll
      for (int e = 0; e < TPT; ++e) { const size_t o = (rb + tg * TPT + e) * 1024 + h * 128 + k; rq[e] = Aq[o]; rk[e] = Akk[o]; }
#pragma unroll
      for (int e2 = 0; e2 < TPT / 2; ++e2) {
        qP[e2] = (unsigned)rq[2 * e2] | ((unsigned)rq[2 * e2 + 1] << 16);
        ktP[e2] = (unsigned)rk[2 * e2] | ((unsigned)rk[2 * e2 + 1] << 16);
        asm volatile("" : "+v"(qP[e2]), "+v"(ktP[e2]));
      }
    }
    __syncthreads();
    float lgC;
    if constexpr (TYPE == 2) { lgC = sc_lg[63]; }
    else {
      float off = 0.f, all = 0.f;
#pragma unroll
      for (int g2 = 0; g2 < KT; ++g2) { const float tv = tot[g2 * 128 + k]; all += tv; if (g2 < tg) off += tv; }
      if constexpr (TYPE == 0) {
#pragma unroll
        for (int e = 0; e < TPT; ++e) lg[e] += off;
      } else {
#pragma unroll
        for (int e = 0; e < TPT; ++e) lgL[(tg * TPT + e) * 128 + k] += off;
      }
      lgC = all;
    }
#define QV(e) GETP(qP, e)
#define LGV(e, t) ((TYPE == 2) ? sc_lg[t] : ((TYPE == 1) ? lgL[(t) * 128 + k] : lg[(TYPE == 0) ? (e) : 0]))
#define LPREV(e, t) ((TYPE == 0) ? (lg[(TYPE == 0) ? (e) : 0] - ldv[(TYPE == 0) ? (e) : 0]) : (sc_lg[t] - sc_g[t]))
#define KTV(e, t) ((TYPE == 2) ? (sc_beta[t] * GETP(ktP, e)) : GETP(ktP, e))
#define KAPV(e, t) ((TYPE == 2) ? GETP(ktP, e) : GETP(kapP, (TYPE == 0) ? (e) : 0))
#define BVV(e, t) ((TYPE == 2) ? (sc_beta[t] * sc_eg[t] * GETP(ktP, e)) : GETP(bvP, (TYPE == 0) ? (e) : 0))
    f32x4 sacc[LOW ? 4 : 1][4];
#pragma unroll
    for (int a = 0; a < (LOW ? 4 : 1); ++a) zero4(sacc[a]);
#pragma unroll
    for (int kh = 0; kh < DKH; ++kh) {
      if (k / 64 == kh) {
        const int kk = k & 63;
#pragma unroll
        for (int e = 0; e < TPT; ++e) {
          const int t = tg * TPT + e;
          if constexpr (TYPE == 2) {
            X0[t * 72 + kk] = f2bf(QV(e)); Y0[t * 72 + kk] = f2bf(KTV(e, t));
            X1[t * 72 + kk] = f2bf(KAPV(e, t)); Y1[t * 72 + kk] = f2bf(BVV(e, t));
          } else {
            const float lgt = LGV(e, t);
            const float el = __expf(lgt), eml = __expf(-lgt);
            X0[t * 72 + kk] = f2bf(QV(e) * el);
            Y0[t * 72 + kk] = f2bf(KTV(e, t) * eml);
            if constexpr (LOW) {
              X1[t * 72 + kk] = f2bf(KAPV(e, t) * __expf(LPREV(e, t)));
              Y1[t * 72 + kk] = f2bf(BVV(e, t) * eml);
            }
          }
        }
      }
      __syncthreads();
      mm_strip(X0, Y0, sacc[0], wave, lane);
      if constexpr (LOW) { mm_strip(X0, Y1, sacc[1], wave, lane); mm_strip(X1, Y0, sacc[2], wave, lane); mm_strip(X1, Y1, sacc[3], wave, lane); }
      __syncthreads();
    }
#pragma unroll
    for (int nb = 0; nb < 4; ++nb)
#pragma unroll
      for (int jj = 0; jj < 4; ++jj) {
        const int t = wave * 16 + quad * 4 + jj, s = nb * 16 + lr;
        float da = 1.f, dl = 1.f;
        if constexpr (TYPE == 2) { const float dd = sc_lg[t] - sc_lg[s]; da = __expf(fminf(dd, 0.f)); dl = __expf(fminf(dd - sc_g[t], 0.f)); }
        Ak[t * 72 + s] = f2bf(s <= t ? sacc[0][nb][jj] * da : 0.f);
        if constexpr (LOW) {
          nAb[t * 72 + s] = f2bf(s <= t ? -sacc[1][nb][jj] * da : 0.f);
          LkT[s * 72 + t] = f2bf(s < t ? sacc[2][nb][jj] * dl : 0.f);
          Lb[t * 64 + (s & 3) * 16 + (s >> 2)] = s < t ? sacc[3][nb][jj] * dl : 0.f;
        }
      }
    __syncthreads();
    f32x4 acc[4];
    if constexpr (LOW) {
      {
        const int q = lane & 3, jc = wave * 16 + (lane >> 2);
        float xr[16];
#pragma unroll
        for (int i = 0; i < 16; ++i) xr[i] = 0.f;
#pragma unroll
        for (int t = 0; t < 64; ++t) {
          float s = 0.f, s2 = 0.f, s3 = 0.f, s4 = 0.f;
          const float* Lr = Lb + t * 64 + q * 16;
#pragma unroll
          for (int i = 0; i < (t + 3) / 4; ++i) { if ((i & 3) == 0) s += Lr[i] * xr[i]; else if ((i & 3) == 1) s2 += Lr[i] * xr[i]; else if ((i & 3) == 2) s3 += Lr[i] * xr[i]; else s4 += Lr[i] * xr[i]; }
          s = (s + s2) + (s3 + s4);
          s = rsum4(s);
          s = ((t == jc) ? 1.f : 0.f) - s;
          xr[t >> 2] = (q == (t & 3)) ? s : xr[t >> 2];
          if (q == 0) Tt[t * 72 + jc] = f2bf(s);
        }
      }
      __syncthreads();
      zero4(acc); mm_strip(Tt, LkT, acc, wave, lane);
#pragma unroll
      for (int nb = 0; nb < 4; ++nb)
#pragma unroll
        for (int jj = 0; jj < 4; ++jj) M1[(wave * 16 + quad * 4 + jj) * 72 + nb * 16 + lr] = f2bf(acc[nb][jj]);
      __syncthreads();
    }
#pragma unroll
    for (int vh = 0; vh < DVH; ++vh) {
#pragma unroll
      for (int e = 0; e < 8; ++e) *(unsigned*)(St1 + vv * 72 + tgv * 16 + 2 * e) = vP[vh][e];
      __syncthreads();
      if constexpr (LOW) {
        zero4(acc); mm_strip(M1, St1, acc, wave, lane);
#pragma unroll
        for (int nb = 0; nb < 4; ++nb)
#pragma unroll
          for (int jj = 0; jj < 4; ++jj) {
            const int t = wave * 16 + quad * 4 + jj, col = nb * 16 + lr; const bf16 u = f2bf(acc[nb][jj]);
            St2[col * 72 + t] = u;
          }
#pragma unroll
        for (int nb = 0; nb < 4; ++nb)
          *(uint2*)(Ou0 + (((((size_t)c * NH + h) * (DV / 16) + vh * 4 + nb) * 4 + wave) * 64 + lane) * 4) = make_uint2(pack2(acc[nb][0], acc[nb][1]), pack2(acc[nb][2], acc[nb][3]));
        __syncthreads();
      }
      zero4(acc); mm_strip(Ak, St1, acc, wave, lane);
      if constexpr (LOW) mm_strip(nAb, St2, acc, wave, lane);
#pragma unroll
      for (int nb = 0; nb < 4; ++nb)
        *(uint2*)(Ool + (((((size_t)c * NH + h) * (DV / 16) + vh * 4 + nb) * 4 + wave) * 64 + lane) * 4) = make_uint2(pack2(acc[nb][0], acc[nb][1]), pack2(acc[nb][2], acc[nb][3]));
      __syncthreads();
    }
    if constexpr (LOW) {
#pragma unroll
      for (int kh = 0; kh < DKH; ++kh) {
        if (k / 64 == kh) {
          const int kk = k & 63;
#pragma unroll
          for (int e = 0; e < TPT; ++e) {
            const int t = tg * TPT + e;
            St1[kk * 72 + t] = f2bf(KAPV(e, t) * __expf(LPREV(e, t)));
            LkT[t * 72 + kk] = f2bf(QV(e) * __expf(LGV(e, t)));
            }
        }
        __syncthreads();
        zero4(acc); mm_strip(Tt, St1, acc, wave, lane);
#pragma unroll
        for (int nb = 0; nb < 4; ++nb)
#pragma unroll
          for (int jj = 0; jj < 4; ++jj) {
            const int t = wave * 16 + quad * 4 + jj, col = nb * 16 + lr; const bf16 u = f2bf(acc[nb][jj]);
            St2[col * 72 + t] = u;
            Ow[(rb + t) * 1024 + h * DK + perm32(kh * 64 + col)] = u;
          }
        __syncthreads();
        zero4(acc); mm_strip(nAb, St2, acc, wave, lane);
#pragma unroll
        for (int nb = 0; nb < 4; ++nb)
#pragma unroll
          for (int jj = 0; jj < 4; ++jj) {
            const int t = wave * 16 + quad * 4 + jj, col = nb * 16 + lr;
            Oq[(rb + t) * LDQ + h * DK + perm32(kh * 64 + col)] = f2bf(acc[nb][jj] + bf2f(LkT[t * 72 + col]));
          }
        __syncthreads();
      }
    } else {
#pragma unroll
      for (int e = 0; e < TPT; ++e) { Oq[(rb + tg * TPT + e) * LDQ + h * DK + perm32(k)] = f2bf(QV(e) * __expf(LGV(e, tg * TPT + e))); }
    }
    {
      unsigned wk[TPT / 2], wb[LOW ? TPT / 2 : 1];
#pragma unroll
      for (int e = 0; e < TPT; e += 2) {
        const int t0 = tg * TPT + e;
        const float d0 = __expf(lgC - LGV(e, t0)), d1 = __expf(lgC - LGV(e + 1, t0 + 1));
        wk[e / 2] = pack2(KTV(e, t0) * d0, KTV(e + 1, t0 + 1) * d1);
        if constexpr (LOW) wb[e / 2] = pack2(BVV(e, t0) * d0, BVV(e + 1, t0 + 1) * d1);
      }
      const size_t co = rb * LDQ + h * DK + cont_off<DK>(k, tg * TPT, LDQ);
#pragma unroll
      for (int e = 0; e < TPT / 8; ++e) {
        *(uint4*)(Okt + co + e * 8) = make_uint4(wk[e * 4], wk[e * 4 + 1], wk[e * 4 + 2], wk[e * 4 + 3]);
        if constexpr (LOW) {
#pragma unroll
          for (int g4 = 0; g4 < 2; ++g4) {
            const int s0 = tg * TPT + e * 8 + g4 * 4;
            *(uint2*)(Obt + rb * 1024 + h * DK + cont_off<DK>(k, perm32(s0), 1024)) = make_uint2(wb[e * 4 + g4 * 2], wb[e * 4 + g4 * 2 + 1]);
          }
        }
      }
#pragma unroll
      for (int vh = 0; vh < DVH; ++vh) {
        const unsigned* wv = vP[vh];
        const size_t vo = rb * 1024 + h * DV + cont_off<DV>(vh * 64 + vv, tgv * 16, 1024);
        *(uint4*)(Ovt + vo) = make_uint4(wv[0], wv[1], wv[2], wv[3]);
        *(uint4*)(Ovt + vo + 8) = make_uint4(wv[4], wv[5], wv[6], wv[7]);
      }
      if (tg == 0) gam[((size_t)c * NH + h) * DK + k] = __expf(lgC);
    }
    __syncthreads();
  }
}

template <int TYPE>
DEVI void phase_seq2(const P& p, int j, char* smem) {
  constexpr int NH = TYPE == 0 ? 16 : (TYPE == 1 ? 4 : 8);
  constexpr int DK = TYPE == 0 ? 64 : 128;
  constexpr int DV = TYPE == 0 ? 64 : (TYPE == 1 ? 256 : 128);
  constexpr bool LOW = TYPE != 1;
  constexpr int NVB = DV / 16, MB = DK / 16, KS = DK / 32, NG = NVB / 4, BIPS = NH * NG;
  constexpr int LDQ = TYPE == 1 ? 512 : 1024;
  constexpr int NOP = LOW ? 4 : 2, RS = DK + 8, OPSZ = 64 * RS, PPR = DK / 8;
  constexpr int PPO = 64 * PPR / 256;
  constexpr int PF = 4;
  bf16* L = (bf16*)smem;
  const int tid = threadIdx.x, lane = tid & 63, wave = tid >> 6, lr = lane & 15, quad = lane >> 4;
  const bf16 *Qp, *Kt, *Vt, *Wp = nullptr, *Bt = nullptr, *U0 = nullptr; bf16* Ol;
  if (TYPE == 0) { Qp = slot(p, 5); Kt = slot(p, 6); Vt = slot(p, 7); Wp = slot(p, 2); Bt = slot(p, 3); Ol = slot(p, 0); U0 = slot(p, 1); }
  else if (TYPE == 1) { Qp = slot(p, 1); Kt = slot(p, 1) + (size_t)MT * 512; Vt = slot(p, 2); Ol = slot(p, 4); }
  else { Qp = slot(p, 5); Kt = slot(p, 6); Vt = slot(p, 7); Wp = slot(p, 1); Bt = slot(p, 2); Ol = slot(p, 3); U0 = slot(p, 0); }
  const float* gam = (const float*)(PWS + WS_GAM);
  unsigned tsink = 0;
  const bool split = (int)gridDim.x > 2 * BIPS;
  const int bstart = !split ? (int)blockIdx.x : ((int)blockIdx.x < BIPS ? (int)blockIdx.x : BIPS + ((int)blockIdx.x - BIPS));
  const int bstep = !split ? (int)gridDim.x : ((int)blockIdx.x < BIPS ? (1 << 30) : ((int)gridDim.x - BIPS));
  for (int bitem = bstart; bitem < 33 * BIPS; bitem += bstep) {
    const int seq = bitem / BIPS, rem = bitem % BIPS, h = rem / NG, vb = (rem % NG) * 4 + wave;
    const int c0 = seq == 0 ? 0 : NPCH + seq - 1, nc = seq == 0 ? NPCH : 1;
    const int vcol = vb * 16 + lr;
    f32x4 H[MB];
    if (seq == 0) {
#pragma unroll
      for (int m = 0; m < MB; ++m) H[m] = (f32x4){0.f, 0.f, 0.f, 0.f};
    } else {
      const int b = seq - 1;
      if (TYPE == 0) {
        const float* S = PIN(3) + (((size_t)j * NSS + b) * 16 + h) * 4096 + (size_t)vcol * 64;
#pragma unroll
        for (int m = 0; m < MB; ++m) { float4 v = *(const float4*)(S + m * 16 + quad * 4); H[m] = (f32x4){v.x, v.y, v.z, v.w}; }
      } else {
        const float* S = PIN(TYPE == 1 ? 4 : 6) + ((size_t)b * NH + h) * DK * DV + vcol;
#pragma unroll
        for (int m = 0; m < MB; ++m)
#pragma unroll
          for (int jj = 0; jj < 4; ++jj) H[m][jj] = S[(size_t)(m * 16 + quad * 4 + jj) * DV];
      }
    }
    u32x4 preA[NOP * PPO], preB[NOP * PPO]; u32x2 poA[4], poB[4], puA[4], puB[4]; bf16x8 pvA[2], pvB[2]; f32x4 pgA[MB], pgB[MB];
    auto issue_sh = [&](int cc, u32x4 (&pre)[NOP * PPO]) {
      const size_t rb_ = (size_t)cc * 64; int tl_ = threadIdx.x; asm volatile("" : "+v"(tl_));
#pragma unroll
      for (int i_ = 0; i_ < PPO; ++i_) { const int w_ = tl_ + 256 * i_; const size_t r_ = rb_ + w_ / PPR; const int c8_ = (w_ % PPR) * 8;
        pre[0 * PPO + i_] = *(const u32x4*)(Qp + r_ * LDQ + h * DK + c8_);
        pre[1 * PPO + i_] = *(const u32x4*)(Kt + r_ * LDQ + h * DK + c8_);
        if constexpr (LOW) { pre[2 * PPO + i_] = *(const u32x4*)(Wp + r_ * 1024 + h * DK + c8_); pre[3 * PPO + i_] = *(const u32x4*)(Bt + r_ * 1024 + h * DK + c8_); } }
    };
    auto issue_pr = [&](int cc, u32x2 (&p_o)[4], u32x2 (&p_u)[4], bf16x8 (&p_v)[2], f32x4 (&p_g)[MB]) {
      const size_t rb_ = (size_t)cc * 64; int tl_ = threadIdx.x; asm volatile("" : "+v"(tl_));
      const int lane = tl_ & 63, lr = lane & 15, quad = lane >> 4, vcol = vb * 16 + lr;
      const size_t fo_ = ((((size_t)cc * NH + h) * NVB + vb) * 4) * 256 + lane * 4;
#pragma unroll
      for (int tb_ = 0; tb_ < 4; ++tb_) { p_o[tb_] = *(const u32x2*)(Ol + fo_ + tb_ * 256); if constexpr (LOW) p_u[tb_] = *(const u32x2*)(U0 + fo_ + tb_ * 256); }
#pragma unroll
      for (int ks_ = 0; ks_ < 2; ++ks_) p_v[ks_] = *(const bf16x8*)(Vt + rb_ * 1024 + h * DV + cont_off<DV>(vcol, ks_ * 32 + quad * 8, 1024));
#pragma unroll
      for (int m_ = 0; m_ < MB; ++m_) p_g[m_] = *(const f32x4*)(gam + ((size_t)cc * NH + h) * DK + m_ * 16 + quad * 4);
    };
    const int cend = c0 + nc;
    auto step = [&](int c, u32x4 (&pre)[NOP * PPO], u32x2 (&p_o)[4], u32x2 (&p_u)[4], bf16x8 (&p_v)[2], f32x4 (&p_g)[MB]) {
#pragma unroll
      for (int o = 0; o < NOP; ++o)
#pragma unroll
        for (int i = 0; i < PPO; ++i) { const int w = tid + 256 * i; *(u32x4*)(L + o * OPSZ + (w / PPR) * RS + (w % PPR) * 8) = pre[o * PPO + i]; }
      __syncthreads();
      if (c + 2 < cend) issue_sh(c + 2, pre);
      unsigned tv[NOP * DK / 128 + 1];
#pragma unroll
      for (int i = 0; i < NOP * DK / 128 + 1; ++i) tv[i] = 0;
      if (false && c + PF < cend) {
        const size_t rb2 = (size_t)(c + PF) * 64;
        if (DK == 128 || tid < 128) {
          const int li = (DK == 128) ? tid : tid; const size_t ro = li / (DK / 64) % 64; const int co = (li % (DK / 64)) * 64;
          const int half = (DK == 128) ? (tid >> 7) : (tid >> 6);
          if (half == 0) { tv[0] = *(const unsigned*)(Qp + (rb2 + ro) * LDQ + h * DK + co); if constexpr (LOW) tv[1] = *(const unsigned*)(Wp + (rb2 + ro) * 1024 + h * DK + co); }
          else { tv[0] = *(const unsigned*)(Kt + (rb2 + ro) * LDQ + h * DK + co); if constexpr (LOW) tv[1] = *(const unsigned*)(Bt + (rb2 + ro) * 1024 + h * DK + co); }
        }
        {
          const size_t fo2 = ((((size_t)(c + PF) * NH + h) * NVB + vb) * 4) * 256;
          const unsigned* tp;
          if (lane < 16) tp = (const unsigned*)(Ol + fo2 + lane * 64);
          else if (LOW && lane < 32) tp = (const unsigned*)(U0 + fo2 + (lane - 16) * 64);
          else if (lane < 48) tp = (const unsigned*)(Vt + rb2 * 1024 + h * DV + cont_off<DV>(vb * 16 + (lane & 15), 0, 1024));
          else tp = (const unsigned*)(gam + ((size_t)(c + PF) * NH + h) * DK + ((lane - 48) & (DK / 32 - 1)) * 32);
          tv[NOP * DK / 128] = *tp;
        }
      }
      bf16x8 hb[KS];
#pragma unroll
      for (int ks = 0; ks < KS; ++ks) {
        const u32x4 hw = {pack2(H[2 * ks][0], H[2 * ks][1]), pack2(H[2 * ks][2], H[2 * ks][3]), pack2(H[2 * ks + 1][0], H[2 * ks + 1][1]), pack2(H[2 * ks + 1][2], H[2 * ks + 1][3])};
        hb[ks] = __builtin_bit_cast(bf16x8, hw);
      }
      const size_t fo = ((((size_t)c * NH + h) * NVB + vb) * 4) * 256 + lane * 4;
      f32x4 U[4];
#pragma unroll
      for (int tb = 0; tb < 4; ++tb) {
        f32x4 o_ = (f32x4){bf2f(p_o[tb].x & 0xffff), bf2f(p_o[tb].x >> 16), bf2f(p_o[tb].y & 0xffff), bf2f(p_o[tb].y >> 16)}, u_;
        if constexpr (LOW) u_ = (f32x4){bf2f(p_u[tb].x & 0xffff), bf2f(p_u[tb].x >> 16), bf2f(p_u[tb].y & 0xffff), bf2f(p_u[tb].y >> 16)};
#pragma unroll
        for (int ks = 0; ks < KS; ++ks) {
          o_ = __builtin_amdgcn_mfma_f32_16x16x32_bf16(*(const bf16x8*)(L + 0 * OPSZ + (tb * 16 + lr) * RS + ks * 32 + quad * 8), hb[ks], o_, 0, 0, 0);
          if constexpr (LOW) u_ = __builtin_amdgcn_mfma_f32_16x16x32_bf16(*(const bf16x8*)(L + 2 * OPSZ + (tb * 16 + lr) * RS + ks * 32 + quad * 8), hb[ks], u_, 0, 0, 0);
        }
        *(u32x2*)(Ol + fo + tb * 256) = (u32x2){pack2(o_[0], o_[1]), pack2(o_[2], o_[3])};
        if constexpr (LOW) U[tb] = u_;
      }
      bf16x8 ubop[2];
      if constexpr (LOW) {
#pragma unroll
        for (int ks = 0; ks < 2; ++ks) {
          const u32x4 uw = {pack2(-U[2 * ks][0], -U[2 * ks][1]), pack2(-U[2 * ks][2], -U[2 * ks][3]), pack2(-U[2 * ks + 1][0], -U[2 * ks + 1][1]), pack2(-U[2 * ks + 1][2], -U[2 * ks + 1][3])};
          ubop[ks] = __builtin_bit_cast(bf16x8, uw);
        }
      }
#pragma unroll
      for (int m = 0; m < MB; ++m) {
        f32x4 hn = (f32x4){H[m][0] * p_g[m][0], H[m][1] * p_g[m][1], H[m][2] * p_g[m][2], H[m][3] * p_g[m][3]};
        const int krow = m * 16 + lr;
#pragma unroll
        for (int ks = 0; ks < 2; ++ks) {
          const int i1 = krow * 64 + ks * 32 + quad * 8;
          bf16x8 a = *(const bf16x8*)(L + 1 * OPSZ + (i1 / DK) * RS + (i1 % DK));
          hn = __builtin_amdgcn_mfma_f32_16x16x32_bf16(a, p_v[ks], hn, 0, 0, 0);
          if constexpr (LOW) {
            hn = __builtin_amdgcn_mfma_f32_16x16x32_bf16(*(const bf16x8*)(L + 3 * OPSZ + (i1 / DK) * RS + (i1 % DK)), ubop[ks], hn, 0, 0, 0);
          }
        }
        H[m] = hn;
      }
#pragma unroll
      for (int i = 0; i < NOP * DK / 128 + 1; ++i) tsink ^= tv[i];
      if (c + 2 < cend) issue_pr(c + 2, p_o, p_u, p_v, p_g);
      __syncthreads();
    };
    issue_sh(c0, preA); issue_pr(c0, poA, puA, pvA, pgA);
    if (nc > 1) { issue_sh(c0 + 1, preB); issue_pr(c0 + 1, poB, puB, pvB, pgB); }
    for (int c = c0; c < cend; c += 2) { step(c, preA, poA, puA, pvA, pgA); if (c + 1 < cend) step(c + 1, preB, poB, puB, pvB, pgB); }
    if (TYPE == 0) {
      float* S = POUT + (seq == 0 ? O_AWKV_P + ((size_t)j * 16 + h) * 4096 : O_AWKV_S + (((size_t)j * NSS + (seq - 1)) * 16 + h) * 4096) + (size_t)vcol * 64;
#pragma unroll
      for (int m = 0; m < MB; ++m) *(float4*)(S + m * 16 + quad * 4) = make_float4(H[m][0], H[m][1], H[m][2], H[m][3]);
    } else {
      const size_t ob = TYPE == 1 ? (seq == 0 ? O_BKV_P : O_BKV_S + (size_t)(seq - 1) * NH * DK * DV)
                                  : (seq == 0 ? O_CKV_P : O_CKV_S + (size_t)(seq - 1) * NH * DK * DV);
      float* S = POUT + ob + (size_t)h * DK * DV + vcol;
#pragma unroll
      for (int m = 0; m < MB; ++m)
#pragma unroll
        for (int jj = 0; jj < 4; ++jj) S[(size_t)(m * 16 + quad * 4 + jj) * DV] = H[m][jj];
    }
  }
  if (tsink == 0x9e3779b9u) ((unsigned*)(PWS + WS_SINK))[0] = tsink;
}

template <int TYPE>
DEVI void phase_post(const P& p, int j, char* smem) {
  constexpr int NH = TYPE == 0 ? 16 : (TYPE == 1 ? 4 : 8);
  constexpr int DV = TYPE == 0 ? 64 : (TYPE == 1 ? 256 : 128);
  constexpr int CPT = DV / 8;
  bf16* vt = (bf16*)smem;
  bf16* ot = (bf16*)(smem + 9216);
  const bf16* O = slot(p, TYPE == 0 ? 0 : (TYPE == 1 ? 4 : 3));
  const bf16* G = slot(p, TYPE == 0 ? 4 : (TYPE == 1 ? 3 : 4));
  bf16* og = slot(p, TYPE == 1 ? 0 : 1);
  const float* sm = (const float*)(PWS + WS_SM);
  for (int item = blockIdx.x; item < NCHUNK * NH; item += gridDim.x) {
    const int c = item / NH, h = item % NH; const size_t rb = (size_t)c * 64;
    int tid = threadIdx.x; asm volatile("" : "+v"(tid));
    const int part = tid & 7;
    if constexpr (TYPE == 0) {
      const bf16* V = slot(p, 7) + rb * 1024 + h * 64;
      const int r = tid >> 2, q4 = (tid & 3) * 16;
      *(uint4*)(vt + r * 72 + q4) = *(const uint4*)(V + (size_t)r * 1024 + q4);
      *(uint4*)(vt + r * 72 + q4 + 8) = *(const uint4*)(V + (size_t)r * 1024 + q4 + 8);
      __syncthreads();
    }
    {
      const uint4* srcp = (const uint4*)(O + ((size_t)c * NH + h) * 64 * DV);
#pragma unroll
      for (int i = 0; i < DV / 32; ++i) *(uint4*)(ot + (size_t)(i * 256 + tid) * 8) = srcp[i * 256 + tid];
      __syncthreads();
    }
#pragma unroll 1
    for (int pass = 0; pass < 2; ++pass) {
      const int t = pass * 32 + (tid >> 3);
      const size_t base = (rb + t) * 1024 + h * DV + part * CPT;
      float o[CPT];
#pragma unroll
      for (int e = 0; e < CPT; ++e) {
        const int v = part * CPT + e;
        o[e] = bf2f(ot[(((v >> 4) * 4 + (t >> 4)) * 64 + ((t & 15) >> 2) * 16 + (v & 15)) * 4 + (t & 3)]);
      }
      float s1 = 0.f, s2 = 0.f;
#pragma unroll
      for (int e = 0; e < CPT; ++e) { s1 += o[e]; s2 += o[e] * o[e]; }
      s1 = rsum8(s1); s2 = rsum8(s2);
      if constexpr (TYPE == 0) {
        const float mean = s1 * (1.f / 64.f); float var = s2 * (1.f / 64.f) - mean * mean; var = fmaxf(var, 0.f);
        const float rs = rsqrtf(var + 64e-5f); const float bonus = sm[(rb + t) * 16 + h];
        const float* lw = PIN(26) + j * 1024 + h * 64 + part * CPT; const float* lb = PIN(27) + j * 1024 + h * 64 + part * CPT;
#pragma unroll
        for (int e = 0; e < CPT; ++e) {
          const float vv = bf2f(vt[(part * CPT + e) * 72 + t]);
          o[e] = (o[e] - mean) * rs * lw[e] + lb[e] + bonus * vv;
        }
      } else {
        const float rs = rsqrtf(s2 * (1.f / DV) + 1e-6f);
        const float* on = PIN(TYPE == 1 ? 32 : 38) + part * CPT;
#pragma unroll
        for (int e = 0; e < CPT; ++e) o[e] = o[e] * rs * on[e];
      }
#pragma unroll
      for (int e = 0; e < CPT; e += 8) {
        uint4 u = *(const uint4*)(G + base + e);
        const unsigned w[4] = {u.x, u.y, u.z, u.w}; unsigned ow[4];
#pragma unroll
        for (int i = 0; i < 4; ++i) {
          float g0 = bf2f(w[i] & 0xffff), g1 = bf2f(w[i] >> 16);
          if constexpr (TYPE != 0) { g0 = silu(g0); g1 = silu(g1); }
          ow[i] = pack2(o[e + 2 * i] * g0, o[e + 2 * i + 1] * g1);
        }
        *(uint4*)(og + base + e) = make_uint4(ow[0], ow[1], ow[2], ow[3]);
      }
    }
    __syncthreads();
  }
}


#define XB_TMO      128
#define XB_XCNT(j)  (256  + 64 * (j))
#define XB_XSUB(j)  (1280 + 64 * (j))
#define XB_XGEN(j)  (2304 + 64 * (j))
#define XB_TOP      3328
#define XB_TOPGEN   3392
#define XCD_BAR_WORDS 3456
#define XB_SPIN_CAP (1u << 18)
#define LAS __attribute__((address_space(3)))
DEVI unsigned xb_ld(unsigned* p)              { return __hip_atomic_load(p, __ATOMIC_RELAXED, __HIP_MEMORY_SCOPE_AGENT); }
DEVI unsigned xb_add(unsigned* p, unsigned v) { return __hip_atomic_fetch_add(p, v, __ATOMIC_RELAXED, __HIP_MEMORY_SCOPE_AGENT); }
DEVI unsigned xb_xcc_id() { return (unsigned)__builtin_amdgcn_s_getreg((3 << 11) | 20) & 0xFu; }
#define XB_SPIN(cond, bar) do { unsigned _sp = 0; while (cond) { __builtin_amdgcn_s_sleep(1); \
    if ((++_sp & 255u) == 0u) { if (xb_ld(&(bar)[XB_TMO])) break; if (_sp > XB_SPIN_CAP) { atomicAdd(&(bar)[XB_TMO], 1u); break; } } } } while (0)
struct XcdBarrier { unsigned* bar; unsigned x; volatile LAS unsigned* st; };
DEVI XcdBarrier xcd_barrier_post(unsigned* bar, volatile LAS unsigned* st) {
  XcdBarrier b; b.bar = bar; b.x = xb_xcc_id(); b.st = st;
  if (threadIdx.x == 0) (void)xb_add(&bar[XB_XCNT(b.x)], 1u);
  return b;
}
DEVI void xcd_barrier_complete(unsigned* bar, unsigned x, unsigned& nloc, unsigned& nx) {
  const unsigned G = gridDim.x * gridDim.y * gridDim.z;
  unsigned sum, cnt, mine, sp = 0u;
  for (;;) {
    sum = 0u; cnt = 0u; mine = 0u;
#pragma unroll
    for (unsigned j = 0; j < 16; ++j) { const unsigned c = xb_ld(&bar[XB_XCNT(j)]); sum += c; cnt += (c > 0u) ? 1u : 0u; mine = (j == x) ? c : mine; }
    if (sum == G) break;
    __builtin_amdgcn_s_sleep(1);
    if ((++sp & 255u) == 0u) { if (xb_ld(&bar[XB_TMO])) break; if (sp > XB_SPIN_CAP) { atomicAdd(&bar[XB_TMO], 1u); break; } }
  }
  nloc = mine > 0u ? mine : 1u; nx = cnt > 0u ? cnt : 1u;
}
DEVI void xcd_barrier(const XcdBarrier& b) {
  asm volatile("s_waitcnt vmcnt(0)" ::: "memory");
  __syncthreads();
  if (threadIdx.x == 0) {
    unsigned* bar = b.bar;
    __builtin_amdgcn_s_waitcnt(0);
    unsigned nloc = b.st[0], nx = b.st[1];
    if (nloc == 0u) { xcd_barrier_complete(bar, b.x, nloc, nx); b.st[0] = nloc; b.st[1] = nx; }
    const unsigned old = xb_add(&bar[XB_XSUB(b.x)], 1u);
    const unsigned gen = old / nloc;
    if (old + 1u == (gen + 1u) * nloc) {
      __builtin_amdgcn_fence(__ATOMIC_RELEASE, "agent");
      asm volatile("s_waitcnt vmcnt(0)" ::: "memory");
      const unsigned og = xb_add(&bar[XB_TOP], 1u);
      const unsigned tg = og / nx;
      if (og + 1u == (tg + 1u) * nx) xb_add(&bar[XB_TOPGEN], 1u);
      else XB_SPIN(xb_ld(&bar[XB_TOPGEN]) == tg, bar);
      __builtin_amdgcn_fence(__ATOMIC_ACQUIRE, "agent");
      xb_add(&bar[XB_XGEN(b.x)], 1u);
      asm volatile("s_waitcnt vmcnt(0)" ::: "memory");
    } else {
      XB_SPIN(xb_ld(&bar[XB_XGEN(b.x)]) == gen, bar);
      __builtin_amdgcn_fence(__ATOMIC_ACQUIRE, "agent");
      asm volatile("s_waitcnt vmcnt(0)" ::: "memory");
    }
  }
  __syncthreads();
}

#ifndef DISMASK
#define DISMASK 0
#endif
#define EN(b) (!((DISMASK >> (b)) & 1))
#define GSYNC() xcd_barrier(xb)
#define GSYNC_CG() do { asm volatile("s_waitcnt vmcnt(0)" ::: "memory"); grid.sync(); } while (0)
__global__ void __launch_bounds__(256, 1) fwd_megakernel(P p) {
  extern __shared__ __attribute__((aligned(16))) char smem[];
  cg::grid_group grid = cg::this_grid();
  volatile LAS unsigned* xst = (volatile LAS unsigned*)(smem + LDS_BYTES - 16);
  if (threadIdx.x == 0) { xst[0] = 0u; xst[1] = 0u; }
  __syncthreads();
  const XcdBarrier xb = xcd_barrier_post((unsigned*)(PWS + WS_BAR), xst);
  bf16* wreg = (bf16*)(PWS + WS_W);
  bf16 *wfin = wreg + W_FIN, *wfout = wreg + W_FOUT, *wmix = wreg + W_MIX;
  float* sm = (float*)(PWS + WS_SM);
  for (int layer = 0; layer < 4; ++layer) {
    const int type = layer % 3, j = layer / 3;
    int tb = 0;
    if (type == 0) phase_norm<0>(p, layer, j, layer == 0, layer == 0);
    else phase_norm<1>(p, layer, j, false, false);
    conv_job(CvFfnIn{PIN(10) + (size_t)layer * 1024 * 2 * FF}, wfin, 1024, 2 * FF, 1024, tb, smem);
    conv_job(CvPlain{PIN(11) + (size_t)layer * FF * 1024, 1024, 1024}, wfout, FF, 1024, FF, tb, smem);
    if (type == 0) {
      for (int i = 0; i < 3; ++i) conv_job(CvPlain{PIN(24) + ((size_t)j * 3 + i) * 1048576, 1024, 1024}, wmix + (size_t)i * 1048576, 1024, 1024, 1024, tb, smem);
      conv_job(CvLora1{PIN(14) + (size_t)j * 65536, PIN(17) + (size_t)j * 65536, PIN(19) + (size_t)j * 131072, PIN(12) + (size_t)j * 6144}, wmix + 3145728, 2048, 256, 2048, tb, smem);
      conv_job(CvPlain{PIN(15) + (size_t)j * 65536, 1024, 1024}, wmix + 3670016, 64, 1024, 64, tb, smem);
      conv_job(CvPlain{PIN(18) + (size_t)j * 65536, 1024, 1024}, wmix + 3735552, 64, 1024, 64, tb, smem);
      conv_job(CvPlain{PIN(20) + (size_t)j * 131072, 1024, 1024}, wmix + 3801088, 128, 1024, 128, tb, smem);
      conv_job(CvPlain{PIN(25) + (size_t)j * 1048576, 1024, 1024}, wmix + 3932160, 1024, 1024, 1024, tb, smem);
    } else if (type == 1) {
      conv_job(CvGlaIn{PIN(28), PIN(29)}, wmix, 1024, 3200, 1024, tb, smem);
      conv_job(CvPlain{PIN(33), 1024, 1024}, wmix + 3276800, 1024, 1024, 1024, tb, smem);
    } else {
      conv_job(CvPlain{PIN(34), 4112, 4112}, wmix, 1024, 4224, 1024, tb, smem);
      conv_job(CvPlain{PIN(39), 1024, 1024}, wmix + 4325376, 1024, 1024, 1024, tb, smem);
    }
    GSYNC();
    tb = 0;
    const bf16* wo;
    if (type == 0) {
      for (int i = 0; i < 3; ++i)
        gemm_job(GemmDesc{slot(p, 2 + i), nullptr, 1024, 1024, wmix + (size_t)i * 1048576, 1024, 144, 8, 1024}, EpiStore{slot(p, 5 + i), 1024, 1.f}, tb, smem);
      gemm_job(GemmDesc{slot(p, 0), slot(p, 1), 1024, 1024, wmix + 3145728, 2048, 144, 2, 2048}, EpiLora1{(bf16*)(PWS + WS_L1)}, tb, smem);
      GSYNC();
      tb = 0;
      const bf16* l1 = (const bf16*)(PWS + WS_L1);
      gemm_job(GemmDesc{l1, nullptr, 256, 64, wmix + 3670016, 64, 144, 8, 64}, EpiLd{slot(p, 2), PIN(13) + j * 1024}, tb, smem);
      gemm_job(GemmDesc{l1 + 64, nullptr, 256, 64, wmix + 3735552, 64, 144, 8, 64}, EpiSig{slot(p, 3), PIN(16) + j * 1024}, tb, smem);
      gemm_job(GemmDesc{l1 + 128, nullptr, 256, 128, wmix + 3801088, 128, 144, 8, 128}, EpiStore{slot(p, 4), 1024, 1.f}, tb, smem);
      GSYNC();
      if (EN(2)) phase_prep<0>(p, j, smem);
      GSYNC();
      if (EN(5)) phase_seq2<0>(p, j, smem);
      GSYNC();
      if (EN(8)) phase_post<0>(p, j, smem);
      wo = wmix + 3932160;
    } else if (type == 1) {
      gemm_job(GemmDesc{slot(p, 0), nullptr, 1024, 1024, wmix, 1024, 144, 25, 1024},
               EpiGlaIn{slot(p, 1), slot(p, 1) + (size_t)MT * 512, slot(p, 2), slot(p, 3), sm}, tb, smem);
      GSYNC();
      if (EN(3)) phase_prep<1>(p, j, smem);
      GSYNC();
      if (EN(6)) phase_seq2<1>(p, j, smem);
      GSYNC();
      if (EN(8)) phase_post<1>(p, j, smem);
      wo = wmix + 3276800;
    } else {
      gemm_job(GemmDesc{slot(p, 0), nullptr, 1024, 1024, wmix, 1024, 144, 33, 1024},
               EpiGdnIn{slot(p, 1), slot(p, 4), sm, POUT}, tb, smem);
      GSYNC();
      if (EN(9)) phase_gdn_conv(p);
      GSYNC();
      if (EN(4)) phase_prep<2>(p, j, smem);
      GSYNC();
      if (EN(7)) phase_seq2<2>(p, j, smem);
      GSYNC();
      if (EN(8)) phase_post<2>(p, j, smem);
      wo = wmix + 4325376;
    }
    GSYNC();
    tb = 0;
    gemm_job(GemmDesc{slot(p, type == 1 ? 0 : 1), nullptr, 1024, 1024, wo, 1024, 144, 8, 1024}, EpiAcc{POUT}, tb, smem);
    GSYNC();
    phase_rms(POUT, PIN(8) + layer * 1024, slot(p, 0), nullptr);
    GSYNC();
    tb = 0;
    gemm_job(GemmDesc{slot(p, 0), nullptr, 1024, 1024, wfin, 1024, 144, 44, 1024}, EpiSwiglu{slot(p, 1)}, tb, smem);
    GSYNC();
    tb = 0;
    gemm_job(GemmDesc{slot(p, 1), nullptr, FF, FF, wfout, FF, 144, 8, FF}, EpiAcc{POUT}, tb, smem);
    if (layer == 3) GSYNC_CG(); else GSYNC();
  }
  phase_rms(POUT, PIN(9), nullptr, POUT);
}

extern "C" void kernel_launch(void* const* d_in, const int* in_sizes, int n_in, void* d_out, int out_size,
                              void* d_ws, size_t ws_size, hipStream_t stream) {
  if (n_in < 40 || ws_size < WS_TOTAL) { fprintf(stderr, "bad args: n_in %d ws %zu need %zu\n", n_in, ws_size, (size_t)WS_TOTAL); return; }
  static int grid_blocks = 0;
  if (!grid_blocks) {
    int dev = 0, cus = 0, per_cu = 0;
    hipGetDevice(&dev);
    hipDeviceGetAttribute(&cus, hipDeviceAttributeMultiprocessorCount, dev);
    hipFuncSetAttribute((const void*)fwd_megakernel, hipFuncAttributeMaxDynamicSharedMemorySize, LDS_BYTES);
    hipOccupancyMaxActiveBlocksPerMultiprocessor(&per_cu, (const void*)fwd_megakernel, 256, LDS_BYTES);
    if (per_cu > 1) per_cu = 1;
    if (per_cu < 1) per_cu = 1;
    grid_blocks = cus * per_cu;
  }
  hipMemsetAsync((char*)d_ws + WS_BAR, 0, 16384, stream);
  P p{};
  for (int i = 0; i < 40; ++i) p.in[i] = (const float*)d_in[i];
  p.out = (float*)d_out; p.ws = (char*)d_ws;
  void* args[] = {&p};
  hipError_t e = hipLaunchCooperativeKernel((const void*)fwd_megakernel, dim3(grid_blocks), dim3(256), args, LDS_BYTES, stream);
  if (e != hipSuccess) fprintf(stderr, "cooperative launch failed: %s (grid %d)\n", hipGetErrorString(e), grid_blocks);
}
```

```cpp
#include <hip/hip_runtime.h>
#include <hip/hip_cooperative_groups.h>
#include <cstdio>
#include <cstdint>
namespace cg = cooperative_groups;

typedef unsigned short bf16;
typedef __attribute__((ext_vector_type(8))) short bf16x8;
typedef __attribute__((ext_vector_type(4))) short bf16x4;
typedef __attribute__((ext_vector_type(4))) float f32x4;
typedef __attribute__((ext_vector_type(4))) unsigned u32x4;
typedef __attribute__((ext_vector_type(2))) unsigned u32x2;

#define DEVI __device__ __forceinline__

constexpr int Dm = 1024, FF = 2816, MT = 18432, MPR = 16384, NSS = 32, NCHUNK = 288, NPCH = 256;
constexpr size_t SLOT = (size_t)MT * 1024 * 2;
constexpr size_t WS_L1 = 8 * SLOT;
constexpr size_t WS_SM = WS_L1 + (size_t)MT * 256 * 2;
constexpr size_t WS_GAM = WS_SM + (size_t)MT * 16 * 4;
constexpr size_t WS_W = WS_GAM + (size_t)NCHUNK * 1024 * 4;
constexpr size_t W_FIN = 0, W_FOUT = 5767168, W_MIX = 8650752;
constexpr size_t WS_SINK = WS_W + (size_t)14200000 * 2 - 64;
constexpr size_t WS_BAR = WS_W + (size_t)14200000 * 2;
constexpr size_t WS_TOTAL = WS_BAR + 16384;
constexpr int LDS_BYTES = 77824;

constexpr size_t O_ASH_P = 18874368, O_AWKV_P = O_ASH_P + 2048, O_BKV_P = O_AWKV_P + 131072,
                 O_CCONV_P = O_BKV_P + 131072, O_CKV_P = O_CCONV_P + 9216, O_ASH_S = O_CKV_P + 131072,
                 O_AWKV_S = O_ASH_S + 65536, O_BKV_S = O_AWKV_S + 4194304, O_CCONV_S = O_BKV_S + 4194304,
                 O_CKV_S = O_CCONV_S + 294912;

struct P { const float* in[40]; float* out; char* ws; };
typedef const __attribute__((address_space(4))) char* kptr_t;
typedef const float* cfp_t; typedef float* fp_t; typedef char* cp_t;
DEVI kptr_t kbase() { kptr_t b = (kptr_t)__builtin_amdgcn_kernarg_segment_ptr(); asm volatile("" : "+s"(b)); return b; }
#define PIN(i) (*(const __attribute__((address_space(4))) cfp_t*)(kbase() + 8 * (i)))
#define POUT (*(const __attribute__((address_space(4))) fp_t*)(kbase() + 320))
#define PWS (*(const __attribute__((address_space(4))) cp_t*)(kbase() + 328))

typedef __attribute__((ext_vector_type(2))) float f32x2;
typedef __attribute__((ext_vector_type(2))) __bf16 bf16x2v;
DEVI unsigned pack2(float a, float b) { f32x2 v = {a, b}; bf16x2v r = __builtin_convertvector(v, bf16x2v); return __builtin_bit_cast(unsigned, r); }
DEVI bf16 f2bf(float f) { return (bf16)(pack2(f, 0.f) & 0xffffu); }
DEVI float bf2f(bf16 h) { return __uint_as_float(((unsigned)h) << 16); }
template <int CTRL> DEVI float dpp_mov(float v) { return __int_as_float(__builtin_amdgcn_mov_dpp(__float_as_int(v), CTRL, 0xF, 0xF, true)); }
DEVI float rsum4(float v) { v += dpp_mov<0xB1>(v); v += dpp_mov<0x4E>(v); return v; }
DEVI float rsum8(float v) { v = rsum4(v); v += dpp_mov<0x141>(v); return v; }
DEVI float rsum16(float v) { v = rsum8(v); v += dpp_mov<0x140>(v); return v; }
DEVI float wsum(float v) {
  v = rsum16(v);
  const int iv = __float_as_int(v);
  return (__int_as_float(__builtin_amdgcn_readlane(iv, 0)) + __int_as_float(__builtin_amdgcn_readlane(iv, 16))) +
         (__int_as_float(__builtin_amdgcn_readlane(iv, 32)) + __int_as_float(__builtin_amdgcn_readlane(iv, 48)));
}
DEVI float sigm(float x) { return 1.f / (1.f + __expf(-x)); }
DEVI float silu(float x) { return x * sigm(x); }
DEVI float softplus(float x) { return x > 20.f ? x : log1pf(__expf(x)); }
DEVI bf16* slot(const P& p, int i) { return (bf16*)(PWS + (size_t)i * SLOT); }

struct GemmDesc { const bf16* A; const bf16* A2; int lda; int ksplit; const bf16* Bt; int ldb; int tiles_m; int tiles_n; int K; };

template <class Epi>
DEVI void gemm_tile(const GemmDesc& g, int mt, int nt, Epi& epi, char* smem) {
  const int tid = threadIdx.x, lane = tid & 63, wave = tid >> 6;
  const int wm = wave >> 1, wn = wave & 1, lr = lane & 15, quad = lane >> 4;
  bf16* sA = (bf16*)smem;
  bf16* sB = sA + 2 * 8192;
  f32x4 acc[4][4];
#pragma unroll
  for (int i = 0; i < 4; ++i)
#pragma unroll
    for (int j = 0; j < 4; ++j) acc[i][j] = (f32x4){0.f, 0.f, 0.f, 0.f};
  const int m0 = mt * 128, n0 = nt * 128;
  const int r0 = tid >> 3, c0 = tid & 7;
  const size_t aoff = (size_t)(m0 + r0) * g.lda + c0 * 8;
  const bf16* bp = g.Bt + (size_t)(n0 + r0) * g.ldb + c0 * 8;
  const int soff = r0 * 64 + ((c0 ^ (r0 & 7)) << 3);
#define GL1(i_, RA, RB) RA##i_ = *(const u32x4*)(base_ + (size_t)(32 * i_) * g.lda); RB##i_ = *(const u32x4*)(bp + k0_ + (size_t)(32 * i_) * g.ldb);
#define GLOAD(kt_, RA, RB) do { const int k0_ = (kt_) << 6; \
    const bf16* base_ = ((k0_ < g.ksplit) ? (g.A + k0_) : (g.A2 + (k0_ - g.ksplit))) + aoff; \
    GL1(0, RA, RB) GL1(1, RA, RB) GL1(2, RA, RB) GL1(3, RA, RB) } while (0)
#define LS1(buf_, i_, RA, RB) *(u32x4*)(sA + (buf_) * 8192 + soff + i_ * 2048) = RA##i_; *(u32x4*)(sB + (buf_) * 8192 + soff + i_ * 2048) = RB##i_;
#define LSTORE(buf_, RA, RB) do { LS1(buf_, 0, RA, RB) LS1(buf_, 1, RA, RB) LS1(buf_, 2, RA, RB) LS1(buf_, 3, RA, RB) } while (0)
#define GSTEP(kt_, RA, RB) do { const int buf_ = (kt_) & 1; \
    if ((kt_) + 1 < nk) { LSTORE(buf_ ^ 1, RA, RB); if ((kt_) + 3 < nk) GLOAD((kt_) + 3, RA, RB); } \
    const bf16* a_ = sA + buf_ * 8192 + (wm * 64 + lr) * 64; const bf16* b_ = sB + buf_ * 8192 + (wn * 64 + lr) * 64; \
    _Pragma("unroll") for (int ks_ = 0; ks_ < 2; ++ks_) { \
      const int co_ = (((ks_ * 4 + quad) ^ (lr & 7)) << 3); bf16x8 af_[4], bf_[4]; \
      _Pragma("unroll") for (int i_ = 0; i_ < 4; ++i_) { af_[i_] = *(const bf16x8*)(a_ + i_ * 1024 + co_); bf_[i_] = *(const bf16x8*)(b_ + i_ * 1024 + co_); } \
      _Pragma("unroll") for (int i_ = 0; i_ < 4; ++i_) _Pragma("unroll") for (int j_ = 0; j_ < 4; ++j_) \
        acc[i_][j_] = __builtin_amdgcn_mfma_f32_16x16x32_bf16(af_[i_], bf_[j_], acc[i_][j_], 0, 0, 0); } \
    __syncthreads(); } while (0)
  const int nk = g.K >> 6;
  u32x4 pa0, pa1, pa2, pa3, pb0, pb1, pb2, pb3, qa0, qa1, qa2, qa3, qb0, qb1, qb2, qb3;
  qa0 = qa1 = qa2 = qa3 = qb0 = qb1 = qb2 = qb3 = (u32x4){0u, 0u, 0u, 0u};
  GLOAD(0, pa, pb);
  if (nk > 1) GLOAD(1, qa, qb);
  LSTORE(0, pa, pb);
  if (nk > 2) GLOAD(2, pa, pb);
  __syncthreads();
  for (int kt = 0; kt < nk; kt += 2) { GSTEP(kt, qa, qb); if (kt + 1 < nk) GSTEP(kt + 1, pa, pb); }
#pragma unroll
  for (int i = 0; i < 4; ++i) {
#pragma unroll
    for (int jj = 0; jj < 4; ++jj) {
      const int row = m0 + wm * 64 + i * 16 + quad * 4 + jj;
      if constexpr (Epi::PAIR) {
#pragma unroll
        for (int j = 0; j < 4; j += 2) {
          const int nn = n0 + wn * 64 + j * 16;
          epi.pair(row, (nn >> 5) * 16 + lr, acc[i][j][jj], acc[i][j + 1][jj]);
        }
      } else {
#pragma unroll
        for (int j = 0; j < 4; ++j) epi(row, n0 + wn * 64 + j * 16 + lr, acc[i][j][jj]);
      }
    }
  }
}

template <class Epi>
DEVI void gemm_job(const GemmDesc& g, Epi epi, int& tbase, char* smem) {
  const int ntiles = g.tiles_m * g.tiles_n, G = gridDim.x;
  const int first = tbase + (((int)blockIdx.x - tbase % G) + G) % G;
  const int width = 8 * g.tiles_n;
  for (int t = first; t < tbase + ntiles; t += G) {
    const int lt = t - tbase;
    const int grp = lt / width, rem = lt % width;
    gemm_tile(g, grp * 8 + (rem & 7), rem >> 3, epi, smem);
  }
  tbase += ntiles;
}

struct EpiStore { static constexpr bool PAIR = false; bf16* C; int ldc; float sc;
  DEVI void operator()(int r, int c, float v) { C[(size_t)r * ldc + c] = f2bf(v * sc); } };
struct EpiLora1 { static constexpr bool PAIR = false; bf16* C;
  DEVI void operator()(int r, int c, float v) { float o = c < 64 ? tanhf(v) : (c < 128 ? v : sigm(v)); C[(size_t)r * 256 + c] = f2bf(o); } };
struct EpiLd { static constexpr bool PAIR = false; bf16* C; const float* w0;
  DEVI void operator()(int r, int c, float v) { float x = w0[c] + v; float lr_ = -softplus(-x) - 0.5f; C[(size_t)r * 1024 + c] = f2bf(-__expf(lr_)); } };
struct EpiSig { static constexpr bool PAIR = false; bf16* C; const float* a0;
  DEVI void operator()(int r, int c, float v) { C[(size_t)r * 1024 + c] = f2bf(sigm(a0[c] + v)); } };
struct EpiAcc { static constexpr bool PAIR = false; float* X;
  DEVI void operator()(int r, int c, float v) { X[(size_t)r * 1024 + c] += v; } };
struct EpiSwiglu { static constexpr bool PAIR = true; bf16* C;
  DEVI void pair(int r, int c, float gt, float up) { C[(size_t)r * FF + c] = f2bf(silu(gt) * up); } };
struct EpiGlaIn { static constexpr bool PAIR = false; bf16 *q, *k, *v, *gate; float* sm;
  DEVI void operator()(int r, int c, float x) {
    if (c < 512) q[(size_t)r * 512 + c] = f2bf(x * 0.08838834764831845f);
    else if (c < 1024) k[(size_t)r * 512 + c - 512] = f2bf(x);
    else if (c < 2048) v[(size_t)r * 1024 + c - 1024] = f2bf(x);
    else if (c < 3072) gate[(size_t)r * 1024 + c - 2048] = f2bf(x);
    else if (c < 3088) sm[(size_t)r * 16 + c - 3072] = x;
  } };
struct EpiGdnIn { static constexpr bool PAIR = false; bf16 *qkv, *z; float* sm; float* out;
  DEVI void operator()(int r, int c, float x) {
    if (c < 3072) {
      qkv[(size_t)r * 3072 + c] = f2bf(x);
      if (r >= MPR - 3) {
        if (r < MPR) out[O_CCONV_P + (size_t)(r - (MPR - 3)) * 3072 + c] = x;
        else { int tt = (r - MPR) & 63; if (tt >= 61) out[O_CCONV_S + ((size_t)((r - MPR) >> 6) * 3 + (tt - 61)) * 3072 + c] = x; }
      }
    } else if (c < 4096) z[(size_t)r * 1024 + c - 3072] = f2bf(x);
    else if (c < 4112) sm[(size_t)r * 16 + c - 4096] = x;
  } };

template <class F>
DEVI void conv_job(F f, bf16* dst, int ldo, int Nd, int Kd, int& tbase, char* smem) {
  float* tile = (float*)smem;
  const int tn = Nd >> 6, tk = Kd >> 6, ntiles = tn * tk, G = gridDim.x, tid = threadIdx.x;
  const int first = tbase + (((int)blockIdx.x - tbase % G) + G) % G;
  for (int t = first; t < tbase + ntiles; t += G) {
    const int lt = t - tbase, n0 = (lt % tn) << 6, k0 = (lt / tn) << 6;
    const int i = tid >> 4, j4 = (tid & 15) << 2;
#pragma unroll
    for (int r = 0; r < 4; ++r) {
      float4 v = f(k0 + i + 16 * r, n0 + j4);
      float* d = tile + (i + 16 * r) * 65 + j4; d[0] = v.x; d[1] = v.y; d[2] = v.z; d[3] = v.w;
    }
    __syncthreads();
    const int jn = tid >> 2, iq = (tid & 3) << 4;
    unsigned w[8];
#pragma unroll
    for (int e = 0; e < 8; ++e) w[e] = pack2(tile[(iq + 2 * e) * 65 + jn], tile[(iq + 2 * e + 1) * 65 + jn]);
    uint4* o = (uint4*)(dst + (size_t)(n0 + jn) * ldo + k0 + iq);
    o[0] = make_uint4(w[0], w[1], w[2], w[3]); o[1] = make_uint4(w[4], w[5], w[6], w[7]);
    __syncthreads();
  }
  tbase += ntiles;
}
struct CvPlain { const float* W; int ld; int nsrc;
  DEVI float4 operator()(int k, int n) const { return n < nsrc ? *(const float4*)(W + (size_t)k * ld + n) : make_float4(0, 0, 0, 0); } };
struct CvFfnIn { const float* W;
  DEVI float4 operator()(int k, int n) const { int blk = n >> 5, w = n & 31; int src = (w < 16) ? blk * 16 + w : FF + blk * 16 + (w - 16);
    return *(const float4*)(W + (size_t)k * (2 * FF) + src); } };
struct CvLora1 { const float *w1, *a1, *g1, *mu;
  DEVI float4 operator()(int k, int n) const {
    int kk = k & 1023; float4 v; float m;
    if (n < 64) { v = *(const float4*)(w1 + kk * 64 + n); m = mu[1 * 1024 + kk]; }
    else if (n < 128) { v = *(const float4*)(a1 + kk * 64 + n - 64); m = mu[4 * 1024 + kk]; }
    else { v = *(const float4*)(g1 + kk * 128 + n - 128); m = mu[5 * 1024 + kk]; }
    float s = (k < 1024) ? (1.f - m) : m;
    return make_float4(v.x * s, v.y * s, v.z * s, v.w * s); } };
struct CvGlaIn { const float *win, *wa1;
  DEVI float4 operator()(int k, int n) const {
    if (n < 3072) return *(const float4*)(win + (size_t)k * 3072 + n);
    if (n < 3088) return *(const float4*)(wa1 + k * 16 + n - 3072);
    return make_float4(0, 0, 0, 0); } };

template <int TYPE>
DEVI void phase_norm(const P& p, int layer, int j, bool from_input, bool copy_x) {
  const int lane = threadIdx.x & 63, wave = threadIdx.x >> 6;
  const float* g = PIN(7) + layer * 1024;
  float* xres = POUT;
  bf16 *h = slot(p, 0), *hs = slot(p, 1), *xr = slot(p, 2), *xk = slot(p, 3), *xv = slot(p, 4);
  const float* mu = PIN(12) + (size_t)j * 6 * 1024;
  for (int row = blockIdx.x * 4 + wave; row < MT; row += gridDim.x * 4) {
    auto src = [&](int r) -> const float* {
      if (from_input) return r < MPR ? PIN(0) + (size_t)r * 1024 : PIN(1) + (size_t)(r - MPR) * 1024;
      return xres + (size_t)r * 1024; };
    const float* xp = src(row);
    float4 xv4[4]; float ss = 0.f;
    float4 pv[4];
    bool pnorm = false;
    if constexpr (TYPE == 0) {
      const bool is_p0 = row < MPR; const int tt0 = is_p0 ? row : ((row - MPR) & 63);
      if (tt0 != 0) { const float* pp = src(row - 1); pnorm = true;
#pragma unroll
        for (int i = 0; i < 4; ++i) pv[i] = *(const float4*)(pp + i * 256 + lane * 4);
      } else if (!is_p0) { const float* sp = PIN(2) + ((size_t)j * NSS + ((row - MPR) >> 6)) * 1024;
#pragma unroll
        for (int i = 0; i < 4; ++i) pv[i] = *(const float4*)(sp + i * 256 + lane * 4);
      } else {
#pragma unroll
        for (int i = 0; i < 4; ++i) pv[i] = make_float4(0.f, 0.f, 0.f, 0.f);
      }
    }
#pragma unroll
    for (int i = 0; i < 4; ++i) { xv4[i] = *(const float4*)(xp + i * 256 + lane * 4); ss += xv4[i].x * xv4[i].x + xv4[i].y * xv4[i].y + xv4[i].z * xv4[i].z + xv4[i].w * xv4[i].w; }
    ss = wsum(ss);
    const float rstd = rsqrtf(ss * (1.f / 1024.f) + 1e-6f);
    if (copy_x) {
#pragma unroll
      for (int i = 0; i < 4; ++i) *(float4*)(xres + (size_t)row * 1024 + i * 256 + lane * 4) = xv4[i];
    }
    float hv[16];
#pragma unroll
    for (int i = 0; i < 4; ++i) { float4 gg = *(const float4*)(g + i * 256 + lane * 4);
      hv[i * 4 + 0] = xv4[i].x * rstd * gg.x; hv[i * 4 + 1] = xv4[i].y * rstd * gg.y; hv[i * 4 + 2] = xv4[i].z * rstd * gg.z; hv[i * 4 + 3] = xv4[i].w * rstd * gg.w; }
#pragma unroll
    for (int i = 0; i < 4; ++i) *(uint2*)(h + (size_t)row * 1024 + i * 256 + lane * 4) = make_uint2(pack2(hv[i * 4], hv[i * 4 + 1]), pack2(hv[i * 4 + 2], hv[i * 4 + 3]));
    if constexpr (TYPE == 0) {
      const bool is_p = row < MPR; const int tt = is_p ? row : ((row - MPR) & 63); const int b = is_p ? 0 : ((row - MPR) >> 6);
      float hp[16];
      {
        float s2 = 0.f;
#pragma unroll
        for (int i = 0; i < 4; ++i) s2 += pv[i].x * pv[i].x + pv[i].y * pv[i].y + pv[i].z * pv[i].z + pv[i].w * pv[i].w;
        s2 = wsum(s2); const float r2 = rsqrtf(s2 * (1.f / 1024.f) + 1e-6f);
#pragma unroll
        for (int i = 0; i < 4; ++i) { float4 gg = *(const float4*)(g + i * 256 + lane * 4);
          const float sx = pnorm ? r2 * gg.x : 1.f, sy = pnorm ? r2 * gg.y : 1.f, sz = pnorm ? r2 * gg.z : 1.f, sw = pnorm ? r2 * gg.w : 1.f;
          hp[i * 4] = pv[i].x * sx; hp[i * 4 + 1] = pv[i].y * sy; hp[i * 4 + 2] = pv[i].z * sz; hp[i * 4 + 3] = pv[i].w * sw; }
      }
#pragma unroll
      for (int i = 0; i < 4; ++i) {
        const int col = i * 256 + lane * 4; const size_t o = (size_t)row * 1024 + col;
        float4 m0 = *(const float4*)(mu + 0 * 1024 + col), m2 = *(const float4*)(mu + 2 * 1024 + col), m3 = *(const float4*)(mu + 3 * 1024 + col);
        const float mm0[4] = {m0.x, m0.y, m0.z, m0.w}, mm2[4] = {m2.x, m2.y, m2.z, m2.w}, mm3[4] = {m3.x, m3.y, m3.z, m3.w};
        float a[4], bb[4], c[4];
#pragma unroll
        for (int e = 0; e < 4; ++e) { float hh = hv[i * 4 + e], xx = hp[i * 4 + e] - hh; a[e] = hh + xx * mm0[e]; bb[e] = hh + xx * mm2[e]; c[e] = hh + xx * mm3[e]; }
        *(uint2*)(hs + o) = make_uint2(pack2(hp[i * 4], hp[i * 4 + 1]), pack2(hp[i * 4 + 2], hp[i * 4 + 3]));
        *(uint2*)(xr + o) = make_uint2(pack2(a[0], a[1]), pack2(a[2], a[3]));
        *(uint2*)(xk + o) = make_uint2(pack2(bb[0], bb[1]), pack2(bb[2], bb[3]));
        *(uint2*)(xv + o) = make_uint2(pack2(c[0], c[1]), pack2(c[2], c[3]));
      }
      if (is_p ? (row == MPR - 1) : (tt == 63)) {
        float* o = POUT + (is_p ? O_ASH_P + (size_t)j * 1024 : O_ASH_S + ((size_t)j * NSS + b) * 1024);
#pragma unroll
        for (int i = 0; i < 4; ++i) *(float4*)(o + i * 256 + lane * 4) = make_float4(hv[i * 4], hv[i * 4 + 1], hv[i * 4 + 2], hv[i * 4 + 3]);
      }
    }
  }
}

DEVI void phase_rms(const float* x, const float* g, bf16* dst, float* fdst) {
  const int lane = threadIdx.x & 63, wave = threadIdx.x >> 6;
  const int nw = gridDim.x * 4;
  for (int row = blockIdx.x * 4 + wave; row < MT; row += 2 * nw) {
    const int row2 = row + nw; const bool has2 = row2 < MT;
    float4 v[4], v2[4]; float ss = 0.f, ss2 = 0.f;
#pragma unroll
    for (int i = 0; i < 4; ++i) v[i] = *(const float4*)(x + (size_t)row * 1024 + i * 256 + lane * 4);
    if (has2) {
#pragma unroll
      for (int i = 0; i < 4; ++i) v2[i] = *(const float4*)(x + (size_t)row2 * 1024 + i * 256 + lane * 4);
    } else {
#pragma unroll
      for (int i = 0; i < 4; ++i) v2[i] = make_float4(0.f, 0.f, 0.f, 0.f);
    }
#pragma unroll
    for (int i = 0; i < 4; ++i) { ss += v[i].x * v[i].x + v[i].y * v[i].y + v[i].z * v[i].z + v[i].w * v[i].w; ss2 += v2[i].x * v2[i].x + v2[i].y * v2[i].y + v2[i].z * v2[i].z + v2[i].w * v2[i].w; }
    ss = wsum(ss); ss2 = wsum(ss2);
    const float r = rsqrtf(ss * (1.f / 1024.f) + 1e-6f), r2 = rsqrtf(ss2 * (1.f / 1024.f) + 1e-6f);
#pragma unroll
    for (int i = 0; i < 4; ++i) { float4 gg = *(const float4*)(g + i * 256 + lane * 4);
      { float a = v[i].x * r * gg.x, b = v[i].y * r * gg.y, c = v[i].z * r * gg.z, d = v[i].w * r * gg.w;
        if (dst) *(uint2*)(dst + (size_t)row * 1024 + i * 256 + lane * 4) = make_uint2(pack2(a, b), pack2(c, d));
        else *(float4*)(fdst + (size_t)row * 1024 + i * 256 + lane * 4) = make_float4(a, b, c, d); }
      if (has2) { float a = v2[i].x * r2 * gg.x, b = v2[i].y * r2 * gg.y, c = v2[i].z * r2 * gg.z, d = v2[i].w * r2 * gg.w;
        if (dst) *(uint2*)(dst + (size_t)row2 * 1024 + i * 256 + lane * 4) = make_uint2(pack2(a, b), pack2(c, d));
        else *(float4*)(fdst + (size_t)row2 * 1024 + i * 256 + lane * 4) = make_float4(a, b, c, d); }
    }
  }
}

DEVI void phase_gdn_conv(const P& p) {
  const bf16* qkv = slot(p, 1); const float* cw = PIN(35); const float* cst = PIN(5);
  const int tid = threadIdx.x;
  for (int item = blockIdx.x; item < (MT / 8) * 3; item += gridDim.x) {
    const int row0 = (item / 3) * 8, sec = item % 3, ch = sec * 1024 + tid * 4;
    const bool is_p = row0 < MPR; const int tt0 = is_p ? row0 : ((row0 - MPR) & 63); const int b = is_p ? 0 : ((row0 - MPR) >> 6);
    float x[11][4];
#pragma unroll
    for (int i = 0; i < 11; ++i) {
      const int pt = tt0 + i;
      if (pt >= 3) { uint2 u = *(const uint2*)(qkv + (size_t)(row0 + i - 3) * 3072 + ch);
        x[i][0] = bf2f(u.x & 0xffff); x[i][1] = bf2f(u.x >> 16); x[i][2] = bf2f(u.y & 0xffff); x[i][3] = bf2f(u.y >> 16); }
      else if (!is_p) { float4 s = *(const float4*)(cst + ((size_t)b * 3 + pt) * 3072 + ch); x[i][0] = s.x; x[i][1] = s.y; x[i][2] = s.z; x[i][3] = s.w; }
      else { x[i][0] = x[i][1] = x[i][2] = x[i][3] = 0.f; }
    }
    float w[4][4];
#pragma unroll
    for (int i = 0; i < 4; ++i) { float4 ww = *(const float4*)(cw + i * 3072 + ch); w[i][0] = ww.x; w[i][1] = ww.y; w[i][2] = ww.z; w[i][3] = ww.w; }
#pragma unroll
    for (int o = 0; o < 8; ++o) {
      float acc[4];
#pragma unroll
      for (int e = 0; e < 4; ++e) { acc[e] = x[o][e] * w[0][e] + x[o + 1][e] * w[1][e] + x[o + 2][e] * w[2][e] + x[o + 3][e] * w[3][e]; acc[e] = silu(acc[e]); }
      if (sec < 2) {
        float ss = acc[0] * acc[0] + acc[1] * acc[1] + acc[2] * acc[2] + acc[3] * acc[3];
#pragma unroll
        for (int once = 0; once < 1; ++once) { ss = rsum16(ss); ss += __shfl_xor(ss, 16); }
        const float r = rsqrtf(ss + 1e-6f) * (sec == 0 ? 0.08838834764831845f : 1.f);
#pragma unroll
        for (int e = 0; e < 4; ++e) acc[e] *= r;
      }
      *(uint2*)(slot(p, 5 + sec) + (size_t)(row0 + o) * 1024 + tid * 4) = make_uint2(pack2(acc[0], acc[1]), pack2(acc[2], acc[3]));
    }
  }
}

DEVI void mm_strip(const bf16* At, const bf16* Bt, f32x4 (&acc)[4], int wave, int lane) {
  const int lr = lane & 15, quad = lane >> 4;
#pragma unroll
  for (int ks = 0; ks < 2; ++ks) {
    bf16x8 a = *(const bf16x8*)(At + (wave * 16 + lr) * 72 + ks * 32 + quad * 8);
#pragma unroll
    for (int nb = 0; nb < 4; ++nb) {
      bf16x8 b = *(const bf16x8*)(Bt + (nb * 16 + lr) * 72 + ks * 32 + quad * 8);
      acc[nb] = __builtin_amdgcn_mfma_f32_16x16x32_bf16(a, b, acc[nb], 0, 0, 0);
    }
  }
}
DEVI void zero4(f32x4 (&a)[4]) {
#pragma unroll
  for (int i = 0; i < 4; ++i) a[i] = (f32x4){0.f, 0.f, 0.f, 0.f};
}

DEVI int perm32(int x) { return (x & ~31) | (((x >> 2) & 3) << 3) | (((x >> 4) & 1) << 2) | (x & 3); }
template <int CW> DEVI size_t cont_off(int r, int s, int LD) { const int idx = r * 64 + s; return (size_t)(idx / CW) * LD + (idx % CW); }

template <int TYPE>
DEVI void phase_prep(const P& p, int j, char* smem) {
  constexpr int NH = TYPE == 0 ? 16 : (TYPE == 1 ? 4 : 8);
  constexpr int DK = TYPE == 0 ? 64 : 128;
  constexpr int DV = TYPE == 0 ? 64 : (TYPE == 1 ? 256 : 128);
  constexpr bool LOW = TYPE != 1;
  constexpr int KT = 256 / DK, TPT = 64 / KT, DKH = DK / 64, DVH = DV / 64;
  constexpr int LDQ = TYPE == 1 ? 512 : 1024;
  bf16* X0 = (bf16*)smem; bf16* X1 = X0 + 4608; bf16* Y0 = X1 + 4608; bf16* Y1 = Y0 + 4608;
  float* Lb = (float*)smem;
  bf16* LkT = (bf16*)(smem + 16384); bf16* Ak = LkT + 4608; bf16* nAb = Ak + 4608;
  bf16* M1 = (bf16*)smem;
  bf16* Tt = (bf16*)(smem + 44032); bf16* St1 = Tt + 4608; bf16* St2 = St1 + 4608;
  if (TYPE == 1) { Y0 = (bf16*)(smem + 9216); Ak = (bf16*)(smem + 18432); St1 = (bf16*)(smem + 27648); }
  float* lgL = (float*)(smem + 36864);
  float* tot = (float*)(smem + 71680);
  float* sc_beta = (float*)(smem + 73728);
  float* sc_eg = sc_beta + 64; float* sc_lg = sc_eg + 64; float* sc_g = sc_lg + 64;

  bf16 *Aq, *Akk, *Av, *Ald = nullptr, *Aa = nullptr, *Oq, *Okt, *Ovt, *Ow = nullptr, *Obt = nullptr, *Ool, *Ou0 = nullptr;
  if (TYPE == 0) { Aq = slot(p, 5); Akk = slot(p, 6); Av = slot(p, 7); Ald = slot(p, 2); Aa = slot(p, 3);
    Oq = Aq; Okt = Akk; Ovt = Av; Ow = Ald; Obt = Aa; Ool = slot(p, 0); Ou0 = slot(p, 1); }
  else if (TYPE == 1) { Aq = slot(p, 1); Akk = slot(p, 1) + (size_t)MT * 512; Av = slot(p, 2); Oq = Aq; Okt = Akk; Ovt = Av; Ool = slot(p, 4); }
  else { Aq = slot(p, 5); Akk = slot(p, 6); Av = slot(p, 7); Oq = Aq; Okt = Akk; Ovt = Av; Ow = slot(p, 1); Obt = slot(p, 2); Ool = slot(p, 3); Ou0 = slot(p, 0); }
  float* sm = (float*)(PWS + WS_SM);
  float* gam = (float*)(PWS + WS_GAM);

  for (int item = blockIdx.x; item < NCHUNK * NH; item += gridDim.x) {
    const int c = item / NH, h = item % NH;
    const size_t rb = (size_t)c * 64;
    int tid = threadIdx.x; asm volatile("" : "+v"(tid));
    const int lane = tid & 63, wave = tid >> 6, lr = lane & 15, quad = lane >> 4;
    const int k = tid % DK, tg = tid / DK;
    const int vv = tid & 63, tgv = tid >> 6;
    unsigned qP[TPT / 2], ktP[TPT / 2], kapP[(TYPE == 0) ? TPT / 2 : 1], bvP[(TYPE == 0) ? TPT / 2 : 1];
    float lg[(TYPE == 0) ? TPT : 1], ldv[(TYPE == 0) ? TPT : 1];
    unsigned vP[DVH][8];
    auto lo16 = [](unsigned w) { return __uint_as_float(w << 16); };
    auto hi16 = [](unsigned w) { return __uint_as_float(w & 0xffff0000u); };
#define GETP(arr, e) (((e) & 1) ? hi16(arr[(e) >> 1]) : lo16(arr[(e) >> 1]))
#pragma unroll
    for (int vh = 0; vh < DVH; ++vh) {
      bf16 va[16];
#pragma unroll
      for (int e = 0; e < 16; ++e) va[e] = Av[(rb + tgv * 16 + e) * 1024 + h * DV + vh * 64 + vv];
#pragma unroll
      for (int e = 0; e < 8; ++e) { vP[vh][e] = (unsigned)va[2 * e] | ((unsigned)va[2 * e + 1] << 16); asm volatile("" : "+v"(vP[vh][e])); }
    }
    if constexpr (TYPE == 2) {
      if (tid < 64) {
        const float a_log = PIN(36)[h], dtb = PIN(37)[h];
        const float braw = sm[(rb + tid) * 16 + h], araw = sm[(rb + tid) * 16 + 8 + h];
        const float gt = -__expf(a_log) * softplus(araw + dtb);
        sc_beta[tid] = sigm(braw); sc_eg[tid] = __expf(gt); sc_g[tid] = gt;
        float cs = gt;
#pragma unroll
        for (int o = 1; o < 64; o <<= 1) { float n = __shfl_up(cs, o); if (lane >= o) cs += n; }
        sc_lg[tid] = cs;
      }
      __syncthreads();
    }
    if constexpr (TYPE == 0) {
      const float k_k = PIN(21)[j * 1024 + h * 64 + k], k_a = PIN(22)[j * 1024 + h * 64 + k], r_k = PIN(23)[j * 1024 + h * 64 + k];
      float run = 0.f;
      bf16 rr[TPT], rk[TPT], ra[TPT], rl[TPT];
#pragma unroll
      for (int e = 0; e < TPT; ++e) {
        const size_t o = (rb + tg * TPT + e) * 1024 + h * 64 + k;
        rr[e] = Aq[o]; rk[e] = Akk[o]; ra[e] = Aa[o]; rl[e] = Ald[o];
      }
#pragma unroll
      for (int e2 = 0; e2 < TPT / 2; ++e2) {
        float qq[2], ka[2], kq[2], bq[2];
#pragma unroll
        for (int u = 0; u < 2; ++u) {
          const int e = e2 * 2 + u;
          const float r = bf2f(rr[e]), kr = bf2f(rk[e]), av = bf2f(ra[e]), l = bf2f(rl[e]);
          const float kk = kr * k_k;
          const float inv = rsqrtf(fmaxf(wsum(kk * kk), 1e-24f));
          qq[u] = r; ka[u] = kk * inv; kq[u] = kr * (1.f + (av - 1.f) * k_a); bq[u] = ka[u] * av; ldv[e] = l;
          const float bo = wsum(r * kq[u] * r_k);
          if (lane == 0) sm[(rb + tg * TPT + e) * 16 + h] = bo;
          run += l; lg[e] = run;
        }
        qP[e2] = pack2(qq[0], qq[1]); kapP[e2] = pack2(ka[0], ka[1]); ktP[e2] = pack2(kq[0], kq[1]); bvP[e2] = pack2(bq[0], bq[1]);
        asm volatile("" : "+v"(qP[e2]), "+v"(kapP[e2]), "+v"(ktP[e2]), "+v"(bvP[e2]));
      }
      tot[tg * 128 + k] = run;
    } else if constexpr (TYPE == 1) {
      float w2[16];
#pragma unroll
      for (int i = 0; i < 16; ++i) w2[i] = PIN(30)[i * 512 + h * 128 + k];
      const float ba = PIN(31)[h * 128 + k];
      bf16 rq[TPT], rk[TPT];
#pragma unroll
      for (int e = 0; e < TPT; ++e) { const size_t row = rb + tg * TPT + e; rq[e] = Aq[row * 512 + h * 128 + k]; rk[e] = Akk[row * 512 + h * 128 + k]; }
      float4 ar[TPT][4];
      float run = 0.f;
#pragma unroll
      for (int e = 0; e < TPT; e += 4) {
#pragma unroll
        for (int u = 0; u < 4; ++u)
#pragma unroll
          for (int q4 = 0; q4 < 4; ++q4) ar[e + u][q4] = *(const float4*)(sm + (rb + tg * TPT + e + u) * 16 + q4 * 4);
#pragma unroll
        for (int u = 0; u < 4; ++u) {
          float s = ba;
#pragma unroll
          for (int q4 = 0; q4 < 4; ++q4) { const float4 a4 = ar[e + u][q4]; s += a4.x * w2[q4 * 4] + a4.y * w2[q4 * 4 + 1] + a4.z * w2[q4 * 4 + 2] + a4.w * w2[q4 * 4 + 3]; }
          const float gk = (fminf(s, 0.f) - log1pf(__expf(-fabsf(s)))) * (1.f / 16.f);
          run += gk; lgL[(tg * TPT + e + u) * 128 + k] = run;
        }
      }
#pragma unroll
      for (int e2 = 0; e2 < TPT / 2; ++e2) {
        qP[e2] = (unsigned)rq[2 * e2] | ((unsigned)rq[2 * e2 + 1] << 16);
        ktP[e2] = (unsigned)rk[2 * e2] | ((unsigned)rk[2 * e2 + 1] << 16);
        asm volatile("" : "+v"(qP[e2]), "+v"(ktP[e2]));
      }
      tot[tg * 128 + k] = run;
    } else {
      bf16 rq[TPT], rk[TPT];
#pragma unroll
      for (int e = 0; e < TPT; ++e) { const size_t o = (rb + tg * TPT + e) * 1024 + h * 128 + k; rq[e] = Aq[o]; rk[e] = Akk[o]; }
#pragma unroll
      for (int e2 = 0; e2 < TPT / 2; ++e2) {
        qP[e2] = (unsigned)rq[2 * e2] | ((unsigned)rq[2 * e2 + 1] << 16);
        ktP[e2] = (unsigned)rk[2 * e2] | ((unsigned)rk[2 * e2 + 1] << 16);
        asm volatile("" : "+v"(qP[e2]), "+v"(ktP[e2]));
      }
    }
    __syncthreads();
    float lgC;
    if constexpr (TYPE == 2) { lgC = sc_lg[63]; }
    else {
      float off = 0.f, all = 0.f;
#pragma unroll
      for (int g2 = 0; g2 < KT; ++g2) { const float tv = tot[g2 * 128 + k]; all += tv; if (g2 < tg) off += tv; }
      if constexpr (TYPE == 0) {
#pragma unroll
        for (int e = 0; e < TPT; ++e) lg[e] += off;
      } else {
#pragma unroll
        for (int e = 0; e < TPT; ++e) lgL[(tg * TPT + e) * 128 + k] += off;
      }
      lgC = all;
    }
#define QV(e) GETP(qP, e)
#define LGV(e, t) ((TYPE == 2) ? sc_lg[t] : ((TYPE == 1) ? lgL[(t) * 128 + k] : lg[(TYPE == 0) ? (e) : 0]))
#define LPREV(e, t) ((TYPE == 0) ? (lg[(TYPE == 0) ? (e) : 0] - ldv[(TYPE == 0) ? (e) : 0]) : (sc_lg[t] - sc_g[t]))
#define KTV(e, t) ((TYPE == 2) ? (sc_beta[t] * GETP(ktP, e)) : GETP(ktP, e))
#define KAPV(e, t) ((TYPE == 2) ? GETP(ktP, e) : GETP(kapP, (TYPE == 0) ? (e) : 0))
#define BVV(e, t) ((TYPE == 2) ? (sc_beta[t] * sc_eg[t] * GETP(ktP, e)) : GETP(bvP, (TYPE == 0) ? (e) : 0))
    f32x4 sacc[LOW ? 4 : 1][4];
#pragma unroll
    for (int a = 0; a < (LOW ? 4 : 1); ++a) zero4(sacc[a]);
#pragma unroll
    for (int kh = 0; kh < DKH; ++kh) {
      if (k / 64 == kh) {
        const int kk = k & 63;
#pragma unroll
        for (int e = 0; e < TPT; ++e) {
          const int t = tg * TPT + e;
          if constexpr (TYPE == 2) {
            X0[t * 72 + kk] = f2bf(QV(e)); Y0[t * 72 + kk] = f2bf(KTV(e, t));
            X1[t * 72 + kk] = f2bf(KAPV(e, t)); Y1[t * 72 + kk] = f2bf(BVV(e, t));
          } else {
            const float lgt = LGV(e, t);
            const float el = __expf(lgt), eml = __expf(-lgt);
            X0[t * 72 + kk] = f2bf(QV(e) * el);
            Y0[t * 72 + kk] = f2bf(KTV(e, t) * eml);
            if constexpr (LOW) {
              X1[t * 72 + kk] = f2bf(KAPV(e, t) * __expf(LPREV(e, t)));
              Y1[t * 72 + kk] = f2bf(BVV(e, t) * eml);
            }
          }
        }
      }
      __syncthreads();
      mm_strip(X0, Y0, sacc[0], wave, lane);
      if constexpr (LOW) { mm_strip(X0, Y1, sacc[1], wave, lane); mm_strip(X1, Y0, sacc[2], wave, lane); mm_strip(X1, Y1, sacc[3], wave, lane); }
      __syncthreads();
    }
#pragma unroll
    for (int nb = 0; nb < 4; ++nb)
#pragma unroll
      for (int jj = 0; jj < 4; ++jj) {
        const int t = wave * 16 + quad * 4 + jj, s = nb * 16 + lr;
        float da = 1.f, dl = 1.f;
        if constexpr (TYPE == 2) { const float dd = sc_lg[t] - sc_lg[s]; da = __expf(fminf(dd, 0.f)); dl = __expf(fminf(dd - sc_g[t], 0.f)); }
        Ak[t * 72 + s] = f2bf(s <= t ? sacc[0][nb][jj] * da : 0.f);
        if constexpr (LOW) {
          nAb[t * 72 + s] = f2bf(s <= t ? -sacc[1][nb][jj] * da : 0.f);
          LkT[s * 72 + t] = f2bf(s < t ? sacc[2][nb][jj] * dl : 0.f);
          Lb[t * 64 + (s & 3) * 16 + (s >> 2)] = s < t ? sacc[3][nb][jj] * dl : 0.f;
        }
      }
    __syncthreads();
    f32x4 acc[4];
    if constexpr (LOW) {
      {
        const int q = lane & 3, jc = wave * 16 + (lane >> 2);
        float xr[16];
#pragma unroll
        for (int i = 0; i < 16; ++i) xr[i] = 0.f;
#pragma unroll
        for (int t = 0; t < 64; ++t) {
          float s = 0.f, s2 = 0.f, s3 = 0.f, s4 = 0.f;
          const float* Lr = Lb + t * 64 + q * 16;
#pragma unroll
          for (int i = 0; i < (t + 3) / 4; ++i) { if ((i & 3) == 0) s += Lr[i] * xr[i]; else if ((i & 3) == 1) s2 += Lr[i] * xr[i]; else if ((i & 3) == 2) s3 += Lr[i] * xr[i]; else s4 += Lr[i] * xr[i]; }
          s = (s + s2) + (s3 + s4);
          s = rsum4(s);
          s = ((t == jc) ? 1.f : 0.f) - s;
          xr[t >> 2] = (q == (t & 3)) ? s : xr[t >> 2];
          if (q == 0) Tt[t * 72 + jc] = f2bf(s);
        }
      }
      __syncthreads();
      zero4(acc); mm_strip(Tt, LkT, acc, wave, lane);
#pragma unroll
      for (int nb = 0; nb < 4; ++nb)
#pragma unroll
        for (int jj = 0; jj < 4; ++jj) M1[(wave * 16 + quad * 4 + jj) * 72 + nb * 16 + lr] = f2bf(acc[nb][jj]);
      __syncthreads();
    }
#pragma unroll
    for (int vh = 0; vh < DVH; ++vh) {
#pragma unroll
      for (int e = 0; e < 8; ++e) *(unsigned*)(St1 + vv * 72 + tgv * 16 + 2 * e) = vP[vh][e];
      __syncthreads();
      if constexpr (LOW) {
        zero4(acc); mm_strip(M1, St1, acc, wave, lane);
#pragma unroll
        for (int nb = 0; nb < 4; ++nb)
#pragma unroll
          for (int jj = 0; jj < 4; ++jj) {
            const int t = wave * 16 + quad * 4 + jj, col = nb * 16 + lr; const bf16 u = f2bf(acc[nb][jj]);
            St2[col * 72 + t] = u;
          }
#pragma unroll
        for (int nb = 0; nb < 4; ++nb)
          *(uint2*)(Ou0 + (((((size_t)c * NH + h) * (DV / 16) + vh * 4 + nb) * 4 + wave) * 64 + lane) * 4) = make_uint2(pack2(acc[nb][0], acc[nb][1]), pack2(acc[nb][2], acc[nb][3]));
        __syncthreads();
      }
      zero4(acc); mm_strip(Ak, St1, acc, wave, lane);
      if constexpr (LOW) mm_strip(nAb, St2, acc, wave, lane);
#pragma unroll
      for (int nb = 0; nb < 4; ++nb)
        *(uint2*)(Ool + (((((size_t)c * NH + h) * (DV / 16) + vh * 4 + nb) * 4 + wave) * 64 + lane) * 4) = make_uint2(pack2(acc[nb][0], acc[nb][1]), pack2(acc[nb][2], acc[nb][3]));
      __syncthreads();
    }
    if constexpr (LOW) {
#pragma unroll
      for (int kh = 0; kh < DKH; ++kh) {
        if (k / 64 == kh) {
          const int kk = k & 63;
#pragma unroll
          for (int e = 0; e < TPT; ++e) {
            const int t = tg * TPT + e;
            St1[kk * 72 + t] = f2bf(KAPV(e, t) * __expf(LPREV(e, t)));
            LkT[t * 72 + kk] = f2bf(QV(e) * __expf(LGV(e, t)));
            }
        }
        __syncthreads();
        zero4(acc); mm_strip(Tt, St1, acc, wave, lane);
#pragma unroll
        for (int nb = 0; nb < 4; ++nb)
#pragma unroll
          for (int jj = 0; jj < 4; ++jj) {
            const int t = wave * 16 + quad * 4 + jj, col = nb * 16 + lr; const bf16 u = f2bf(acc[nb][jj]);
            St2[col * 72 + t] = u;
            Ow[(rb + t) * 1024 + h * DK + perm32(kh * 64 + col)] = u;
          }
        __syncthreads();
        zero4(acc); mm_strip(nAb, St2, acc, wave, lane);
#pragma unroll
        for (int nb = 0; nb < 4; ++nb)
#pragma unroll
          for (int jj = 0; jj < 4; ++jj) {
            const int t = wave * 16 + quad * 4 + jj, col = nb * 16 + lr;
            Oq[(rb + t) * LDQ + h * DK + perm32(kh * 64 + col)] = f2bf(acc[nb][jj] + bf2f(LkT[t * 72 + col]));
          }
        __syncthreads();
      }
    } else {
#pragma unroll
      for (int e = 0; e < TPT; ++e) { Oq[(rb + tg * TPT + e) * LDQ + h * DK + perm32(k)] = f2bf(QV(e) * __expf(LGV(e, tg * TPT + e))); }
    }
    {
      unsigned wk[TPT / 2], wb[LOW ? TPT / 2 : 1];
#pragma unroll
      for (int e = 0; e < TPT; e += 2) {
        const int t0 = tg * TPT + e;
        const float d0 = __expf(lgC - LGV(e, t0)), d1 = __expf(lgC - LGV(e + 1, t0 + 1));
        wk[e / 2] = pack2(KTV(e, t0) * d0, KTV(e + 1, t0 + 1) * d1);
        if constexpr (LOW) wb[e / 2] = pack2(BVV(e, t0) * d0, BVV(e + 1, t0 + 1) * d1);
      }
      const size_t co = rb * LDQ + h * DK + cont_off<DK>(k, tg * TPT, LDQ);
#pragma unroll
      for (int e = 0; e < TPT / 8; ++e) {
        *(uint4*)(Okt + co + e * 8) = make_uint4(wk[e * 4], wk[e * 4 + 1], wk[e * 4 + 2], wk[e * 4 + 3]);
        if constexpr (LOW) {
#pragma unroll
          for (int g4 = 0; g4 < 2; ++g4) {
            const int s0 = tg * TPT + e * 8 + g4 * 4;
            *(uint2*)(Obt + rb * 1024 + h * DK + cont_off<DK>(k, perm32(s0), 1024)) = make_uint2(wb[e * 4 + g4 * 2], wb[e * 4 + g4 * 2 + 1]);
          }
        }
      }
#pragma unroll
      for (int vh = 0; vh < DVH; ++vh) {
        const unsigned* wv = vP[vh];
        const size_t vo = rb * 1024 + h * DV + cont_off<DV>(vh * 64 + vv, tgv * 16, 1024);
        *(uint4*)(Ovt + vo) = make_uint4(wv[0], wv[1], wv[2], wv[3]);
        *(uint4*)(Ovt + vo + 8) = make_uint4(wv[4], wv[5], wv[6], wv[7]);
      }
      if (tg == 0) gam[((size_t)c * NH + h) * DK + k] = __expf(lgC);
    }
    __syncthreads();
  }
}

template <int TYPE>
DEVI void phase_seq2(const P& p, int j, char* smem) {
  constexpr int NH = TYPE == 0 ? 16 : (TYPE == 1 ? 4 : 8);
  constexpr int DK = TYPE == 0 ? 64 : 128;
  constexpr int DV = TYPE == 0 ? 64 : (TYPE == 1 ? 256 : 128);
  constexpr bool LOW = TYPE != 1;
  constexpr int NVB = DV / 16, MB = DK / 16, KS = DK / 32, NG = NVB / 4, BIPS = NH * NG;
  constexpr int LDQ = TYPE == 1 ? 512 : 1024;
  constexpr int NOP = LOW ? 4 : 2, RS = DK + 8, OPSZ = 64 * RS, PPR = DK / 8;
  constexpr int PPO = 64 * PPR / 256;
  constexpr int PF = 4;
  bf16* L = (bf16*)smem;
  const int tid = threadIdx.x, lane = tid & 63, wave = tid >> 6, lr = lane & 15, quad = lane >> 4;
  const bf16 *Qp, *Kt, *Vt, *Wp = nullptr, *Bt = nullptr, *U0 = nullptr; bf16* Ol;
  if (TYPE == 0) { Qp = slot(p, 5); Kt = slot(p, 6); Vt = slot(p, 7); Wp = slot(p, 2); Bt = slot(p, 3); Ol = slot(p, 0); U0 = slot(p, 1); }
  else if (TYPE == 1) { Qp = slot(p, 1); Kt = slot(p, 1) + (size_t)MT * 512; Vt = slot(p, 2); Ol = slot(p, 4); }
  else { Qp = slot(p, 5); Kt = slot(p, 6); Vt = slot(p, 7); Wp = slot(p, 1); Bt = slot(p, 2); Ol = slot(p, 3); U0 = slot(p, 0); }
  const float* gam = (const float*)(PWS + WS_GAM);
  unsigned tsink = 0;
  const bool split = (int)gridDim.x > 2 * BIPS;
  const int bstart = !split ? (int)blockIdx.x : ((int)blockIdx.x < BIPS ? (int)blockIdx.x : BIPS + ((int)blockIdx.x - BIPS));
  const int bstep = !split ? (int)gridDim.x : ((int)blockIdx.x < BIPS ? (1 << 30) : ((int)gridDim.x - BIPS));
  for (int bitem = bstart; bitem < 33 * BIPS; bitem += bstep) {
    const int seq = bitem / BIPS, rem = bitem % BIPS, h = rem / NG, vb = (rem % NG) * 4 + wave;
    const int c0 = seq == 0 ? 0 : NPCH + seq - 1, nc = seq == 0 ? NPCH : 1;
    const int vcol = vb * 16 + lr;
    f32x4 H[MB];
    if (seq == 0) {
#pragma unroll
      for (int m = 0; m < MB; ++m) H[m] = (f32x4){0.f, 0.f, 0.f, 0.f};
    } else {
      const int b = seq - 1;
      if (TYPE == 0) {
        const float* S = PIN(3) + (((size_t)j * NSS + b) * 16 + h) * 4096 + (size_t)vcol * 64;
#pragma unroll
        for (int m = 0; m < MB; ++m) { float4 v = *(const float4*)(S + m * 16 + quad * 4); H[m] = (f32x4){v.x, v.y, v.z, v.w}; }
      } else {
        const float* S = PIN(TYPE == 1 ? 4 : 6) + ((size_t)b * NH + h) * DK * DV + vcol;
#pragma unroll
        for (int m = 0; m < MB; ++m)
#pragma unroll
          for (int jj = 0; jj < 4; ++jj) H[m][jj] = S[(size_t)(m * 16 + quad * 4 + jj) * DV];
      }
    }
    u32x4 preA[NOP * PPO], preB[NOP * PPO]; u32x2 poA[4], poB[4], puA[4], puB[4]; bf16x8 pvA[2], pvB[2]; f32x4 pgA[MB], pgB[MB];
    auto issue_sh = [&](int cc, u32x4 (&pre)[NOP * PPO]) {
      const size_t rb_ = (size_t)cc * 64; int tl_ = threadIdx.x; asm volatile("" : "+v"(tl_));
#pragma unroll
      for (int i_ = 0; i_ < PPO; ++i_) { const int w_ = tl_ + 256 * i_; const size_t r_ = rb_ + w_ / PPR; const int c8_ = (w_ % PPR) * 8;
        pre[0 * PPO + i_] = *(const u32x4*)(Qp + r_ * LDQ + h * DK + c8_);
        pre[1 * PPO + i_] = *(const u32x4*)(Kt + r_ * LDQ + h * DK + c8_);
        if constexpr (LOW) { pre[2 * PPO + i_] = *(const u32x4*)(Wp + r_ * 1024 + h * DK + c8_); pre[3 * PPO + i_] = *(const u32x4*)(Bt + r_ * 1024 + h * DK + c8_); } }
    };
    auto issue_pr = [&](int cc, u32x2 (&p_o)[4], u32x2 (&p_u)[4], bf16x8 (&p_v)[2], f32x4 (&p_g)[MB]) {
      const size_t rb_ = (size_t)cc * 64; int tl_ = threadIdx.x; asm volatile("" : "+v"(tl_));
      const int lane = tl_ & 63, lr = lane & 15, quad = lane >> 4, vcol = vb * 16 + lr;
      const size_t fo_ = ((((size_t)cc * NH + h) * NVB + vb) * 4) * 256 + lane * 4;
#pragma unroll
      for (int tb_ = 0; tb_ < 4; ++tb_) { p_o[tb_] = *(const u32x2*)(Ol + fo_ + tb_ * 256); if constexpr (LOW) p_u[tb_] = *(const u32x2*)(U0 + fo_ + tb_ * 256); }
#pragma unroll
      for (int ks_ = 0; ks_ < 2; ++ks_) p_v[ks_] = *(const bf16x8*)(Vt + rb_ * 1024 + h * DV + cont_off<DV>(vcol, ks_ * 32 + quad * 8, 1024));
#pragma unroll
      for (int m_ = 0; m_ < MB; ++m_) p_g[m_] = *(const f32x4*)(gam + ((size_t)cc * NH + h) * DK + m_ * 16 + quad * 4);
    };
    const int cend = c0 + nc;
    auto step = [&](int c, u32x4 (&pre)[NOP * PPO], u32x2 (&p_o)[4], u32x2 (&p_u)[4], bf16x8 (&p_v)[2], f32x4 (&p_g)[MB]) {
#pragma unroll
      for (int o = 0; o < NOP; ++o)
#pragma unroll
        for (int i = 0; i < PPO; ++i) { const int w = tid + 256 * i; *(u32x4*)(L + o * OPSZ + (w / PPR) * RS + (w % PPR) * 8) = pre[o * PPO + i]; }
      __syncthreads();
      if (c + 2 < cend) issue_sh(c + 2, pre);
      unsigned tv[NOP * DK / 128 + 1];
#pragma unroll
      for (int i = 0; i < NOP * DK / 128 + 1; ++i) tv[i] = 0;
      if (false && c + PF < cend) {
        const size_t rb2 = (size_t)(c + PF) * 64;
        if (DK == 128 || tid < 128) {
          const int li = (DK == 128) ? tid : tid; const size_t ro = li / (DK / 64) % 64; const int co = (li % (DK / 64)) * 64;
          const int half = (DK == 128) ? (tid >> 7) : (tid >> 6);
          if (half == 0) { tv[0] = *(const unsigned*)(Qp + (rb2 + ro) * LDQ + h * DK + co); if constexpr (LOW) tv[1] = *(const unsigned*)(Wp + (rb2 + ro) * 1024 + h * DK + co); }
          else { tv[0] = *(const unsigned*)(Kt + (rb2 + ro) * LDQ + h * DK + co); if constexpr (LOW) tv[1] = *(const unsigned*)(Bt + (rb2 + ro) * 1024 + h * DK + co); }
        }
        {
          const size_t fo2 = ((((size_t)(c + PF) * NH + h) * NVB + vb) * 4) * 256;
          const unsigned* tp;
          if (lane < 16) tp = (const unsigned*)(Ol + fo2 + lane * 64);
          else if (LOW && lane < 32) tp = (const unsigned*)(U0 + fo2 + (lane - 16) * 64);
          else if (lane < 48) tp = (const unsigned*)(Vt + rb2 * 1024 + h * DV + cont_off<DV>(vb * 16 + (lane & 15), 0, 1024));
          else tp = (const unsigned*)(gam + ((size_t)(c + PF) * NH + h) * DK + ((lane - 48) & (DK / 32 - 1)) * 32);
          tv[NOP * DK / 128] = *tp;
        }
      }
      bf16x8 hb[KS];
#pragma unroll
      for (int ks = 0; ks < KS; ++ks) {
        const u32x4 hw = {pack2(H[2 * ks][0], H[2 * ks][1]), pack2(H[2 * ks][2], H[2 * ks][3]), pack2(H[2 * ks + 1][0], H[2 * ks + 1][1]), pack2(H[2 * ks + 1][2], H[2 * ks + 1][3])};
        hb[ks] = __builtin_bit_cast(bf16x8, hw);
      }
      const size_t fo = ((((size_t)c * NH + h) * NVB + vb) * 4) * 256 + lane * 4;
      f32x4 U[4];
#pragma unroll
      for (int tb = 0; tb < 4; ++tb) {
        f32x4 o_ = (f32x4){bf2f(p_o[tb].x & 0xffff), bf2f(p_o[tb].x >> 16), bf2f(p_o[tb].y & 0xffff), bf2f(p_o[tb].y >> 16)}, u_;
        if constexpr (LOW) u_ = (f32x4){bf2f(p_u[tb].x & 0xffff), bf2f(p_u[tb].x >> 16), bf2f(p_u[tb].y & 0xffff), bf2f(p_u[tb].y >> 16)};
#pragma unroll
        for (int ks = 0; ks < KS; ++ks) {
          o_ = __builtin_amdgcn_mfma_f32_16x16x32_bf16(*(const bf16x8*)(L + 0 * OPSZ + (tb * 16 + lr) * RS + ks * 32 + quad * 8), hb[ks], o_, 0, 0, 0);
          if constexpr (LOW) u_ = __builtin_amdgcn_mfma_f32_16x16x32_bf16(*(const bf16x8*)(L + 2 * OPSZ + (tb * 16 + lr) * RS + ks * 32 + quad * 8), hb[ks], u_, 0, 0, 0);
        }
        *(u32x2*)(Ol + fo + tb * 256) = (u32x2){pack2(o_[0], o_[1]), pack2(o_[2], o_[3])};
        if constexpr (LOW) U[tb] = u_;
      }
      bf16x8 ubop[2];
      if constexpr (LOW) {
#pragma unroll
        for (int ks = 0; ks < 2; ++ks) {
          const u32x4 uw = {pack2(-U[2 * ks][0], -U[2 * ks][1]), pack2(-U[2 * ks][2], -U[2 * ks][3]), pack2(-U[2 * ks + 1][0], -U[2 * ks + 1][1]), pack2(-U[2 * ks + 1][2], -U[2 * ks + 1][3])};
          ubop[ks] = __builtin_bit_cast(bf16x8, uw);
        }
      }
#pragma unroll
      for (int m = 0; m < MB; ++m) {
        f32x4 hn = (f32x4){H[m][0] * p_g[m][0], H[m][1] * p_g[m][1], H[m][2] * p_g[m][2], H[m][3] * p_g[m][3]};
        const int krow = m * 16 + lr;
#pragma unroll
        for (int ks = 0; ks < 2; ++ks) {
          const int i1 = krow * 64 + ks * 32 + quad * 8;
          bf16x8 a = *(const bf16x8*)(L + 1 * OPSZ + (i1 / DK) * RS + (i1 % DK));
          hn = __builtin_amdgcn_mfma_f32_16x16x32_bf16(a, p_v[ks], hn, 0, 0, 0);
          if constexpr (LOW) {
            hn = __builtin_amdgcn_mfma_f32_16x16x32_bf16(*(const bf16x8*)(L + 3 * OPSZ + (i1 / DK) * RS + (i1 % DK)), ubop[ks], hn, 0, 0, 0);
          }
        }
        H[m] = hn;
      }
#pragma unroll
      for (int i = 0; i < NOP * DK / 128 + 1; ++i) tsink ^= tv[i];
      if (c + 2 < cend) issue_pr(c + 2, p_o, p_u, p_v, p_g);
      __syncthreads();
    };
    issue_sh(c0, preA); issue_pr(c0, poA, puA, pvA, pgA);
    if (nc > 1) { issue_sh(c0 + 1, preB); issue_pr(c0 + 1, poB, puB, pvB, pgB); }
    for (int c = c0; c < cend; c += 2) { step(c, preA, poA, puA, pvA, pgA); if (c + 1 < cend) step(c + 1, preB, poB, puB, pvB, pgB); }
    if (TYPE == 0) {
      float* S = POUT + (seq == 0 ? O_AWKV_P + ((size_t)j * 16 + h) * 4096 : O_AWKV_S + (((size_t)j * NSS + (seq - 1)) * 16 + h) * 4096) + (size_t)vcol * 64;
#pragma unroll
      for (int m = 0; m < MB; ++m) *(float4*)(S + m * 16 + quad * 4) = make_float4(H[m][0], H[m][1], H[m][2], H[m][3]);
    } else {
      const size_t ob = TYPE == 1 ? (seq == 0 ? O_BKV_P : O_BKV_S + (size_t)(seq - 1) * NH * DK * DV)
                                  : (seq == 0 ? O_CKV_P : O_CKV_S + (size_t)(seq - 1) * NH * DK * DV);
      float* S = POUT + ob + (size_t)h * DK * DV + vcol;
#pragma unroll
      for (int m = 0; m < MB; ++m)
#pragma unroll
        for (int jj = 0; jj < 4; ++jj) S[(size_t)(m * 16 + quad * 4 + jj) * DV] = H[m][jj];
    }
  }
  if (tsink == 0x9e3779b9u) ((unsigned*)(PWS + WS_SINK))[0] = tsink;
}

template <int TYPE>
DEVI void phase_post(const P& p, int j, char* smem) {
  constexpr int NH = TYPE == 0 ? 16 : (TYPE == 1 ? 4 : 8);
  constexpr int DV = TYPE == 0 ? 64 : (TYPE == 1 ? 256 : 128);
  constexpr int CPT = DV / 8;
  bf16* vt = (bf16*)smem;
  bf16* ot = (bf16*)(smem + 9216);
  const bf16* O = slot(p, TYPE == 0 ? 0 : (TYPE == 1 ? 4 : 3));
  const bf16* G = slot(p, TYPE == 0 ? 4 : (TYPE == 1 ? 3 : 4));
  bf16* og = slot(p, TYPE == 1 ? 0 : 1);
  const float* sm = (const float*)(PWS + WS_SM);
  for (int item = blockIdx.x; item < NCHUNK * NH; item += gridDim.x) {
    const int c = item / NH, h = item % NH; const size_t rb = (size_t)c * 64;
    int tid = threadIdx.x; asm volatile("" : "+v"(tid));
    const int part = tid & 7;
    if constexpr (TYPE == 0) {
      const bf16* V = slot(p, 7) + rb * 1024 + h * 64;
      const int r = tid >> 2, q4 = (tid & 3) * 16;
      *(uint4*)(vt + r * 72 + q4) = *(const uint4*)(V + (size_t)r * 1024 + q4);
      *(uint4*)(vt + r * 72 + q4 + 8) = *(const uint4*)(V + (size_t)r * 1024 + q4 + 8);
      __syncthreads();
    }
    {
      const uint4* srcp = (const uint4*)(O + ((size_t)c * NH + h) * 64 * DV);
#pragma unroll
      for (int i = 0; i < DV / 32; ++i) *(uint4*)(ot + (size_t)(i * 256 + tid) * 8) = srcp[i * 256 + tid];
      __syncthreads();
    }
#pragma unroll
    for (int pass = 0; pass < 2; ++pass) {
      const int t = pass * 32 + (tid >> 3);
      const size_t base = (rb + t) * 1024 + h * DV + part * CPT;
      float o[CPT];
#pragma unroll
      for (int e = 0; e < CPT; ++e) {
        const int v = part * CPT + e;
        o[e] = bf2f(ot[(((v >> 4) * 4 + (t >> 4)) * 64 + ((t & 15) >> 2) * 16 + (v & 15)) * 4 + (t & 3)]);
      }
      float s1 = 0.f, s2 = 0.f;
#pragma unroll
      for (int e = 0; e < CPT; ++e) { s1 += o[e]; s2 += o[e] * o[e]; }
      s1 = rsum8(s1); s2 = rsum8(s2);
      if constexpr (TYPE == 0) {
        const float mean = s1 * (1.f / 64.f); float var = s2 * (1.f / 64.f) - mean * mean; var = fmaxf(var, 0.f);
        const float rs = rsqrtf(var + 64e-5f); const float bonus = sm[(rb + t) * 16 + h];
        const float* lw = PIN(26) + j * 1024 + h * 64 + part * CPT; const float* lb = PIN(27) + j * 1024 + h * 64 + part * CPT;
#pragma unroll
        for (int e = 0; e < CPT; ++e) {
          const float vv = bf2f(vt[(part * CPT + e) * 72 + t]);
          o[e] = (o[e] - mean) * rs * lw[e] + lb[e] + bonus * vv;
        }
      } else {
        const float rs = rsqrtf(s2 * (1.f / DV) + 1e-6f);
        const float* on = PIN(TYPE == 1 ? 32 : 38) + part * CPT;
#pragma unroll
        for (int e = 0; e < CPT; ++e) o[e] = o[e] * rs * on[e];
      }
#pragma unroll
      for (int e = 0; e < CPT; e += 8) {
        uint4 u = *(const uint4*)(G + base + e);
        const unsigned w[4] = {u.x, u.y, u.z, u.w}; unsigned ow[4];
#pragma unroll
        for (int i = 0; i < 4; ++i) {
          float g0 = bf2f(w[i] & 0xffff), g1 = bf2f(w[i] >> 16);
          if constexpr (TYPE != 0) { g0 = silu(g0); g1 = silu(g1); }
          ow[i] = pack2(o[e + 2 * i] * g0, o[e + 2 * i + 1] * g1);
        }
        *(uint4*)(og + base + e) = make_uint4(ow[0], ow[1], ow[2], ow[3]);
      }
    }
    __syncthreads();
  }
}


#define XB_TMO      128
#define XB_XCNT(j)  (256  + 64 * (j))
#define XB_XSUB(j)  (1280 + 64 * (j))
#define XB_XGEN(j)  (2304 + 64 * (j))
#define XB_TOP      3328
#define XB_TOPGEN   3392
#define XCD_BAR_WORDS 3456
#define XB_SPIN_CAP (1u << 18)
#define LAS __attribute__((address_space(3)))
DEVI unsigned xb_ld(unsigned* p)              { return __hip_atomic_load(p, __ATOMIC_RELAXED, __HIP_MEMORY_SCOPE_AGENT); }
DEVI unsigned xb_add(unsigned* p, unsigned v) { return __hip_atomic_fetch_add(p, v, __ATOMIC_RELAXED, __HIP_MEMORY_SCOPE_AGENT); }
DEVI unsigned xb_xcc_id() { return (unsigned)__builtin_amdgcn_s_getreg((3 << 11) | 20) & 0xFu; }
#define XB_SPIN(cond, bar) do { unsigned _sp = 0; while (cond) { __builtin_amdgcn_s_sleep(1); \
    if ((++_sp & 255u) == 0u) { if (xb_ld(&(bar)[XB_TMO])) break; if (_sp > XB_SPIN_CAP) { atomicAdd(&(bar)[XB_TMO], 1u); break; } } } } while (0)
struct XcdBarrier { unsigned* bar; unsigned x; volatile LAS unsigned* st; };
DEVI XcdBarrier xcd_barrier_post(unsigned* bar, volatile LAS unsigned* st) {
  XcdBarrier b; b.bar = bar; b.x = xb_xcc_id(); b.st = st;
  if (threadIdx.x == 0) (void)xb_add(&bar[XB_XCNT(b.x)], 1u);
  return b;
}
DEVI void xcd_barrier_complete(unsigned* bar, unsigned x, unsigned& nloc, unsigned& nx) {
  const unsigned G = gridDim.x * gridDim.y * gridDim.z;
  unsigned sum, cnt, mine, sp = 0u;
  for (;;) {
    sum = 0u; cnt = 0u; mine = 0u;
#pragma unroll
    for (unsigned j = 0; j < 16; ++j) { const unsigned c = xb_ld(&bar[XB_XCNT(j)]); sum += c; cnt += (c > 0u) ? 1u : 0u; mine = (j == x) ? c : mine; }
    if (sum == G) break;
    __builtin_amdgcn_s_sleep(1);
    if ((++sp & 255u) == 0u) { if (xb_ld(&bar[XB_TMO])) break; if (sp > XB_SPIN_CAP) { atomicAdd(&bar[XB_TMO], 1u); break; } }
  }
  nloc = mine > 0u ? mine : 1u; nx = cnt > 0u ? cnt : 1u;
}
DEVI void xcd_barrier(const XcdBarrier& b) {
  asm volatile("s_waitcnt vmcnt(0)" ::: "memory");
  __syncthreads();
  if (threadIdx.x == 0) {
    unsigned* bar = b.bar;
    __builtin_amdgcn_s_waitcnt(0);
    unsigned nloc = b.st[0], nx = b.st[1];
    if (nloc == 0u) { xcd_barrier_complete(bar, b.x, nloc, nx); b.st[0] = nloc; b.st[1] = nx; }
    const unsigned old = xb_add(&bar[XB_XSUB(b.x)], 1u);
    const unsigned gen = old / nloc;
    if (old + 1u == (gen + 1u) * nloc) {
      __builtin_amdgcn_fence(__ATOMIC_RELEASE, "agent");
      asm volatile("s_waitcnt vmcnt(0)" ::: "memory");
      const unsigned og = xb_add(&bar[XB_TOP], 1u);
      const unsigned tg = og / nx;
      if (og + 1u == (tg + 1u) * nx) xb_add(&bar[XB_TOPGEN], 1u);
      else XB_SPIN(xb_ld(&bar[XB_TOPGEN]) == tg, bar);
      __builtin_amdgcn_fence(__ATOMIC_ACQUIRE, "agent");
      xb_add(&bar[XB_XGEN(b.x)], 1u);
      asm volatile("s_waitcnt vmcnt(0)" ::: "memory");
    } else {
      XB_SPIN(xb_ld(&bar[XB_XGEN(b.x)]) == gen, bar);
      __builtin_amdgcn_fence(__ATOMIC_ACQUIRE, "agent");
      asm volatile("s_waitcnt vmcnt(0)" ::: "memory");
    }
  }
  __syncthreads();
}

#ifndef DISMASK
#define DISMASK 0
#endif
#define EN(b) (!((DISMASK >> (b)) & 1))
#define GSYNC() xcd_barrier(xb)
#define GSYNC_CG() do { asm volatile("s_waitcnt vmcnt(0)" ::: "memory"); grid.sync(); } while (0)
__global__ void __launch_bounds__(256, 1) fwd_megakernel(P p) {
  extern __shared__ __attribute__((aligned(16))) char smem[];
  cg::grid_group grid = cg::this_grid();
  volatile LAS unsigned* xst = (volatile LAS unsigned*)(smem + LDS_BYTES - 16);
  if (threadIdx.x == 0) { xst[0] = 0u; xst[1] = 0u; }
  __syncthreads();
  const XcdBarrier xb = xcd_barrier_post((unsigned*)(PWS + WS_BAR), xst);
  bf16* wreg = (bf16*)(PWS + WS_W);
  bf16 *wfin = wreg + W_FIN, *wfout = wreg + W_FOUT, *wmix = wreg + W_MIX;
  float* sm = (float*)(PWS + WS_SM);
  for (int layer = 0; layer < 4; ++layer) {
    const int type = layer % 3, j = layer / 3;
    int tb = 0;
    if (type == 0) phase_norm<0>(p, layer, j, layer == 0, layer == 0);
    else phase_norm<1>(p, layer, j, false, false);
    conv_job(CvFfnIn{PIN(10) + (size_t)layer * 1024 * 2 * FF}, wfin, 1024, 2 * FF, 1024, tb, smem);
    conv_job(CvPlain{PIN(11) + (size_t)layer * FF * 1024, 1024, 1024}, wfout, FF, 1024, FF, tb, smem);
    if (type == 0) {
      for (int i = 0; i < 3; ++i) conv_job(CvPlain{PIN(24) + ((size_t)j * 3 + i) * 1048576, 1024, 1024}, wmix + (size_t)i * 1048576, 1024, 1024, 1024, tb, smem);
      conv_job(CvLora1{PIN(14) + (size_t)j * 65536, PIN(17) + (size_t)j * 65536, PIN(19) + (size_t)j * 131072, PIN(12) + (size_t)j * 6144}, wmix + 3145728, 2048, 256, 2048, tb, smem);
      conv_job(CvPlain{PIN(15) + (size_t)j * 65536, 1024, 1024}, wmix + 3670016, 64, 1024, 64, tb, smem);
      conv_job(CvPlain{PIN(18) + (size_t)j * 65536, 1024, 1024}, wmix + 3735552, 64, 1024, 64, tb, smem);
      conv_job(CvPlain{PIN(20) + (size_t)j * 131072, 1024, 1024}, wmix + 3801088, 128, 1024, 128, tb, smem);
      conv_job(CvPlain{PIN(25) + (size_t)j * 1048576, 1024, 1024}, wmix + 3932160, 1024, 1024, 1024, tb, smem);
    } else if (type == 1) {
      conv_job(CvGlaIn{PIN(28), PIN(29)}, wmix, 1024, 3200, 1024, tb, smem);
      conv_job(CvPlain{PIN(33), 1024, 1024}, wmix + 3276800, 1024, 1024, 1024, tb, smem);
    } else {
      conv_job(CvPlain{PIN(34), 4112, 4112}, wmix, 1024, 4224, 1024, tb, smem);
      conv_job(CvPlain{PIN(39), 1024, 1024}, wmix + 4325376, 1024, 1024, 1024, tb, smem);
    }
    GSYNC();
    tb = 0;
    const bf16* wo;
    if (type == 0) {
      for (int i = 0; i < 3; ++i)
        gemm_job(GemmDesc{slot(p, 2 + i), nullptr, 1024, 1024, wmix + (size_t)i * 1048576, 1024, 144, 8, 1024}, EpiStore{slot(p, 5 + i), 1024, 1.f}, tb, smem);
      gemm_job(GemmDesc{slot(p, 0), slot(p, 1), 1024, 1024, wmix + 3145728, 2048, 144, 2, 2048}, EpiLora1{(bf16*)(PWS + WS_L1)}, tb, smem);
      GSYNC();
      tb = 0;
      const bf16* l1 = (const bf16*)(PWS + WS_L1);
      gemm_job(GemmDesc{l1, nullptr, 256, 64, wmix + 3670016, 64, 144, 8, 64}, EpiLd{slot(p, 2), PIN(13) + j * 1024}, tb, smem);
      gemm_job(GemmDesc{l1 + 64, nullptr, 256, 64, wmix + 3735552, 64, 144, 8, 64}, EpiSig{slot(p, 3), PIN(16) + j * 1024}, tb, smem);
      gemm_job(GemmDesc{l1 + 128, nullptr, 256, 128, wmix + 3801088, 128, 144, 8, 128}, EpiStore{slot(p, 4), 1024, 1.f}, tb, smem);
      GSYNC();
      if (EN(2)) phase_prep<0>(p, j, smem);
      GSYNC();
      if (EN(5)) phase_seq2<0>(p, j, smem);
      GSYNC();
      if (EN(8)) phase_post<0>(p, j, smem);
      wo = wmix + 3932160;
    } else if (type == 1) {
      gemm_job(GemmDesc{slot(p, 0), nullptr, 1024, 1024, wmix, 1024, 144, 25, 1024},
               EpiGlaIn{slot(p, 1), slot(p, 1) + (size_t)MT * 512, slot(p, 2), slot(p, 3), sm}, tb, smem);
      GSYNC();
      if (EN(3)) phase_prep<1>(p, j, smem);
      GSYNC();
      if (EN(6)) phase_seq2<1>(p, j, smem);
      GSYNC();
      if (EN(8)) phase_post<1>(p, j, smem);
      wo = wmix + 3276800;
    } else {
      gemm_job(GemmDesc{slot(p, 0), nullptr, 1024, 1024, wmix, 1024, 144, 33, 1024},
               EpiGdnIn{slot(p, 1), slot(p, 4), sm, POUT}, tb, smem);
      GSYNC();
      if (EN(9)) phase_gdn_conv(p);
      GSYNC();
      if (EN(4)) phase_prep<2>(p, j, smem);
      GSYNC();
      if (EN(7)) phase_seq2<2>(p, j, smem);
      GSYNC();
      if (EN(8)) phase_post<2>(p, j, smem);
      wo = wmix + 4325376;
    }
    GSYNC();
    tb = 0;
    gemm_job(GemmDesc{slot(p, type == 1 ? 0 : 1), nullptr, 1024, 1024, wo, 1024, 144, 8, 1024}, EpiAcc{POUT}, tb, smem);
    GSYNC();
    phase_rms(POUT, PIN(8) + layer * 1024, slot(p, 0), nullptr);
    GSYNC();
    tb = 0;
    gemm_job(GemmDesc{slot(p, 0), nullptr, 1024, 1024, wfin, 1024, 144, 44, 1024}, EpiSwiglu{slot(p, 1)}, tb, smem);
    GSYNC();
    tb = 0;
    gemm_job(GemmDesc{slot(p, 1), nullptr, FF, FF, wfout, FF, 144, 8, FF}, EpiAcc{POUT}, tb, smem);
    if (layer == 3) GSYNC_CG(); else GSYNC();
  }
  phase_rms(POUT, PIN(9), nullptr, POUT);
}

extern "C" void kernel_launch(void* const* d_in, const int* in_sizes, int n_in, void* d_out, int out_size,
                              void* d_ws, size_t ws_size, hipStream_t stream) {
  if (n_in < 40 || ws_size < WS_TOTAL) { fprintf(stderr, "bad args: n_in %d ws %zu need %zu\n", n_in, ws_size, (size_t)WS_TOTAL); return; }
  static int grid_blocks = 0;
  if (!grid_blocks) {
    int dev = 0, cus = 0, per_cu = 0;
    hipGetDevice(&dev);
    hipDeviceGetAttribute(&cus, hipDeviceAttributeMultiprocessorCount, dev);
    hipFuncSetAttribute((const void*)fwd_megakernel, hipFuncAttributeMaxDynamicSharedMemorySize, LDS_BYTES);
    hipOccupancyMaxActiveBlocksPerMultiprocessor(&per_cu, (const void*)fwd_megakernel, 256, LDS_BYTES);
    if (per_cu > 1) per_cu = 1;
    if (per_cu < 1) per_cu = 1;
    grid_blocks = cus * per_cu;
  }
  hipMemsetAsync((char*)d_ws + WS_BAR, 0, 16384, stream);
  P p{};
  for (int i = 0; i < 40; ++i) p.in[i] = (const float*)d_in[i];
  p.out = (float*)d_out; p.ws = (char*)d_ws;
  void* args[] = {&p};
  hipError_t e = hipLaunchCooperativeKernel((const void*)fwd_megakernel, dim3(grid_blocks), dim3(256), args, LDS_BYTES, stream);
  if (e != hipSuccess) fprintf(stderr, "cooperative launch failed: %s (grid %d)\n", hipGetErrorString(e), grid_blocks);
}
```
